# Optimizing an MI355X kernel written in HIP

```python
import math
import jax
import jax.numpy as jnp
from jax import lax
import numpy as np

D_MODEL = 1024
BATCH = 8
SEQ = 2048
DEPTH = 1

CHUNK = 64
RMS_EPS = 1e-6
N_MOD = 6

FOX_HEADS = 8
FOX_HEAD_DIM = 64
FOX_WIDTH = FOX_HEADS * FOX_HEAD_DIM
Q_BLOCK = 128

SSM_WIDTH = 512
SSM_GROUP = 16
SSM_GROUPS = SSM_WIDTH // SSM_GROUP
SSM_STATE = 64
DT_MIN = 1e-3
DT_MAX = 1e-1
LAMBDA_RE_MAX = -1e-4

IN_SIZES = (FOX_WIDTH, FOX_WIDTH, FOX_WIDTH, FOX_HEADS, SSM_WIDTH, D_MODEL, D_MODEL)
IN_COLS = sum(IN_SIZES)

N_GROUPS = 4
EXPERTS_PER_GROUP = 8
N_EXPERTS = N_GROUPS * EXPERTS_PER_GROUP
TOP_K = 2
D_EXPERT = 512
MOE_BLOCK = 128

kernel_name = 'hybrid_fox_s5_hmoe_block'


def _in_splits():
    idx, acc = [], 0
    for s in IN_SIZES[:-1]:
        acc += s
        idx.append(acc)
    return idx


def _rmsnorm(x, g):
    xf = x.astype(jnp.float32)
    xf = xf * lax.rsqrt(jnp.mean(xf * xf, axis=-1, keepdims=True) + RMS_EPS)
    return xf.astype(x.dtype) * g


def _modulate(h, shift, scale):
    return h * (1.0 + scale[:, None, :]) + shift[:, None, :]


def _forgetting_attention(q, k, v, log_f):
    bsz, seq, nh, hd = q.shape
    nqb = seq // Q_BLOCK
    q = q.transpose(0, 2, 1, 3)
    k = k.transpose(0, 2, 1, 3)
    v = v.transpose(0, 2, 1, 3)
    cum = jnp.cumsum(log_f, axis=1).transpose(0, 2, 1)
    q_blocks = q.reshape(bsz, nh, nqb, Q_BLOCK, hd).transpose(2, 0, 1, 3, 4)
    cum_blocks = cum.reshape(bsz, nh, nqb, Q_BLOCK).transpose(2, 0, 1, 3)
    k_pos = jnp.arange(seq)
    scale = hd ** -0.5

    def one_block(args):
        qb, cb, i = args
        s = jnp.einsum('bhqd,bhkd->bhqk', qb, k).astype(jnp.float32) * scale
        s = s + cb[..., :, None] - cum[..., None, :]
        q_pos = i * Q_BLOCK + jnp.arange(Q_BLOCK)
        s = jnp.where(k_pos[None, :] <= q_pos[:, None], s, -jnp.inf)
        p = jax.nn.softmax(s, axis=-1).astype(v.dtype)
        return jnp.einsum('bhqk,bhkd->bhqd', p, v)

    out = lax.map(one_block, (q_blocks, cum_blocks, jnp.arange(nqb)))
    return out.transpose(1, 0, 3, 2, 4).reshape(bsz, seq, nh * hd)


def _complex_affine_combine(e1, e2):
    a1r, a1i, b1r, b1i = e1
    a2r, a2i, b2r, b2i = e2
    ar = a2r * a1r - a2i * a1i
    ai = a2r * a1i + a2i * a1r
    br = a2r * b1r - a2i * b1i + b2r
    bi = a2r * b1i + a2i * b1r + b2i
    return ar, ai, br, bi


def _s5_glu(u, lam_re, lam_im, log_dt, b_re, b_im, c_re, c_im, d_skip, w_glu):
    f32 = jnp.float32
    bsz, seq, _ = u.shape
    uf = u.astype(f32)
    ug = uf.reshape(bsz, seq, SSM_GROUPS, SSM_GROUP)
    lam_re = jnp.minimum(lam_re.astype(f32), LAMBDA_RE_MAX)
    lam_im = lam_im.astype(f32)
    dt = jnp.exp(log_dt.astype(f32))[:, None]
    mag = jnp.exp(lam_re * dt)
    a_re = mag * jnp.cos(lam_im * dt)
    a_im = mag * jnp.sin(lam_im * dt)
    den = lam_re * lam_re + lam_im * lam_im
    nr = a_re - 1.0
    co_re = (nr * lam_re + a_im * lam_im) / den
    co_im = (a_im * lam_re - nr * lam_im) / den
    b_re = b_re.astype(f32)
    b_im = b_im.astype(f32)
    bb_re = co_re[..., None] * b_re - co_im[..., None] * b_im
    bb_im = co_re[..., None] * b_im + co_im[..., None] * b_re
    bu_re = jnp.einsum('bsgc,gpc->bsgp', ug, bb_re)
    bu_im = jnp.einsum('bsgc,gpc->bsgp', ug, bb_im)
    a_re_t = jnp.broadcast_to(a_re, bu_re.shape)
    a_im_t = jnp.broadcast_to(a_im, bu_re.shape)
    _, _, x_re, x_im = lax.associative_scan(
        _complex_affine_combine, (a_re_t, a_im_t, bu_re, bu_im), axis=1)
    y = (jnp.einsum('gcp,bsgp->bsgc', c_re.astype(f32), x_re)
         - jnp.einsum('gcp,bsgp->bsgc', c_im.astype(f32), x_im))
    y = y.reshape(bsz, seq, SSM_WIDTH) + d_skip.astype(f32) * uf
    y = jax.nn.gelu(y).astype(u.dtype)
    lin, gate = jnp.split(y @ w_glu, 2, axis=-1)
    return lin * jax.nn.sigmoid(gate)


def _hier_moe(h, w_rg, b_rg, w_rexp, b_rexp, w_gate, w_up, w_down):
    bsz, seq, d = h.shape
    n_tok = bsz * seq
    hf = h.reshape(n_tok, d)
    lg = (hf @ w_rg).astype(jnp.float32) + b_rg.astype(jnp.float32)
    pg = jax.nn.softmax(lg, axis=-1)
    gi = jnp.argmax(lg, axis=-1).astype(jnp.int32)
    pg_sel = jnp.take_along_axis(pg, gi[:, None], axis=-1)[:, 0]
    le = (hf @ w_rexp).astype(jnp.float32) + b_rexp.astype(jnp.float32)
    le = le.reshape(n_tok, N_GROUPS, EXPERTS_PER_GROUP)
    le_sel = jnp.take_along_axis(le, gi[:, None, None], axis=1)[:, 0]
    top_v, top_i = lax.top_k(le_sel, TOP_K)
    weights = pg_sel[:, None] * jax.nn.softmax(top_v, axis=-1)
    eid = gi[:, None] * EXPERTS_PER_GROUP + top_i.astype(jnp.int32)
    n_assign = n_tok * TOP_K
    flat_e = eid.reshape(-1)
    flat_t = jnp.repeat(jnp.arange(n_tok, dtype=jnp.int32), TOP_K)
    flat_w = weights.reshape(-1)
    order = jnp.argsort(flat_e)
    se = flat_e[order]
    counts = jnp.bincount(flat_e, length=N_EXPERTS)
    starts = jnp.cumsum(counts) - counts
    pcounts = ((counts + MOE_BLOCK - 1) // MOE_BLOCK) * MOE_BLOCK
    pends = jnp.cumsum(pcounts)
    pstarts = pends - pcounts
    dest = pstarts[se] + (jnp.arange(n_assign) - starts[se])
    rows = n_assign + N_EXPERTS * MOE_BLOCK
    n_blocks = rows // MOE_BLOCK
    row_tok = jnp.full((rows,), n_tok, jnp.int32).at[dest].set(flat_t[order])
    row_w = jnp.zeros((rows,), jnp.float32).at[dest].set(flat_w[order])
    blk_e = jnp.minimum(jnp.searchsorted(pends, jnp.arange(n_blocks) * MOE_BLOCK, side='right'),
                        N_EXPERTS - 1)
    x_pad = jnp.concatenate([hf, jnp.zeros((1, d), hf.dtype)], axis=0)
    x_rows = x_pad[row_tok].reshape(n_blocks, MOE_BLOCK, d)

    def run_block(args):
        xb, e = args
        hid = jax.nn.silu(xb @ w_gate[e]) * (xb @ w_up[e])
        return hid @ w_down[e]

    y_rows = lax.map(run_block, (x_rows, blk_e)).reshape(rows, d)
    y = jnp.zeros((n_tok + 1, d), h.dtype).at[row_tok].add(y_rows * row_w[:, None].astype(h.dtype))
    return y[:n_tok].reshape(bsz, seq, d)


def setup_inputs(seed: int = 0) -> dict:
    key = jax.random.key(seed)
    ks = jax.random.split(key, 32)
    L, D, f32 = DEPTH, D_MODEL, jnp.float32

    def nrm(k, shape, scale):
        return jax.random.normal(k, shape, f32) * scale

    x = nrm(ks[0], (BATCH, SEQ, D), 1.0)
    c = nrm(ks[1], (BATCH, D), 1.0)
    w_ada = nrm(ks[2], (L, D, N_MOD * D), 0.02)
    b_ada = (jnp.repeat(jnp.array([0.0, 0.0, 1.0, 0.0, 0.0, 1.0], f32), D)[None]
             + nrm(ks[3], (L, N_MOD * D), 0.02))
    norm_mix_g = 1.0 + nrm(ks[4], (L, D), 0.02)
    w_in = nrm(ks[5], (L, D, IN_COLS), D ** -0.5)
    b_forget = 3.0 + nrm(ks[6], (L, FOX_HEADS), 0.5)
    w_out_fox = nrm(ks[7], (L, FOX_WIDTH, D), FOX_WIDTH ** -0.5)
    n_idx = jnp.arange(SSM_STATE, dtype=f32)
    lambda_re = -0.5 + nrm(ks[8], (L, SSM_GROUPS, SSM_STATE), 0.01)
    lambda_im = math.pi * n_idx + nrm(ks[9], (L, SSM_GROUPS, SSM_STATE), 0.01)
    log_dt = jax.random.uniform(ks[10], (L, SSM_GROUPS), f32, math.log(DT_MIN), math.log(DT_MAX))
    ssm_b_re = nrm(ks[11], (L, SSM_GROUPS, SSM_STATE, SSM_GROUP), (2 * SSM_GROUP) ** -0.5)
    ssm_b_im = nrm(ks[12], (L, SSM_GROUPS, SSM_STATE, SSM_GROUP), (2 * SSM_GROUP) ** -0.5)
    ssm_c_re = nrm(ks[13], (L, SSM_GROUPS, SSM_GROUP, SSM_STATE), SSM_STATE ** -0.5)
    ssm_c_im = nrm(ks[14], (L, SSM_GROUPS, SSM_GROUP, SSM_STATE), SSM_STATE ** -0.5)
    d_skip = nrm(ks[15], (L, SSM_WIDTH), 1.0)
    w_glu = nrm(ks[16], (L, SSM_WIDTH, 2 * SSM_WIDTH), SSM_WIDTH ** -0.5)
    w_out_ssm = nrm(ks[17], (L, SSM_WIDTH, D), SSM_WIDTH ** -0.5)
    w_o = nrm(ks[18], (L, D, D), D ** -0.5)
    norm_ffn_g = 1.0 + nrm(ks[19], (L, D), 0.02)
    w_router_group = nrm(ks[20], (L, D, N_GROUPS), D ** -0.5)
    b_router_group = nrm(ks[21], (L, N_GROUPS), 0.01)
    w_router_expert = nrm(ks[22], (L, D, N_EXPERTS), D ** -0.5)
    b_router_expert = nrm(ks[23], (L, N_EXPERTS), 0.01)
    w_gate_e = nrm(ks[24], (L, N_EXPERTS, D, D_EXPERT), D ** -0.5)
    w_up_e = nrm(ks[25], (L, N_EXPERTS, D, D_EXPERT), D ** -0.5)
    w_down_e = nrm(ks[26], (L, N_EXPERTS, D_EXPERT, D), D_EXPERT ** -0.5)
    final_g = 1.0 + nrm(ks[27], (D,), 0.02)
    return {'x': x, 'c': c, 'w_ada': w_ada, 'b_ada': b_ada, 'norm_mix_g': norm_mix_g,
            'w_in': w_in, 'b_forget': b_forget, 'w_out_fox': w_out_fox,
            'lambda_re': lambda_re, 'lambda_im': lambda_im, 'log_dt': log_dt,
            'ssm_b_re': ssm_b_re, 'ssm_b_im': ssm_b_im, 'ssm_c_re': ssm_c_re, 'ssm_c_im': ssm_c_im,
            'd_skip': d_skip, 'w_glu': w_glu, 'w_out_ssm': w_out_ssm, 'w_o': w_o,
            'norm_ffn_g': norm_ffn_g, 'w_router_group': w_router_group,
            'b_router_group': b_router_group, 'w_router_expert': w_router_expert,
            'b_router_expert': b_router_expert, 'w_gate_e': w_gate_e, 'w_up_e': w_up_e,
            'w_down_e': w_down_e, 'final_g': final_g}


def reference(x, c, w_ada, b_ada, norm_mix_g, w_in, b_forget, w_out_fox,
              lambda_re, lambda_im, log_dt, ssm_b_re, ssm_b_im, ssm_c_re, ssm_c_im,
              d_skip, w_glu, w_out_ssm, w_o, norm_ffn_g, w_router_group,
              b_router_group, w_router_expert, b_router_expert, w_gate_e, w_up_e,
              w_down_e, final_g):
    bsz, seq = x.shape[0], x.shape[1]
    c_act = jax.nn.silu(c)
    for l in range(DEPTH):
        mod = c_act @ w_ada[l] + b_ada[l]
        sh1, sc1, g1, sh2, sc2, g2 = jnp.split(mod, N_MOD, axis=-1)
        h = _modulate(_rmsnorm(x, norm_mix_g[l]), sh1, sc1)
        q, k, v, f_logit, u, ga, gb = jnp.split(h @ w_in[l], _in_splits(), axis=-1)
        log_f = jax.nn.log_sigmoid((f_logit + b_forget[l]).astype(jnp.float32))
        hs = (bsz, seq, FOX_HEADS, FOX_HEAD_DIM)
        o_fox = _forgetting_attention(q.reshape(hs), k.reshape(hs), v.reshape(hs), log_f)
        o_ssm = _s5_glu(u, lambda_re[l], lambda_im[l], log_dt[l], ssm_b_re[l], ssm_b_im[l],
                        ssm_c_re[l], ssm_c_im[l], d_skip[l], w_glu[l])
        merged = (jax.nn.sigmoid(ga) * (o_fox @ w_out_fox[l])
                  + jax.nn.sigmoid(gb) * (o_ssm @ w_out_ssm[l]))
        x = x + g1[:, None, :] * (merged @ w_o[l])
        h2 = _modulate(_rmsnorm(x, norm_ffn_g[l]), sh2, sc2)
        x = x + g2[:, None, :] * _hier_moe(h2, w_router_group[l], b_router_group[l],
                                            w_router_expert[l], b_router_expert[l],
                                            w_gate_e[l], w_up_e[l], w_down_e[l])
    return _rmsnorm(x, final_g)
```

```cpp
#include <hip/hip_runtime.h>
#include <cstdio>
#include <cstdint>

#ifndef MK_N_LAUNCHES
#define MK_N_LAUNCHES 11
#endif

constexpr int NB = 8, SEQ = 2048, D = 1024, M = NB * SEQ;
constexpr int NH = 8, HD = 64, FW = 512;
constexpr int SW = 512, NG = 32, NS = 64;
constexpr int INC = 4104;
constexpr int NE = 32, DE = 512;
constexpr int CAP = 16384;
constexpr float RMS_EPS = 1e-6f;
constexpr float LOG2E = 1.4426950408889634f;
constexpr float QSCALE = 0.125f * 1.4426950408889634f;

namespace pg8 {
#define PG8_LAS __attribute__((address_space(3)))
typedef unsigned short bf16_t;
typedef short bf16x8 __attribute__((ext_vector_type(8)));
typedef float f32x4 __attribute__((ext_vector_type(4)));
typedef unsigned u32x4 __attribute__((ext_vector_type(4)));
constexpr int BM = 256, BK = 64, HALF = 128, HTB = HALF * BK * 2, STAGE_BYTES = 8 * HTB, NXCD = 8, WGM = 8;

__host__ __device__ __forceinline__ int lds_byte(int r, int c) { const int st = (r >> 4) * 2 + (c >> 5), rr = r & 15, cc = c & 31, ob = rr * 64 + cc * 2; return st * 1024 + (ob ^ (((ob >> 9) & 1) << 5)); }
__host__ __device__ __forceinline__ void stage_rc(int b, int& R, int& C) { const int st = b / 1024, sb = b % 1024, swz = sb ^ (((sb >> 9) & 1) << 5); R = (st >> 1) * 16 + swz / 64; C = (st & 1) * 32 + (swz % 64) / 2; }
__host__ __device__ __forceinline__ int perm32(int rho) { const int n = rho >> 4, i = rho & 15; return 8 * (i >> 2) + 4 * n + (i & 3); }

struct Unit { int pm, pn, e, rows, lbase; };
struct Gemm { const bf16_t* A; const bf16_t* Bt; int K; };

struct StaticOrder {
    static constexpr bool GATHER = false;
    int nM, nN, nwg, G, c;
    __host__ __device__ void init(int M_, int N_, int G_, int c_) { nM = M_ / BM; nN = N_ / BM; nwg = nM * nN; G = G_; c = c_; }
    __host__ __device__ bool next(int i, Unit& u) const {
        const long L = (long)i * G + c; if (L >= nwg) return false;
        int wgid = (int)L; { const int q = nwg / NXCD, r = nwg % NXCD, xcd = wgid % NXCD, off = wgid / NXCD; wgid = (xcd < r ? xcd * (q + 1) : r * (q + 1) + (xcd - r) * q) + off; }
        const int nig = WGM * nN, gid = wgid / nig, fm = gid * WGM, gsz = (nM - fm) < WGM ? (nM - fm) : WGM;
        u.pm = fm + ((wgid % nig) % gsz); u.pn = (wgid % nig) / gsz; u.e = 0; u.rows = 256; u.lbase = 0; return true;
    }
    __device__ __forceinline__ size_t a_base(const Unit& u, int K) const { return (size_t)u.pm * BM * K * 2; }
    __device__ __forceinline__ size_t b_base(const Unit& u, int K) const { return (size_t)u.pn * BM * K * 2; }
    __device__ __forceinline__ void a_offsets(const Unit&, const int*, const int*, int, unsigned (&)[2][2]) const {}
};

__device__ __forceinline__ unsigned cvt_pk_bf16(float lo, float hi) { unsigned r; asm volatile("v_cvt_pk_bf16_f32 %0, %1, %2" : "=v"(r) : "v"(lo), "v"(hi)); return r; }

template <class Epi, class Sched, bool ALIGN_EPI>
__device__ __forceinline__ void gemm_phase(PG8_LAS unsigned char* lds, const Gemm g, const Sched& S, const Epi& E) {
    constexpr bool GATHER = Sched::GATHER;
    const int tid = threadIdx.x, wid = __builtin_amdgcn_readfirstlane(tid >> 6), lane = tid & 63, wr = wid >> 2, wc = wid & 3, fr = lane & 15, fq = lane >> 4;
    const int K = g.K, nt = K / BK;
    unsigned voffB[2], voC[2][2], voN[2][2]; int Rr[2], Cc[2];
#pragma unroll
    for (int i = 0; i < 2; ++i) { int R, C; stage_rc(tid * 16 + i * 8192, R, C); Rr[i] = R; Cc[i] = C; const int Rb = Epi::PERM ? ((R & ~31) + perm32(R & 31)) : R;
        voffB[i] = (unsigned)(Rb * K + C) * 2u; }
    const size_t kstep = (size_t)(BK * 2);
    const size_t hstep = (size_t)HALF * K * 2;
    const unsigned ldsw = (unsigned)wid * 1024u;
    const int aoff = lds_byte(wr * 64 + fr, fq * 8), boff = lds_byte(wc * 32 + fr, fq * 8);
#define PG8_SA(b, h) (((b) * 2 + (h)) * HTB)
#define PG8_SB(b, h) ((4 + (b) * 2 + (h)) * HTB)
#define PG8_STAGE(bufoff, gbase, voff) do { _Pragma("unroll") for (int _i = 0; _i < 2; ++_i) \
        __builtin_amdgcn_global_load_lds((const unsigned*)((const char*)(gbase) + (voff)[_i]), (PG8_LAS unsigned*)(lds + (bufoff) + ldsw + _i * 8192), 16, 0, 0); } while (0)
#define PG8_LDA(dst, b, h) do { _Pragma("unroll") for (int m = 0; m < 4; ++m) _Pragma("unroll") for (int k = 0; k < 2; ++k) dst[m][k] = *(const PG8_LAS bf16x8*)(lds + PG8_SA(b, h) + aoff + m * 2048 + k * 1024); } while (0)
#define PG8_LDB(dst, b, h) do { _Pragma("unroll") for (int n = 0; n < 2; ++n) _Pragma("unroll") for (int k = 0; k < 2; ++k) dst[n][k] = *(const PG8_LAS bf16x8*)(lds + PG8_SB(b, h) + boff + n * 2048 + k * 1024); } while (0)
#define PG8_MMA(ai, bj, At, Bt) do { __builtin_amdgcn_s_setprio(1); _Pragma("unroll") for (int m = 0; m < 4; ++m) _Pragma("unroll") for (int n = 0; n < 2; ++n) _Pragma("unroll") for (int k = 0; k < 2; ++k) \
        acc[ai][bj][m][n] = __builtin_amdgcn_mfma_f32_16x16x32_bf16(Bt[n][k], At[m][k], acc[ai][bj][m][n], 0, 0, 0); __builtin_amdgcn_s_setprio(0); } while (0)
#define PG8_WAIT_V(n) asm volatile("s_waitcnt vmcnt(" #n ")" ::: "memory")
#define PG8_WAIT_L(n) asm volatile("s_waitcnt lgkmcnt(" #n ")" ::: "memory")
#define PG8_BAR __builtin_amdgcn_s_barrier()
#define PG8_SCHED __builtin_amdgcn_sched_barrier(0)
    Unit cur, nxt; int ui = 0;
    if (!S.next(0, cur)) return;
    f32x4 acc[2][2][4][2];
#pragma unroll
    for (int a = 0; a < 2; ++a)
#pragma unroll
        for (int b = 0; b < 2; ++b)
#pragma unroll
            for (int m = 0; m < 4; ++m)
#pragma unroll
                for (int n = 0; n < 2; ++n) acc[a][b][m][n] = (f32x4){0.f, 0.f, 0.f, 0.f};
    bf16x8 At[4][2], B0[2][2], B1[2][2];
    if constexpr (GATHER) S.a_offsets(cur, Rr, Cc, K, voC);
    else {
#pragma unroll
        for (int h = 0; h < 2; ++h)
#pragma unroll
            for (int i = 0; i < 2; ++i) voC[h][i] = (unsigned)((Rr[i] + h * HALF) * K + Cc[i]) * 2u;
    }
    const char* cA = (const char*)g.A + S.a_base(cur, K); const char* cB = (const char*)g.Bt + S.b_base(cur, K);
    PG8_STAGE(PG8_SB(0, 0), cB, voffB); PG8_STAGE(PG8_SB(0, 1), cB + hstep, voffB); PG8_STAGE(PG8_SA(0, 0), cA, voC[0]); PG8_STAGE(PG8_SA(0, 1), cA, voC[1]);
    if (wr == 1) PG8_BAR;
    PG8_WAIT_V(2); PG8_BAR;
    PG8_STAGE(PG8_SB(1, 0), cB + kstep, voffB); PG8_STAGE(PG8_SA(1, 0), cA + kstep, voC[0]); PG8_STAGE(PG8_SB(1, 1), cB + hstep + kstep, voffB);
    PG8_WAIT_V(6); PG8_BAR;
    for (;;) {
        const bool has_next = S.next(ui + 1, nxt);
        const char* nA = has_next ? (const char*)g.A + S.a_base(nxt, K) : cA; const char* nB = has_next ? (const char*)g.Bt + S.b_base(nxt, K) : cB;
        if constexpr (GATHER) {
            if (has_next) S.a_offsets(nxt, Rr, Cc, K, voN);
            else {
#pragma unroll
                for (int h = 0; h < 2; ++h)
#pragma unroll
                    for (int i = 0; i < 2; ++i) voN[h][i] = voC[h][i];
            }
        }
        for (int t = 0; t < nt; t += 2) {
            const bool last = (t == nt - 2);
            const char* a1 = cA + (size_t)(t + 1) * kstep;
            const char* a2 = last ? nA : cA + (size_t)(t + 2) * kstep; const char* b2 = last ? nB : cB + (size_t)(t + 2) * kstep;
            const char* a3 = a2 + kstep; const char* b3 = b2 + kstep;
            unsigned vo2[2][2];
#pragma unroll
            for (int h = 0; h < 2; ++h)
#pragma unroll
                for (int i = 0; i < 2; ++i) vo2[h][i] = GATHER ? (last ? voN[h][i] : voC[h][i]) : voC[h][i];
            PG8_LDB(B0, 0, 0); PG8_LDB(B1, 0, 1); PG8_SCHED; PG8_LDA(At, 0, 0); PG8_STAGE(PG8_SA(1, 1), a1, voC[1]);
            PG8_WAIT_V(8); PG8_WAIT_L(0); PG8_BAR; PG8_MMA(0, 0, At, B0); PG8_MMA(0, 1, At, B1); PG8_BAR; PG8_SCHED;
            PG8_LDA(At, 0, 1); PG8_STAGE(PG8_SB(0, 0), b2, voffB); PG8_STAGE(PG8_SB(0, 1), b2 + hstep, voffB); PG8_STAGE(PG8_SA(0, 0), a2, vo2[0]);
            PG8_WAIT_V(8); PG8_WAIT_L(0); PG8_BAR; PG8_MMA(1, 0, At, B0); PG8_MMA(1, 1, At, B1); PG8_BAR; PG8_SCHED;
            PG8_LDB(B0, 1, 0); PG8_LDB(B1, 1, 1); PG8_SCHED; PG8_LDA(At, 1, 0); PG8_STAGE(PG8_SA(0, 1), a2, vo2[1]);
            PG8_WAIT_V(8); PG8_WAIT_L(0); PG8_BAR; PG8_MMA(0, 0, At, B0); PG8_MMA(0, 1, At, B1); PG8_BAR; PG8_SCHED;
            PG8_LDA(At, 1, 1); PG8_STAGE(PG8_SB(1, 0), b3, voffB); PG8_STAGE(PG8_SB(1, 1), b3 + hstep, voffB); PG8_STAGE(PG8_SA(1, 0), a3, vo2[0]);
            PG8_WAIT_V(8); PG8_WAIT_L(0); PG8_BAR; PG8_MMA(1, 0, At, B0); PG8_MMA(1, 1, At, B1); PG8_BAR; PG8_SCHED;
        }
        if constexpr (ALIGN_EPI) { if (wr == 0) PG8_BAR; }
        E(acc, cur, wr, wc, fr, fq);
        if (!has_next) break;
#pragma unroll
        for (int a = 0; a < 2; ++a)
#pragma unroll
            for (int b = 0; b < 2; ++b)
#pragma unroll
                for (int m = 0; m < 4; ++m)
#pragma unroll
                    for (int n = 0; n < 2; ++n) acc[a][b][m][n] = (f32x4){0.f, 0.f, 0.f, 0.f};
        cur = nxt; cA = nA; cB = nB; ++ui;
        if constexpr (GATHER) {
#pragma unroll
            for (int h = 0; h < 2; ++h)
#pragma unroll
                for (int i = 0; i < 2; ++i) voC[h][i] = voN[h][i];
        }
        if constexpr (ALIGN_EPI) { if (wr == 1) PG8_BAR; }
    }
    PG8_WAIT_V(0);
    if constexpr (!ALIGN_EPI) { if (wr == 0) PG8_BAR; }
    PG8_BAR;
#undef PG8_SA
#undef PG8_SB
#undef PG8_STAGE
#undef PG8_LDA
#undef PG8_LDB
#undef PG8_MMA
#undef PG8_WAIT_V
#undef PG8_WAIT_L
#undef PG8_BAR
#undef PG8_SCHED
}
}

constexpr int NWAVES = 8;
constexpr int NPH = 11;
constexpr int N_LAUNCHES = MK_N_LAUNCHES;
static_assert(N_LAUNCHES == 1 || N_LAUNCHES == NPH, "MK_N_LAUNCHES is 1 (one launch) or NPH (one launch per phase)");

constexpr size_t MiB = 1u << 20;
constexpr size_t WS_CTL = 0, CTL_ZERO_BYTES = 1 * MiB;
constexpr size_t WS_MOD = 1 * MiB;
constexpr size_t WS_LOGF = 1 * MiB + 256 * 1024;
constexpr size_t WS_ROUTE = 2 * MiB;
constexpr size_t WS_RW = 2 * MiB + 256 * 1024;
constexpr size_t WS_CUM = 2 * MiB + 512 * 1024;
constexpr size_t WS_LIST = 3 * MiB;
constexpr size_t WS_WIN = 6 * MiB;
constexpr size_t WS_WGLU = 14 * MiB, WS_WOF = 15 * MiB, WS_WOS = 16 * MiB, WS_WO = 17 * MiB;
constexpr size_t WS_WGU = 20 * MiB;
constexpr size_t WS_WD = 84 * MiB;
constexpr size_t WS_H = 116 * MiB;
constexpr size_t WS_Y = 148 * MiB;
constexpr size_t WS_MIX = 164 * MiB;
constexpr size_t WS_Q = WS_MIX, WS_K = WS_MIX + 16 * MiB, WS_V = WS_MIX + 32 * MiB, WS_U = WS_MIX + 48 * MiB, WS_SGA = WS_MIX + 64 * MiB, WS_SGB = WS_MIX + 96 * MiB;
constexpr size_t WS_HID = WS_MIX;
constexpr size_t WS_YROWS = WS_MIX + 40 * MiB;
constexpr size_t WS_END = 292 * MiB;
static_assert(WS_YROWS + (size_t)M * 2 * 1024 * 2 <= WS_END && WS_SGB + (size_t)M * 1024 * 2 <= WS_END, "d_ws map");

constexpr int CW_TMO = 0;
constexpr int CW_CNT = 2048;
constexpr int CW_BAR = 8192;

constexpr int RING_OFF = 0, RING_BYTES = 131072;
constexpr int LDSCTL_OFF = RING_BYTES, MISC_OFF = LDSCTL_OFF + 320, MOE_OFF = LDSCTL_OFF + 1024;
constexpr int LDS_BYTES = 147456;

#define GAS __attribute__((address_space(1)))
#define LAS __attribute__((address_space(3)))
typedef unsigned short bf16;
typedef unsigned v4u __attribute__((ext_vector_type(4)));
typedef unsigned v2u __attribute__((ext_vector_type(2)));
typedef float f32x4 __attribute__((ext_vector_type(4)));
typedef float f32x2 __attribute__((ext_vector_type(2)));
typedef GAS unsigned gu32;
#define RLX_AGENT __ATOMIC_RELAXED, __HIP_MEMORY_SCOPE_AGENT
#define LDS_WAIT() asm volatile("s_waitcnt lgkmcnt(0)" ::: "memory")
#define VM_WAIT() asm volatile("s_waitcnt vmcnt(0)" ::: "memory")
__device__ __forceinline__ unsigned f2bf(float f) { unsigned u = __builtin_bit_cast(unsigned, f); return (u + 0x7fffu + ((u >> 16) & 1u)) >> 16; }
__device__ __forceinline__ unsigned pk2(float lo, float hi) { return f2bf(lo) | (f2bf(hi) << 16); }
__device__ __forceinline__ float bflo(unsigned w) { return __uint_as_float(w << 16); }
__device__ __forceinline__ float bfhi(unsigned w) { return __uint_as_float(w & 0xffff0000u); }
__device__ __forceinline__ float fast_sigmoid(float v) { return __builtin_amdgcn_rcpf(1.f + __builtin_amdgcn_exp2f(-LOG2E * v)); }

#define XB_TMO      128
#define XB_XCNT(j)  (256  + 64 * (j))
#define XB_XSUB(j)  (1280 + 64 * (j))
#define XB_XGEN(j)  (2304 + 64 * (j))
#define XB_TOP      3328
#define XB_TOPGEN   3392
#define XCD_BAR_WORDS 3456
#define XB_SPIN_CAP (1u << 18)
__device__ __forceinline__ unsigned xb_ld(unsigned* p)              { return __hip_atomic_load(p, __ATOMIC_RELAXED, __HIP_MEMORY_SCOPE_AGENT); }
__device__ __forceinline__ unsigned xb_add(unsigned* p, unsigned v) { return __hip_atomic_fetch_add(p, v, __ATOMIC_RELAXED, __HIP_MEMORY_SCOPE_AGENT); }
__device__ __forceinline__ unsigned xb_xcc_id() { return (unsigned)__builtin_amdgcn_s_getreg((3 << 11) | 20) & 0xFu; }
#define XB_SPIN(cond, bar) do { unsigned _sp = 0; while (cond) { __builtin_amdgcn_s_sleep(1); \
    if ((++_sp & 255u) == 0u) { if (xb_ld(&(bar)[XB_TMO])) break; if (_sp > XB_SPIN_CAP) { atomicAdd(&(bar)[XB_TMO], 1u); break; } } } } while (0)
struct XcdBarrier { unsigned* bar; unsigned x; volatile LAS unsigned* st; };
__device__ __forceinline__ XcdBarrier xcd_barrier_post(unsigned* bar, volatile LAS unsigned* st) {
    XcdBarrier b; b.bar = bar; b.x = xb_xcc_id(); b.st = st;
    if (threadIdx.x == 0) (void)xb_add(&bar[XB_XCNT(b.x)], 1u);
    return b;
}
__device__ __forceinline__ void xcd_barrier_complete(unsigned* bar, unsigned x, unsigned& nloc, unsigned& nx) {
    const unsigned G = gridDim.x * gridDim.y * gridDim.z;
    unsigned sum, cnt, mine, sp = 0u;
    for (;;) {
        sum = 0u; cnt = 0u; mine = 0u;
#pragma unroll
        for (unsigned j = 0; j < 16; ++j) { const unsigned c = xb_ld(&bar[XB_XCNT(j)]); sum += c; cnt += (c > 0u) ? 1u : 0u; mine = (j == x) ? c : mine; }
        if (sum == G) break;
        __builtin_amdgcn_s_sleep(1);
        if ((++sp & 255u) == 0u) { if (xb_ld(&bar[XB_TMO])) break; if (sp > XB_SPIN_CAP) { atomicAdd(&bar[XB_TMO], 1u); break; } }
    }
    nloc = mine > 0u ? mine : 1u; nx = cnt > 0u ? cnt : 1u;
}
__device__ __forceinline__ void xcd_barrier(const XcdBarrier& b) {
    asm volatile("s_waitcnt vmcnt(0)" ::: "memory");
    __syncthreads();
    if (threadIdx.x == 0) {
        unsigned* bar = b.bar;
        __builtin_amdgcn_s_waitcnt(0);
        unsigned nloc = b.st[0], nx = b.st[1];
        if (nloc == 0u) { xcd_barrier_complete(bar, b.x, nloc, nx); b.st[0] = nloc; b.st[1] = nx; }
        const unsigned old = xb_add(&bar[XB_XSUB(b.x)], 1u);
        const unsigned gen = old / nloc;
        if (old + 1u == (gen + 1u) * nloc) {
            __builtin_amdgcn_fence(__ATOMIC_RELEASE, "agent");
            asm volatile("s_waitcnt vmcnt(0)" ::: "memory");
            const unsigned og = xb_add(&bar[XB_TOP], 1u);
            const unsigned tg = og / nx;
            if (og + 1u == (tg + 1u) * nx) xb_add(&bar[XB_TOPGEN], 1u);
            else XB_SPIN(xb_ld(&bar[XB_TOPGEN]) == tg, bar);
            __builtin_amdgcn_fence(__ATOMIC_ACQUIRE, "agent");
            xb_add(&bar[XB_XGEN(b.x)], 1u);
            asm volatile("s_waitcnt vmcnt(0)" ::: "memory");
        } else {
            XB_SPIN(xb_ld(&bar[XB_XGEN(b.x)]) == gen, bar);
            __builtin_amdgcn_fence(__ATOMIC_ACQUIRE, "agent");
            asm volatile("s_waitcnt vmcnt(0)" ::: "memory");
        }
    }
    __syncthreads();
}

struct Frame {
    LAS unsigned char* lds;
    volatile LAS unsigned* MISC;
    gu32* ctl;
    int tid, lane, wave, vcu, G;
    const float *x, *c, *w_ada, *b_ada, *norm_mix_g, *w_in, *b_forget, *w_out_fox, *lambda_re, *lambda_im, *log_dt, *b_re, *b_im, *c_re, *c_im, *d_skip, *w_glu, *w_out_ssm, *w_o,
        *norm_ffn_g, *w_rg, *b_rg, *w_rexp, *b_rexp, *w_gate, *w_up, *w_down, *final_g;
    float* out;
    float *MOD, *LOGF, *CUM, *RW; int* ROUTE; unsigned* LIST;
    bf16 *WIN, *WGLU, *WOF, *WOS, *WO, *WGU, *WD, *H, *Y, *Q, *K, *V, *U, *SGA, *SGB, *HID, *YROWS;
};

__device__ __forceinline__ float wave_sum(float v) {
#pragma unroll
    for (int o = 1; o < 64; o <<= 1) v += __shfl_xor(v, o);
    return v;
}

__device__ __forceinline__ void transpose_item(const float* src, int ld_src, bf16* dst, int ld_dst, LAS float* scr, int lane) {
#pragma unroll 8
    for (int i = 0; i < 32; ++i) { const int kk = 2 * i + (lane >> 5); scr[kk * 33 + (lane & 31)] = src[(size_t)kk * ld_src + (lane & 31)]; }
    LDS_WAIT(); asm volatile("" ::: "memory");
    const int c = lane & 7;
#pragma unroll
    for (int j = 0; j < 4; ++j) { const int n = (lane >> 3) + 8 * j; const LAS float* s = scr + (8 * c) * 33 + n;
        v4u o; o.x = pk2(s[0 * 33], s[1 * 33]); o.y = pk2(s[2 * 33], s[3 * 33]); o.z = pk2(s[4 * 33], s[5 * 33]); o.w = pk2(s[6 * 33], s[7 * 33]);
        *(GAS v4u*)(dst + (size_t)n * ld_dst + 8 * c) = o; }
    LDS_WAIT(); asm volatile("" ::: "memory");
}

__device__ __forceinline__ void p0_prologue(Frame& F) {
    {
        LAS float* cact = (LAS float*)(F.lds);
        LAS float* red = (LAS float*)(F.lds + 32768);
        for (int i = F.tid; i < 8192; i += 512) { const float v = F.c[i]; cact[i] = v / (1.f + __expf(-v)); }
        __syncthreads();
        for (int it = F.vcu; it < 192; it += F.G) {
            const int cl = F.lane & 31, hf = F.lane >> 5, col = it * 32 + cl;
            float a[8];
#pragma unroll
            for (int b = 0; b < 8; ++b) a[b] = 0.f;
            for (int i = 0; i < 64; ++i) {
                const int k = 16 * i + 2 * F.wave + hf;
                const float w = F.w_ada[(size_t)k * 6144 + col];
#pragma unroll
                for (int b = 0; b < 8; ++b) a[b] += cact[b * 1024 + k] * w;
            }
#pragma unroll
            for (int b = 0; b < 8; ++b) { a[b] += __shfl_xor(a[b], 32); if (hf == 0) red[(F.wave * 8 + b) * 32 + cl] = a[b]; }
            __syncthreads();
            if (F.tid < 256) { const int b = F.tid >> 5, c2 = F.tid & 31; float s = 0.f;
#pragma unroll
                for (int w = 0; w < 8; ++w) s += red[(w * 8 + b) * 32 + c2];
                F.MOD[b * 6144 + it * 32 + c2] = s + F.b_ada[it * 32 + c2]; }
            __syncthreads();
        }
        __syncthreads();
    }
    LAS float* scr = (LAS float*)(F.lds + RING_OFF + F.wave * 16384);
    const int gw = F.vcu * NWAVES + F.wave, NGW = F.G * NWAVES;
    constexpr int I_A = 16 * 48, I_B = 16 * 80, I_C = 8 * 32, I_D = 8 * 32, I_E = 8 * 32, I_F = 16 * 32, I_G = 32 * 256, I_H = 32 * 256, I_I = 32 * 256;
    constexpr int NITEMS = I_A + I_B + I_C + I_D + I_E + I_F + I_G + I_H + I_I;
    for (int it = gw; it < NITEMS; it += NGW) {
        int r = it;
        if (r < I_A) { const int kb = r / 48, nb = r % 48; transpose_item(F.w_in + (size_t)(64 * kb) * INC + 32 * nb, INC, F.WIN + (size_t)(32 * nb) * 1024 + 64 * kb, 1024, scr, F.lane); continue; } r -= I_A;
        if (r < I_B) { const int kb = r / 80, nb = r % 80; transpose_item(F.w_in + (size_t)(64 * kb) * INC + 1544 + 32 * nb, INC, F.WIN + (size_t)(1536 + 32 * nb) * 1024 + 64 * kb, 1024, scr, F.lane); continue; } r -= I_B;
        if (r < I_C) { const int kb = r / 32, nb = r % 32, n0 = 32 * nb, half = n0 >> 9, within = n0 & 511, pn = within >> 7, q = within & 127;
            transpose_item(F.w_glu + (size_t)(64 * kb) * 1024 + n0, 1024, F.WGLU + (size_t)(pn * 256 + half * 128 + q) * 512 + 64 * kb, 512, scr, F.lane); continue; } r -= I_C;
        if (r < I_D) { const int kb = r / 32, nb = r % 32; transpose_item(F.w_out_fox + (size_t)(64 * kb) * 1024 + 32 * nb, 1024, F.WOF + (size_t)(32 * nb) * 512 + 64 * kb, 512, scr, F.lane); continue; } r -= I_D;
        if (r < I_E) { const int kb = r / 32, nb = r % 32; transpose_item(F.w_out_ssm + (size_t)(64 * kb) * 1024 + 32 * nb, 1024, F.WOS + (size_t)(32 * nb) * 512 + 64 * kb, 512, scr, F.lane); continue; } r -= I_E;
        if (r < I_F) { const int kb = r / 32, nb = r % 32; transpose_item(F.w_o + (size_t)(64 * kb) * 1024 + 32 * nb, 1024, F.WO + (size_t)(32 * nb) * 1024 + 64 * kb, 1024, scr, F.lane); continue; } r -= I_F;
        if (r < I_G + I_H) { const int up = r >= I_G; if (up) r -= I_G; const int e = r >> 8, rr = r & 255, kb = rr >> 4, nb = rr & 15, n0 = 32 * nb, pn = n0 >> 7, q = n0 & 127;
            const float* src = (up ? F.w_up : F.w_gate) + (size_t)e * 1024 * 512 + (size_t)(64 * kb) * 512 + n0;
            transpose_item(src, 512, F.WGU + (size_t)e * 1024 * 1024 + (size_t)(pn * 256 + up * 128 + q) * 1024 + 64 * kb, 1024, scr, F.lane); continue; } r -= I_G + I_H;
        { const int e = r >> 8, rr = r & 255, kb = rr >> 5, nb = rr & 31;
            transpose_item(F.w_down + (size_t)e * 512 * 1024 + (size_t)(64 * kb) * 1024 + 32 * nb, 1024, F.WD + (size_t)e * 1024 * 512 + (size_t)(32 * nb) * 512 + 64 * kb, 512, scr, F.lane); }
    }
}

__device__ __forceinline__ void p1_rows(Frame& F) {
    LAS float* wfT = (LAS float*)(F.lds);
    for (int idx = F.tid; idx < 8192; idx += 512) { const int k = idx >> 3, j = idx & 7; wfT[j * 1024 + k] = F.w_in[(size_t)k * INC + 1536 + j]; }
    __syncthreads();
    const int gw = F.vcu * NWAVES + F.wave, NGW = F.G * NWAVES;
    for (int ch = gw; ch < M / 8; ch += NGW) {
        const int b = (ch * 8) / SEQ;
        const float* mod = F.MOD + b * 6144;
        f32x4 es[4], sh[4];
#pragma unroll
        for (int j = 0; j < 4; ++j) { const int c = 4 * F.lane + 256 * j; const f32x4 g4 = *(const f32x4*)(F.norm_mix_g + c), sc = *(const f32x4*)(mod + 1024 + c); es[j] = g4 * (sc + 1.f); sh[j] = *(const f32x4*)(mod + c); }
        for (int r = 0; r < 8; ++r) {
            const int m = ch * 8 + r;
            const GAS f32x4* xr = (const GAS f32x4*)(F.x + (size_t)m * D) + F.lane;
            f32x4 v[4]; float ss = 0.f;
#pragma unroll
            for (int j = 0; j < 4; ++j) { v[j] = xr[64 * j]; ss += (v[j].x * v[j].x + v[j].y * v[j].y) + (v[j].z * v[j].z + v[j].w * v[j].w); }
            const float rstd = 1.f / sqrtf(wave_sum(ss) * (1.f / D) + RMS_EPS);
            GAS v2u* o8 = (GAS v2u*)(F.H + (size_t)m * D) + F.lane;
#pragma unroll
            for (int j = 0; j < 4; ++j) { v[j] = v[j] * rstd * es[j] + sh[j]; v2u w; w.x = pk2(v[j].x, v[j].y); w.y = pk2(v[j].z, v[j].w); o8[64 * j] = w; }
            float f[8];
#pragma unroll
            for (int jj = 0; jj < 8; ++jj) { float a = 0.f;
#pragma unroll
                for (int j = 0; j < 4; ++j) { const f32x4 w4 = *(const LAS f32x4*)(wfT + jj * 1024 + 4 * F.lane + 256 * j); a += (v[j].x * w4.x + v[j].y * w4.y) + (v[j].z * w4.z + v[j].w * w4.w); }
                f[jj] = wave_sum(a); }
            if (F.lane < 8) {
                float z = f[0];
#pragma unroll
                for (int jj = 1; jj < 8; ++jj) z = (F.lane == jj) ? f[jj] : z;
                z += F.b_forget[F.lane];
                F.LOGF[(size_t)m * 8 + F.lane] = fminf(z, 0.f) - log1pf(expf(-fabsf(z)));
            }
        }
    }
}

__device__ __forceinline__ void p2_cumscan(Frame& F) {
    const int gw = F.wave * F.G + F.vcu, NGW = F.G * NWAVES;
    for (int u = gw; u < NB * NH; u += NGW) {
        const int b = u >> 3, h = u & 7;
        float v[32]; float run = 0.f;
#pragma unroll
        for (int i = 0; i < 32; ++i) { run += F.LOGF[((size_t)b * SEQ + 32 * F.lane + i) * 8 + h]; v[i] = run; }
        float incl = run;
#pragma unroll
        for (int o = 1; o < 64; o <<= 1) { const float t = __shfl_up(incl, o); if (F.lane >= o) incl += t; }
        const float excl = incl - run;
#pragma unroll
        for (int i = 0; i < 32; ++i) F.CUM[(size_t)u * SEQ + 32 * F.lane + i] = v[i] + excl;
    }
}

using pg8::Unit;
struct EpiInProj {
    static constexpr bool PERM = true;
    bf16* mix;
    __device__ __forceinline__ void operator()(const f32x4 (&acc)[2][2][4][2], const Unit& u, int wr, int wc, int fr, int fq) const {
        const int pn = u.pn; bf16* base; int ldc, colt, mode;
        if (pn < 8) { base = mix + (size_t)(pn >> 1) * ((size_t)M * 512); ldc = 512; colt = (pn & 1) * 256; mode = pn < 2 ? 1 : 0; }
        else { const int g = (pn - 8) >> 2; base = mix + (size_t)4 * M * 512 + (size_t)g * ((size_t)M * 1024); ldc = 1024; colt = ((pn - 8) & 3) * 256; mode = 2; }
        const int row0 = u.pm * 256 + wr * 64 + fr, col0 = colt + wc * 32 + 8 * fq;
#pragma unroll
        for (int ai = 0; ai < 2; ++ai)
#pragma unroll
            for (int m = 0; m < 4; ++m) { bf16* rowp = base + (size_t)(row0 + ai * 128 + m * 16) * ldc + col0;
#pragma unroll
                for (int bj = 0; bj < 2; ++bj) { f32x4 v0 = acc[ai][bj][m][0], v1 = acc[ai][bj][m][1];
                    if (mode == 1) { v0 = v0 * QSCALE; v1 = v1 * QSCALE; }
                    else if (mode == 2) {
#pragma unroll
                        for (int e = 0; e < 4; ++e) { v0[e] = fast_sigmoid(v0[e]); v1[e] = fast_sigmoid(v1[e]); } }
                    v4u w; w.x = pg8::cvt_pk_bf16(v0[0], v0[1]); w.y = pg8::cvt_pk_bf16(v0[2], v0[3]); w.z = pg8::cvt_pk_bf16(v1[0], v1[1]); w.w = pg8::cvt_pk_bf16(v1[2], v1[3]);
                    *(v4u*)(rowp + bj * 128) = w; } }
    }
};
template <int MODE> struct EpiGate {
    static constexpr bool PERM = true;
    bf16* T; const bf16* Gt;
    __device__ __forceinline__ void operator()(const f32x4 (&acc)[2][2][4][2], const Unit& u, int wr, int wc, int fr, int fq) const {
        const int row0 = u.pm * 256 + wr * 64 + fr, col0 = u.pn * 256 + wc * 32 + 8 * fq;
#pragma unroll
        for (int ai = 0; ai < 2; ++ai)
#pragma unroll
            for (int m = 0; m < 4; ++m) { const size_t off = (size_t)(row0 + ai * 128 + m * 16) * 1024 + col0;
#pragma unroll
                for (int bj = 0; bj < 2; ++bj) { const f32x4 v0 = acc[ai][bj][m][0], v1 = acc[ai][bj][m][1];
                    const v4u t = *(const v4u*)(T + off + bj * 128); v4u w;
                    if (MODE == 0) {
                        w.x = pg8::cvt_pk_bf16(bflo(t.x) * v0[0], bfhi(t.x) * v0[1]); w.y = pg8::cvt_pk_bf16(bflo(t.y) * v0[2], bfhi(t.y) * v0[3]);
                        w.z = pg8::cvt_pk_bf16(bflo(t.z) * v1[0], bfhi(t.z) * v1[1]); w.w = pg8::cvt_pk_bf16(bflo(t.w) * v1[2], bfhi(t.w) * v1[3]);
                    } else {
                        const v4u gg = *(const v4u*)(Gt + off + bj * 128);
                        w.x = pg8::cvt_pk_bf16(bflo(t.x) + bflo(gg.x) * v0[0], bfhi(t.x) + bfhi(gg.x) * v0[1]); w.y = pg8::cvt_pk_bf16(bflo(t.y) + bflo(gg.y) * v0[2], bfhi(t.y) + bfhi(gg.y) * v0[3]);
                        w.z = pg8::cvt_pk_bf16(bflo(t.z) + bflo(gg.z) * v1[0], bfhi(t.z) + bfhi(gg.z) * v1[1]); w.w = pg8::cvt_pk_bf16(bflo(t.w) + bflo(gg.w) * v1[2], bfhi(t.w) + bfhi(gg.w) * v1[3]);
                    }
                    *(v4u*)(T + off + bj * 128) = w; } }
    }
};
template <int MODE> struct EpiPair {
    static constexpr bool PERM = true;
    bf16* O;
    __device__ __forceinline__ void operator()(const f32x4 (&acc)[2][2][4][2], const Unit& u, int wr, int wc, int fr, int fq) const {
        const int row0 = u.pm * 256 + wr * 64 + fr, col0 = u.pn * 128 + wc * 32 + 8 * fq;
#pragma unroll
        for (int ai = 0; ai < 2; ++ai)
#pragma unroll
            for (int m = 0; m < 4; ++m) { f32x4 r0, r1;
#pragma unroll
                for (int e = 0; e < 4; ++e) {
                    if (MODE == 0) { r0[e] = acc[ai][0][m][0][e] * fast_sigmoid(acc[ai][1][m][0][e]); r1[e] = acc[ai][0][m][1][e] * fast_sigmoid(acc[ai][1][m][1][e]); }
                    else { const float g0 = acc[ai][0][m][0][e], g1 = acc[ai][0][m][1][e]; r0[e] = g0 * fast_sigmoid(g0) * acc[ai][1][m][0][e]; r1[e] = g1 * fast_sigmoid(g1) * acc[ai][1][m][1][e]; } }
                v4u w; w.x = pg8::cvt_pk_bf16(r0[0], r0[1]); w.y = pg8::cvt_pk_bf16(r0[2], r0[3]); w.z = pg8::cvt_pk_bf16(r1[0], r1[1]); w.w = pg8::cvt_pk_bf16(r1[2], r1[3]);
                *(v4u*)(O + (size_t)(row0 + ai * 128 + m * 16) * 512 + col0) = w; }
    }
};
struct EpiResid {
    static constexpr bool PERM = false;
    const float* x; float* out; const float* mod;
    __device__ __forceinline__ void operator()(const f32x4 (&acc)[2][2][4][2], const Unit& u, int wr, int wc, int fr, int fq) const {
        const int row0 = u.pm * 256 + wr * 64 + fr, col0 = u.pn * 256 + wc * 32 + 4 * fq;
        const int b = (u.pm * 256) / SEQ;
        f32x4 gv[2][2];
#pragma unroll
        for (int bj = 0; bj < 2; ++bj)
#pragma unroll
            for (int n = 0; n < 2; ++n) gv[bj][n] = *(const f32x4*)(mod + (size_t)b * 6144 + 2048 + col0 + bj * 128 + n * 16);
#pragma unroll
        for (int ai = 0; ai < 2; ++ai)
#pragma unroll
            for (int m = 0; m < 4; ++m) { const size_t off = (size_t)(row0 + ai * 128 + m * 16) * 1024 + col0;
#pragma unroll
                for (int bj = 0; bj < 2; ++bj)
#pragma unroll
                    for (int n = 0; n < 2; ++n) { const f32x4 xv = *(const f32x4*)(x + off + bj * 128 + n * 16); *(f32x4*)(out + off + bj * 128 + n * 16) = xv + gv[bj][n] * acc[ai][bj][m][n]; } }
    }
};
struct EpiDown {
    static constexpr bool PERM = true;
    bf16* Y; const unsigned* list; const float* rw;
    __device__ __forceinline__ void operator()(const f32x4 (&acc)[2][2][4][2], const Unit& u, int wr, int wc, int fr, int fq) const {
        const int col0 = u.pn * 256 + wc * 32 + 8 * fq;
#pragma unroll
        for (int ai = 0; ai < 2; ++ai)
#pragma unroll
            for (int m = 0; m < 4; ++m) { const int r = ai * 128 + wr * 64 + m * 16 + fr;
                if (r < u.rows) { const unsigned aid = list[u.lbase + r]; const float wgt = rw[aid]; bf16* rowp = Y + (size_t)aid * 1024 + col0;
#pragma unroll
                    for (int bj = 0; bj < 2; ++bj) { const f32x4 v0 = acc[ai][bj][m][0] * wgt, v1 = acc[ai][bj][m][1] * wgt;
                        v4u w; w.x = pg8::cvt_pk_bf16(v0[0], v0[1]); w.y = pg8::cvt_pk_bf16(v0[2], v0[3]); w.z = pg8::cvt_pk_bf16(v1[0], v1[1]); w.w = pg8::cvt_pk_bf16(v1[2], v1[3]);
                        *(v4u*)(rowp + bj * 128) = w; } } }
    }
};

template <bool GATHER_> struct MoeOrder {
    static constexpr bool GATHER = GATHER_;
    int G, c, nunits; const LAS int* tab; const unsigned* list; size_t estride; int bK;
    __device__ __forceinline__ bool next(int i, Unit& u) const {
        const int L = i * G + c; if (L >= nunits) return false;
        const int mt = L >> 2; u.pn = L & 3; int e = 0;
        while (e < NE - 1 && mt >= tab[e + 1]) ++e;
        const int j = mt - tab[e]; u.e = e; u.pm = mt; u.lbase = e * CAP + j * 256; const int left = tab[33 + e] - j * 256; u.rows = left < 256 ? left : 256; return true;
    }
    __device__ __forceinline__ size_t a_base(const Unit& u, int K) const { return GATHER ? (size_t)0 : (size_t)u.pm * 256 * K * 2; }
    __device__ __forceinline__ size_t b_base(const Unit& u, int K) const { return (size_t)u.e * estride + (size_t)u.pn * 256 * K * 2; }
    __device__ __forceinline__ void a_offsets(const Unit& u, const int* Rr, const int* Cc, int K, unsigned (&vo)[2][2]) const {
#pragma unroll
        for (int h = 0; h < 2; ++h)
#pragma unroll
            for (int i = 0; i < 2; ++i) { const int r = h * 128 + Rr[i]; const unsigned aid = list[u.lbase + (r < u.rows ? r : 0)]; vo[h][i] = (unsigned)((aid >> 1) * (unsigned)K + (unsigned)Cc[i]) * 2u; }
    }
};
__device__ __forceinline__ int moe_tables(Frame& F) {
    LAS int* tab = (LAS int*)(F.lds + MOE_OFF);
    if (F.tid == 0) { int acc = 0;
        for (int e = 0; e < NE; ++e) { const int c = (int)F.ctl[CW_CNT + 64 * e]; tab[e] = acc; tab[33 + e] = c; acc += (c + 255) >> 8; }
        tab[32] = acc; }
    __syncthreads();
    return tab[32];
}

__device__ __forceinline__ void attn_simple_unit(Frame& F, int b, int h, int qblk) {
    LAS bf16* Ks = (LAS bf16*)(F.lds);
    LAS bf16* Vs = (LAS bf16*)(F.lds + 8192);
    LAS float* cs = (LAS float*)(F.lds + 16384);
    const int q = qblk * 512 + F.tid;
    const size_t rowq = (size_t)b * SEQ + q;
    float qv[64], o[64];
    { const bf16* qp = F.Q + rowq * 512 + h * 64;
#pragma unroll
      for (int i = 0; i < 8; ++i) { const v4u w = *(const v4u*)(qp + 8 * i); qv[8 * i] = bflo(w.x); qv[8 * i + 1] = bfhi(w.x); qv[8 * i + 2] = bflo(w.y); qv[8 * i + 3] = bfhi(w.y); qv[8 * i + 4] = bflo(w.z); qv[8 * i + 5] = bfhi(w.z); qv[8 * i + 6] = bflo(w.w); qv[8 * i + 7] = bfhi(w.w); } }
#pragma unroll
    for (int d = 0; d < 64; ++d) o[d] = 0.f;
    float mrun = -INFINITY, l = 0.f;
    const int ntiles = (qblk * 512 + 512) / 64;
    const int wave_tile = (qblk * 512 + F.wave * 64) / 64;
    for (int kt = 0; kt < ntiles; ++kt) {
        __syncthreads();
        { const size_t krow = (size_t)b * SEQ + kt * 64 + (F.tid >> 3); const int ch = (F.tid & 7) * 8;
          *(LAS v4u*)(Ks + (F.tid >> 3) * 64 + ch) = *(const v4u*)(F.K + krow * 512 + h * 64 + ch);
          *(LAS v4u*)(Vs + (F.tid >> 3) * 64 + ch) = *(const v4u*)(F.V + krow * 512 + h * 64 + ch);
          if (F.tid < 64) cs[F.tid] = F.CUM[(size_t)(b * NH + h) * SEQ + kt * 64 + F.tid] * LOG2E; }
        __syncthreads();
        if (kt <= wave_tile) {
#pragma unroll 1
            for (int kk = 0; kk < 64; ++kk) {
                float dot = 0.f;
#pragma unroll
                for (int c8 = 0; c8 < 8; ++c8) { const v4u w = *(const LAS v4u*)(Ks + kk * 64 + c8 * 8);
                    dot += qv[8 * c8] * bflo(w.x) + qv[8 * c8 + 1] * bfhi(w.x) + qv[8 * c8 + 2] * bflo(w.y) + qv[8 * c8 + 3] * bfhi(w.y) + qv[8 * c8 + 4] * bflo(w.z) + qv[8 * c8 + 5] * bfhi(w.z) + qv[8 * c8 + 6] * bflo(w.w) + qv[8 * c8 + 7] * bfhi(w.w); }
                const float sc = (kt * 64 + kk > q) ? -INFINITY : dot - cs[kk];
                const float mnew = fmaxf(mrun, sc);
                const float corr = (mnew > -INFINITY) ? __builtin_amdgcn_exp2f(mrun - mnew) : 1.f;
                const float p = (mnew > -INFINITY) ? __builtin_amdgcn_exp2f(sc - mnew) : 0.f;
                l = l * corr + p;
#pragma unroll
                for (int c8 = 0; c8 < 8; ++c8) { const v4u w = *(const LAS v4u*)(Vs + kk * 64 + c8 * 8);
                    o[8 * c8] = o[8 * c8] * corr + p * bflo(w.x); o[8 * c8 + 1] = o[8 * c8 + 1] * corr + p * bfhi(w.x); o[8 * c8 + 2] = o[8 * c8 + 2] * corr + p * bflo(w.y); o[8 * c8 + 3] = o[8 * c8 + 3] * corr + p * bfhi(w.y);
                    o[8 * c8 + 4] = o[8 * c8 + 4] * corr + p * bflo(w.z); o[8 * c8 + 5] = o[8 * c8 + 5] * corr + p * bfhi(w.z); o[8 * c8 + 6] = o[8 * c8 + 6] * corr + p * bflo(w.w); o[8 * c8 + 7] = o[8 * c8 + 7] * corr + p * bfhi(w.w); }
                mrun = mnew;
            }
        }
    }
    const float inv = 1.f / l;
    bf16* op = F.Q + rowq * 512 + h * 64;
#pragma unroll
    for (int i = 0; i < 8; ++i) { v4u w; w.x = pk2(o[8 * i] * inv, o[8 * i + 1] * inv); w.y = pk2(o[8 * i + 2] * inv, o[8 * i + 3] * inv); w.z = pk2(o[8 * i + 4] * inv, o[8 * i + 5] * inv); w.w = pk2(o[8 * i + 6] * inv, o[8 * i + 7] * inv); *(v4u*)(op + 8 * i) = w; }
    __syncthreads();
}

__device__ __forceinline__ float gelu_tanh(float v) { const float t = 0.7978845608028654f * (v + 0.044715f * v * v * v); return 0.5f * v * (1.f + tanhf(t)); }
__device__ __forceinline__ void ssm_simple_unit(Frame& F, int b, int g, LAS unsigned char* wl) {
    const int p = F.lane;
    LAS f32x2* xs = (LAS f32x2*)wl;
    LAS float* Cp = (LAS float*)(wl + 33280);
#pragma unroll
    for (int c = 0; c < 16; ++c) { Cp[p * 32 + c] = F.c_re[(size_t)(g * 16 + c) * 64 + p]; Cp[p * 32 + 16 + c] = F.c_im[(size_t)(g * 16 + c) * 64 + p]; }
    const float dt = expf(F.log_dt[g]);
    const float lr = fminf(F.lambda_re[g * 64 + p], -1e-4f), li = F.lambda_im[g * 64 + p];
    const float mag = expf(lr * dt), ar = mag * cosf(li * dt), ai = mag * sinf(li * dt);
    const float den = lr * lr + li * li, nr = ar - 1.f;
    const float cor = (nr * lr + ai * li) / den, coi = (ai * lr - nr * li) / den;
    float bbr[16], bbi[16];
#pragma unroll
    for (int c = 0; c < 16; ++c) { const float br = F.b_re[(size_t)(g * 64 + p) * 16 + c], bi = F.b_im[(size_t)(g * 64 + p) * 16 + c]; bbr[c] = cor * br - coi * bi; bbi[c] = cor * bi + coi * br; }
    float dsk[16];
#pragma unroll
    for (int c = 0; c < 16; ++c) dsk[c] = F.d_skip[g * 16 + c];
    LDS_WAIT(); asm volatile("" ::: "memory");
    float xr = 0.f, xi = 0.f;
    for (int t0 = 0; t0 < SEQ; t0 += 64) {
#pragma unroll 2
        for (int tt = 0; tt < 64; ++tt) {
            const bf16* up = F.U + ((size_t)b * SEQ + t0 + tt) * 512 + g * 16;
            const v4u w0 = *(const v4u*)up, w1 = *(const v4u*)(up + 8);
            float uu[16] = {bflo(w0.x), bfhi(w0.x), bflo(w0.y), bfhi(w0.y), bflo(w0.z), bfhi(w0.z), bflo(w0.w), bfhi(w0.w), bflo(w1.x), bfhi(w1.x), bflo(w1.y), bfhi(w1.y), bflo(w1.z), bfhi(w1.z), bflo(w1.w), bfhi(w1.w)};
            float bur = 0.f, bui = 0.f;
#pragma unroll
            for (int c = 0; c < 16; ++c) { bur += bbr[c] * uu[c]; bui += bbi[c] * uu[c]; }
            const float n_r = ar * xr - ai * xi + bur, n_i = ar * xi + ai * xr + bui; xr = n_r; xi = n_i;
            xs[tt * 65 + p] = (f32x2){xr, xi};
        }
        LDS_WAIT(); asm volatile("" ::: "memory");
        float y[16];
#pragma unroll
        for (int c = 0; c < 16; ++c) y[c] = 0.f;
#pragma unroll 4
        for (int pp = 0; pp < 64; ++pp) {
            const f32x2 xv = xs[F.lane * 65 + pp];
#pragma unroll
            for (int c4 = 0; c4 < 4; ++c4) { const f32x4 cr = *(const LAS f32x4*)(Cp + pp * 32 + c4 * 4), ci = *(const LAS f32x4*)(Cp + pp * 32 + 16 + c4 * 4);
                y[4 * c4] += cr.x * xv.x - ci.x * xv.y; y[4 * c4 + 1] += cr.y * xv.x - ci.y * xv.y; y[4 * c4 + 2] += cr.z * xv.x - ci.z * xv.y; y[4 * c4 + 3] += cr.w * xv.x - ci.w * xv.y; }
        }
        const size_t row = (size_t)b * SEQ + t0 + F.lane;
        const bf16* up = F.U + row * 512 + g * 16;
        const v4u w0 = *(const v4u*)up, w1 = *(const v4u*)(up + 8);
        const float uu[16] = {bflo(w0.x), bfhi(w0.x), bflo(w0.y), bfhi(w0.y), bflo(w0.z), bfhi(w0.z), bflo(w0.w), bfhi(w0.w), bflo(w1.x), bfhi(w1.x), bflo(w1.y), bfhi(w1.y), bflo(w1.z), bfhi(w1.z), bflo(w1.w), bfhi(w1.w)};
        float r[16];
#pragma unroll
        for (int c = 0; c < 16; ++c) r[c] = gelu_tanh(y[c] + dsk[c] * uu[c]);
        v4u o0, o1; o0.x = pk2(r[0], r[1]); o0.y = pk2(r[2], r[3]); o0.z = pk2(r[4], r[5]); o0.w = pk2(r[6], r[7]); o1.x = pk2(r[8], r[9]); o1.y = pk2(r[10], r[11]); o1.z = pk2(r[12], r[13]); o1.w = pk2(r[14], r[15]);
        bf16* yp = F.Y + row * 512 + g * 16; *(v4u*)yp = o0; *(v4u*)(yp + 8) = o1;
        LDS_WAIT(); asm volatile("" ::: "memory");
    }
}

__device__ __forceinline__ void p7_block(Frame& F, int blk) {
    LAS int* eL = (LAS int*)(F.lds);
    LAS unsigned* baseL = (LAS unsigned*)(F.lds + 1024);
    const int b = (blk * 64) / SEQ;
    const float* mod = F.MOD + b * 6144;
    f32x4 es[4], sh[4];
#pragma unroll
    for (int j = 0; j < 4; ++j) { const int c = 4 * F.lane + 256 * j; const f32x4 g4 = *(const f32x4*)(F.norm_ffn_g + c), sc = *(const f32x4*)(mod + 4096 + c); es[j] = g4 * (sc + 1.f); sh[j] = *(const f32x4*)(mod + 3072 + c); }
    for (int r = 0; r < 8; ++r) {
        const int rl = F.wave * 8 + r, m = blk * 64 + rl;
        const GAS f32x4* xr = (const GAS f32x4*)(F.out + (size_t)m * D) + F.lane;
        f32x4 v[4]; float ss = 0.f;
#pragma unroll
        for (int j = 0; j < 4; ++j) { v[j] = xr[64 * j]; ss += (v[j].x * v[j].x + v[j].y * v[j].y) + (v[j].z * v[j].z + v[j].w * v[j].w); }
        const float rstd = 1.f / sqrtf(wave_sum(ss) * (1.f / D) + RMS_EPS);
        GAS v2u* o8 = (GAS v2u*)(F.H + (size_t)m * D) + F.lane;
#pragma unroll
        for (int j = 0; j < 4; ++j) { v[j] = v[j] * rstd * es[j] + sh[j]; v2u w; w.x = pk2(v[j].x, v[j].y); w.y = pk2(v[j].z, v[j].w); o8[64 * j] = w; }
        float lg[4] = {0.f, 0.f, 0.f, 0.f};
#pragma unroll
        for (int j = 0; j < 4; ++j) { const int k = 4 * F.lane + 256 * j;
#pragma unroll
            for (int e = 0; e < 4; ++e) { const f32x4 w4 = *(const f32x4*)(F.w_rg + (size_t)(k + e) * 4); const float hv = v[j][e]; lg[0] += hv * w4.x; lg[1] += hv * w4.y; lg[2] += hv * w4.z; lg[3] += hv * w4.w; } }
#pragma unroll
        for (int i = 0; i < 4; ++i) lg[i] = wave_sum(lg[i]) + F.b_rg[i];
        int gi = 0; float lmax = lg[0];
#pragma unroll
        for (int i = 1; i < 4; ++i) if (lg[i] > lmax) { lmax = lg[i]; gi = i; }
        float se = 0.f;
#pragma unroll
        for (int i = 0; i < 4; ++i) se += expf(lg[i] - lmax);
        const float pg = 1.f / se;
        gi = __builtin_amdgcn_readfirstlane(gi);
        float le[8] = {0.f, 0.f, 0.f, 0.f, 0.f, 0.f, 0.f, 0.f};
#pragma unroll
        for (int j = 0; j < 4; ++j) { const int k = 4 * F.lane + 256 * j;
#pragma unroll
            for (int e = 0; e < 4; ++e) { const float* wp = F.w_rexp + (size_t)(k + e) * 32 + gi * 8; const f32x4 wa = *(const f32x4*)wp, wb = *(const f32x4*)(wp + 4); const float hv = v[j][e];
                le[0] += hv * wa.x; le[1] += hv * wa.y; le[2] += hv * wa.z; le[3] += hv * wa.w; le[4] += hv * wb.x; le[5] += hv * wb.y; le[6] += hv * wb.z; le[7] += hv * wb.w; } }
#pragma unroll
        for (int i = 0; i < 8; ++i) le[i] = wave_sum(le[i]) + F.b_rexp[gi * 8 + i];
        int i0 = 0; float v0 = le[0];
#pragma unroll
        for (int i = 1; i < 8; ++i) if (le[i] > v0) { v0 = le[i]; i0 = i; }
        int i1 = -1; float v1 = -INFINITY;
#pragma unroll
        for (int i = 0; i < 8; ++i) if (i != i0 && (i1 < 0 || le[i] > v1)) { v1 = le[i]; i1 = i; }
        const float ex = expf(v1 - v0), p0 = 1.f / (1.f + ex), p1 = ex * p0;
        if (F.lane == 0) { const int e0 = gi * 8 + i0, e1 = gi * 8 + i1; eL[2 * rl] = e0; eL[2 * rl + 1] = e1;
            F.ROUTE[(size_t)m * 2] = e0; F.ROUTE[(size_t)m * 2 + 1] = e1; F.RW[(size_t)m * 2] = pg * p0; F.RW[(size_t)m * 2 + 1] = pg * p1; }
    }
    __syncthreads();
    int e = 0, rank = 0, total = 0;
    if (F.tid < 128) { e = eL[F.tid];
        for (int a = 0; a < 128; ++a) { const int m_ = (eL[a] == e); total += m_; rank += (m_ && a < F.tid); }
        if (rank == 0) baseL[e] = __hip_atomic_fetch_add((unsigned*)(F.ctl + CW_CNT + 64 * e), (unsigned)total, RLX_AGENT); }
    __syncthreads();
    if (F.tid < 128) { const unsigned pos = baseL[e] + (unsigned)rank; F.LIST[(size_t)e * CAP + pos] = (unsigned)((blk * 64 + (F.tid >> 1)) * 2 + (F.tid & 1)); }
    __syncthreads();
}

__device__ __forceinline__ void p10_rows(Frame& F) {
    const int gw = F.vcu * NWAVES + F.wave, NGW = F.G * NWAVES;
    for (int ch = gw; ch < M / 8; ch += NGW) {
        const int b = (ch * 8) / SEQ;
        const float* mod = F.MOD + b * 6144 + 5120;
        f32x4 g2[4], fg[4];
#pragma unroll
        for (int j = 0; j < 4; ++j) { const int c = 4 * F.lane + 256 * j; g2[j] = *(const f32x4*)(mod + c); fg[j] = *(const f32x4*)(F.final_g + c); }
        for (int r = 0; r < 8; ++r) {
            const int m = ch * 8 + r;
            GAS f32x4* xr = (GAS f32x4*)(F.out + (size_t)m * D) + F.lane;
            const GAS v2u* y0 = (const GAS v2u*)(F.YROWS + (size_t)(2 * m) * D) + F.lane; const GAS v2u* y1 = (const GAS v2u*)(F.YROWS + (size_t)(2 * m + 1) * D) + F.lane;
            f32x4 v[4]; float ss = 0.f;
#pragma unroll
            for (int j = 0; j < 4; ++j) { const f32x4 xv = xr[64 * j]; const v2u a = y0[64 * j], bb = y1[64 * j];
                f32x4 yv; yv.x = bflo(a.x) + bflo(bb.x); yv.y = bfhi(a.x) + bfhi(bb.x); yv.z = bflo(a.y) + bflo(bb.y); yv.w = bfhi(a.y) + bfhi(bb.y);
                v[j] = xv + g2[j] * yv; ss += (v[j].x * v[j].x + v[j].y * v[j].y) + (v[j].z * v[j].z + v[j].w * v[j].w); }
            const float rstd = 1.f / sqrtf(wave_sum(ss) * (1.f / D) + RMS_EPS);
#pragma unroll
            for (int j = 0; j < 4; ++j) xr[64 * j] = v[j] * rstd * fg[j];
        }
    }
}

struct Args { const float* in[28]; float* out; unsigned char* ws; int ph_lo, ph_hi; };
__global__ void __launch_bounds__(NWAVES * 64, 2) fwd(Args args) {
    extern __shared__ __attribute__((aligned(16))) unsigned char lds[];
    Frame F;
    F.lds = (LAS unsigned char*)lds;
    F.MISC = (volatile LAS unsigned*)(F.lds + MISC_OFF);
    F.tid = threadIdx.x; F.lane = F.tid & 63; F.wave = __builtin_amdgcn_readfirstlane(F.tid >> 6);
    F.G = gridDim.x; { const int bx = blockIdx.x; F.vcu = (F.G % 8 == 0) ? (bx % 8) * (F.G / 8) + bx / 8 : bx; }
    unsigned char* ws = args.ws;
    F.ctl = (gu32*)(ws + WS_CTL);
    F.x = args.in[0]; F.c = args.in[1]; F.w_ada = args.in[2]; F.b_ada = args.in[3]; F.norm_mix_g = args.in[4]; F.w_in = args.in[5]; F.b_forget = args.in[6]; F.w_out_fox = args.in[7];
    F.lambda_re = args.in[8]; F.lambda_im = args.in[9]; F.log_dt = args.in[10]; F.b_re = args.in[11]; F.b_im = args.in[12]; F.c_re = args.in[13]; F.c_im = args.in[14]; F.d_skip = args.in[15];
    F.w_glu = args.in[16]; F.w_out_ssm = args.in[17]; F.w_o = args.in[18]; F.norm_ffn_g = args.in[19]; F.w_rg = args.in[20]; F.b_rg = args.in[21]; F.w_rexp = args.in[22]; F.b_rexp = args.in[23];
    F.w_gate = args.in[24]; F.w_up = args.in[25]; F.w_down = args.in[26]; F.final_g = args.in[27]; F.out = args.out;
    F.MOD = (float*)(ws + WS_MOD); F.LOGF = (float*)(ws + WS_LOGF); F.CUM = (float*)(ws + WS_CUM); F.RW = (float*)(ws + WS_RW); F.ROUTE = (int*)(ws + WS_ROUTE); F.LIST = (unsigned*)(ws + WS_LIST);
    F.WIN = (bf16*)(ws + WS_WIN); F.WGLU = (bf16*)(ws + WS_WGLU); F.WOF = (bf16*)(ws + WS_WOF); F.WOS = (bf16*)(ws + WS_WOS); F.WO = (bf16*)(ws + WS_WO); F.WGU = (bf16*)(ws + WS_WGU); F.WD = (bf16*)(ws + WS_WD);
    F.H = (bf16*)(ws + WS_H); F.Y = (bf16*)(ws + WS_Y); F.Q = (bf16*)(ws + WS_Q); F.K = (bf16*)(ws + WS_K); F.V = (bf16*)(ws + WS_V); F.U = (bf16*)(ws + WS_U); F.SGA = (bf16*)(ws + WS_SGA); F.SGB = (bf16*)(ws + WS_SGB);
    F.HID = (bf16*)(ws + WS_HID); F.YROWS = (bf16*)(ws + WS_YROWS);
    for (int u = F.tid; u < (LDS_BYTES - LDSCTL_OFF) / 4; u += NWAVES * 64) ((LAS unsigned*)(F.lds + LDSCTL_OFF))[u] = 0u;
    __syncthreads();
    XcdBarrier bar; bar.bar = (unsigned*)(F.ctl + CW_BAR); bar.x = 0; bar.st = nullptr;
    if (N_LAUNCHES == 1) bar = xcd_barrier_post((unsigned*)(F.ctl + CW_BAR), F.MISC + 8);
#define GRID_BAR() do { if (N_LAUNCHES == 1) xcd_barrier(bar); } while (0)
    const int lo = args.ph_lo, hi = args.ph_hi;
#ifndef PH_MASK
#define PH_MASK 0x7ff
#endif
#define IN(k) ((((PH_MASK) >> (k)) & 1) && lo <= (k) && (k) < hi)
#define BOTH(k) (IN(k) && IN((k) + 1))

    if (IN(0)) { p0_prologue(F); if (BOTH(0)) GRID_BAR(); }
    if (IN(1)) { p1_rows(F); if (BOTH(1)) GRID_BAR(); }
    if (IN(2)) {
        p2_cumscan(F); VM_WAIT(); __syncthreads();
        pg8::Gemm g{F.H, F.WIN, 1024}; pg8::StaticOrder S; S.init(M, 4096, F.G, (int)blockIdx.x);
        EpiInProj E{F.Q};
        pg8::gemm_phase<EpiInProj, pg8::StaticOrder, true>(F.lds + RING_OFF, g, S, E);
        if (BOTH(2)) GRID_BAR();
    }
    if (IN(3)) {
        for (int u = F.vcu; u < NB * NH * 4; u += F.G) { const int bh = u >> 2, qblk = 3 - (u & 3); attn_simple_unit(F, bh >> 3, bh & 7, qblk); }
        __syncthreads();
        if (F.wave < 3) for (int u = F.wave * F.G + F.vcu; u < NB * NG; u += 3 * F.G) ssm_simple_unit(F, u >> 5, u & 31, F.lds + F.wave * 41472);
        __syncthreads();
        if (BOTH(3)) GRID_BAR();
    }
    if (IN(4)) {
        { pg8::Gemm g{F.Q, F.WOF, 512}; pg8::StaticOrder S; S.init(M, 1024, F.G, (int)blockIdx.x); EpiGate<0> E{F.SGA, nullptr};
          pg8::gemm_phase<EpiGate<0>, pg8::StaticOrder, true>(F.lds + RING_OFF, g, S, E); }
        { pg8::Gemm g{F.Y, F.WGLU, 512}; pg8::StaticOrder S; S.init(M, 1024, F.G, (int)blockIdx.x); EpiPair<0> E{F.V};
          pg8::gemm_phase<EpiPair<0>, pg8::StaticOrder, true>(F.lds + RING_OFF, g, S, E); }
        if (BOTH(4)) GRID_BAR();
    }
    if (IN(5)) {
        pg8::Gemm g{F.V, F.WOS, 512}; pg8::StaticOrder S; S.init(M, 1024, F.G, (int)blockIdx.x); EpiGate<1> E{F.SGA, F.SGB};
        pg8::gemm_phase<EpiGate<1>, pg8::StaticOrder, true>(F.lds + RING_OFF, g, S, E);
        if (BOTH(5)) GRID_BAR();
    }
    if (IN(6)) {
        pg8::Gemm g{F.SGA, F.WO, 1024}; pg8::StaticOrder S; S.init(M, 1024, F.G, (int)blockIdx.x); EpiResid E{F.x, F.out, F.MOD};
        pg8::gemm_phase<EpiResid, pg8::StaticOrder, true>(F.lds + RING_OFF, g, S, E);
        if (BOTH(6)) GRID_BAR();
    }
    if (IN(7)) {
        for (int blk = F.vcu; blk < M / 64; blk += F.G) p7_block(F, blk);
        if (BOTH(7)) GRID_BAR();
    }
    if (IN(8)) {
        const int mt = moe_tables(F);
        MoeOrder<true> S{F.G, (int)blockIdx.x, mt * 4, (const LAS int*)(F.lds + MOE_OFF), F.LIST, (size_t)1024 * 1024 * 2, 0};
        pg8::Gemm g{F.H, F.WGU, 1024}; EpiPair<1> E{F.HID};
        pg8::gemm_phase<EpiPair<1>, MoeOrder<true>, true>(F.lds + RING_OFF, g, S, E);
        if (BOTH(8)) GRID_BAR();
    }
    if (IN(9)) {
        const int mt = moe_tables(F);
        MoeOrder<false> S{F.G, (int)blockIdx.x, mt * 4, (const LAS int*)(F.lds + MOE_OFF), F.LIST, (size_t)1024 * 512 * 2, 0};
        pg8::Gemm g{F.HID, F.WD, 512}; EpiDown E{F.YROWS, F.LIST, F.RW};
        pg8::gemm_phase<EpiDown, MoeOrder<false>, true>(F.lds + RING_OFF, g, S, E);
        if (BOTH(9)) GRID_BAR();
    }
    if (IN(10)) { p10_rows(F); }
#undef IN
#undef BOTH
}

extern "C" void kernel_launch(void* const* d_in, const int* in_sizes, int n_in, void* d_out, int out_size, void* d_ws, size_t ws_size, hipStream_t stream) {
    static int grid = 0;
    if (grid == 0) {
        if (n_in != 28 || in_sizes[0] != M * D || out_size != M * D || ws_size < WS_END) { fprintf(stderr, "kernel_launch: unexpected shapes (n_in %d, in0 %d, out %d, ws %zu); nothing launched\n", n_in, n_in > 0 ? in_sizes[0] : -1, out_size, ws_size); grid = -1; return; }
        int dev = 0, cus = 0, per_cu = 0;
        if (hipGetDevice(&dev) != hipSuccess || hipDeviceGetAttribute(&cus, hipDeviceAttributeMultiprocessorCount, dev) != hipSuccess) { grid = -1; return; }
        if (hipFuncSetAttribute((const void*)fwd, hipFuncAttributeMaxDynamicSharedMemorySize, LDS_BYTES) != hipSuccess) { fprintf(stderr, "kernel_launch: hipFuncSetAttribute failed\n"); grid = -1; return; }
        if (hipOccupancyMaxActiveBlocksPerMultiprocessor(&per_cu, (const void*)fwd, NWAVES * 64, LDS_BYTES) != hipSuccess || per_cu < 1) { fprintf(stderr, "kernel_launch: occupancy query reports %d\n", per_cu); }
        (void)hipGetLastError();
        grid = cus;
    }
    if (grid < 0) return;
    if (hipMemsetAsync((char*)d_ws + WS_CTL, 0, CTL_ZERO_BYTES, stream) != hipSuccess) return;
    Args a{};
    for (int i = 0; i < 28; ++i) a.in[i] = (const float*)d_in[i];
    a.out = (float*)d_out; a.ws = (unsigned char*)d_ws;
    for (int li = 0; li < N_LAUNCHES; ++li) {
        a.ph_lo = (N_LAUNCHES == NPH) ? li : 0; a.ph_hi = (N_LAUNCHES == NPH) ? li + 1 : NPH;
        hipLaunchKernelGGL(fwd, dim3(grid), dim3(NWAVES * 64), LDS_BYTES, stream, a);
        if (hipPeekAtLastError() != hipSuccess) { fprintf(stderr, "kernel_launch: launch %d failed\n", li); break; }
    }
}
```

```cpp
#include <hip/hip_runtime.h>
#include <cstdio>
#include <cstdint>

#ifndef MK_N_LAUNCHES
#define MK_N_LAUNCHES 1
#endif

constexpr int NB = 8, SEQ = 2048, D = 1024, M = NB * SEQ;
constexpr int NH = 8, HD = 64, FW = 512;
constexpr int SW = 512, NG = 32, NS = 64;
constexpr int INC = 4104;
constexpr int NE = 32, DE = 512;
constexpr int CAP = 16384;
constexpr float RMS_EPS = 1e-6f;
constexpr float LOG2E = 1.4426950408889634f;
constexpr float QSCALE = 0.125f * 1.4426950408889634f;

namespace pg8 {
#define PG8_LAS __attribute__((address_space(3)))
typedef unsigned short bf16_t;
typedef short bf16x8 __attribute__((ext_vector_type(8)));
typedef float f32x4 __attribute__((ext_vector_type(4)));
typedef unsigned u32x4 __attribute__((ext_vector_type(4)));
constexpr int BM = 256, BK = 64, HALF = 128, HTB = HALF * BK * 2, STAGE_BYTES = 8 * HTB, NXCD = 8, WGM = 8;

__host__ __device__ __forceinline__ int lds_byte(int r, int c) { const int st = (r >> 4) * 2 + (c >> 5), rr = r & 15, cc = c & 31, ob = rr * 64 + cc * 2; return st * 1024 + (ob ^ (((ob >> 9) & 1) << 5)); }
__host__ __device__ __forceinline__ void stage_rc(int b, int& R, int& C) { const int st = b / 1024, sb = b % 1024, swz = sb ^ (((sb >> 9) & 1) << 5); R = (st >> 1) * 16 + swz / 64; C = (st & 1) * 32 + (swz % 64) / 2; }
__host__ __device__ __forceinline__ int perm32(int rho) { const int n = rho >> 4, i = rho & 15; return 8 * (i >> 2) + 4 * n + (i & 3); }

struct Unit { int pm, pn, e, rows, lbase; };
struct Gemm { const bf16_t* A; const bf16_t* Bt; int K; };

struct StaticOrder {
    static constexpr bool GATHER = false;
    int nM, nN, nwg, G, c;
    __host__ __device__ void init(int M_, int N_, int G_, int c_) { nM = M_ / BM; nN = N_ / BM; nwg = nM * nN; G = G_; c = c_; }
    __host__ __device__ bool next(int i, Unit& u) const {
        const long L = (long)i * G + c; if (L >= nwg) return false;
        int wgid = (int)L; { const int q = nwg / NXCD, r = nwg % NXCD, xcd = wgid % NXCD, off = wgid / NXCD; wgid = (xcd < r ? xcd * (q + 1) : r * (q + 1) + (xcd - r) * q) + off; }
        const int nig = WGM * nN, gid = wgid / nig, fm = gid * WGM, gsz = (nM - fm) < WGM ? (nM - fm) : WGM;
        u.pm = fm + ((wgid % nig) % gsz); u.pn = (wgid % nig) / gsz; u.e = 0; u.rows = 256; u.lbase = 0; return true;
    }
    __device__ __forceinline__ size_t a_base(const Unit& u, int K) const { return (size_t)u.pm * BM * K * 2; }
    __device__ __forceinline__ size_t b_base(const Unit& u, int K) const { return (size_t)u.pn * BM * K * 2; }
    __device__ __forceinline__ void a_offsets(const Unit&, const int*, const int*, int, unsigned (&)[2][2]) const {}
};

__device__ __forceinline__ unsigned cvt_pk_bf16(float lo, float hi) { unsigned r; asm volatile("v_cvt_pk_bf16_f32 %0, %1, %2" : "=v"(r) : "v"(lo), "v"(hi)); return r; }

template <class Epi, class Sched, bool ALIGN_EPI>
__device__ __forceinline__ void gemm_phase(PG8_LAS unsigned char* lds, const Gemm g, const Sched& S, const Epi& E) {
    constexpr bool GATHER = Sched::GATHER;
    const int tid = threadIdx.x, wid = __builtin_amdgcn_readfirstlane(tid >> 6), lane = tid & 63, wr = wid >> 2, wc = wid & 3, fr = lane & 15, fq = lane >> 4;
    const int K = g.K, nt = K / BK;
    unsigned voffB[2], voC[2][2], voN[2][2]; int Rr[2], Cc[2];
#pragma unroll
    for (int i = 0; i < 2; ++i) { int R, C; stage_rc(tid * 16 + i * 8192, R, C); Rr[i] = R; Cc[i] = C; const int Rb = Epi::PERM ? ((R & ~31) + perm32(R & 31)) : R;
        voffB[i] = (unsigned)(Rb * K + C) * 2u; }
    const size_t kstep = (size_t)(BK * 2);
    const size_t hstep = (size_t)HALF * K * 2;
    const unsigned ldsw = (unsigned)wid * 1024u;
    const int aoff = lds_byte(wr * 64 + fr, fq * 8), boff = lds_byte(wc * 32 + fr, fq * 8);
#define PG8_SA(b, h) (((b) * 2 + (h)) * HTB)
#define PG8_SB(b, h) ((4 + (b) * 2 + (h)) * HTB)
#define PG8_STAGE(bufoff, gbase, voff) do { _Pragma("unroll") for (int _i = 0; _i < 2; ++_i) \
        __builtin_amdgcn_global_load_lds((const unsigned*)((const char*)(gbase) + (voff)[_i]), (PG8_LAS unsigned*)(lds + (bufoff) + ldsw + _i * 8192), 16, 0, 0); } while (0)
#define PG8_LDA(dst, b, h) do { _Pragma("unroll") for (int m = 0; m < 4; ++m) _Pragma("unroll") for (int k = 0; k < 2; ++k) dst[m][k] = *(const PG8_LAS bf16x8*)(lds + PG8_SA(b, h) + aoff + m * 2048 + k * 1024); } while (0)
#define PG8_LDB(dst, b, h) do { _Pragma("unroll") for (int n = 0; n < 2; ++n) _Pragma("unroll") for (int k = 0; k < 2; ++k) dst[n][k] = *(const PG8_LAS bf16x8*)(lds + PG8_SB(b, h) + boff + n * 2048 + k * 1024); } while (0)
#define PG8_MMA(ai, bj, At, Bt) do { __builtin_amdgcn_s_setprio(1); _Pragma("unroll") for (int m = 0; m < 4; ++m) _Pragma("unroll") for (int n = 0; n < 2; ++n) _Pragma("unroll") for (int k = 0; k < 2; ++k) \
        acc[ai][bj][m][n] = __builtin_amdgcn_mfma_f32_16x16x32_bf16(Bt[n][k], At[m][k], acc[ai][bj][m][n], 0, 0, 0); __builtin_amdgcn_s_setprio(0); } while (0)
#define PG8_WAIT_V(n) asm volatile("s_waitcnt vmcnt(" #n ")" ::: "memory")
#define PG8_WAIT_L(n) asm volatile("s_waitcnt lgkmcnt(" #n ")" ::: "memory")
#define PG8_BAR __builtin_amdgcn_s_barrier()
#define PG8_SCHED __builtin_amdgcn_sched_barrier(0)
    Unit cur, nxt; int ui = 0;
    if (!S.next(0, cur)) return;
    f32x4 acc[2][2][4][2];
#pragma unroll
    for (int a = 0; a < 2; ++a)
#pragma unroll
        for (int b = 0; b < 2; ++b)
#pragma unroll
            for (int m = 0; m < 4; ++m)
#pragma unroll
                for (int n = 0; n < 2; ++n) acc[a][b][m][n] = (f32x4){0.f, 0.f, 0.f, 0.f};
    bf16x8 At[4][2], B0[2][2], B1[2][2];
    if constexpr (GATHER) S.a_offsets(cur, Rr, Cc, K, voC);
    else {
#pragma unroll
        for (int h = 0; h < 2; ++h)
#pragma unroll
            for (int i = 0; i < 2; ++i) voC[h][i] = (unsigned)((Rr[i] + h * HALF) * K + Cc[i]) * 2u;
    }
    const char* cA = (const char*)g.A + S.a_base(cur, K); const char* cB = (const char*)g.Bt + S.b_base(cur, K);
    PG8_STAGE(PG8_SB(0, 0), cB, voffB); PG8_STAGE(PG8_SB(0, 1), cB + hstep, voffB); PG8_STAGE(PG8_SA(0, 0), cA, voC[0]); PG8_STAGE(PG8_SA(0, 1), cA, voC[1]);
    if (wr == 1) PG8_BAR;
    PG8_WAIT_V(2); PG8_BAR;
    PG8_STAGE(PG8_SB(1, 0), cB + kstep, voffB); PG8_STAGE(PG8_SA(1, 0), cA + kstep, voC[0]); PG8_STAGE(PG8_SB(1, 1), cB + hstep + kstep, voffB);
    PG8_WAIT_V(6); PG8_BAR;
    for (;;) {
        const bool has_next = S.next(ui + 1, nxt);
        const char* nA = has_next ? (const char*)g.A + S.a_base(nxt, K) : cA; const char* nB = has_next ? (const char*)g.Bt + S.b_base(nxt, K) : cB;
        if constexpr (GATHER) {
            if (has_next) S.a_offsets(nxt, Rr, Cc, K, voN);
            else {
#pragma unroll
                for (int h = 0; h < 2; ++h)
#pragma unroll
                    for (int i = 0; i < 2; ++i) voN[h][i] = voC[h][i];
            }
        }
        for (int t = 0; t < nt; t += 2) {
            const bool last = (t == nt - 2);
            const char* a1 = cA + (size_t)(t + 1) * kstep;
            const char* a2 = last ? nA : cA + (size_t)(t + 2) * kstep; const char* b2 = last ? nB : cB + (size_t)(t + 2) * kstep;
            const char* a3 = a2 + kstep; const char* b3 = b2 + kstep;
            unsigned vo2[2][2];
#pragma unroll
            for (int h = 0; h < 2; ++h)
#pragma unroll
                for (int i = 0; i < 2; ++i) vo2[h][i] = GATHER ? (last ? voN[h][i] : voC[h][i]) : voC[h][i];
            PG8_LDB(B0, 0, 0); PG8_LDB(B1, 0, 1); PG8_SCHED; PG8_LDA(At, 0, 0); PG8_STAGE(PG8_SA(1, 1), a1, voC[1]);
            PG8_WAIT_V(8); PG8_WAIT_L(0); PG8_BAR; PG8_MMA(0, 0, At, B0); PG8_MMA(0, 1, At, B1); PG8_BAR; PG8_SCHED;
            PG8_LDA(At, 0, 1); PG8_STAGE(PG8_SB(0, 0), b2, voffB); PG8_STAGE(PG8_SB(0, 1), b2 + hstep, voffB); PG8_STAGE(PG8_SA(0, 0), a2, vo2[0]);
            PG8_WAIT_V(8); PG8_WAIT_L(0); PG8_BAR; PG8_MMA(1, 0, At, B0); PG8_MMA(1, 1, At, B1); PG8_BAR; PG8_SCHED;
            PG8_LDB(B0, 1, 0); PG8_LDB(B1, 1, 1); PG8_SCHED; PG8_LDA(At, 1, 0); PG8_STAGE(PG8_SA(0, 1), a2, vo2[1]);
            PG8_WAIT_V(8); PG8_WAIT_L(0); PG8_BAR; PG8_MMA(0, 0, At, B0); PG8_MMA(0, 1, At, B1); PG8_BAR; PG8_SCHED;
            PG8_LDA(At, 1, 1); PG8_STAGE(PG8_SB(1, 0), b3, voffB); PG8_STAGE(PG8_SB(1, 1), b3 + hstep, voffB); PG8_STAGE(PG8_SA(1, 0), a3, vo2[0]);
            PG8_WAIT_V(8); PG8_WAIT_L(0); PG8_BAR; PG8_MMA(1, 0, At, B0); PG8_MMA(1, 1, At, B1); PG8_BAR; PG8_SCHED;
        }
        if constexpr (ALIGN_EPI) { if (wr == 0) PG8_BAR; }
        E(acc, cur, wr, wc, fr, fq);
        if (!has_next) break;
#pragma unroll
        for (int a = 0; a < 2; ++a)
#pragma unroll
            for (int b = 0; b < 2; ++b)
#pragma unroll
                for (int m = 0; m < 4; ++m)
#pragma unroll
                    for (int n = 0; n < 2; ++n) acc[a][b][m][n] = (f32x4){0.f, 0.f, 0.f, 0.f};
        cur = nxt; cA = nA; cB = nB; ++ui;
        if constexpr (GATHER) {
#pragma unroll
            for (int h = 0; h < 2; ++h)
#pragma unroll
                for (int i = 0; i < 2; ++i) voC[h][i] = voN[h][i];
        }
        if constexpr (ALIGN_EPI) { if (wr == 1) PG8_BAR; }
    }
    PG8_WAIT_V(0);
    if constexpr (!ALIGN_EPI) { if (wr == 0) PG8_BAR; }
    PG8_BAR;
#undef PG8_SA
#undef PG8_SB
#undef PG8_STAGE
#undef PG8_LDA
#undef PG8_LDB
#undef PG8_MMA
#undef PG8_WAIT_V
#undef PG8_WAIT_L
#undef PG8_BAR
#undef PG8_SCHED
}
}

constexpr int NWAVES = 8;
constexpr int NPH = 11;
constexpr int N_LAUNCHES = MK_N_LAUNCHES;
static_assert(N_LAUNCHES == 1 || N_LAUNCHES == NPH, "MK_N_LAUNCHES is 1 (one launch) or NPH (one launch per phase)");

constexpr size_t MiB = 1u << 20;
constexpr size_t WS_CTL = 0, CTL_ZERO_BYTES = 1 * MiB;
constexpr size_t WS_MOD = 1 * MiB;
constexpr size_t WS_LOGF = 1 * MiB + 256 * 1024;
constexpr size_t WS_ROUTE = 2 * MiB;
constexpr size_t WS_RW = 2 * MiB + 256 * 1024;
constexpr size_t WS_CUM = 2 * MiB + 512 * 1024;
constexpr size_t WS_LIST = 3 * MiB;
constexpr size_t WS_WIN = 6 * MiB;
constexpr size_t WS_WGLU = 14 * MiB, WS_WOF = 15 * MiB, WS_WOS = 16 * MiB, WS_WO = 17 * MiB;
constexpr size_t WS_WGU = 20 * MiB;
constexpr size_t WS_WD = 84 * MiB;
constexpr size_t WS_H = 116 * MiB;
constexpr size_t WS_Y = 148 * MiB;
constexpr size_t WS_MIX = 164 * MiB;
constexpr size_t WS_Q = WS_MIX, WS_K = WS_MIX + 16 * MiB, WS_V = WS_MIX + 32 * MiB, WS_U = WS_MIX + 48 * MiB, WS_SGA = WS_MIX + 64 * MiB, WS_SGB = WS_MIX + 96 * MiB;
constexpr size_t WS_HID = WS_MIX;
constexpr size_t WS_YROWS = WS_MIX + 40 * MiB;
constexpr size_t WS_END = 292 * MiB;
static_assert(WS_YROWS + (size_t)M * 2 * 1024 * 2 <= WS_END && WS_SGB + (size_t)M * 1024 * 2 <= WS_END, "d_ws map");

constexpr int CW_TMO = 0;
constexpr int CW_CNT = 2048;
constexpr int CW_BAR = 8192;

constexpr int RING_OFF = 0, RING_BYTES = 131072;
constexpr int LDSCTL_OFF = RING_BYTES, MISC_OFF = LDSCTL_OFF + 320, MOE_OFF = LDSCTL_OFF + 1024;
constexpr int LDS_BYTES = 147456;

#define GAS __attribute__((address_space(1)))
#define LAS __attribute__((address_space(3)))
typedef unsigned short bf16;
typedef unsigned v4u __attribute__((ext_vector_type(4)));
typedef unsigned v2u __attribute__((ext_vector_type(2)));
typedef float f32x4 __attribute__((ext_vector_type(4)));
typedef float f32x2 __attribute__((ext_vector_type(2)));
typedef GAS unsigned gu32;
#define RLX_AGENT __ATOMIC_RELAXED, __HIP_MEMORY_SCOPE_AGENT
#define LDS_WAIT() asm volatile("s_waitcnt lgkmcnt(0)" ::: "memory")
#define VM_WAIT() asm volatile("s_waitcnt vmcnt(0)" ::: "memory")
__device__ __forceinline__ unsigned f2bf(float f) { unsigned u = __builtin_bit_cast(unsigned, f); return (u + 0x7fffu + ((u >> 16) & 1u)) >> 16; }
__device__ __forceinline__ unsigned pk2(float lo, float hi) { return f2bf(lo) | (f2bf(hi) << 16); }
__device__ __forceinline__ float bflo(unsigned w) { return __uint_as_float(w << 16); }
__device__ __forceinline__ float bfhi(unsigned w) { return __uint_as_float(w & 0xffff0000u); }
__device__ __forceinline__ float fast_sigmoid(float v) { return __builtin_amdgcn_rcpf(1.f + __builtin_amdgcn_exp2f(-LOG2E * v)); }

#define XB_TMO      128
#define XB_XCNT(j)  (256  + 64 * (j))
#define XB_XSUB(j)  (1280 + 64 * (j))
#define XB_XGEN(j)  (2304 + 64 * (j))
#define XB_TOP      3328
#define XB_TOPGEN   3392
#define XCD_BAR_WORDS 3456
#define XB_SPIN_CAP (1u << 18)
__device__ __forceinline__ unsigned xb_ld(unsigned* p)              { return __hip_atomic_load(p, __ATOMIC_RELAXED, __HIP_MEMORY_SCOPE_AGENT); }
__device__ __forceinline__ unsigned xb_add(unsigned* p, unsigned v) { return __hip_atomic_fetch_add(p, v, __ATOMIC_RELAXED, __HIP_MEMORY_SCOPE_AGENT); }
__device__ __forceinline__ unsigned xb_xcc_id() { return (unsigned)__builtin_amdgcn_s_getreg((3 << 11) | 20) & 0xFu; }
#define XB_SPIN(cond, bar) do { unsigned _sp = 0; while (cond) { __builtin_amdgcn_s_sleep(1); \
    if ((++_sp & 255u) == 0u) { if (xb_ld(&(bar)[XB_TMO])) break; if (_sp > XB_SPIN_CAP) { atomicAdd(&(bar)[XB_TMO], 1u); break; } } } } while (0)
struct XcdBarrier { unsigned* bar; unsigned x; volatile LAS unsigned* st; };
__device__ __forceinline__ XcdBarrier xcd_barrier_post(unsigned* bar, volatile LAS unsigned* st) {
    XcdBarrier b; b.bar = bar; b.x = xb_xcc_id(); b.st = st;
    if (threadIdx.x == 0) (void)xb_add(&bar[XB_XCNT(b.x)], 1u);
    return b;
}
__device__ __forceinline__ void xcd_barrier_complete(unsigned* bar, unsigned x, unsigned& nloc, unsigned& nx) {
    const unsigned G = gridDim.x * gridDim.y * gridDim.z;
    unsigned sum, cnt, mine, sp = 0u;
    for (;;) {
        sum = 0u; cnt = 0u; mine = 0u;
#pragma unroll
        for (unsigned j = 0; j < 16; ++j) { const unsigned c = xb_ld(&bar[XB_XCNT(j)]); sum += c; cnt += (c > 0u) ? 1u : 0u; mine = (j == x) ? c : mine; }
        if (sum == G) break;
        __builtin_amdgcn_s_sleep(1);
        if ((++sp & 255u) == 0u) { if (xb_ld(&bar[XB_TMO])) break; if (sp > XB_SPIN_CAP) { atomicAdd(&bar[XB_TMO], 1u); break; } }
    }
    nloc = mine > 0u ? mine : 1u; nx = cnt > 0u ? cnt : 1u;
}
__device__ __forceinline__ void xcd_barrier(const XcdBarrier& b) {
    asm volatile("s_waitcnt vmcnt(0)" ::: "memory");
    __syncthreads();
    if (threadIdx.x == 0) {
        unsigned* bar = b.bar;
        __builtin_amdgcn_s_waitcnt(0);
        unsigned nloc = b.st[0], nx = b.st[1];
        if (nloc == 0u) { xcd_barrier_complete(bar, b.x, nloc, nx); b.st[0] = nloc; b.st[1] = nx; }
        const unsigned old = xb_add(&bar[XB_XSUB(b.x)], 1u);
        const unsigned gen = old / nloc;
        if (old + 1u == (gen + 1u) * nloc) {
            __builtin_amdgcn_fence(__ATOMIC_RELEASE, "agent");
            asm volatile("s_waitcnt vmcnt(0)" ::: "memory");
            const unsigned og = xb_add(&bar[XB_TOP], 1u);
            const unsigned tg = og / nx;
            if (og + 1u == (tg + 1u) * nx) xb_add(&bar[XB_TOPGEN], 1u);
            else XB_SPIN(xb_ld(&bar[XB_TOPGEN]) == tg, bar);
            __builtin_amdgcn_fence(__ATOMIC_ACQUIRE, "agent");
            xb_add(&bar[XB_XGEN(b.x)], 1u);
            asm volatile("s_waitcnt vmcnt(0)" ::: "memory");
        } else {
            XB_SPIN(xb_ld(&bar[XB_XGEN(b.x)]) == gen, bar);
            __builtin_amdgcn_fence(__ATOMIC_ACQUIRE, "agent");
            asm volatile("s_waitcnt vmcnt(0)" ::: "memory");
        }
    }
    __syncthreads();
}

struct Frame {
    LAS unsigned char* lds;
    volatile LAS unsigned* MISC;
    gu32* ctl;
    int tid, lane, wave, vcu, G;
    const float *x, *c, *w_ada, *b_ada, *norm_mix_g, *w_in, *b_forget, *w_out_fox, *lambda_re, *lambda_im, *log_dt, *b_re, *b_im, *c_re, *c_im, *d_skip, *w_glu, *w_out_ssm, *w_o,
        *norm_ffn_g, *w_rg, *b_rg, *w_rexp, *b_rexp, *w_gate, *w_up, *w_down, *final_g;
    float* out;
    float *MOD, *LOGF, *CUM, *RW; int* ROUTE; unsigned* LIST;
    bf16 *WIN, *WGLU, *WOF, *WOS, *WO, *WGU, *WD, *H, *Y, *Q, *K, *V, *U, *SGA, *SGB, *HID, *YROWS;
};

__device__ __forceinline__ float wave_sum(float v) {
#pragma unroll
    for (int o = 1; o < 64; o <<= 1) v += __shfl_xor(v, o);
    return v;
}

__device__ __forceinline__ void transpose_item(const float* src, int ld_src, bf16* dst, int ld_dst, LAS float* scr, int lane) {
#pragma unroll 8
    for (int i = 0; i < 32; ++i) { const int kk = 2 * i + (lane >> 5); scr[kk * 33 + (lane & 31)] = src[(size_t)kk * ld_src + (lane & 31)]; }
    LDS_WAIT(); asm volatile("" ::: "memory");
    const int c = lane & 7;
#pragma unroll
    for (int j = 0; j < 4; ++j) { const int n = (lane >> 3) + 8 * j; const LAS float* s = scr + (8 * c) * 33 + n;
        v4u o; o.x = pk2(s[0 * 33], s[1 * 33]); o.y = pk2(s[2 * 33], s[3 * 33]); o.z = pk2(s[4 * 33], s[5 * 33]); o.w = pk2(s[6 * 33], s[7 * 33]);
        *(GAS v4u*)(dst + (size_t)n * ld_dst + 8 * c) = o; }
    LDS_WAIT(); asm volatile("" ::: "memory");
}

__device__ __forceinline__ void p0_prologue(Frame& F) {
    {
        LAS float* cact = (LAS float*)(F.lds);
        LAS float* red = (LAS float*)(F.lds + 32768);
        for (int i = F.tid; i < 8192; i += 512) { const float v = F.c[i]; cact[i] = v / (1.f + __expf(-v)); }
        __syncthreads();
        for (int it = F.vcu; it < 192; it += F.G) {
            const int cl = F.lane & 31, hf = F.lane >> 5, col = it * 32 + cl;
            float a[8];
#pragma unroll
            for (int b = 0; b < 8; ++b) a[b] = 0.f;
            for (int i = 0; i < 64; ++i) {
                const int k = 16 * i + 2 * F.wave + hf;
                const float w = F.w_ada[(size_t)k * 6144 + col];
#pragma unroll
                for (int b = 0; b < 8; ++b) a[b] += cact[b * 1024 + k] * w;
            }
#pragma unroll
            for (int b = 0; b < 8; ++b) { a[b] += __shfl_xor(a[b], 32); if (hf == 0) red[(F.wave * 8 + b) * 32 + cl] = a[b]; }
            __syncthreads();
            if (F.tid < 256) { const int b = F.tid >> 5, c2 = F.tid & 31; float s = 0.f;
#pragma unroll
                for (int w = 0; w < 8; ++w) s += red[(w * 8 + b) * 32 + c2];
                F.MOD[b * 6144 + it * 32 + c2] = s + F.b_ada[it * 32 + c2]; }
            __syncthreads();
        }
        __syncthreads();
    }
    LAS float* scr = (LAS float*)(F.lds + RING_OFF + F.wave * 16384);
    const int gw = F.vcu * NWAVES + F.wave, NGW = F.G * NWAVES;
    constexpr int I_A = 16 * 48, I_B = 16 * 80, I_C = 8 * 32, I_D = 8 * 32, I_E = 8 * 32, I_F = 16 * 32, I_G = 32 * 256, I_H = 32 * 256, I_I = 32 * 256;
    constexpr int NITEMS = I_A + I_B + I_C + I_D + I_E + I_F + I_G + I_H + I_I;
    for (int it = gw; it < NITEMS; it += NGW) {
        int r = it;
        if (r < I_A) { const int kb = r / 48, nb = r % 48; transpose_item(F.w_in + (size_t)(64 * kb) * INC + 32 * nb, INC, F.WIN + (size_t)(32 * nb) * 1024 + 64 * kb, 1024, scr, F.lane); continue; } r -= I_A;
        if (r < I_B) { const int kb = r / 80, nb = r % 80; transpose_item(F.w_in + (size_t)(64 * kb) * INC + 1544 + 32 * nb, INC, F.WIN + (size_t)(1536 + 32 * nb) * 1024 + 64 * kb, 1024, scr, F.lane); continue; } r -= I_B;
        if (r < I_C) { const int kb = r / 32, nb = r % 32, n0 = 32 * nb, half = n0 >> 9, within = n0 & 511, pn = within >> 7, q = within & 127;
            transpose_item(F.w_glu + (size_t)(64 * kb) * 1024 + n0, 1024, F.WGLU + (size_t)(pn * 256 + half * 128 + q) * 512 + 64 * kb, 512, scr, F.lane); continue; } r -= I_C;
        if (r < I_D) { const int kb = r / 32, nb = r % 32; transpose_item(F.w_out_fox + (size_t)(64 * kb) * 1024 + 32 * nb, 1024, F.WOF + (size_t)(32 * nb) * 512 + 64 * kb, 512, scr, F.lane); continue; } r -= I_D;
        if (r < I_E) { const int kb = r / 32, nb = r % 32; transpose_item(F.w_out_ssm + (size_t)(64 * kb) * 1024 + 32 * nb, 1024, F.WOS + (size_t)(32 * nb) * 512 + 64 * kb, 512, scr, F.lane); continue; } r -= I_E;
        if (r < I_F) { const int kb = r / 32, nb = r % 32; transpose_item(F.w_o + (size_t)(64 * kb) * 1024 + 32 * nb, 1024, F.WO + (size_t)(32 * nb) * 1024 + 64 * kb, 1024, scr, F.lane); continue; } r -= I_F;
        if (r < I_G + I_H) { const int up = r >= I_G; if (up) r -= I_G; const int e = r >> 8, rr = r & 255, kb = rr >> 4, nb = rr & 15, n0 = 32 * nb, pn = n0 >> 7, q = n0 & 127;
            const float* src = (up ? F.w_up : F.w_gate) + (size_t)e * 1024 * 512 + (size_t)(64 * kb) * 512 + n0;
            transpose_item(src, 512, F.WGU + (size_t)e * 1024 * 1024 + (size_t)(pn * 256 + up * 128 + q) * 1024 + 64 * kb, 1024, scr, F.lane); continue; } r -= I_G + I_H;
        { const int e = r >> 8, rr = r & 255, kb = rr >> 5, nb = rr & 31;
            transpose_item(F.w_down + (size_t)e * 512 * 1024 + (size_t)(64 * kb) * 1024 + 32 * nb, 1024, F.WD + (size_t)e * 1024 * 512 + (size_t)(32 * nb) * 512 + 64 * kb, 512, scr, F.lane); }
    }
}

__device__ __forceinline__ void p1_rows(Frame& F) {
    LAS float* wfT = (LAS float*)(F.lds);
    for (int idx = F.tid; idx < 8192; idx += 512) { const int k = idx >> 3, j = idx & 7; wfT[j * 1024 + k] = F.w_in[(size_t)k * INC + 1536 + j]; }
    __syncthreads();
    const int gw = F.vcu * NWAVES + F.wave, NGW = F.G * NWAVES;
    for (int ch = gw; ch < M / 8; ch += NGW) {
        const int b = (ch * 8) / SEQ;
        const float* mod = F.MOD + b * 6144;
        f32x4 es[4], sh[4];
#pragma unroll
        for (int j = 0; j < 4; ++j) { const int c = 4 * F.lane + 256 * j; const f32x4 g4 = *(const f32x4*)(F.norm_mix_g + c), sc = *(const f32x4*)(mod + 1024 + c); es[j] = g4 * (sc + 1.f); sh[j] = *(const f32x4*)(mod + c); }
        for (int r = 0; r < 8; ++r) {
            const int m = ch * 8 + r;
            const GAS f32x4* xr = (const GAS f32x4*)(F.x + (size_t)m * D) + F.lane;
            f32x4 v[4]; float ss = 0.f;
#pragma unroll
            for (int j = 0; j < 4; ++j) { v[j] = xr[64 * j]; ss += (v[j].x * v[j].x + v[j].y * v[j].y) + (v[j].z * v[j].z + v[j].w * v[j].w); }
            const float rstd = 1.f / sqrtf(wave_sum(ss) * (1.f / D) + RMS_EPS);
            GAS v2u* o8 = (GAS v2u*)(F.H + (size_t)m * D) + F.lane;
#pragma unroll
            for (int j = 0; j < 4; ++j) { v[j] = v[j] * rstd * es[j] + sh[j]; v2u w; w.x = pk2(v[j].x, v[j].y); w.y = pk2(v[j].z, v[j].w); o8[64 * j] = w; }
            float f[8];
#pragma unroll
            for (int jj = 0; jj < 8; ++jj) { float a = 0.f;
#pragma unroll
                for (int j = 0; j < 4; ++j) { const f32x4 w4 = *(const LAS f32x4*)(wfT + jj * 1024 + 4 * F.lane + 256 * j); a += (v[j].x * w4.x + v[j].y * w4.y) + (v[j].z * w4.z + v[j].w * w4.w); }
                f[jj] = wave_sum(a); }
            if (F.lane < 8) {
                float z = f[0];
#pragma unroll
                for (int jj = 1; jj < 8; ++jj) z = (F.lane == jj) ? f[jj] : z;
                z += F.b_forget[F.lane];
                F.LOGF[(size_t)m * 8 + F.lane] = fminf(z, 0.f) - log1pf(expf(-fabsf(z)));
            }
        }
    }
}

__device__ __forceinline__ void p2_cumscan(Frame& F) {
    const int gw = F.wave * F.G + F.vcu, NGW = F.G * NWAVES;
    for (int u = gw; u < NB * NH; u += NGW) {
        const int b = u >> 3, h = u & 7;
        float v[32]; float run = 0.f;
#pragma unroll
        for (int i = 0; i < 32; ++i) { run += F.LOGF[((size_t)b * SEQ + 32 * F.lane + i) * 8 + h]; v[i] = run; }
        float incl = run;
#pragma unroll
        for (int o = 1; o < 64; o <<= 1) { const float t = __shfl_up(incl, o); if (F.lane >= o) incl += t; }
        const float excl = incl - run;
#pragma unroll
        for (int i = 0; i < 32; ++i) F.CUM[(size_t)u * SEQ + 32 * F.lane + i] = v[i] + excl;
    }
}

using pg8::Unit;
struct EpiInProj {
    static constexpr bool PERM = true;
    bf16* mix;
    __device__ __forceinline__ void operator()(const f32x4 (&acc)[2][2][4][2], const Unit& u, int wr, int wc, int fr, int fq) const {
        const int pn = u.pn; bf16* base; int ldc, colt, mode;
        if (pn < 8) { base = mix + (size_t)(pn >> 1) * ((size_t)M * 512); ldc = 512; colt = (pn & 1) * 256; mode = pn < 2 ? 1 : 0; }
        else { const int g = (pn - 8) >> 2; base = mix + (size_t)4 * M * 512 + (size_t)g * ((size_t)M * 1024); ldc = 1024; colt = ((pn - 8) & 3) * 256; mode = 2; }
        const int row0 = u.pm * 256 + wr * 64 + fr, col0 = colt + wc * 32 + 8 * fq;
#pragma unroll
        for (int ai = 0; ai < 2; ++ai)
#pragma unroll
            for (int m = 0; m < 4; ++m) { bf16* rowp = base + (size_t)(row0 + ai * 128 + m * 16) * ldc + col0;
#pragma unroll
                for (int bj = 0; bj < 2; ++bj) { f32x4 v0 = acc[ai][bj][m][0], v1 = acc[ai][bj][m][1];
                    if (mode == 1) { v0 = v0 * QSCALE; v1 = v1 * QSCALE; }
                    else if (mode == 2) {
#pragma unroll
                        for (int e = 0; e < 4; ++e) { v0[e] = fast_sigmoid(v0[e]); v1[e] = fast_sigmoid(v1[e]); } }
                    v4u w; w.x = pg8::cvt_pk_bf16(v0[0], v0[1]); w.y = pg8::cvt_pk_bf16(v0[2], v0[3]); w.z = pg8::cvt_pk_bf16(v1[0], v1[1]); w.w = pg8::cvt_pk_bf16(v1[2], v1[3]);
                    *(v4u*)(rowp + bj * 128) = w; } }
    }
};
template <int MODE> struct EpiGate {
    static constexpr bool PERM = true;
    bf16* T; const bf16* Gt;
    __device__ __forceinline__ void operator()(const f32x4 (&acc)[2][2][4][2], const Unit& u, int wr, int wc, int fr, int fq) const {
        const int row0 = u.pm * 256 + wr * 64 + fr, col0 = u.pn * 256 + wc * 32 + 8 * fq;
#pragma unroll
        for (int ai = 0; ai < 2; ++ai)
#pragma unroll
            for (int m = 0; m < 4; ++m) { const size_t off = (size_t)(row0 + ai * 128 + m * 16) * 1024 + col0;
#pragma unroll
                for (int bj = 0; bj < 2; ++bj) { const f32x4 v0 = acc[ai][bj][m][0], v1 = acc[ai][bj][m][1];
                    const v4u t = *(const v4u*)(T + off + bj * 128); v4u w;
                    if (MODE == 0) {
                        w.x = pg8::cvt_pk_bf16(bflo(t.x) * v0[0], bfhi(t.x) * v0[1]); w.y = pg8::cvt_pk_bf16(bflo(t.y) * v0[2], bfhi(t.y) * v0[3]);
                        w.z = pg8::cvt_pk_bf16(bflo(t.z) * v1[0], bfhi(t.z) * v1[1]); w.w = pg8::cvt_pk_bf16(bflo(t.w) * v1[2], bfhi(t.w) * v1[3]);
                    } else {
                        const v4u gg = *(const v4u*)(Gt + off + bj * 128);
                        w.x = pg8::cvt_pk_bf16(bflo(t.x) + bflo(gg.x) * v0[0], bfhi(t.x) + bfhi(gg.x) * v0[1]); w.y = pg8::cvt_pk_bf16(bflo(t.y) + bflo(gg.y) * v0[2], bfhi(t.y) + bfhi(gg.y) * v0[3]);
                        w.z = pg8::cvt_pk_bf16(bflo(t.z) + bflo(gg.z) * v1[0], bfhi(t.z) + bfhi(gg.z) * v1[1]); w.w = pg8::cvt_pk_bf16(bflo(t.w) + bflo(gg.w) * v1[2], bfhi(t.w) + bfhi(gg.w) * v1[3]);
                    }
                    *(v4u*)(T + off + bj * 128) = w; } }
    }
};
template <int MODE> struct EpiPair {
    static constexpr bool PERM = true;
    bf16* O;
    __device__ __forceinline__ void operator()(const f32x4 (&acc)[2][2][4][2], const Unit& u, int wr, int wc, int fr, int fq) const {
        const int row0 = u.pm * 256 + wr * 64 + fr, col0 = u.pn * 128 + wc * 32 + 8 * fq;
#pragma unroll
        for (int ai = 0; ai < 2; ++ai)
#pragma unroll
            for (int m = 0; m < 4; ++m) { f32x4 r0, r1;
#pragma unroll
                for (int e = 0; e < 4; ++e) {
                    if (MODE == 0) { r0[e] = acc[ai][0][m][0][e] * fast_sigmoid(acc[ai][1][m][0][e]); r1[e] = acc[ai][0][m][1][e] * fast_sigmoid(acc[ai][1][m][1][e]); }
                    else { const float g0 = acc[ai][0][m][0][e], g1 = acc[ai][0][m][1][e]; r0[e] = g0 * fast_sigmoid(g0) * acc[ai][1][m][0][e]; r1[e] = g1 * fast_sigmoid(g1) * acc[ai][1][m][1][e]; } }
                v4u w; w.x = pg8::cvt_pk_bf16(r0[0], r0[1]); w.y = pg8::cvt_pk_bf16(r0[2], r0[3]); w.z = pg8::cvt_pk_bf16(r1[0], r1[1]); w.w = pg8::cvt_pk_bf16(r1[2], r1[3]);
                *(v4u*)(O + (size_t)(row0 + ai * 128 + m * 16) * 512 + col0) = w; }
    }
};
struct EpiResid {
    static constexpr bool PERM = false;
    const float* x; float* out; const float* mod;
    __device__ __forceinline__ void operator()(const f32x4 (&acc)[2][2][4][2], const Unit& u, int wr, int wc, int fr, int fq) const {
        const int row0 = u.pm * 256 + wr * 64 + fr, col0 = u.pn * 256 + wc * 32 + 4 * fq;
        const int b = (u.pm * 256) / SEQ;
        f32x4 gv[2][2];
#pragma unroll
        for (int bj = 0; bj < 2; ++bj)
#pragma unroll
            for (int n = 0; n < 2; ++n) gv[bj][n] = *(const f32x4*)(mod + (size_t)b * 6144 + 2048 + col0 + bj * 128 + n * 16);
#pragma unroll
        for (int ai = 0; ai < 2; ++ai)
#pragma unroll
            for (int m = 0; m < 4; ++m) { const size_t off = (size_t)(row0 + ai * 128 + m * 16) * 1024 + col0;
#pragma unroll
                for (int bj = 0; bj < 2; ++bj)
#pragma unroll
                    for (int n = 0; n < 2; ++n) { const f32x4 xv = *(const f32x4*)(x + off + bj * 128 + n * 16); *(f32x4*)(out + off + bj * 128 + n * 16) = xv + gv[bj][n] * acc[ai][bj][m][n]; } }
    }
};
struct EpiDown {
    static constexpr bool PERM = true;
    bf16* Y; const unsigned* list; const float* rw;
    __device__ __forceinline__ void operator()(const f32x4 (&acc)[2][2][4][2], const Unit& u, int wr, int wc, int fr, int fq) const {
        const int col0 = u.pn * 256 + wc * 32 + 8 * fq;
#pragma unroll
        for (int ai = 0; ai < 2; ++ai)
#pragma unroll
            for (int m = 0; m < 4; ++m) { const int r = ai * 128 + wr * 64 + m * 16 + fr;
                if (r < u.rows) { const unsigned aid = list[u.lbase + r]; const float wgt = rw[aid]; bf16* rowp = Y + (size_t)aid * 1024 + col0;
#pragma unroll
                    for (int bj = 0; bj < 2; ++bj) { const f32x4 v0 = acc[ai][bj][m][0] * wgt, v1 = acc[ai][bj][m][1] * wgt;
                        v4u w; w.x = pg8::cvt_pk_bf16(v0[0], v0[1]); w.y = pg8::cvt_pk_bf16(v0[2], v0[3]); w.z = pg8::cvt_pk_bf16(v1[0], v1[1]); w.w = pg8::cvt_pk_bf16(v1[2], v1[3]);
                        *(v4u*)(rowp + bj * 128) = w; } } }
    }
};

template <bool GATHER_> struct MoeOrder {
    static constexpr bool GATHER = GATHER_;
    int G, c, nunits; const LAS int* tab; const unsigned* list; size_t estride; int bK;
    __device__ __forceinline__ bool next(int i, Unit& u) const {
        const int L = i * G + c; if (L >= nunits) return false;
        const int mt = L >> 2; u.pn = L & 3; int e = 0;
        while (e < NE - 1 && mt >= tab[e + 1]) ++e;
        const int j = mt - tab[e]; u.e = e; u.pm = mt; u.lbase = e * CAP + j * 256; const int left = tab[33 + e] - j * 256; u.rows = left < 256 ? left : 256; return true;
    }
    __device__ __forceinline__ size_t a_base(const Unit& u, int K) const { return GATHER ? (size_t)0 : (size_t)u.pm * 256 * K * 2; }
    __device__ __forceinline__ size_t b_base(const Unit& u, int K) const { return (size_t)u.e * estride + (size_t)u.pn * 256 * K * 2; }
    __device__ __forceinline__ void a_offsets(const Unit& u, const int* Rr, const int* Cc, int K, unsigned (&vo)[2][2]) const {
#pragma unroll
        for (int h = 0; h < 2; ++h)
#pragma unroll
            for (int i = 0; i < 2; ++i) { const int r = h * 128 + Rr[i]; const unsigned aid = list[u.lbase + (r < u.rows ? r : 0)]; vo[h][i] = (unsigned)((aid >> 1) * (unsigned)K + (unsigned)Cc[i]) * 2u; }
    }
};
__device__ __forceinline__ int moe_tables(Frame& F) {
    LAS int* tab = (LAS int*)(F.lds + MOE_OFF);
    if (F.tid == 0) { int acc = 0;
        for (int e = 0; e < NE; ++e) { const int c = (int)F.ctl[CW_CNT + 64 * e]; tab[e] = acc; tab[33 + e] = c; acc += (c + 255) >> 8; }
        tab[32] = acc; }
    __syncthreads();
    return tab[32];
}

__device__ __forceinline__ void attn_simple_unit(Frame& F, int b, int h, int qblk) {
    LAS bf16* Ks = (LAS bf16*)(F.lds);
    LAS bf16* Vs = (LAS bf16*)(F.lds + 8192);
    LAS float* cs = (LAS float*)(F.lds + 16384);
    const int q = qblk * 512 + F.tid;
    const size_t rowq = (size_t)b * SEQ + q;
    float qv[64], o[64];
    { const bf16* qp = F.Q + rowq * 512 + h * 64;
#pragma unroll
      for (int i = 0; i < 8; ++i) { const v4u w = *(const v4u*)(qp + 8 * i); qv[8 * i] = bflo(w.x); qv[8 * i + 1] = bfhi(w.x); qv[8 * i + 2] = bflo(w.y); qv[8 * i + 3] = bfhi(w.y); qv[8 * i + 4] = bflo(w.z); qv[8 * i + 5] = bfhi(w.z); qv[8 * i + 6] = bflo(w.w); qv[8 * i + 7] = bfhi(w.w); } }
#pragma unroll
    for (int d = 0; d < 64; ++d) o[d] = 0.f;
    float mrun = -INFINITY, l = 0.f;
    const int ntiles = (qblk * 512 + 512) / 64;
    const int wave_tile = (qblk * 512 + F.wave * 64) / 64;
    for (int kt = 0; kt < ntiles; ++kt) {
        __syncthreads();
        { const size_t krow = (size_t)b * SEQ + kt * 64 + (F.tid >> 3); const int ch = (F.tid & 7) * 8;
          *(LAS v4u*)(Ks + (F.tid >> 3) * 64 + ch) = *(const v4u*)(F.K + krow * 512 + h * 64 + ch);
          *(LAS v4u*)(Vs + (F.tid >> 3) * 64 + ch) = *(const v4u*)(F.V + krow * 512 + h * 64 + ch);
          if (F.tid < 64) cs[F.tid] = F.CUM[(size_t)(b * NH + h) * SEQ + kt * 64 + F.tid] * LOG2E; }
        __syncthreads();
        if (kt <= wave_tile) {
#pragma unroll 1
            for (int kk = 0; kk < 64; ++kk) {
                float dot = 0.f;
#pragma unroll
                for (int c8 = 0; c8 < 8; ++c8) { const v4u w = *(const LAS v4u*)(Ks + kk * 64 + c8 * 8);
                    dot += qv[8 * c8] * bflo(w.x) + qv[8 * c8 + 1] * bfhi(w.x) + qv[8 * c8 + 2] * bflo(w.y) + qv[8 * c8 + 3] * bfhi(w.y) + qv[8 * c8 + 4] * bflo(w.z) + qv[8 * c8 + 5] * bfhi(w.z) + qv[8 * c8 + 6] * bflo(w.w) + qv[8 * c8 + 7] * bfhi(w.w); }
                const float sc = (kt * 64 + kk > q) ? -INFINITY : dot - cs[kk];
                const float mnew = fmaxf(mrun, sc);
                const float corr = (mnew > -INFINITY) ? __builtin_amdgcn_exp2f(mrun - mnew) : 1.f;
                const float p = (mnew > -INFINITY) ? __builtin_amdgcn_exp2f(sc - mnew) : 0.f;
                l = l * corr + p;
#pragma unroll
                for (int c8 = 0; c8 < 8; ++c8) { const v4u w = *(const LAS v4u*)(Vs + kk * 64 + c8 * 8);
                    o[8 * c8] = o[8 * c8] * corr + p * bflo(w.x); o[8 * c8 + 1] = o[8 * c8 + 1] * corr + p * bfhi(w.x); o[8 * c8 + 2] = o[8 * c8 + 2] * corr + p * bflo(w.y); o[8 * c8 + 3] = o[8 * c8 + 3] * corr + p * bfhi(w.y);
                    o[8 * c8 + 4] = o[8 * c8 + 4] * corr + p * bflo(w.z); o[8 * c8 + 5] = o[8 * c8 + 5] * corr + p * bfhi(w.z); o[8 * c8 + 6] = o[8 * c8 + 6] * corr + p * bflo(w.w); o[8 * c8 + 7] = o[8 * c8 + 7] * corr + p * bfhi(w.w); }
                mrun = mnew;
            }
        }
    }
    const float inv = 1.f / l;
    bf16* op = F.Q + rowq * 512 + h * 64;
#pragma unroll
    for (int i = 0; i < 8; ++i) { v4u w; w.x = pk2(o[8 * i] * inv, o[8 * i + 1] * inv); w.y = pk2(o[8 * i + 2] * inv, o[8 * i + 3] * inv); w.z = pk2(o[8 * i + 4] * inv, o[8 * i + 5] * inv); w.w = pk2(o[8 * i + 6] * inv, o[8 * i + 7] * inv); *(v4u*)(op + 8 * i) = w; }
    __syncthreads();
}

__device__ __forceinline__ float gelu_tanh(float v) { const float t = 0.7978845608028654f * (v + 0.044715f * v * v * v); return 0.5f * v * (1.f + tanhf(t)); }
__device__ __forceinline__ void ssm_simple_unit(Frame& F, int b, int g, LAS unsigned char* wl) {
    const int p = F.lane;
    LAS f32x2* xs = (LAS f32x2*)wl;
    LAS float* Cp = (LAS float*)(wl + 33280);
#pragma unroll
    for (int c = 0; c < 16; ++c) { Cp[p * 32 + c] = F.c_re[(size_t)(g * 16 + c) * 64 + p]; Cp[p * 32 + 16 + c] = F.c_im[(size_t)(g * 16 + c) * 64 + p]; }
    const float dt = expf(F.log_dt[g]);
    const float lr = fminf(F.lambda_re[g * 64 + p], -1e-4f), li = F.lambda_im[g * 64 + p];
    const float mag = expf(lr * dt), ar = mag * cosf(li * dt), ai = mag * sinf(li * dt);
    const float den = lr * lr + li * li, nr = ar - 1.f;
    const float cor = (nr * lr + ai * li) / den, coi = (ai * lr - nr * li) / den;
    float bbr[16], bbi[16];
#pragma unroll
    for (int c = 0; c < 16; ++c) { const float br = F.b_re[(size_t)(g * 64 + p) * 16 + c], bi = F.b_im[(size_t)(g * 64 + p) * 16 + c]; bbr[c] = cor * br - coi * bi; bbi[c] = cor * bi + coi * br; }
    float dsk[16];
#pragma unroll
    for (int c = 0; c < 16; ++c) dsk[c] = F.d_skip[g * 16 + c];
    LDS_WAIT(); asm volatile("" ::: "memory");
    float xr = 0.f, xi = 0.f;
    for (int t0 = 0; t0 < SEQ; t0 += 64) {
#pragma unroll 2
        for (int tt = 0; tt < 64; ++tt) {
            const bf16* up = F.U + ((size_t)b * SEQ + t0 + tt) * 512 + g * 16;
            const v4u w0 = *(const v4u*)up, w1 = *(const v4u*)(up + 8);
            float uu[16] = {bflo(w0.x), bfhi(w0.x), bflo(w0.y), bfhi(w0.y), bflo(w0.z), bfhi(w0.z), bflo(w0.w), bfhi(w0.w), bflo(w1.x), bfhi(w1.x), bflo(w1.y), bfhi(w1.y), bflo(w1.z), bfhi(w1.z), bflo(w1.w), bfhi(w1.w)};
            float bur = 0.f, bui = 0.f;
#pragma unroll
            for (int c = 0; c < 16; ++c) { bur += bbr[c] * uu[c]; bui += bbi[c] * uu[c]; }
            const float n_r = ar * xr - ai * xi + bur, n_i = ar * xi + ai * xr + bui; xr = n_r; xi = n_i;
            xs[tt * 65 + p] = (f32x2){xr, xi};
        }
        LDS_WAIT(); asm volatile("" ::: "memory");
        float y[16];
#pragma unroll
        for (int c = 0; c < 16; ++c) y[c] = 0.f;
#pragma unroll 4
        for (int pp = 0; pp < 64; ++pp) {
            const f32x2 xv = xs[F.lane * 65 + pp];
#pragma unroll
            for (int c4 = 0; c4 < 4; ++c4) { const f32x4 cr = *(const LAS f32x4*)(Cp + pp * 32 + c4 * 4), ci = *(const LAS f32x4*)(Cp + pp * 32 + 16 + c4 * 4);
                y[4 * c4] += cr.x * xv.x - ci.x * xv.y; y[4 * c4 + 1] += cr.y * xv.x - ci.y * xv.y; y[4 * c4 + 2] += cr.z * xv.x - ci.z * xv.y; y[4 * c4 + 3] += cr.w * xv.x - ci.w * xv.y; }
        }
        const size_t row = (size_t)b * SEQ + t0 + F.lane;
        const bf16* up = F.U + row * 512 + g * 16;
        const v4u w0 = *(const v4u*)up, w1 = *(const v4u*)(up + 8);
        const float uu[16] = {bflo(w0.x), bfhi(w0.x), bflo(w0.y), bfhi(w0.y), bflo(w0.z), bfhi(w0.z), bflo(w0.w), bfhi(w0.w), bflo(w1.x), bfhi(w1.x), bflo(w1.y), bfhi(w1.y), bflo(w1.z), bfhi(w1.z), bflo(w1.w), bfhi(w1.w)};
        float r[16];
#pragma unroll
        for (int c = 0; c < 16; ++c) r[c] = gelu_tanh(y[c] + dsk[c] * uu[c]);
        v4u o0, o1; o0.x = pk2(r[0], r[1]); o0.y = pk2(r[2], r[3]); o0.z = pk2(r[4], r[5]); o0.w = pk2(r[6], r[7]); o1.x = pk2(r[8], r[9]); o1.y = pk2(r[10], r[11]); o1.z = pk2(r[12], r[13]); o1.w = pk2(r[14], r[15]);
        bf16* yp = F.Y + row * 512 + g * 16; *(v4u*)yp = o0; *(v4u*)(yp + 8) = o1;
        LDS_WAIT(); asm volatile("" ::: "memory");
    }
}

__device__ __forceinline__ void p7_block(Frame& F, int blk) {
    LAS int* eL = (LAS int*)(F.lds);
    LAS unsigned* baseL = (LAS unsigned*)(F.lds + 1024);
    const int b = (blk * 64) / SEQ;
    const float* mod = F.MOD + b * 6144;
    f32x4 es[4], sh[4];
#pragma unroll
    for (int j = 0; j < 4; ++j) { const int c = 4 * F.lane + 256 * j; const f32x4 g4 = *(const f32x4*)(F.norm_ffn_g + c), sc = *(const f32x4*)(mod + 4096 + c); es[j] = g4 * (sc + 1.f); sh[j] = *(const f32x4*)(mod + 3072 + c); }
    for (int r = 0; r < 8; ++r) {
        const int rl = F.wave * 8 + r, m = blk * 64 + rl;
        const GAS f32x4* xr = (const GAS f32x4*)(F.out + (size_t)m * D) + F.lane;
        f32x4 v[4]; float ss = 0.f;
#pragma unroll
        for (int j = 0; j < 4; ++j) { v[j] = xr[64 * j]; ss += (v[j].x * v[j].x + v[j].y * v[j].y) + (v[j].z * v[j].z + v[j].w * v[j].w); }
        const float rstd = 1.f / sqrtf(wave_sum(ss) * (1.f / D) + RMS_EPS);
        GAS v2u* o8 = (GAS v2u*)(F.H + (size_t)m * D) + F.lane;
#pragma unroll
        for (int j = 0; j < 4; ++j) { v[j] = v[j] * rstd * es[j] + sh[j]; v2u w; w.x = pk2(v[j].x, v[j].y); w.y = pk2(v[j].z, v[j].w); o8[64 * j] = w; }
        float lg[4] = {0.f, 0.f, 0.f, 0.f};
#pragma unroll
        for (int j = 0; j < 4; ++j) { const int k = 4 * F.lane + 256 * j;
#pragma unroll
            for (int e = 0; e < 4; ++e) { const f32x4 w4 = *(const f32x4*)(F.w_rg + (size_t)(k + e) * 4); const float hv = v[j][e]; lg[0] += hv * w4.x; lg[1] += hv * w4.y; lg[2] += hv * w4.z; lg[3] += hv * w4.w; } }
#pragma unroll
        for (int i = 0; i < 4; ++i) lg[i] = wave_sum(lg[i]) + F.b_rg[i];
        int gi = 0; float lmax = lg[0];
#pragma unroll
        for (int i = 1; i < 4; ++i) if (lg[i] > lmax) { lmax = lg[i]; gi = i; }
        float se = 0.f;
#pragma unroll
        for (int i = 0; i < 4; ++i) se += expf(lg[i] - lmax);
        const float pg = 1.f / se;
        gi = __builtin_amdgcn_readfirstlane(gi);
        float le[8] = {0.f, 0.f, 0.f, 0.f, 0.f, 0.f, 0.f, 0.f};
#pragma unroll
        for (int j = 0; j < 4; ++j) { const int k = 4 * F.lane + 256 * j;
#pragma unroll
            for (int e = 0; e < 4; ++e) { const float* wp = F.w_rexp + (size_t)(k + e) * 32 + gi * 8; const f32x4 wa = *(const f32x4*)wp, wb = *(const f32x4*)(wp + 4); const float hv = v[j][e];
                le[0] += hv * wa.x; le[1] += hv * wa.y; le[2] += hv * wa.z; le[3] += hv * wa.w; le[4] += hv * wb.x; le[5] += hv * wb.y; le[6] += hv * wb.z; le[7] += hv * wb.w; } }
#pragma unroll
        for (int i = 0; i < 8; ++i) le[i] = wave_sum(le[i]) + F.b_rexp[gi * 8 + i];
        int i0 = 0; float v0 = le[0];
#pragma unroll
        for (int i = 1; i < 8; ++i) if (le[i] > v0) { v0 = le[i]; i0 = i; }
        int i1 = -1; float v1 = -INFINITY;
#pragma unroll
        for (int i = 0; i < 8; ++i) if (i != i0 && (i1 < 0 || le[i] > v1)) { v1 = le[i]; i1 = i; }
        const float ex = expf(v1 - v0), p0 = 1.f / (1.f + ex), p1 = ex * p0;
        if (F.lane == 0) { const int e0 = gi * 8 + i0, e1 = gi * 8 + i1; eL[2 * rl] = e0; eL[2 * rl + 1] = e1;
            F.ROUTE[(size_t)m * 2] = e0; F.ROUTE[(size_t)m * 2 + 1] = e1; F.RW[(size_t)m * 2] = pg * p0; F.RW[(size_t)m * 2 + 1] = pg * p1; }
    }
    __syncthreads();
    int e = 0, rank = 0, total = 0;
    if (F.tid < 128) { e = eL[F.tid];
        for (int a = 0; a < 128; ++a) { const int m_ = (eL[a] == e); total += m_; rank += (m_ && a < F.tid); }
        if (rank == 0) baseL[e] = __hip_atomic_fetch_add((unsigned*)(F.ctl + CW_CNT + 64 * e), (unsigned)total, RLX_AGENT); }
    __syncthreads();
    if (F.tid < 128) { const unsigned pos = baseL[e] + (unsigned)rank; F.LIST[(size_t)e * CAP + pos] = (unsigned)((blk * 64 + (F.tid >> 1)) * 2 + (F.tid & 1)); }
    __syncthreads();
}

__device__ __forceinline__ void p10_rows(Frame& F) {
    const int gw = F.vcu * NWAVES + F.wave, NGW = F.G * NWAVES;
    for (int ch = gw; ch < M / 8; ch += NGW) {
        const int b = (ch * 8) / SEQ;
        const float* mod = F.MOD + b * 6144 + 5120;
        f32x4 g2[4], fg[4];
#pragma unroll
        for (int j = 0; j < 4; ++j) { const int c = 4 * F.lane + 256 * j; g2[j] = *(const f32x4*)(mod + c); fg[j] = *(const f32x4*)(F.final_g + c); }
        for (int r = 0; r < 8; ++r) {
            const int m = ch * 8 + r;
            GAS f32x4* xr = (GAS f32x4*)(F.out + (size_t)m * D) + F.lane;
            const GAS v2u* y0 = (const GAS v2u*)(F.YROWS + (size_t)(2 * m) * D) + F.lane; const GAS v2u* y1 = (const GAS v2u*)(F.YROWS + (size_t)(2 * m + 1) * D) + F.lane;
            f32x4 v[4]; float ss = 0.f;
#pragma unroll
            for (int j = 0; j < 4; ++j) { const f32x4 xv = xr[64 * j]; const v2u a = y0[64 * j], bb = y1[64 * j];
                f32x4 yv; yv.x = bflo(a.x) + bflo(bb.x); yv.y = bfhi(a.x) + bfhi(bb.x); yv.z = bflo(a.y) + bflo(bb.y); yv.w = bfhi(a.y) + bfhi(bb.y);
                v[j] = xv + g2[j] * yv; ss += (v[j].x * v[j].x + v[j].y * v[j].y) + (v[j].z * v[j].z + v[j].w * v[j].w); }
            const float rstd = 1.f / sqrtf(wave_sum(ss) * (1.f / D) + RMS_EPS);
#pragma unroll
            for (int j = 0; j < 4; ++j) xr[64 * j] = v[j] * rstd * fg[j];
        }
    }
}

struct Args { const float* in[28]; float* out; unsigned char* ws; int ph_lo, ph_hi; };
__global__ void __launch_bounds__(NWAVES * 64, 2) fwd(Args args) {
    extern __shared__ __attribute__((aligned(16))) unsigned char lds[];
    Frame F;
    F.lds = (LAS unsigned char*)lds;
    F.MISC = (volatile LAS unsigned*)(F.lds + MISC_OFF);
    F.tid = threadIdx.x; F.lane = F.tid & 63; F.wave = __builtin_amdgcn_readfirstlane(F.tid >> 6);
    F.G = gridDim.x; { const int bx = blockIdx.x; F.vcu = (F.G % 8 == 0) ? (bx % 8) * (F.G / 8) + bx / 8 : bx; }
    unsigned char* ws = args.ws;
    F.ctl = (gu32*)(ws + WS_CTL);
    F.x = args.in[0]; F.c = args.in[1]; F.w_ada = args.in[2]; F.b_ada = args.in[3]; F.norm_mix_g = args.in[4]; F.w_in = args.in[5]; F.b_forget = args.in[6]; F.w_out_fox = args.in[7];
    F.lambda_re = args.in[8]; F.lambda_im = args.in[9]; F.log_dt = args.in[10]; F.b_re = args.in[11]; F.b_im = args.in[12]; F.c_re = args.in[13]; F.c_im = args.in[14]; F.d_skip = args.in[15];
    F.w_glu = args.in[16]; F.w_out_ssm = args.in[17]; F.w_o = args.in[18]; F.norm_ffn_g = args.in[19]; F.w_rg = args.in[20]; F.b_rg = args.in[21]; F.w_rexp = args.in[22]; F.b_rexp = args.in[23];
    F.w_gate = args.in[24]; F.w_up = args.in[25]; F.w_down = args.in[26]; F.final_g = args.in[27]; F.out = args.out;
    F.MOD = (float*)(ws + WS_MOD); F.LOGF = (float*)(ws + WS_LOGF); F.CUM = (float*)(ws + WS_CUM); F.RW = (float*)(ws + WS_RW); F.ROUTE = (int*)(ws + WS_ROUTE); F.LIST = (unsigned*)(ws + WS_LIST);
    F.WIN = (bf16*)(ws + WS_WIN); F.WGLU = (bf16*)(ws + WS_WGLU); F.WOF = (bf16*)(ws + WS_WOF); F.WOS = (bf16*)(ws + WS_WOS); F.WO = (bf16*)(ws + WS_WO); F.WGU = (bf16*)(ws + WS_WGU); F.WD = (bf16*)(ws + WS_WD);
    F.H = (bf16*)(ws + WS_H); F.Y = (bf16*)(ws + WS_Y); F.Q = (bf16*)(ws + WS_Q); F.K = (bf16*)(ws + WS_K); F.V = (bf16*)(ws + WS_V); F.U = (bf16*)(ws + WS_U); F.SGA = (bf16*)(ws + WS_SGA); F.SGB = (bf16*)(ws + WS_SGB);
    F.HID = (bf16*)(ws + WS_HID); F.YROWS = (bf16*)(ws + WS_YROWS);
    for (int u = F.tid; u < (LDS_BYTES - LDSCTL_OFF) / 4; u += NWAVES * 64) ((LAS unsigned*)(F.lds + LDSCTL_OFF))[u] = 0u;
    __syncthreads();
    XcdBarrier bar; bar.bar = (unsigned*)(F.ctl + CW_BAR); bar.x = 0; bar.st = nullptr;
    if (N_LAUNCHES == 1) bar = xcd_barrier_post((unsigned*)(F.ctl + CW_BAR), F.MISC + 8);
#define GRID_BAR() do { if (N_LAUNCHES == 1) xcd_barrier(bar); } while (0)
    const int lo = args.ph_lo, hi = args.ph_hi;
#ifndef PH_MASK
#define PH_MASK 0x7ff
#endif
#define IN(k) ((((PH_MASK) >> (k)) & 1) && lo <= (k) && (k) < hi)
#define BOTH(k) (IN(k) && IN((k) + 1))

    if (IN(0)) { p0_prologue(F); if (BOTH(0)) GRID_BAR(); }
    if (IN(1)) { p1_rows(F); if (BOTH(1)) GRID_BAR(); }
    if (IN(2)) {
        p2_cumscan(F); VM_WAIT(); __syncthreads();
        pg8::Gemm g{F.H, F.WIN, 1024}; pg8::StaticOrder S; S.init(M, 4096, F.G, (int)blockIdx.x);
        EpiInProj E{F.Q};
        pg8::gemm_phase<EpiInProj, pg8::StaticOrder, true>(F.lds + RING_OFF, g, S, E);
        if (BOTH(2)) GRID_BAR();
    }
    if (IN(3)) {
        for (int u = F.vcu; u < NB * NH * 4; u += F.G) { const int bh = u >> 2, qblk = 3 - (u & 3); attn_simple_unit(F, bh >> 3, bh & 7, qblk); }
        __syncthreads();
        if (F.wave < 3) for (int u = F.wave * F.G + F.vcu; u < NB * NG; u += 3 * F.G) ssm_simple_unit(F, u >> 5, u & 31, F.lds + F.wave * 41472);
        __syncthreads();
        if (BOTH(3)) GRID_BAR();
    }
    if (IN(4)) {
        { pg8::Gemm g{F.Q, F.WOF, 512}; pg8::StaticOrder S; S.init(M, 1024, F.G, (int)blockIdx.x); EpiGate<0> E{F.SGA, nullptr};
          pg8::gemm_phase<EpiGate<0>, pg8::StaticOrder, true>(F.lds + RING_OFF, g, S, E); }
        { pg8::Gemm g{F.Y, F.WGLU, 512}; pg8::StaticOrder S; S.init(M, 1024, F.G, (int)blockIdx.x); EpiPair<0> E{F.V};
          pg8::gemm_phase<EpiPair<0>, pg8::StaticOrder, true>(F.lds + RING_OFF, g, S, E); }
        if (BOTH(4)) GRID_BAR();
    }
    if (IN(5)) {
        pg8::Gemm g{F.V, F.WOS, 512}; pg8::StaticOrder S; S.init(M, 1024, F.G, (int)blockIdx.x); EpiGate<1> E{F.SGA, F.SGB};
        pg8::gemm_phase<EpiGate<1>, pg8::StaticOrder, true>(F.lds + RING_OFF, g, S, E);
        if (BOTH(5)) GRID_BAR();
    }
    if (IN(6)) {
        pg8::Gemm g{F.SGA, F.WO, 1024}; pg8::StaticOrder S; S.init(M, 1024, F.G, (int)blockIdx.x); EpiResid E{F.x, F.out, F.MOD};
        pg8::gemm_phase<EpiResid, pg8::StaticOrder, true>(F.lds + RING_OFF, g, S, E);
        if (BOTH(6)) GRID_BAR();
    }
    if (IN(7)) {
        for (int blk = F.vcu; blk < M / 64; blk += F.G) p7_block(F, blk);
        if (BOTH(7)) GRID_BAR();
    }
    if (IN(8)) {
        const int mt = moe_tables(F);
        MoeOrder<true> S{F.G, (int)blockIdx.x, mt * 4, (const LAS int*)(F.lds + MOE_OFF), F.LIST, (size_t)1024 * 1024 * 2, 0};
        pg8::Gemm g{F.H, F.WGU, 1024}; EpiPair<1> E{F.HID};
        pg8::gemm_phase<EpiPair<1>, MoeOrder<true>, true>(F.lds + RING_OFF, g, S, E);
        if (BOTH(8)) GRID_BAR();
    }
    if (IN(9)) {
        const int mt = moe_tables(F);
        MoeOrder<false> S{F.G, (int)blockIdx.x, mt * 4, (const LAS int*)(F.lds + MOE_OFF), F.LIST, (size_t)1024 * 512 * 2, 0};
        pg8::Gemm g{F.HID, F.WD, 512}; EpiDown E{F.YROWS, F.LIST, F.RW};
        pg8::gemm_phase<EpiDown, MoeOrder<false>, true>(F.lds + RING_OFF, g, S, E);
        if (BOTH(9)) GRID_BAR();
    }
    if (IN(10)) { p10_rows(F); }
#undef IN
#undef BOTH
}

extern "C" void kernel_launch(void* const* d_in, const int* in_sizes, int n_in, void* d_out, int out_size, void* d_ws, size_t ws_size, hipStream_t stream) {
    static int grid = 0;
    if (grid == 0) {
        if (n_in != 28 || in_sizes[0] != M * D || out_size != M * D || ws_size < WS_END) { fprintf(stderr, "kernel_launch: unexpected shapes (n_in %d, in0 %d, out %d, ws %zu); nothing launched\n", n_in, n_in > 0 ? in_sizes[0] : -1, out_size, ws_size); grid = -1; return; }
        int dev = 0, cus = 0, per_cu = 0;
        if (hipGetDevice(&dev) != hipSuccess || hipDeviceGetAttribute(&cus, hipDeviceAttributeMultiprocessorCount, dev) != hipSuccess) { grid = -1; return; }
        if (hipFuncSetAttribute((const void*)fwd, hipFuncAttributeMaxDynamicSharedMemorySize, LDS_BYTES) != hipSuccess) { fprintf(stderr, "kernel_launch: hipFuncSetAttribute failed\n"); grid = -1; return; }
        if (hipOccupancyMaxActiveBlocksPerMultiprocessor(&per_cu, (const void*)fwd, NWAVES * 64, LDS_BYTES) != hipSuccess || per_cu < 1) { fprintf(stderr, "kernel_launch: occupancy query reports %d\n", per_cu); }
        (void)hipGetLastError();
        grid = cus;
    }
    if (grid < 0) return;
    if (hipMemsetAsync((char*)d_ws + WS_CTL, 0, CTL_ZERO_BYTES, stream) != hipSuccess) return;
    Args a{};
    for (int i = 0; i < 28; ++i) a.in[i] = (const float*)d_in[i];
    a.out = (float*)d_out; a.ws = (unsigned char*)d_ws;
    for (int li = 0; li < N_LAUNCHES; ++li) {
        a.ph_lo = (N_LAUNCHES == NPH) ? li : 0; a.ph_hi = (N_LAUNCHES == NPH) ? li + 1 : NPH;
        hipLaunchKernelGGL(fwd, dim3(grid), dim3(NWAVES * 64), LDS_BYTES, stream, a);
        if (hipPeekAtLastError() != hipSuccess) { fprintf(stderr, "kernel_launch: launch %d failed\n", li); break; }
    }
}
```

```cpp
#include <hip/hip_runtime.h>
#include <cstdio>
#include <cstdint>

#ifndef MK_N_LAUNCHES
#define MK_N_LAUNCHES 1
#endif

constexpr int NB = 8, SEQ = 2048, D = 1024, M = NB * SEQ;
constexpr int NH = 8, HD = 64, FW = 512;
constexpr int SW = 512, NG = 32, NS = 64;
constexpr int INC = 4104;
constexpr int NE = 32, DE = 512;
constexpr int CAP = 16384;
constexpr float RMS_EPS = 1e-6f;
constexpr float LOG2E = 1.4426950408889634f;
constexpr float QSCALE = 0.125f * 1.4426950408889634f;

__device__ __forceinline__ int tid_opaque() { int t = (int)threadIdx.x; asm volatile("" : "+v"(t)); return t; }

namespace pg8 {
#define PG8_LAS __attribute__((address_space(3)))
typedef unsigned short bf16_t;
typedef short bf16x8 __attribute__((ext_vector_type(8)));
typedef float f32x4 __attribute__((ext_vector_type(4)));
typedef unsigned u32x4 __attribute__((ext_vector_type(4)));
constexpr int BM = 256, BK = 64, HALF = 128, HTB = HALF * BK * 2, STAGE_BYTES = 8 * HTB, NXCD = 8, WGM = 8;

__host__ __device__ __forceinline__ int lds_byte(int r, int c) { const int st = (r >> 4) * 2 + (c >> 5), rr = r & 15, cc = c & 31, ob = rr * 64 + cc * 2; return st * 1024 + (ob ^ (((ob >> 9) & 1) << 5)); }
__host__ __device__ __forceinline__ void stage_rc(int b, int& R, int& C) { const int st = b / 1024, sb = b % 1024, swz = sb ^ (((sb >> 9) & 1) << 5); R = (st >> 1) * 16 + swz / 64; C = (st & 1) * 32 + (swz % 64) / 2; }
__host__ __device__ __forceinline__ int perm32(int rho) { const int n = rho >> 4, i = rho & 15; return 8 * (i >> 2) + 4 * n + (i & 3); }

struct Unit { int pm, pn, e, rows, lbase; };
struct Gemm { const bf16_t* A; const bf16_t* Bt; int K; };

struct StaticOrder {
    static constexpr bool GATHER = false;
    int nM, nN, nwg, G, c;
    __host__ __device__ void init(int M_, int N_, int G_, int c_) { nM = M_ / BM; nN = N_ / BM; nwg = nM * nN; G = G_; c = c_; }
    __host__ __device__ bool next(int i, Unit& u) const {
        const long L = (long)i * G + c; if (L >= nwg) return false;
        int wgid = (int)L; { const int q = nwg / NXCD, r = nwg % NXCD, xcd = wgid % NXCD, off = wgid / NXCD; wgid = (xcd < r ? xcd * (q + 1) : r * (q + 1) + (xcd - r) * q) + off; }
        const int nig = WGM * nN, gid = wgid / nig, fm = gid * WGM, gsz = (nM - fm) < WGM ? (nM - fm) : WGM;
        u.pm = fm + ((wgid % nig) % gsz); u.pn = (wgid % nig) / gsz; u.e = 0; u.rows = 256; u.lbase = 0; return true;
    }
    __device__ __forceinline__ size_t a_base(const Unit& u, int K) const { return (size_t)u.pm * BM * K * 2; }
    __device__ __forceinline__ size_t b_base(const Unit& u, int K) const { return (size_t)u.pn * BM * K * 2; }
    __device__ __forceinline__ void a_offsets(const Unit&, const int*, const int*, int, unsigned (&)[2][2]) const {}
};

__device__ __forceinline__ unsigned cvt_pk_bf16(float lo, float hi) { unsigned r; asm volatile("v_cvt_pk_bf16_f32 %0, %1, %2" : "=v"(r) : "v"(lo), "v"(hi)); return r; }

template <class Epi, class Sched, bool ALIGN_EPI>
__device__ __forceinline__ void gemm_phase(PG8_LAS unsigned char* lds, const Gemm g, const Sched& S, const Epi& E) {
    constexpr bool GATHER = Sched::GATHER;
    const int tid = tid_opaque(), wid = __builtin_amdgcn_readfirstlane(tid >> 6), lane = tid & 63, wr = wid >> 2, wc = wid & 3, fr = lane & 15, fq = lane >> 4;
    const int K = g.K, nt = K / BK;
    unsigned voffB[2], voC[2][2], voN[2][2]; int Rr[2], Cc[2];
#pragma unroll
    for (int i = 0; i < 2; ++i) { int R, C; stage_rc(tid * 16 + i * 8192, R, C); Rr[i] = R; Cc[i] = C; const int Rb = Epi::PERM ? ((R & ~31) + perm32(R & 31)) : R;
        voffB[i] = (unsigned)(Rb * K + C) * 2u; }
    const size_t kstep = (size_t)(BK * 2);
    const size_t hstep = (size_t)HALF * K * 2;
    const unsigned ldsw = (unsigned)wid * 1024u;
    const int aoff = lds_byte(wr * 64 + fr, fq * 8), boff = lds_byte(wc * 32 + fr, fq * 8);
#define PG8_SA(b, h) (((b) * 2 + (h)) * HTB)
#define PG8_SB(b, h) ((4 + (b) * 2 + (h)) * HTB)
#define PG8_STAGE(bufoff, gbase, voff) do { _Pragma("unroll") for (int _i = 0; _i < 2; ++_i) \
        __builtin_amdgcn_global_load_lds((const unsigned*)((const char*)(gbase) + (voff)[_i]), (PG8_LAS unsigned*)(lds + (bufoff) + ldsw + _i * 8192), 16, 0, 0); } while (0)
#define PG8_LDA(dst, b, h) do { _Pragma("unroll") for (int m = 0; m < 4; ++m) _Pragma("unroll") for (int k = 0; k < 2; ++k) dst[m][k] = *(const PG8_LAS bf16x8*)(lds + PG8_SA(b, h) + aoff + m * 2048 + k * 1024); } while (0)
#define PG8_LDB(dst, b, h) do { _Pragma("unroll") for (int n = 0; n < 2; ++n) _Pragma("unroll") for (int k = 0; k < 2; ++k) dst[n][k] = *(const PG8_LAS bf16x8*)(lds + PG8_SB(b, h) + boff + n * 2048 + k * 1024); } while (0)
#define PG8_MMA(ai, bj, At, Bt) do { __builtin_amdgcn_s_setprio(1); _Pragma("unroll") for (int m = 0; m < 4; ++m) _Pragma("unroll") for (int n = 0; n < 2; ++n) _Pragma("unroll") for (int k = 0; k < 2; ++k) \
        acc[ai][bj][m][n] = __builtin_amdgcn_mfma_f32_16x16x32_bf16(Bt[n][k], At[m][k], acc[ai][bj][m][n], 0, 0, 0); __builtin_amdgcn_s_setprio(0); } while (0)
#define PG8_WAIT_V(n) asm volatile("s_waitcnt vmcnt(" #n ")" ::: "memory")
#define PG8_WAIT_L(n) asm volatile("s_waitcnt lgkmcnt(" #n ")" ::: "memory")
#define PG8_BAR __builtin_amdgcn_s_barrier()
#define PG8_SCHED __builtin_amdgcn_sched_barrier(0)
    Unit cur, nxt; int ui = 0;
    if (!S.next(0, cur)) return;
    f32x4 acc[2][2][4][2];
#pragma unroll
    for (int a = 0; a < 2; ++a)
#pragma unroll
        for (int b = 0; b < 2; ++b)
#pragma unroll
            for (int m = 0; m < 4; ++m)
#pragma unroll
                for (int n = 0; n < 2; ++n) acc[a][b][m][n] = (f32x4){0.f, 0.f, 0.f, 0.f};
    bf16x8 At[4][2], B0[2][2], B1[2][2];
    if constexpr (GATHER) S.a_offsets(cur, Rr, Cc, K, voC);
    else {
#pragma unroll
        for (int h = 0; h < 2; ++h)
#pragma unroll
            for (int i = 0; i < 2; ++i) voC[h][i] = (unsigned)((Rr[i] + h * HALF) * K + Cc[i]) * 2u;
    }
    const char* cA = (const char*)g.A + S.a_base(cur, K); const char* cB = (const char*)g.Bt + S.b_base(cur, K);
    PG8_STAGE(PG8_SB(0, 0), cB, voffB); PG8_STAGE(PG8_SB(0, 1), cB + hstep, voffB); PG8_STAGE(PG8_SA(0, 0), cA, voC[0]); PG8_STAGE(PG8_SA(0, 1), cA, voC[1]);
    if (wr == 1) PG8_BAR;
    PG8_WAIT_V(2); PG8_BAR;
    PG8_STAGE(PG8_SB(1, 0), cB + kstep, voffB); PG8_STAGE(PG8_SA(1, 0), cA + kstep, voC[0]); PG8_STAGE(PG8_SB(1, 1), cB + hstep + kstep, voffB);
    PG8_WAIT_V(6); PG8_BAR;
    for (;;) {
        const bool has_next = S.next(ui + 1, nxt);
        const char* nA = has_next ? (const char*)g.A + S.a_base(nxt, K) : cA; const char* nB = has_next ? (const char*)g.Bt + S.b_base(nxt, K) : cB;
        if constexpr (GATHER) {
            if (has_next) S.a_offsets(nxt, Rr, Cc, K, voN);
            else {
#pragma unroll
                for (int h = 0; h < 2; ++h)
#pragma unroll
                    for (int i = 0; i < 2; ++i) voN[h][i] = voC[h][i];
            }
        }
        for (int t = 0; t < nt; t += 2) {
            const bool last = (t == nt - 2);
            const char* a1 = cA + (size_t)(t + 1) * kstep;
            const char* a2 = last ? nA : cA + (size_t)(t + 2) * kstep; const char* b2 = last ? nB : cB + (size_t)(t + 2) * kstep;
            const char* a3 = a2 + kstep; const char* b3 = b2 + kstep;
            unsigned vo2[2][2];
#pragma unroll
            for (int h = 0; h < 2; ++h)
#pragma unroll
                for (int i = 0; i < 2; ++i) vo2[h][i] = GATHER ? (last ? voN[h][i] : voC[h][i]) : voC[h][i];
            PG8_LDB(B0, 0, 0); PG8_LDB(B1, 0, 1); PG8_SCHED; PG8_LDA(At, 0, 0); PG8_STAGE(PG8_SA(1, 1), a1, voC[1]);
            PG8_WAIT_V(8); PG8_WAIT_L(0); PG8_BAR; PG8_MMA(0, 0, At, B0); PG8_MMA(0, 1, At, B1); PG8_BAR; PG8_SCHED;
            PG8_LDA(At, 0, 1); PG8_STAGE(PG8_SB(0, 0), b2, voffB); PG8_STAGE(PG8_SB(0, 1), b2 + hstep, voffB); PG8_STAGE(PG8_SA(0, 0), a2, vo2[0]);
            PG8_WAIT_V(8); PG8_WAIT_L(0); PG8_BAR; PG8_MMA(1, 0, At, B0); PG8_MMA(1, 1, At, B1); PG8_BAR; PG8_SCHED;
            PG8_LDB(B0, 1, 0); PG8_LDB(B1, 1, 1); PG8_SCHED; PG8_LDA(At, 1, 0); PG8_STAGE(PG8_SA(0, 1), a2, vo2[1]);
            PG8_WAIT_V(8); PG8_WAIT_L(0); PG8_BAR; PG8_MMA(0, 0, At, B0); PG8_MMA(0, 1, At, B1); PG8_BAR; PG8_SCHED;
            PG8_LDA(At, 1, 1); PG8_STAGE(PG8_SB(1, 0), b3, voffB); PG8_STAGE(PG8_SB(1, 1), b3 + hstep, voffB); PG8_STAGE(PG8_SA(1, 0), a3, vo2[0]);
            PG8_WAIT_V(8); PG8_WAIT_L(0); PG8_BAR; PG8_MMA(1, 0, At, B0); PG8_MMA(1, 1, At, B1); PG8_BAR; PG8_SCHED;
        }
        if constexpr (ALIGN_EPI) { if (wr == 0) PG8_BAR; }
        E(acc, cur, wr, wc, fr, fq);
        if (!has_next) break;
#pragma unroll
        for (int a = 0; a < 2; ++a)
#pragma unroll
            for (int b = 0; b < 2; ++b)
#pragma unroll
                for (int m = 0; m < 4; ++m)
#pragma unroll
                    for (int n = 0; n < 2; ++n) acc[a][b][m][n] = (f32x4){0.f, 0.f, 0.f, 0.f};
        cur = nxt; cA = nA; cB = nB; ++ui;
        if constexpr (GATHER) {
#pragma unroll
            for (int h = 0; h < 2; ++h)
#pragma unroll
                for (int i = 0; i < 2; ++i) voC[h][i] = voN[h][i];
        }
        if constexpr (ALIGN_EPI) { if (wr == 1) PG8_BAR; }
    }
    PG8_WAIT_V(0);
    if constexpr (!ALIGN_EPI) { if (wr == 0) PG8_BAR; }
    PG8_BAR;
#undef PG8_SA
#undef PG8_SB
#undef PG8_STAGE
#undef PG8_LDA
#undef PG8_LDB
#undef PG8_MMA
#undef PG8_WAIT_V
#undef PG8_WAIT_L
#undef PG8_BAR
#undef PG8_SCHED
}
}

#include <hip/hip_bf16.h>
#include <cmath>
namespace attn_body {
using bf16=__hip_bfloat16;
using bf16x8=__attribute__((ext_vector_type(8)))short;
using s16x4=__attribute__((ext_vector_type(4)))short;
using f32x16=__attribute__((ext_vector_type(16)))float;
using u32x4=__attribute__((ext_vector_type(4)))unsigned;
using f32x4v=__attribute__((ext_vector_type(4)))float;
constexpr int BATCH=8,NHEAD=8,SEQ=2048,D=64,DM=NHEAD*D;
constexpr int NW=8,QBLK=32,QB=QBLK*NW,KVBLK=64,NQB=SEQ/QB;
constexpr int ATTN_PITCH=DM, ATTN_UNIT_ROWS=QB;
__device__ __forceinline__ int crow(int r,int hi){return (r&3)+8*(r>>2)+4*hi;}
#define SBAR() __builtin_amdgcn_sched_barrier(0)
__device__ __forceinline__ void cmask(f32x16&p0,f32x16&p1,int jb,int qrel,int hi){
  const float NEG=-INFINITY; int kb=64*jb+4*hi;
  #pragma unroll
  for(int r=0;r<16;++r){int kv=kb+(r&3)+8*(r>>2); if(kv>qrel)p0[r]=NEG; if(kv+32>qrel)p1[r]=NEG;}
}

constexpr int NSLOT=3, SLOTB=8192;
constexpr int LDS_K=0, LDS_V=NSLOT*SLOTB, LDS_WS=2*NSLOT*SLOTB, LDS_OST=LDS_WS+NW*64*4, LDS_CB=LDS_OST+NW*4096, LDS_BYTES=LDS_CB+SEQ*4;
constexpr float C2=0.125f*1.4426950408889634f;
__device__ __forceinline__ void glds16(const void*gsrc,unsigned lds_dst){unsigned keep;
  asm volatile("s_mov_b32 %0, m0\n\ts_mov_b32 m0, %2\n\ts_nop 0\n\tglobal_load_lds_dwordx4 %1, off\n\ts_mov_b32 m0, %0":"=&s"(keep):"v"(gsrc),"s"(lds_dst):"memory");}
__device__ __forceinline__ float max3f(float a,float b,float c){float r;asm("v_max3_f32 %0, %1, %2, %3":"=v"(r):"v"(a),"v"(b),"v"(c));return r;}
__device__ __forceinline__ float max2f(float a,float b){float r;asm("v_max_f32_e32 %0, %1, %2":"=v"(r):"v"(a),"v"(b));return r;}
__device__ __forceinline__ float fadd_s(float a,float b){float r;asm("v_add_f32_e32 %0, %1, %2":"=v"(r):"v"(a),"v"(b));return r;}
__device__ __forceinline__ float fsub_s(float a,float b){float r;asm("v_sub_f32_e32 %0, %1, %2":"=v"(r):"v"(a),"v"(b));return r;}
typedef float f32x2_t __attribute__((ext_vector_type(2))); typedef __bf16 bf16x2_t __attribute__((ext_vector_type(2)));
__device__ __forceinline__ unsigned cvtpk_s(float lo,float hi){f32x2_t v={lo,hi};bf16x2_t b=__builtin_convertvector(v,bf16x2_t);return __builtin_bit_cast(unsigned,b);}
#define WAIT_BAR(N) asm volatile("s_waitcnt vmcnt(" #N ") lgkmcnt(0)\n\ts_barrier":::"memory")

__device__ __forceinline__ void qkt(f32x16&p0,f32x16&p1,const char*Kslot,const bf16x8*qr,int r32,int hi){
  const char*kb=Kslot+hi*1024+r32*16;
  #pragma unroll
  for(int d0=0;d0<4;++d0){
    const bf16x8 b0=*reinterpret_cast<const bf16x8*>(kb+d0*2048);
    const bf16x8 b1=*reinterpret_cast<const bf16x8*>(kb+d0*2048+512);
    p0=__builtin_amdgcn_mfma_f32_32x32x16_bf16(b0,qr[d0],p0,0,0,0);p1=__builtin_amdgcn_mfma_f32_32x32x16_bf16(b1,qr[d0],p1,0,0,0);}
}
typedef __attribute__((address_space(3))) const char* lds_cptr;
typedef short v4i16_t __attribute__((ext_vector_type(4)));
__device__ __forceinline__ void kload8(bf16x8*kf,lds_cptr kp){
  kf[0]=*(const __attribute__((address_space(3))) bf16x8*)(kp);      kf[1]=*(const __attribute__((address_space(3))) bf16x8*)(kp+512);
  kf[2]=*(const __attribute__((address_space(3))) bf16x8*)(kp+2048); kf[3]=*(const __attribute__((address_space(3))) bf16x8*)(kp+2560);
  kf[4]=*(const __attribute__((address_space(3))) bf16x8*)(kp+4096); kf[5]=*(const __attribute__((address_space(3))) bf16x8*)(kp+4608);
  kf[6]=*(const __attribute__((address_space(3))) bf16x8*)(kp+6144); kf[7]=*(const __attribute__((address_space(3))) bf16x8*)(kp+6656);
}
__device__ __forceinline__ void kload2(bf16x8*kf,lds_cptr kp,int j){ kf[2*j]=*(const __attribute__((address_space(3))) bf16x8*)(kp+j*2048); kf[2*j+1]=*(const __attribute__((address_space(3))) bf16x8*)(kp+j*2048+512); }
__device__ __forceinline__ s16x4 vtr(lds_cptr p){ return __builtin_bit_cast(s16x4,__builtin_amdgcn_ds_read_tr16_b64_v4i16((__attribute__((address_space(3))) v4i16_t*)p)); }
__device__ __forceinline__ float rowmax(const f32x16&p0,const f32x16&p1){
  float a=max3f(p0[0],p0[1],p1[0]),b=max3f(p0[2],p0[3],p1[1]);a=max3f(a,p1[2],p1[3]);
  #pragma unroll
  for(int r=4;r<16;r+=4){a=max3f(a,p0[r],p0[r+1]);b=max3f(b,p0[r+2],p0[r+3]);a=max3f(a,p1[r],p1[r+1]);b=max3f(b,p1[r+2],p1[r+3]);}
  const float m=max2f(a,b);
  auto rr=__builtin_amdgcn_permlane32_swap(__float_as_uint(m),__float_as_uint(m),false,false);
  return max2f(__uint_as_float(rr[0]),__uint_as_float(rr[1]));
}
__device__ __forceinline__ void pv(f32x16*o,int vb,bf16x8 pa0,bf16x8 pa1,bf16x8 pa2,bf16x8 pa3){
  #pragma unroll
  for(int d0=0;d0<2;++d0){s16x4 lo[4],hi[4];
    #pragma unroll
    for(int ks=0;ks<4;++ks){
      asm volatile("ds_read_b64_tr_b16 %0,%1 offset:%c2":"=&v"(lo[ks]):"v"(vb),"i"(d0*4096+ks*1024):"memory");
      asm volatile("ds_read_b64_tr_b16 %0,%1 offset:%c2":"=&v"(hi[ks]):"v"(vb),"i"(d0*4096+ks*1024+512):"memory");}
    asm volatile("s_waitcnt lgkmcnt(0)":::"memory");SBAR();
    #define PK(k) (bf16x8){lo[k][0],lo[k][1],lo[k][2],lo[k][3],hi[k][0],hi[k][1],hi[k][2],hi[k][3]}
    o[d0]=__builtin_amdgcn_mfma_f32_32x32x16_bf16(pa0,PK(0),o[d0],0,0,0);
    o[d0]=__builtin_amdgcn_mfma_f32_32x32x16_bf16(pa1,PK(1),o[d0],0,0,0);
    o[d0]=__builtin_amdgcn_mfma_f32_32x32x16_bf16(pa2,PK(2),o[d0],0,0,0);
    o[d0]=__builtin_amdgcn_mfma_f32_32x32x16_bf16(pa3,PK(3),o[d0],0,0,0);
    #undef PK
  }
}

#ifndef ATTN_STORE16
#define ATTN_STORE16(p,v) (*(u32x4*)(p)=(v))
#endif
template<int THRL> __device__ __forceinline__ void attn_unit(int b,int h,int qb,const bf16*Q,const bf16*__restrict__ K,const bf16*__restrict__ V,bf16*O,const float*__restrict__ CB,char*shm){
  const int tid=tid_opaque(),lane=tid&63,r32=lane&31,hi=lane>>5; const int wid=__builtin_amdgcn_readfirstlane(tid>>6);
  const long rowbase=(long)b*SEQ; const int q0=qb*QB;
  const bf16*Qw=Q+(rowbase+q0+wid*QBLK)*DM+h*D;
  const bf16*Kh=K+rowbase*DM+h*D,*Vh=V+rowbase*DM+h*D;
  const lds_cptr shm3=(lds_cptr)shm;
  const unsigned lds0=(unsigned)(uintptr_t)shm;
  float*wsf=(float*)(shm+LDS_WS)+wid*64;
  const bf16*ksrc=Kh+(long)lane*DM+wid*8;
  const bf16*vsrc=Vh+(long)(16*(wid&3)+(lane>>2))*DM+(wid>>2)*32+(lane&3)*8;
  const unsigned kdst=lds0+LDS_K+wid*1024, vdst=lds0+LDS_V+wid*1024;
  #define DMA_K(t,slot) glds16(ksrc+(long)(t)*KVBLK*DM,(unsigned)__builtin_amdgcn_readfirstlane(kdst+(slot)))
  #define DMA_V(t,slot) glds16(vsrc+(long)(t)*KVBLK*DM,(unsigned)__builtin_amdgcn_readfirstlane(vdst+(slot)))
  const int vb0=(int)(lds0+LDS_V)+((lane>>4)&1)*32+(lane&3)*8+(4*hi+((lane&15)>>2))*64;
  const char*Kbase=shm+LDS_K; bf16x8 kf[8];
  const lds_cptr kp0=shm3+LDS_K+hi*1024+r32*16; const lds_cptr vp0=shm3+LDS_V+((lane>>4)&1)*32+(lane&3)*8+(4*hi+((lane&15)>>2))*64;
  const int NT=(q0+QB)/KVBLK;
  typedef __attribute__((address_space(3))) const f32x4v* lds_cf4; const lds_cf4 cb4=(lds_cf4)(shm3+LDS_CB)+hi;
  { __attribute__((address_space(3))) float* cbw=(__attribute__((address_space(3))) float*)(shm3+LDS_CB); for(int i=tid;i<q0+QB;i+=NW*64)cbw[i]=CB[i]*1.4426950408889634f; }
  #define CINIT1(C,t,o_) do{ _Pragma("unroll") for(int g_=0;g_<4;++g_){ const f32x4v a_=cb4[(t)*16+2*g_+(o_)]; \
      C[4*g_]=nm-a_[0]; C[4*g_+1]=nm-a_[1]; C[4*g_+2]=nm-a_[2]; C[4*g_+3]=nm-a_[3]; } }while(0)
  #define CINIT(C0,C1,t) do{ CINIT1(C0,t,0); CINIT1(C1,t,8); }while(0)
  DMA_K(0,0);DMA_V(0,0);DMA_K(1,SLOTB);
  bf16x8 qr[4];
  #pragma unroll
  for(int d0=0;d0<4;++d0)qr[d0]=*reinterpret_cast<const bf16x8*>(&Qw[(long)r32*DM+d0*16+hi*8]);
  float l_reg=0.f,nm=0.f;f32x16 o[2];o[0]=f32x16{};o[1]=f32x16{};
  const int qrel=wid*QBLK+r32;
  #define CMASK(P0,P1,t) do{int jb_=(t)-(NT-4); if(jb_>=0)cmask(P0,P1,jb_,qrel,hi);}while(0)
  bool resc=false;
  #define START(P0,P1) do{ const float rm=rowmax(P0,P1); resc=false; \
    { const float dl=rm; nm=fsub_s(nm,dl); \
      _Pragma("unroll") for(int r=0;r<16;++r){P0[r]=fsub_s(P0[r],dl);P1[r]=fsub_s(P1[r],dl);} \
      } \
    _Pragma("unroll") for(int r=0;r<16;++r)P0[r]=__builtin_amdgcn_exp2f(P0[r]); }while(0)
  #define RESC() do{ if(resc){ asm volatile("s_waitcnt lgkmcnt(0)":::"memory"); \
      _Pragma("unroll") for(int d_=0;d_<2;++d_) _Pragma("unroll") for(int r=0;r<16;++r)o[d_][r]*=wsf[crow(r,hi)]; } }while(0)
  f32x16 pA0,pA1,pB0,pB1;
  int sl_prev=0,sl_cur=0,sl_next=SLOTB;
  #define ROT() do{sl_prev=sl_cur;sl_cur=sl_next;sl_next=(sl_next==(NSLOT-1)*SLOTB)?0:sl_next+SLOTB;}while(0)
  DMA_K(2,2*SLOTB);
  WAIT_BAR(3);
  CINIT(pA0,pA1,0); qkt(pA0,pA1,Kbase,qr,r32,hi);asm volatile("s_nop 15\n\ts_nop 7":"+v"(pA0),"+v"(pA1));CMASK(pA0,pA1,0);
  START(pA0,pA1);
  _Pragma("unroll") for(int r=0;r<16;++r)pA1[r]=__builtin_amdgcn_exp2f(pA1[r]);
  WAIT_BAR(0);
  DMA_K(3,0);DMA_V(1,SLOTB);
  ROT();
  kload8(kf,kp0+sl_cur);
  WAIT_BAR(2);
  s16x4 vlo[8],vhi[8]; u32x4 pw0,pw1,pw2,pw3;
  #define PKW(P,B) cvtpk_s(P[B],P[B+1])
  #define PAF(k) __builtin_bit_cast(bf16x8,pw##k)
  #define VFR(i) (bf16x8){vlo[i][0],vlo[i][1],vlo[i][2],vlo[i][3],vhi[i][0],vhi[i][1],vhi[i][2],vhi[i][3]}
  #define PIN(x) asm volatile("":"+v"(x))
  #define MX3(a,b,c) __builtin_fmaxf(__builtin_fmaxf((a),(b)),(c))
  #define GAPA(MF,A0,A1,A2,A3,W0,W1,PW) do{ MF; sacc+=A0; sacc+=A1; sacc+=A2; sacc+=A3; PIN(sacc); W0; W1; PIN(PW); SBAR(); }while(0)
  #define EX(v) __builtin_amdgcn_exp2f(v)
  #define GAPB(MF,X,B) do{ MF; X[B]=EX(X[B]); X[B+1]=EX(X[B+1]); X[B+2]=EX(X[B+2]); X[B+3]=EX(X[B+3]); PIN(X); SBAR(); }while(0)
  #define VRD(i) do{ vlo[i]=vtr(vp_+(((i)>>2)*4096+((i)&3)*1024)); vhi[i]=vtr(vp_+(((i)>>2)*4096+((i)&3)*1024+512)); }while(0)
  #define KRD(G,j) do{ if(G){ kload2(kf,kp0+sl_next,j); SBAR(); } }while(0)
  #define STEP(C0,C1,P0,P1,t,GK,GV,GL) do{ SBAR(); \
    const lds_cptr vp_=vp0+sl_prev; \
    CINIT1(C0,t,0); SBAR(); \
    VRD(0); SBAR(); float sacc=(P0[0]+P0[1]); \
    GAPA(C0=__builtin_amdgcn_mfma_f32_32x32x16_bf16(kf[0],qr[0],C0,0,0,0), P0[2],P0[3],P0[4],P0[5],     pw0[0]=PKW(P0,0), pw0[1]=PKW(P0,2), pw0); \
    CINIT1(C1,t,8); SBAR(); VRD(4); SBAR(); GAPA(C1=__builtin_amdgcn_mfma_f32_32x32x16_bf16(kf[1],qr[0],C1,0,0,0), P0[6],P0[7],P0[8],P0[9],     pw0[2]=PKW(P0,4), pw0[3]=PKW(P0,6), pw0); \
    VRD(1); SBAR(); GAPA(C0=__builtin_amdgcn_mfma_f32_32x32x16_bf16(kf[2],qr[1],C0,0,0,0),   P0[10],P0[11],P0[12],P0[13], pw1[0]=PKW(P0,8), pw1[1]=PKW(P0,10), pw1); \
    VRD(5); SBAR(); GAPA(C1=__builtin_amdgcn_mfma_f32_32x32x16_bf16(kf[3],qr[1],C1,0,0,0),   P0[14],P0[15],P1[0],P1[1],   pw1[2]=PKW(P0,12),pw1[3]=PKW(P0,14), pw1); \
    VRD(2); SBAR(); GAPA(C0=__builtin_amdgcn_mfma_f32_32x32x16_bf16(kf[4],qr[2],C0,0,0,0),   P1[2],P1[3],P1[4],P1[5],     pw2[0]=PKW(P1,0), pw2[1]=PKW(P1,2), pw2); \
    VRD(6); SBAR(); GAPA(C1=__builtin_amdgcn_mfma_f32_32x32x16_bf16(kf[5],qr[2],C1,0,0,0),   P1[6],P1[7],P1[8],P1[9],     pw2[2]=PKW(P1,4), pw2[3]=PKW(P1,6), pw2); \
    VRD(3); SBAR(); GAPA(C0=__builtin_amdgcn_mfma_f32_32x32x16_bf16(kf[6],qr[3],C0,0,0,0),   P1[10],P1[11],P1[12],P1[13], pw3[0]=PKW(P1,8), pw3[1]=PKW(P1,10), pw3); \
    VRD(7); SBAR(); GAPA(C1=__builtin_amdgcn_mfma_f32_32x32x16_bf16(kf[7],qr[3],C1,0,0,0),   P1[14],P1[15],0.f,0.f,       pw3[2]=PKW(P1,12),pw3[3]=PKW(P1,14), pw3); \
    l_reg+=sacc; \
    if(GK){DMA_K((t)+3,sl_cur);} if(GV){DMA_V((t)+1,sl_next);} \
    CMASK(C0,C1,t); \
    { float a=MX3(C0[0],C0[1],C1[0]),b=MX3(C0[2],C0[3],C1[1]); a=MX3(a,C1[2],C1[3]); \
      _Pragma("unroll") for(int r=4;r<16;r+=4){a=MX3(a,C0[r],C0[r+1]);b=MX3(b,C0[r+2],C0[r+3]);a=MX3(a,C1[r],C1[r+1]);b=MX3(b,C1[r+2],C1[r+3]);} \
      float rm=__builtin_fmaxf(a,b); { auto rr=__builtin_amdgcn_permlane32_swap(__float_as_uint(rm),__float_as_uint(rm),false,false); rm=__builtin_fmaxf(__uint_as_float(rr[0]),__uint_as_float(rr[1])); } \
      resc=false; \
      if(__builtin_expect(__any(rm>(float)THRL),0)){ const float dl=__builtin_fmaxf(rm,0.f); nm-=dl; \
        _Pragma("unroll") for(int r=0;r<16;++r){C0[r]-=dl;C1[r]-=dl;} \
        const float f=__builtin_amdgcn_exp2f(-dl); l_reg*=f; if(hi==0)wsf[r32]=f; resc=true; } } \
    SBAR(); \
    GAPB(o[0]=__builtin_amdgcn_mfma_f32_32x32x16_bf16(PAF(0),VFR(0),o[0],0,0,0), C0,0); \
    GAPB(o[1]=__builtin_amdgcn_mfma_f32_32x32x16_bf16(PAF(0),VFR(4),o[1],0,0,0), C0,4); \
    KRD(GL,0); GAPB(o[0]=__builtin_amdgcn_mfma_f32_32x32x16_bf16(PAF(1),VFR(1),o[0],0,0,0), C0,8); \
    KRD(GL,1); GAPB(o[1]=__builtin_amdgcn_mfma_f32_32x32x16_bf16(PAF(1),VFR(5),o[1],0,0,0), C0,12); \
    KRD(GL,2); GAPB(o[0]=__builtin_amdgcn_mfma_f32_32x32x16_bf16(PAF(2),VFR(2),o[0],0,0,0), C1,0); \
    KRD(GL,3); GAPB(o[1]=__builtin_amdgcn_mfma_f32_32x32x16_bf16(PAF(2),VFR(6),o[1],0,0,0), C1,4); \
    GAPB(o[0]=__builtin_amdgcn_mfma_f32_32x32x16_bf16(PAF(3),VFR(3),o[0],0,0,0), C1,8); \
    GAPB(o[1]=__builtin_amdgcn_mfma_f32_32x32x16_bf16(PAF(3),VFR(7),o[1],0,0,0), C1,12); \
    }while(0)
  int t=1;
  #undef CMASK
  #define CMASK(P0,P1,t) do{}while(0)
  for(;t+5<NT;t+=2){
    STEP(pB0,pB1,pA0,pA1,t,true,true,true);     WAIT_BAR(2); RESC(); ROT();
    STEP(pA0,pA1,pB0,pB1,t+1,true,true,true);   WAIT_BAR(2); RESC(); ROT();
  }
  #undef CMASK
  #define CMASK(P0,P1,t) do{int jb_=(t)-(NT-4); if(jb_>=0)cmask(P0,P1,jb_,qrel,hi);}while(0)
  #define ENDW(tt) do{ if((tt)+3<NT){WAIT_BAR(2);} else if((tt)+2<NT){WAIT_BAR(1);} else {WAIT_BAR(0);} }while(0)
  for(;t+1<NT;t+=2){
    STEP(pB0,pB1,pA0,pA1,t,(t+3<NT),(t+1<NT),(t+1<NT));       ENDW(t);   RESC(); ROT();
    STEP(pA0,pA1,pB0,pB1,t+1,(t+4<NT),(t+2<NT),(t+2<NT));     ENDW(t+1); RESC(); ROT();
  }
  STEP(pB0,pB1,pA0,pA1,NT-1,false,false,false); RESC();
  { float sacc=pB0[0]+pB0[1]; _Pragma("unroll") for(int r=2;r<16;++r)sacc+=pB0[r]; _Pragma("unroll") for(int r=0;r<16;++r)sacc+=pB1[r]; l_reg+=sacc;
    pw0=(u32x4){PKW(pB0,0),PKW(pB0,2),PKW(pB0,4),PKW(pB0,6)};pw1=(u32x4){PKW(pB0,8),PKW(pB0,10),PKW(pB0,12),PKW(pB0,14)};pw2=(u32x4){PKW(pB1,0),PKW(pB1,2),PKW(pB1,4),PKW(pB1,6)};pw3=(u32x4){PKW(pB1,8),PKW(pB1,10),PKW(pB1,12),PKW(pB1,14)};
    SBAR(); pv(o,vb0+sl_cur,PAF(0),PAF(1),PAF(2),PAF(3)); }
  #undef PKW
  #undef PAF
  #undef VFR
  #undef PIN
  #undef MX3
  #undef GAPA
  #undef GAPB
  #undef EX
  #undef VRD
  #undef KRD
  #undef STEP
  #undef ENDW
  {auto rr=__builtin_amdgcn_permlane32_swap(__float_as_uint(l_reg),__float_as_uint(l_reg),false,false);l_reg=__uint_as_float(rr[0])+__uint_as_float(rr[1]);}
  if(hi==0)wsf[32+r32]=l_reg;asm volatile("s_waitcnt lgkmcnt(0)":::"memory");
  float rli[16];
  #pragma unroll
  for(int r=0;r<16;++r)rli[r]=__builtin_amdgcn_rcpf(wsf[32+crow(r,hi)]);
  bf16*Ow=O+(rowbase+q0+wid*QBLK)*DM+h*D;
  { bf16*stg=(bf16*)(shm+LDS_OST)+wid*2048;
    #pragma unroll
    for(int r=0;r<16;++r){const int orow=crow(r,hi);
      #pragma unroll
      for(int d0=0;d0<2;++d0)stg[orow*64+d0*32+r32]=__float2bfloat16(o[d0][r]*rli[r]);}
    asm volatile("s_waitcnt lgkmcnt(0)":::"memory");
    #pragma unroll
    for(int i=0;i<4;++i){const int row=i*8+(lane>>3),ch=lane&7; const u32x4 v=*(const u32x4*)(stg+row*64+ch*8); ATTN_STORE16(Ow+(long)row*DM+ch*8,v);} }
  asm volatile("s_waitcnt lgkmcnt(0)\n\ts_barrier":::"memory");
  #undef DMA_K
  #undef DMA_V
  #undef CMASK
  #undef START
  #undef RESC
  #undef ROT
  #undef CINIT
  #undef CINIT1
}
constexpr int ATTN_LDS_BYTES=LDS_BYTES;
struct AttnTensors { const bf16* Q; const bf16* K; const bf16* V; bf16* O; const float* CB; };
struct AttnUnit { int bh; int qb; };
struct StaticOrder {
  int vcu, G;
  __device__ __forceinline__ StaticOrder(int grid,int v):vcu(v),G(grid){}
  __device__ __forceinline__ bool next(int i,AttnUnit&u)const{
    if(G==256){ if(i>=2)return false; const int s=vcu&3; u.bh=vcu>>2; u.qb=(i==0)?7-s:s; return true; }
    const int L=i*G+vcu; if(L>=BATCH*NHEAD*NQB)return false; u.bh=L>>3; u.qb=7-(L&7); return true; }
  __device__ __forceinline__ void a_ready(const AttnUnit&)const{}
  __device__ __forceinline__ void done(const AttnUnit&)const{}
};
template<class Sched,int THRL=8> __device__ __forceinline__ void attn_phase(char*lds,const AttnTensors&T,const Sched&S){
  AttnUnit u;
  for(int i=0;S.next(i,u);++i){ S.a_ready(u); attn_unit<THRL>(u.bh/NHEAD,u.bh%NHEAD,u.qb,T.Q,T.K,T.V,T.O,T.CB+(long)u.bh*SEQ,lds); S.done(u); }
}
#undef SBAR
#undef WAIT_BAR
}

constexpr int NWAVES = 8;
constexpr int NPH = 11;
constexpr int N_LAUNCHES = MK_N_LAUNCHES;
static_assert(N_LAUNCHES == 1 || N_LAUNCHES == NPH, "MK_N_LAUNCHES is 1 (one launch) or NPH (one launch per phase)");

constexpr size_t MiB = 1u << 20;
constexpr size_t WS_CTL = 0, CTL_ZERO_BYTES = 1 * MiB;
constexpr size_t WS_MOD = 1 * MiB;
constexpr size_t WS_LOGF = 1 * MiB + 256 * 1024;
constexpr size_t WS_ROUTE = 2 * MiB;
constexpr size_t WS_RW = 2 * MiB + 256 * 1024;
constexpr size_t WS_CUM = 2 * MiB + 512 * 1024;
constexpr size_t WS_LIST = 3 * MiB;
constexpr size_t WS_CUMP = 5 * MiB;
constexpr size_t WS_WIN = 6 * MiB;
constexpr size_t WS_WGLU = 14 * MiB, WS_WOF = 15 * MiB, WS_WOS = 16 * MiB, WS_WO = 17 * MiB;
constexpr size_t WS_WGU = 20 * MiB;
constexpr size_t WS_WD = 84 * MiB;
constexpr size_t WS_H = 116 * MiB;
constexpr size_t WS_Y = 148 * MiB;
constexpr size_t WS_MIX = 164 * MiB;
constexpr size_t WS_Q = WS_MIX, WS_K = WS_MIX + 16 * MiB, WS_V = WS_MIX + 32 * MiB, WS_U = WS_MIX + 48 * MiB, WS_SGA = WS_MIX + 64 * MiB, WS_SGB = WS_MIX + 96 * MiB;
constexpr size_t WS_HID = WS_MIX;
constexpr size_t WS_YROWS = WS_MIX + 40 * MiB;
constexpr size_t WS_END = 292 * MiB;
static_assert(WS_YROWS + (size_t)M * 2 * 1024 * 2 <= WS_END && WS_SGB + (size_t)M * 1024 * 2 <= WS_END, "d_ws map");

constexpr int CW_TMO = 0;
constexpr int CW_CNT = 2048;
constexpr int CW_BAR = 8192;

constexpr int RING_OFF = 0, RING_BYTES = 131072;
constexpr int LDSCTL_OFF = RING_BYTES, MISC_OFF = LDSCTL_OFF + 320, MOE_OFF = LDSCTL_OFF + 1024;
constexpr int LDS_BYTES = 147456;

#define GAS __attribute__((address_space(1)))
#define LAS __attribute__((address_space(3)))
typedef unsigned short bf16;
typedef unsigned v4u __attribute__((ext_vector_type(4)));
typedef unsigned v2u __attribute__((ext_vector_type(2)));
typedef float f32x4 __attribute__((ext_vector_type(4)));
typedef float f32x2 __attribute__((ext_vector_type(2)));
typedef GAS unsigned gu32;
#define RLX_AGENT __ATOMIC_RELAXED, __HIP_MEMORY_SCOPE_AGENT
#define LDS_WAIT() asm volatile("s_waitcnt lgkmcnt(0)" ::: "memory")
#define VM_WAIT() asm volatile("s_waitcnt vmcnt(0)" ::: "memory")
__device__ __forceinline__ unsigned f2bf(float f) { unsigned u = __builtin_bit_cast(unsigned, f); return (u + 0x7fffu + ((u >> 16) & 1u)) >> 16; }
__device__ __forceinline__ unsigned pk2(float lo, float hi) { return f2bf(lo) | (f2bf(hi) << 16); }
__device__ __forceinline__ float bflo(unsigned w) { return __uint_as_float(w << 16); }
__device__ __forceinline__ float bfhi(unsigned w) { return __uint_as_float(w & 0xffff0000u); }
__device__ __forceinline__ float fast_sigmoid(float v) { return __builtin_amdgcn_rcpf(1.f + __builtin_amdgcn_exp2f(-LOG2E * v)); }

#define XB_TMO      128
#define XB_XCNT(j)  (256  + 64 * (j))
#define XB_XSUB(j)  (1280 + 64 * (j))
#define XB_XGEN(j)  (2304 + 64 * (j))
#define XB_TOP      3328
#define XB_TOPGEN   3392
#define XCD_BAR_WORDS 3456
#define XB_SPIN_CAP (1u << 18)
__device__ __forceinline__ unsigned xb_ld(unsigned* p)              { return __hip_atomic_load(p, __ATOMIC_RELAXED, __HIP_MEMORY_SCOPE_AGENT); }
__device__ __forceinline__ unsigned xb_add(unsigned* p, unsigned v) { return __hip_atomic_fetch_add(p, v, __ATOMIC_RELAXED, __HIP_MEMORY_SCOPE_AGENT); }
__device__ __forceinline__ unsigned xb_xcc_id() { return (unsigned)__builtin_amdgcn_s_getreg((3 << 11) | 20) & 0xFu; }
#define XB_SPIN(cond, bar) do { unsigned _sp = 0; while (cond) { __builtin_amdgcn_s_sleep(1); \
    if ((++_sp & 255u) == 0u) { if (xb_ld(&(bar)[XB_TMO])) break; if (_sp > XB_SPIN_CAP) { atomicAdd(&(bar)[XB_TMO], 1u); break; } } } } while (0)
struct XcdBarrier { unsigned* bar; unsigned x; volatile LAS unsigned* st; };
__device__ __forceinline__ XcdBarrier xcd_barrier_post(unsigned* bar, volatile LAS unsigned* st) {
    XcdBarrier b; b.bar = bar; b.x = xb_xcc_id(); b.st = st;
    if (threadIdx.x == 0) (void)xb_add(&bar[XB_XCNT(b.x)], 1u);
    return b;
}
__device__ __forceinline__ void xcd_barrier_complete(unsigned* bar, unsigned x, unsigned& nloc, unsigned& nx) {
    const unsigned G = gridDim.x * gridDim.y * gridDim.z;
    unsigned sum, cnt, mine, sp = 0u;
    for (;;) {
        sum = 0u; cnt = 0u; mine = 0u;
#pragma unroll
        for (unsigned j = 0; j < 16; ++j) { const unsigned c = xb_ld(&bar[XB_XCNT(j)]); sum += c; cnt += (c > 0u) ? 1u : 0u; mine = (j == x) ? c : mine; }
        if (sum == G) break;
        __builtin_amdgcn_s_sleep(1);
        if ((++sp & 255u) == 0u) { if (xb_ld(&bar[XB_TMO])) break; if (sp > XB_SPIN_CAP) { atomicAdd(&bar[XB_TMO], 1u); break; } }
    }
    nloc = mine > 0u ? mine : 1u; nx = cnt > 0u ? cnt : 1u;
}
__device__ __forceinline__ void xcd_barrier(const XcdBarrier& b) {
    asm volatile("s_waitcnt vmcnt(0)" ::: "memory");
    __syncthreads();
    if (threadIdx.x == 0) {
        unsigned* bar = b.bar;
        __builtin_amdgcn_s_waitcnt(0);
        unsigned nloc = b.st[0], nx = b.st[1];
        if (nloc == 0u) { xcd_barrier_complete(bar, b.x, nloc, nx); b.st[0] = nloc; b.st[1] = nx; }
        const unsigned old = xb_add(&bar[XB_XSUB(b.x)], 1u);
        const unsigned gen = old / nloc;
        if (old + 1u == (gen + 1u) * nloc) {
            __builtin_amdgcn_fence(__ATOMIC_RELEASE, "agent");
            asm volatile("s_waitcnt vmcnt(0)" ::: "memory");
            const unsigned og = xb_add(&bar[XB_TOP], 1u);
            const unsigned tg = og / nx;
            if (og + 1u == (tg + 1u) * nx) xb_add(&bar[XB_TOPGEN], 1u);
            else XB_SPIN(xb_ld(&bar[XB_TOPGEN]) == tg, bar);
            __builtin_amdgcn_fence(__ATOMIC_ACQUIRE, "agent");
            xb_add(&bar[XB_XGEN(b.x)], 1u);
            asm volatile("s_waitcnt vmcnt(0)" ::: "memory");
        } else {
            XB_SPIN(xb_ld(&bar[XB_XGEN(b.x)]) == gen, bar);
            __builtin_amdgcn_fence(__ATOMIC_ACQUIRE, "agent");
            asm volatile("s_waitcnt vmcnt(0)" ::: "memory");
        }
    }
    __syncthreads();
}

struct Frame {
    LAS unsigned char* lds;
    volatile LAS unsigned* MISC;
    gu32* ctl;
    int tid, lane, wave, vcu, G;
    const float *x, *c, *w_ada, *b_ada, *norm_mix_g, *w_in, *b_forget, *w_out_fox, *lambda_re, *lambda_im, *log_dt, *b_re, *b_im, *c_re, *c_im, *d_skip, *w_glu, *w_out_ssm, *w_o,
        *norm_ffn_g, *w_rg, *b_rg, *w_rexp, *b_rexp, *w_gate, *w_up, *w_down, *final_g;
    float* out;
    float *MOD, *LOGF, *CUM, *RW; int* ROUTE; unsigned* LIST; unsigned* CUMP;
    bf16 *WIN, *WGLU, *WOF, *WOS, *WO, *WGU, *WD, *H, *Y, *Q, *K, *V, *U, *SGA, *SGB, *HID, *YROWS;
};

__device__ __forceinline__ float wave_sum(float v) {
#pragma unroll
    for (int o = 1; o < 64; o <<= 1) v += __shfl_xor(v, o);
    return v;
}

__device__ __forceinline__ void transpose_item(const float* src, int ld_src, bf16* dst, int ld_dst, LAS float* scr, int lane) {
#pragma unroll 8
    for (int i = 0; i < 32; ++i) { const int kk = 2 * i + (lane >> 5); scr[kk * 33 + (lane & 31)] = src[(size_t)kk * ld_src + (lane & 31)]; }
    LDS_WAIT(); asm volatile("" ::: "memory");
    const int c = lane & 7;
#pragma unroll
    for (int j = 0; j < 4; ++j) { const int n = (lane >> 3) + 8 * j; const LAS float* s = scr + (8 * c) * 33 + n;
        v4u o; o.x = pk2(s[0 * 33], s[1 * 33]); o.y = pk2(s[2 * 33], s[3 * 33]); o.z = pk2(s[4 * 33], s[5 * 33]); o.w = pk2(s[6 * 33], s[7 * 33]);
        *(GAS v4u*)(dst + (size_t)n * ld_dst + 8 * c) = o; }
    LDS_WAIT(); asm volatile("" ::: "memory");
}

__device__ __forceinline__ void p0_prologue(Frame& F) {
    {
        LAS float* cact = (LAS float*)(F.lds);
        LAS float* red = (LAS float*)(F.lds + 32768);
        for (int i = F.tid; i < 8192; i += 512) { const float v = F.c[i]; cact[i] = v / (1.f + __expf(-v)); }
        __syncthreads();
        for (int it = F.vcu; it < 192; it += F.G) {
            const int cl = F.lane & 31, hf = F.lane >> 5, col = it * 32 + cl;
            float a[8];
#pragma unroll
            for (int b = 0; b < 8; ++b) a[b] = 0.f;
            for (int i = 0; i < 64; ++i) {
                const int k = 16 * i + 2 * F.wave + hf;
                const float w = F.w_ada[(size_t)k * 6144 + col];
#pragma unroll
                for (int b = 0; b < 8; ++b) a[b] += cact[b * 1024 + k] * w;
            }
#pragma unroll
            for (int b = 0; b < 8; ++b) { a[b] += __shfl_xor(a[b], 32); if (hf == 0) red[(F.wave * 8 + b) * 32 + cl] = a[b]; }
            __syncthreads();
            if (F.tid < 256) { const int b = F.tid >> 5, c2 = F.tid & 31; float s = 0.f;
#pragma unroll
                for (int w = 0; w < 8; ++w) s += red[(w * 8 + b) * 32 + c2];
                F.MOD[b * 6144 + it * 32 + c2] = s + F.b_ada[it * 32 + c2]; }
            __syncthreads();
        }
        __syncthreads();
    }
    LAS float* scr = (LAS float*)(F.lds + RING_OFF + F.wave * 16384);
    const int gw = F.vcu * NWAVES + F.wave, NGW = F.G * NWAVES;
    constexpr int I_A = 16 * 48, I_B = 16 * 80, I_C = 8 * 32, I_D = 8 * 32, I_E = 8 * 32, I_F = 16 * 32, I_G = 32 * 256, I_H = 32 * 256, I_I = 32 * 256;
    constexpr int NITEMS = I_A + I_B + I_C + I_D + I_E + I_F + I_G + I_H + I_I;
    for (int it = gw; it < NITEMS; it += NGW) {
        int r = it;
        if (r < I_A) { const int kb = r / 48, nb = r % 48; transpose_item(F.w_in + (size_t)(64 * kb) * INC + 32 * nb, INC, F.WIN + (size_t)(32 * nb) * 1024 + 64 * kb, 1024, scr, F.lane); continue; } r -= I_A;
        if (r < I_B) { const int kb = r / 80, nb = r % 80; transpose_item(F.w_in + (size_t)(64 * kb) * INC + 1544 + 32 * nb, INC, F.WIN + (size_t)(1536 + 32 * nb) * 1024 + 64 * kb, 1024, scr, F.lane); continue; } r -= I_B;
        if (r < I_C) { const int kb = r / 32, nb = r % 32, n0 = 32 * nb, half = n0 >> 9, within = n0 & 511, pn = within >> 7, q = within & 127;
            transpose_item(F.w_glu + (size_t)(64 * kb) * 1024 + n0, 1024, F.WGLU + (size_t)(pn * 256 + half * 128 + q) * 512 + 64 * kb, 512, scr, F.lane); continue; } r -= I_C;
        if (r < I_D) { const int kb = r / 32, nb = r % 32; transpose_item(F.w_out_fox + (size_t)(64 * kb) * 1024 + 32 * nb, 1024, F.WOF + (size_t)(32 * nb) * 512 + 64 * kb, 512, scr, F.lane); continue; } r -= I_D;
        if (r < I_E) { const int kb = r / 32, nb = r % 32; transpose_item(F.w_out_ssm + (size_t)(64 * kb) * 1024 + 32 * nb, 1024, F.WOS + (size_t)(32 * nb) * 512 + 64 * kb, 512, scr, F.lane); continue; } r -= I_E;
        if (r < I_F) { const int kb = r / 32, nb = r % 32; transpose_item(F.w_o + (size_t)(64 * kb) * 1024 + 32 * nb, 1024, F.WO + (size_t)(32 * nb) * 1024 + 64 * kb, 1024, scr, F.lane); continue; } r -= I_F;
        if (r < I_G + I_H) { const int up = r >= I_G; if (up) r -= I_G; const int e = r >> 8, rr = r & 255, kb = rr >> 4, nb = rr & 15, n0 = 32 * nb, pn = n0 >> 7, q = n0 & 127;
            const float* src = (up ? F.w_up : F.w_gate) + (size_t)e * 1024 * 512 + (size_t)(64 * kb) * 512 + n0;
            transpose_item(src, 512, F.WGU + (size_t)e * 1024 * 1024 + (size_t)(pn * 256 + up * 128 + q) * 1024 + 64 * kb, 1024, scr, F.lane); continue; } r -= I_G + I_H;
        { const int e = r >> 8, rr = r & 255, kb = rr >> 5, nb = rr & 31;
            transpose_item(F.w_down + (size_t)e * 512 * 1024 + (size_t)(64 * kb) * 1024 + 32 * nb, 1024, F.WD + (size_t)e * 1024 * 512 + (size_t)(32 * nb) * 512 + 64 * kb, 512, scr, F.lane); }
    }
}

__device__ __forceinline__ void p1_rows(Frame& F) {
    LAS float* wfT = (LAS float*)(F.lds);
    for (int idx = F.tid; idx < 8192; idx += 512) { const int k = idx >> 3, j = idx & 7; wfT[j * 1024 + k] = F.w_in[(size_t)k * INC + 1536 + j]; }
    __syncthreads();
    const int gw = F.vcu * NWAVES + F.wave, NGW = F.G * NWAVES;
    for (int ch = gw; ch < M / 8; ch += NGW) {
        const int b = (ch * 8) / SEQ;
        const float* mod = F.MOD + b * 6144;
        f32x4 es[4], sh[4];
#pragma unroll
        for (int j = 0; j < 4; ++j) { const int c = 4 * F.lane + 256 * j; const f32x4 g4 = *(const f32x4*)(F.norm_mix_g + c), sc = *(const f32x4*)(mod + 1024 + c); es[j] = g4 * (sc + 1.f); sh[j] = *(const f32x4*)(mod + c); }
        for (int r = 0; r < 8; ++r) {
            const int m = ch * 8 + r;
            const GAS f32x4* xr = (const GAS f32x4*)(F.x + (size_t)m * D) + F.lane;
            f32x4 v[4]; float ss = 0.f;
#pragma unroll
            for (int j = 0; j < 4; ++j) { v[j] = xr[64 * j]; ss += (v[j].x * v[j].x + v[j].y * v[j].y) + (v[j].z * v[j].z + v[j].w * v[j].w); }
            const float rstd = 1.f / sqrtf(wave_sum(ss) * (1.f / D) + RMS_EPS);
            GAS v2u* o8 = (GAS v2u*)(F.H + (size_t)m * D) + F.lane;
#pragma unroll
            for (int j = 0; j < 4; ++j) { v[j] = v[j] * rstd * es[j] + sh[j]; v2u w; w.x = pk2(v[j].x, v[j].y); w.y = pk2(v[j].z, v[j].w); o8[64 * j] = w; }
            float f[8];
#pragma unroll
            for (int jj = 0; jj < 8; ++jj) { float a = 0.f;
#pragma unroll
                for (int j = 0; j < 4; ++j) { const f32x4 w4 = *(const LAS f32x4*)(wfT + jj * 1024 + 4 * F.lane + 256 * j); a += (v[j].x * w4.x + v[j].y * w4.y) + (v[j].z * w4.z + v[j].w * w4.w); }
                f[jj] = wave_sum(a); }
            if (F.lane < 8) {
                float z = f[0];
#pragma unroll
                for (int jj = 1; jj < 8; ++jj) z = (F.lane == jj) ? f[jj] : z;
                z += F.b_forget[F.lane];
                F.LOGF[(size_t)m * 8 + F.lane] = fminf(z, 0.f) - log1pf(expf(-fabsf(z)));
            }
        }
    }
}

__device__ __forceinline__ void p2_cumscan(Frame& F) {
    const int gw = F.wave * F.G + F.vcu, NGW = F.G * NWAVES;
    for (int u = gw; u < NB * NH; u += NGW) {
        const int b = u >> 3, h = u & 7;
        float v[32]; float run = 0.f;
#pragma unroll
        for (int i = 0; i < 32; ++i) { run += F.LOGF[((size_t)b * SEQ + 32 * F.lane + i) * 8 + h]; v[i] = run; }
        float incl = run;
#pragma unroll
        for (int o = 1; o < 64; o <<= 1) { const float t = __shfl_up(incl, o); if (F.lane >= o) incl += t; }
        const float excl = incl - run;
#pragma unroll
        for (int i = 0; i < 32; ++i) { const float cv = v[i] + excl; F.CUM[(size_t)u * SEQ + 32 * F.lane + i] = cv;
            const float nb = -cv * LOG2E; const unsigned hb = f2bf(nb); const float lo = nb - __uint_as_float(hb << 16); F.CUMP[(size_t)u * SEQ + 32 * F.lane + i] = hb | (f2bf(lo) << 16); }
    }
}

using pg8::Unit;
struct EpiInProj {
    static constexpr bool PERM = true;
    bf16* mix;
    __device__ __forceinline__ void operator()(const f32x4 (&acc)[2][2][4][2], const Unit& u, int wr, int wc, int fr, int fq) const {
        const int pn = u.pn; bf16* base; int ldc, colt, mode;
        if (pn < 8) { base = mix + (size_t)(pn >> 1) * ((size_t)M * 512); ldc = 512; colt = (pn & 1) * 256; mode = pn < 2 ? 1 : 0; }
        else { const int g = (pn - 8) >> 2; base = mix + (size_t)4 * M * 512 + (size_t)g * ((size_t)M * 1024); ldc = 1024; colt = ((pn - 8) & 3) * 256; mode = 2; }
        const int row0 = u.pm * 256 + wr * 64 + fr, col0 = colt + wc * 32 + 8 * fq;
#pragma unroll
        for (int ai = 0; ai < 2; ++ai)
#pragma unroll
            for (int m = 0; m < 4; ++m) { bf16* rowp = base + (size_t)(row0 + ai * 128 + m * 16) * ldc + col0;
#pragma unroll
                for (int bj = 0; bj < 2; ++bj) { f32x4 v0 = acc[ai][bj][m][0], v1 = acc[ai][bj][m][1];
                    if (mode == 1) { v0 = v0 * QSCALE; v1 = v1 * QSCALE; }
                    else if (mode == 2) {
#pragma unroll
                        for (int e = 0; e < 4; ++e) { v0[e] = fast_sigmoid(v0[e]); v1[e] = fast_sigmoid(v1[e]); } }
                    v4u w; w.x = pg8::cvt_pk_bf16(v0[0], v0[1]); w.y = pg8::cvt_pk_bf16(v0[2], v0[3]); w.z = pg8::cvt_pk_bf16(v1[0], v1[1]); w.w = pg8::cvt_pk_bf16(v1[2], v1[3]);
                    *(v4u*)(rowp + bj * 128) = w; } }
    }
};
template <int MODE> struct EpiGate {
    static constexpr bool PERM = true;
    bf16* T; const bf16* Gt;
    __device__ __forceinline__ void operator()(const f32x4 (&acc)[2][2][4][2], const Unit& u, int wr, int wc, int fr, int fq) const {
        const int row0 = u.pm * 256 + wr * 64 + fr, col0 = u.pn * 256 + wc * 32 + 8 * fq;
#pragma unroll
        for (int ai = 0; ai < 2; ++ai)
#pragma unroll
            for (int m = 0; m < 4; ++m) { const size_t off = (size_t)(row0 + ai * 128 + m * 16) * 1024 + col0;
#pragma unroll
                for (int bj = 0; bj < 2; ++bj) { const f32x4 v0 = acc[ai][bj][m][0], v1 = acc[ai][bj][m][1];
                    const v4u t = *(const v4u*)(T + off + bj * 128); v4u w;
                    if (MODE == 0) {
                        w.x = pg8::cvt_pk_bf16(bflo(t.x) * v0[0], bfhi(t.x) * v0[1]); w.y = pg8::cvt_pk_bf16(bflo(t.y) * v0[2], bfhi(t.y) * v0[3]);
                        w.z = pg8::cvt_pk_bf16(bflo(t.z) * v1[0], bfhi(t.z) * v1[1]); w.w = pg8::cvt_pk_bf16(bflo(t.w) * v1[2], bfhi(t.w) * v1[3]);
                    } else {
                        const v4u gg = *(const v4u*)(Gt + off + bj * 128);
                        w.x = pg8::cvt_pk_bf16(bflo(t.x) + bflo(gg.x) * v0[0], bfhi(t.x) + bfhi(gg.x) * v0[1]); w.y = pg8::cvt_pk_bf16(bflo(t.y) + bflo(gg.y) * v0[2], bfhi(t.y) + bfhi(gg.y) * v0[3]);
                        w.z = pg8::cvt_pk_bf16(bflo(t.z) + bflo(gg.z) * v1[0], bfhi(t.z) + bfhi(gg.z) * v1[1]); w.w = pg8::cvt_pk_bf16(bflo(t.w) + bflo(gg.w) * v1[2], bfhi(t.w) + bfhi(gg.w) * v1[3]);
                    }
                    *(v4u*)(T + off + bj * 128) = w; } }
    }
};
template <int MODE> struct EpiPair {
    static constexpr bool PERM = true;
    bf16* O;
    __device__ __forceinline__ void operator()(const f32x4 (&acc)[2][2][4][2], const Unit& u, int wr, int wc, int fr, int fq) const {
        const int row0 = u.pm * 256 + wr * 64 + fr, col0 = u.pn * 128 + wc * 32 + 8 * fq;
#pragma unroll
        for (int ai = 0; ai < 2; ++ai)
#pragma unroll
            for (int m = 0; m < 4; ++m) { f32x4 r0, r1;
#pragma unroll
                for (int e = 0; e < 4; ++e) {
                    if (MODE == 0) { r0[e] = acc[ai][0][m][0][e] * fast_sigmoid(acc[ai][1][m][0][e]); r1[e] = acc[ai][0][m][1][e] * fast_sigmoid(acc[ai][1][m][1][e]); }
                    else { const float g0 = acc[ai][0][m][0][e], g1 = acc[ai][0][m][1][e]; r0[e] = g0 * fast_sigmoid(g0) * acc[ai][1][m][0][e]; r1[e] = g1 * fast_sigmoid(g1) * acc[ai][1][m][1][e]; } }
                v4u w; w.x = pg8::cvt_pk_bf16(r0[0], r0[1]); w.y = pg8::cvt_pk_bf16(r0[2], r0[3]); w.z = pg8::cvt_pk_bf16(r1[0], r1[1]); w.w = pg8::cvt_pk_bf16(r1[2], r1[3]);
                *(v4u*)(O + (size_t)(row0 + ai * 128 + m * 16) * 512 + col0) = w; }
    }
};
struct EpiResid {
    static constexpr bool PERM = false;
    const float* x; float* out; const float* mod;
    __device__ __forceinline__ void operator()(const f32x4 (&acc)[2][2][4][2], const Unit& u, int wr, int wc, int fr, int fq) const {
        const int row0 = u.pm * 256 + wr * 64 + fr, col0 = u.pn * 256 + wc * 32 + 4 * fq;
        const int b = (u.pm * 256) / SEQ;
        f32x4 gv[2][2];
#pragma unroll
        for (int bj = 0; bj < 2; ++bj)
#pragma unroll
            for (int n = 0; n < 2; ++n) gv[bj][n] = *(const f32x4*)(mod + (size_t)b * 6144 + 2048 + col0 + bj * 128 + n * 16);
#pragma unroll
        for (int ai = 0; ai < 2; ++ai)
#pragma unroll
            for (int m = 0; m < 4; ++m) { const size_t off = (size_t)(row0 + ai * 128 + m * 16) * 1024 + col0;
#pragma unroll
                for (int bj = 0; bj < 2; ++bj)
#pragma unroll
                    for (int n = 0; n < 2; ++n) { const f32x4 xv = *(const f32x4*)(x + off + bj * 128 + n * 16); *(f32x4*)(out + off + bj * 128 + n * 16) = xv + gv[bj][n] * acc[ai][bj][m][n]; } }
    }
};
struct EpiDown {
    static constexpr bool PERM = true;
    bf16* Y; const unsigned* list; const float* rw;
    __device__ __forceinline__ void operator()(const f32x4 (&acc)[2][2][4][2], const Unit& u, int wr, int wc, int fr, int fq) const {
        const int col0 = u.pn * 256 + wc * 32 + 8 * fq;
#pragma unroll
        for (int ai = 0; ai < 2; ++ai)
#pragma unroll
            for (int m = 0; m < 4; ++m) { const int r = ai * 128 + wr * 64 + m * 16 + fr;
                if (r < u.rows) { const unsigned aid = list[u.lbase + r]; const float wgt = rw[aid]; bf16* rowp = Y + (size_t)aid * 1024 + col0;
#pragma unroll
                    for (int bj = 0; bj < 2; ++bj) { const f32x4 v0 = acc[ai][bj][m][0] * wgt, v1 = acc[ai][bj][m][1] * wgt;
                        v4u w; w.x = pg8::cvt_pk_bf16(v0[0], v0[1]); w.y = pg8::cvt_pk_bf16(v0[2], v0[3]); w.z = pg8::cvt_pk_bf16(v1[0], v1[1]); w.w = pg8::cvt_pk_bf16(v1[2], v1[3]);
                        *(v4u*)(rowp + bj * 128) = w; } } }
    }
};

template <bool GATHER_> struct MoeOrder {
    static constexpr bool GATHER = GATHER_;
    int G, c, nunits; const LAS int* tab; const unsigned* list; size_t estride; int bK;
    __device__ __forceinline__ bool next(int i, Unit& u) const {
        const int L = i * G + c; if (L >= nunits) return false;
        const int mt = L >> 2; u.pn = L & 3; int e = 0;
        while (e < NE - 1 && mt >= tab[e + 1]) ++e;
        const int j = mt - tab[e]; u.e = e; u.pm = mt; u.lbase = e * CAP + j * 256; const int left = tab[33 + e] - j * 256; u.rows = left < 256 ? left : 256; return true;
    }
    __device__ __forceinline__ size_t a_base(const Unit& u, int K) const { return GATHER ? (size_t)0 : (size_t)u.pm * 256 * K * 2; }
    __device__ __forceinline__ size_t b_base(const Unit& u, int K) const { return (size_t)u.e * estride + (size_t)u.pn * 256 * K * 2; }
    __device__ __forceinline__ void a_offsets(const Unit& u, const int* Rr, const int* Cc, int K, unsigned (&vo)[2][2]) const {
#pragma unroll
        for (int h = 0; h < 2; ++h)
#pragma unroll
            for (int i = 0; i < 2; ++i) { const int r = h * 128 + Rr[i]; const unsigned aid = list[u.lbase + (r < u.rows ? r : 0)]; vo[h][i] = (unsigned)((aid >> 1) * (unsigned)K + (unsigned)Cc[i]) * 2u; }
    }
};
__device__ __forceinline__ int moe_tables(Frame& F) {
    LAS int* tab = (LAS int*)(F.lds + MOE_OFF);
    if (F.tid == 0) { int acc = 0;
        for (int e = 0; e < NE; ++e) { const int c = (int)F.ctl[CW_CNT + 64 * e]; tab[e] = acc; tab[33 + e] = c; acc += (c + 255) >> 8; }
        tab[32] = acc; }
    __syncthreads();
    return tab[32];
}

__device__ __forceinline__ void attn_simple_unit(Frame& F, int b, int h, int qblk) {
    LAS bf16* Ks = (LAS bf16*)(F.lds);
    LAS bf16* Vs = (LAS bf16*)(F.lds + 8192);
    LAS float* cs = (LAS float*)(F.lds + 16384);
    const int q = qblk * 512 + F.tid;
    const size_t rowq = (size_t)b * SEQ + q;
    float qv[64], o[64];
    { const bf16* qp = F.Q + rowq * 512 + h * 64;
#pragma unroll
      for (int i = 0; i < 8; ++i) { const v4u w = *(const v4u*)(qp + 8 * i); qv[8 * i] = bflo(w.x); qv[8 * i + 1] = bfhi(w.x); qv[8 * i + 2] = bflo(w.y); qv[8 * i + 3] = bfhi(w.y); qv[8 * i + 4] = bflo(w.z); qv[8 * i + 5] = bfhi(w.z); qv[8 * i + 6] = bflo(w.w); qv[8 * i + 7] = bfhi(w.w); } }
#pragma unroll
    for (int d = 0; d < 64; ++d) o[d] = 0.f;
    float mrun = -INFINITY, l = 0.f;
    const int ntiles = (qblk * 512 + 512) / 64;
    const int wave_tile = (qblk * 512 + F.wave * 64) / 64;
    for (int kt = 0; kt < ntiles; ++kt) {
        __syncthreads();
        { const size_t krow = (size_t)b * SEQ + kt * 64 + (F.tid >> 3); const int ch = (F.tid & 7) * 8;
          *(LAS v4u*)(Ks + (F.tid >> 3) * 64 + ch) = *(const v4u*)(F.K + krow * 512 + h * 64 + ch);
          *(LAS v4u*)(Vs + (F.tid >> 3) * 64 + ch) = *(const v4u*)(F.V + krow * 512 + h * 64 + ch);
          if (F.tid < 64) cs[F.tid] = F.CUM[(size_t)(b * NH + h) * SEQ + kt * 64 + F.tid] * LOG2E; }
        __syncthreads();
        if (kt <= wave_tile) {
#pragma unroll 1
            for (int kk = 0; kk < 64; ++kk) {
                float dot = 0.f;
#pragma unroll
                for (int c8 = 0; c8 < 8; ++c8) { const v4u w = *(const LAS v4u*)(Ks + kk * 64 + c8 * 8);
                    dot += qv[8 * c8] * bflo(w.x) + qv[8 * c8 + 1] * bfhi(w.x) + qv[8 * c8 + 2] * bflo(w.y) + qv[8 * c8 + 3] * bfhi(w.y) + qv[8 * c8 + 4] * bflo(w.z) + qv[8 * c8 + 5] * bfhi(w.z) + qv[8 * c8 + 6] * bflo(w.w) + qv[8 * c8 + 7] * bfhi(w.w); }
                const float sc = (kt * 64 + kk > q) ? -INFINITY : dot - cs[kk];
                const float mnew = fmaxf(mrun, sc);
                const float corr = (mnew > -INFINITY) ? __builtin_amdgcn_exp2f(mrun - mnew) : 1.f;
                const float p = (mnew > -INFINITY) ? __builtin_amdgcn_exp2f(sc - mnew) : 0.f;
                l = l * corr + p;
#pragma unroll
                for (int c8 = 0; c8 < 8; ++c8) { const v4u w = *(const LAS v4u*)(Vs + kk * 64 + c8 * 8);
                    o[8 * c8] = o[8 * c8] * corr + p * bflo(w.x); o[8 * c8 + 1] = o[8 * c8 + 1] * corr + p * bfhi(w.x); o[8 * c8 + 2] = o[8 * c8 + 2] * corr + p * bflo(w.y); o[8 * c8 + 3] = o[8 * c8 + 3] * corr + p * bfhi(w.y);
                    o[8 * c8 + 4] = o[8 * c8 + 4] * corr + p * bflo(w.z); o[8 * c8 + 5] = o[8 * c8 + 5] * corr + p * bfhi(w.z); o[8 * c8 + 6] = o[8 * c8 + 6] * corr + p * bflo(w.w); o[8 * c8 + 7] = o[8 * c8 + 7] * corr + p * bfhi(w.w); }
                mrun = mnew;
            }
        }
    }
    const float inv = 1.f / l;
    bf16* op = F.Q + rowq * 512 + h * 64;
#pragma unroll
    for (int i = 0; i < 8; ++i) { v4u w; w.x = pk2(o[8 * i] * inv, o[8 * i + 1] * inv); w.y = pk2(o[8 * i + 2] * inv, o[8 * i + 3] * inv); w.z = pk2(o[8 * i + 4] * inv, o[8 * i + 5] * inv); w.w = pk2(o[8 * i + 6] * inv, o[8 * i + 7] * inv); *(v4u*)(op + 8 * i) = w; }
    __syncthreads();
}

__device__ __forceinline__ float gelu_tanh(float v) { const float t = 0.7978845608028654f * (v + 0.044715f * v * v * v); return 0.5f * v * (1.f + tanhf(t)); }
__device__ __forceinline__ void ssm_simple_unit(Frame& F, int b, int g, LAS unsigned char* wl) {
    const int p = F.lane;
    LAS f32x2* xs = (LAS f32x2*)wl;
    LAS float* Cp = (LAS float*)(wl + 33280);
#pragma unroll
    for (int c = 0; c < 16; ++c) { Cp[p * 32 + c] = F.c_re[(size_t)(g * 16 + c) * 64 + p]; Cp[p * 32 + 16 + c] = F.c_im[(size_t)(g * 16 + c) * 64 + p]; }
    const float dt = expf(F.log_dt[g]);
    const float lr = fminf(F.lambda_re[g * 64 + p], -1e-4f), li = F.lambda_im[g * 64 + p];
    const float mag = expf(lr * dt), ar = mag * cosf(li * dt), ai = mag * sinf(li * dt);
    const float den = lr * lr + li * li, nr = ar - 1.f;
    const float cor = (nr * lr + ai * li) / den, coi = (ai * lr - nr * li) / den;
    float bbr[16], bbi[16];
#pragma unroll
    for (int c = 0; c < 16; ++c) { const float br = F.b_re[(size_t)(g * 64 + p) * 16 + c], bi = F.b_im[(size_t)(g * 64 + p) * 16 + c]; bbr[c] = cor * br - coi * bi; bbi[c] = cor * bi + coi * br; }
    float dsk[16];
#pragma unroll
    for (int c = 0; c < 16; ++c) dsk[c] = F.d_skip[g * 16 + c];
    LDS_WAIT(); asm volatile("" ::: "memory");
    float xr = 0.f, xi = 0.f;
    for (int t0 = 0; t0 < SEQ; t0 += 64) {
#pragma unroll 2
        for (int tt = 0; tt < 64; ++tt) {
            const bf16* up = F.U + ((size_t)b * SEQ + t0 + tt) * 512 + g * 16;
            const v4u w0 = *(const v4u*)up, w1 = *(const v4u*)(up + 8);
            float uu[16] = {bflo(w0.x), bfhi(w0.x), bflo(w0.y), bfhi(w0.y), bflo(w0.z), bfhi(w0.z), bflo(w0.w), bfhi(w0.w), bflo(w1.x), bfhi(w1.x), bflo(w1.y), bfhi(w1.y), bflo(w1.z), bfhi(w1.z), bflo(w1.w), bfhi(w1.w)};
            float bur = 0.f, bui = 0.f;
#pragma unroll
            for (int c = 0; c < 16; ++c) { bur += bbr[c] * uu[c]; bui += bbi[c] * uu[c]; }
            const float n_r = ar * xr - ai * xi + bur, n_i = ar * xi + ai * xr + bui; xr = n_r; xi = n_i;
            xs[tt * 65 + p] = (f32x2){xr, xi};
        }
        LDS_WAIT(); asm volatile("" ::: "memory");
        float y[16];
#pragma unroll
        for (int c = 0; c < 16; ++c) y[c] = 0.f;
#pragma unroll 4
        for (int pp = 0; pp < 64; ++pp) {
            const f32x2 xv = xs[F.lane * 65 + pp];
#pragma unroll
            for (int c4 = 0; c4 < 4; ++c4) { const f32x4 cr = *(const LAS f32x4*)(Cp + pp * 32 + c4 * 4), ci = *(const LAS f32x4*)(Cp + pp * 32 + 16 + c4 * 4);
                y[4 * c4] += cr.x * xv.x - ci.x * xv.y; y[4 * c4 + 1] += cr.y * xv.x - ci.y * xv.y; y[4 * c4 + 2] += cr.z * xv.x - ci.z * xv.y; y[4 * c4 + 3] += cr.w * xv.x - ci.w * xv.y; }
        }
        const size_t row = (size_t)b * SEQ + t0 + F.lane;
        const bf16* up = F.U + row * 512 + g * 16;
        const v4u w0 = *(const v4u*)up, w1 = *(const v4u*)(up + 8);
        const float uu[16] = {bflo(w0.x), bfhi(w0.x), bflo(w0.y), bfhi(w0.y), bflo(w0.z), bfhi(w0.z), bflo(w0.w), bfhi(w0.w), bflo(w1.x), bfhi(w1.x), bflo(w1.y), bfhi(w1.y), bflo(w1.z), bfhi(w1.z), bflo(w1.w), bfhi(w1.w)};
        float r[16];
#pragma unroll
        for (int c = 0; c < 16; ++c) r[c] = gelu_tanh(y[c] + dsk[c] * uu[c]);
        v4u o0, o1; o0.x = pk2(r[0], r[1]); o0.y = pk2(r[2], r[3]); o0.z = pk2(r[4], r[5]); o0.w = pk2(r[6], r[7]); o1.x = pk2(r[8], r[9]); o1.y = pk2(r[10], r[11]); o1.z = pk2(r[12], r[13]); o1.w = pk2(r[14], r[15]);
        bf16* yp = F.Y + row * 512 + g * 16; *(v4u*)yp = o0; *(v4u*)(yp + 8) = o1;
        LDS_WAIT(); asm volatile("" ::: "memory");
    }
}

__device__ __forceinline__ void p7_block(Frame& F, int blk) {
    LAS int* eL = (LAS int*)(F.lds);
    LAS unsigned* baseL = (LAS unsigned*)(F.lds + 1024);
    const int b = (blk * 64) / SEQ;
    const float* mod = F.MOD + b * 6144;
    f32x4 es[4], sh[4];
#pragma unroll
    for (int j = 0; j < 4; ++j) { const int c = 4 * F.lane + 256 * j; const f32x4 g4 = *(const f32x4*)(F.norm_ffn_g + c), sc = *(const f32x4*)(mod + 4096 + c); es[j] = g4 * (sc + 1.f); sh[j] = *(const f32x4*)(mod + 3072 + c); }
    for (int r = 0; r < 8; ++r) {
        const int rl = F.wave * 8 + r, m = blk * 64 + rl;
        const GAS f32x4* xr = (const GAS f32x4*)(F.out + (size_t)m * D) + F.lane;
        f32x4 v[4]; float ss = 0.f;
#pragma unroll
        for (int j = 0; j < 4; ++j) { v[j] = xr[64 * j]; ss += (v[j].x * v[j].x + v[j].y * v[j].y) + (v[j].z * v[j].z + v[j].w * v[j].w); }
        const float rstd = 1.f / sqrtf(wave_sum(ss) * (1.f / D) + RMS_EPS);
        GAS v2u* o8 = (GAS v2u*)(F.H + (size_t)m * D) + F.lane;
#pragma unroll
        for (int j = 0; j < 4; ++j) { v[j] = v[j] * rstd * es[j] + sh[j]; v2u w; w.x = pk2(v[j].x, v[j].y); w.y = pk2(v[j].z, v[j].w); o8[64 * j] = w; }
        float lg[4] = {0.f, 0.f, 0.f, 0.f};
#pragma unroll
        for (int j = 0; j < 4; ++j) { const int k = 4 * F.lane + 256 * j;
#pragma unroll
            for (int e = 0; e < 4; ++e) { const f32x4 w4 = *(const f32x4*)(F.w_rg + (size_t)(k + e) * 4); const float hv = v[j][e]; lg[0] += hv * w4.x; lg[1] += hv * w4.y; lg[2] += hv * w4.z; lg[3] += hv * w4.w; } }
#pragma unroll
        for (int i = 0; i < 4; ++i) lg[i] = wave_sum(lg[i]) + F.b_rg[i];
        int gi = 0; float lmax = lg[0];
#pragma unroll
        for (int i = 1; i < 4; ++i) if (lg[i] > lmax) { lmax = lg[i]; gi = i; }
        float se = 0.f;
#pragma unroll
        for (int i = 0; i < 4; ++i) se += expf(lg[i] - lmax);
        const float pg = 1.f / se;
        gi = __builtin_amdgcn_readfirstlane(gi);
        float le[8] = {0.f, 0.f, 0.f, 0.f, 0.f, 0.f, 0.f, 0.f};
#pragma unroll
        for (int j = 0; j < 4; ++j) { const int k = 4 * F.lane + 256 * j;
#pragma unroll
            for (int e = 0; e < 4; ++e) { const float* wp = F.w_rexp + (size_t)(k + e) * 32 + gi * 8; const f32x4 wa = *(const f32x4*)wp, wb = *(const f32x4*)(wp + 4); const float hv = v[j][e];
                le[0] += hv * wa.x; le[1] += hv * wa.y; le[2] += hv * wa.z; le[3] += hv * wa.w; le[4] += hv * wb.x; le[5] += hv * wb.y; le[6] += hv * wb.z; le[7] += hv * wb.w; } }
#pragma unroll
        for (int i = 0; i < 8; ++i) le[i] = wave_sum(le[i]) + F.b_rexp[gi * 8 + i];
        int i0 = 0; float v0 = le[0];
#pragma unroll
        for (int i = 1; i < 8; ++i) if (le[i] > v0) { v0 = le[i]; i0 = i; }
        int i1 = -1; float v1 = -INFINITY;
#pragma unroll
        for (int i = 0; i < 8; ++i) if (i != i0 && (i1 < 0 || le[i] > v1)) { v1 = le[i]; i1 = i; }
        const float ex = expf(v1 - v0), p0 = 1.f / (1.f + ex), p1 = ex * p0;
        if (F.lane == 0) { const int e0 = gi * 8 + i0, e1 = gi * 8 + i1; eL[2 * rl] = e0; eL[2 * rl + 1] = e1;
            F.ROUTE[(size_t)m * 2] = e0; F.ROUTE[(size_t)m * 2 + 1] = e1; F.RW[(size_t)m * 2] = pg * p0; F.RW[(size_t)m * 2 + 1] = pg * p1; }
    }
    __syncthreads();
    int e = 0, rank = 0, total = 0;
    if (F.tid < 128) { e = eL[F.tid];
        for (int a = 0; a < 128; ++a) { const int m_ = (eL[a] == e); total += m_; rank += (m_ && a < F.tid); }
        if (rank == 0) baseL[e] = __hip_atomic_fetch_add((unsigned*)(F.ctl + CW_CNT + 64 * e), (unsigned)total, RLX_AGENT); }
    __syncthreads();
    if (F.tid < 128) { const unsigned pos = baseL[e] + (unsigned)rank; F.LIST[(size_t)e * CAP + pos] = (unsigned)((blk * 64 + (F.tid >> 1)) * 2 + (F.tid & 1)); }
    __syncthreads();
}

__device__ __forceinline__ void p10_rows(Frame& F) {
    const int gw = F.vcu * NWAVES + F.wave, NGW = F.G * NWAVES;
    for (int ch = gw; ch < M / 8; ch += NGW) {
        const int b = (ch * 8) / SEQ;
        const float* mod = F.MOD + b * 6144 + 5120;
        f32x4 g2[4], fg[4];
#pragma unroll
        for (int j = 0; j < 4; ++j) { const int c = 4 * F.lane + 256 * j; g2[j] = *(const f32x4*)(mod + c); fg[j] = *(const f32x4*)(F.final_g + c); }
        for (int r = 0; r < 8; ++r) {
            const int m = ch * 8 + r;
            GAS f32x4* xr = (GAS f32x4*)(F.out + (size_t)m * D) + F.lane;
            const GAS v2u* y0 = (const GAS v2u*)(F.YROWS + (size_t)(2 * m) * D) + F.lane; const GAS v2u* y1 = (const GAS v2u*)(F.YROWS + (size_t)(2 * m + 1) * D) + F.lane;
            f32x4 v[4]; float ss = 0.f;
#pragma unroll
            for (int j = 0; j < 4; ++j) { const f32x4 xv = xr[64 * j]; const v2u a = y0[64 * j], bb = y1[64 * j];
                f32x4 yv; yv.x = bflo(a.x) + bflo(bb.x); yv.y = bfhi(a.x) + bfhi(bb.x); yv.z = bflo(a.y) + bflo(bb.y); yv.w = bfhi(a.y) + bfhi(bb.y);
                v[j] = xv + g2[j] * yv; ss += (v[j].x * v[j].x + v[j].y * v[j].y) + (v[j].z * v[j].z + v[j].w * v[j].w); }
            const float rstd = 1.f / sqrtf(wave_sum(ss) * (1.f / D) + RMS_EPS);
#pragma unroll
            for (int j = 0; j < 4; ++j) xr[64 * j] = v[j] * rstd * fg[j];
        }
    }
}

struct Args { const float* in[28]; float* out; unsigned char* ws; int ph_lo, ph_hi; };
typedef const __attribute__((address_space(4))) Args* KArgs;
__device__ __forceinline__ void load_ptrs(Frame& F) {
    KArgs ka = (KArgs)__builtin_amdgcn_kernarg_segment_ptr();
    asm volatile("" : "+s"(ka));
    F.tid = tid_opaque(); F.lane = F.tid & 63; F.wave = __builtin_amdgcn_readfirstlane(F.tid >> 6);
    unsigned char* ws = ka->ws;
    F.ctl = (gu32*)(ws + WS_CTL);
    F.x = ka->in[0]; F.c = ka->in[1]; F.w_ada = ka->in[2]; F.b_ada = ka->in[3]; F.norm_mix_g = ka->in[4]; F.w_in = ka->in[5]; F.b_forget = ka->in[6]; F.w_out_fox = ka->in[7];
    F.lambda_re = ka->in[8]; F.lambda_im = ka->in[9]; F.log_dt = ka->in[10]; F.b_re = ka->in[11]; F.b_im = ka->in[12]; F.c_re = ka->in[13]; F.c_im = ka->in[14]; F.d_skip = ka->in[15];
    F.w_glu = ka->in[16]; F.w_out_ssm = ka->in[17]; F.w_o = ka->in[18]; F.norm_ffn_g = ka->in[19]; F.w_rg = ka->in[20]; F.b_rg = ka->in[21]; F.w_rexp = ka->in[22]; F.b_rexp = ka->in[23];
    F.w_gate = ka->in[24]; F.w_up = ka->in[25]; F.w_down = ka->in[26]; F.final_g = ka->in[27]; F.out = ka->out;
    F.MOD = (float*)(ws + WS_MOD); F.LOGF = (float*)(ws + WS_LOGF); F.CUM = (float*)(ws + WS_CUM); F.RW = (float*)(ws + WS_RW); F.ROUTE = (int*)(ws + WS_ROUTE); F.LIST = (unsigned*)(ws + WS_LIST); F.CUMP = (unsigned*)(ws + WS_CUMP);
    F.WIN = (bf16*)(ws + WS_WIN); F.WGLU = (bf16*)(ws + WS_WGLU); F.WOF = (bf16*)(ws + WS_WOF); F.WOS = (bf16*)(ws + WS_WOS); F.WO = (bf16*)(ws + WS_WO); F.WGU = (bf16*)(ws + WS_WGU); F.WD = (bf16*)(ws + WS_WD);
    F.H = (bf16*)(ws + WS_H); F.Y = (bf16*)(ws + WS_Y); F.Q = (bf16*)(ws + WS_Q); F.K = (bf16*)(ws + WS_K); F.V = (bf16*)(ws + WS_V); F.U = (bf16*)(ws + WS_U); F.SGA = (bf16*)(ws + WS_SGA); F.SGB = (bf16*)(ws + WS_SGB);
    F.HID = (bf16*)(ws + WS_HID); F.YROWS = (bf16*)(ws + WS_YROWS);
}
__global__ void __launch_bounds__(NWAVES * 64, 2) fwd(Args args) {
    extern __shared__ __attribute__((aligned(16))) unsigned char lds[];
    Frame F;
    F.lds = (LAS unsigned char*)lds;
    F.MISC = (volatile LAS unsigned*)(F.lds + MISC_OFF);
    F.tid = threadIdx.x; F.lane = F.tid & 63; F.wave = __builtin_amdgcn_readfirstlane(F.tid >> 6);
    F.G = gridDim.x; { const int bx = blockIdx.x; F.vcu = (F.G % 8 == 0) ? (bx % 8) * (F.G / 8) + bx / 8 : bx; }
    load_ptrs(F);
    for (int u = F.tid; u < (LDS_BYTES - LDSCTL_OFF) / 4; u += NWAVES * 64) ((LAS unsigned*)(F.lds + LDSCTL_OFF))[u] = 0u;
    __syncthreads();
    if (N_LAUNCHES == 1) (void)xcd_barrier_post((unsigned*)(F.ctl + CW_BAR), F.MISC + 8);
#define GRID_BAR() do { if (N_LAUNCHES == 1) { load_ptrs(F); XcdBarrier b_; b_.bar = (unsigned*)(F.ctl + CW_BAR); b_.x = xb_xcc_id(); b_.st = (volatile LAS unsigned*)(F.lds + MISC_OFF) + 8; xcd_barrier(b_); } } while (0)
    const int lo = (N_LAUNCHES == 1) ? 0 : args.ph_lo, hi = (N_LAUNCHES == 1) ? NPH : args.ph_hi;
#ifndef PH_MASK
#define PH_MASK 0x7ff
#endif
#define IN(k) ((((PH_MASK) >> (k)) & 1) && lo <= (k) && (k) < hi)
#define BOTH(k) (IN(k) && IN((k) + 1))

    if (IN(0)) { load_ptrs(F); p0_prologue(F); if (BOTH(0)) GRID_BAR(); }
    if (IN(1)) { load_ptrs(F); p1_rows(F); if (BOTH(1)) GRID_BAR(); }
    if (IN(2)) { load_ptrs(F);
        p2_cumscan(F); VM_WAIT(); __syncthreads();
        pg8::Gemm g{F.H, F.WIN, 1024}; pg8::StaticOrder S; S.init(M, 4096, F.G, (int)blockIdx.x);
        EpiInProj E{F.Q};
        pg8::gemm_phase<EpiInProj, pg8::StaticOrder, true>(F.lds + RING_OFF, g, S, E);
        if (BOTH(2)) GRID_BAR();
    }
    if (IN(3)) { load_ptrs(F);
#if defined(ATTN_SIMPLE)
        for (int u = F.vcu; u < NB * NH * 4; u += F.G) { const int bh = u >> 2, qblk = 3 - (u & 3); attn_simple_unit(F, bh >> 3, bh & 7, qblk); }
#else
        { static_assert(attn_body::ATTN_LDS_BYTES <= RING_BYTES, "attention LDS");
          const attn_body::AttnTensors AT{(const attn_body::bf16*)F.Q, (const attn_body::bf16*)F.K, (const attn_body::bf16*)F.V, (attn_body::bf16*)F.Q, F.CUM};
          const attn_body::StaticOrder S((int)F.G, F.vcu);
          attn_body::attn_phase<attn_body::StaticOrder>((char*)lds + RING_OFF, AT, S); }
#endif
        __syncthreads();
        if (F.wave < 3) for (int u = F.wave * F.G + F.vcu; u < NB * NG; u += 3 * F.G) ssm_simple_unit(F, u >> 5, u & 31, F.lds + F.wave * 41472);
        __syncthreads();
        if (BOTH(3)) GRID_BAR();
    }
    if (IN(4)) { load_ptrs(F);
        { pg8::Gemm g{F.Q, F.WOF, 512}; pg8::StaticOrder S; S.init(M, 1024, F.G, (int)blockIdx.x); EpiGate<0> E{F.SGA, nullptr};
          pg8::gemm_phase<EpiGate<0>, pg8::StaticOrder, true>(F.lds + RING_OFF, g, S, E); }
        { pg8::Gemm g{F.Y, F.WGLU, 512}; pg8::StaticOrder S; S.init(M, 1024, F.G, (int)blockIdx.x); EpiPair<0> E{F.V};
          pg8::gemm_phase<EpiPair<0>, pg8::StaticOrder, true>(F.lds + RING_OFF, g, S, E); }
        if (BOTH(4)) GRID_BAR();
    }
    if (IN(5)) { load_ptrs(F);
        pg8::Gemm g{F.V, F.WOS, 512}; pg8::StaticOrder S; S.init(M, 1024, F.G, (int)blockIdx.x); EpiGate<1> E{F.SGA, F.SGB};
        pg8::gemm_phase<EpiGate<1>, pg8::StaticOrder, true>(F.lds + RING_OFF, g, S, E);
        if (BOTH(5)) GRID_BAR();
    }
    if (IN(6)) { load_ptrs(F);
        pg8::Gemm g{F.SGA, F.WO, 1024}; pg8::StaticOrder S; S.init(M, 1024, F.G, (int)blockIdx.x); EpiResid E{F.x, F.out, F.MOD};
        pg8::gemm_phase<EpiResid, pg8::StaticOrder, true>(F.lds + RING_OFF, g, S, E);
        if (BOTH(6)) GRID_BAR();
    }
    if (IN(7)) { load_ptrs(F);
        for (int blk = F.vcu; blk < M / 64; blk += F.G) p7_block(F, blk);
        if (BOTH(7)) GRID_BAR();
    }
    if (IN(8)) { load_ptrs(F);
        const int mt = moe_tables(F);
        MoeOrder<true> S{F.G, (int)blockIdx.x, mt * 4, (const LAS int*)(F.lds + MOE_OFF), F.LIST, (size_t)1024 * 1024 * 2, 0};
        pg8::Gemm g{F.H, F.WGU, 1024}; EpiPair<1> E{F.HID};
        pg8::gemm_phase<EpiPair<1>, MoeOrder<true>, true>(F.lds + RING_OFF, g, S, E);
        if (BOTH(8)) GRID_BAR();
    }
    if (IN(9)) { load_ptrs(F);
        const int mt = moe_tables(F);
        MoeOrder<false> S{F.G, (int)blockIdx.x, mt * 4, (const LAS int*)(F.lds + MOE_OFF), F.LIST, (size_t)1024 * 512 * 2, 0};
        pg8::Gemm g{F.HID, F.WD, 512}; EpiDown E{F.YROWS, F.LIST, F.RW};
        pg8::gemm_phase<EpiDown, MoeOrder<false>, true>(F.lds + RING_OFF, g, S, E);
        if (BOTH(9)) GRID_BAR();
    }
    if (IN(10)) { load_ptrs(F); p10_rows(F); }
#undef IN
#undef BOTH
}

extern "C" void kernel_launch(void* const* d_in, const int* in_sizes, int n_in, void* d_out, int out_size, void* d_ws, size_t ws_size, hipStream_t stream) {
    static int grid = 0;
    if (grid == 0) {
        if (n_in != 28 || in_sizes[0] != M * D || out_size != M * D || ws_size < WS_END) { fprintf(stderr, "kernel_launch: unexpected shapes (n_in %d, in0 %d, out %d, ws %zu); nothing launched\n", n_in, n_in > 0 ? in_sizes[0] : -1, out_size, ws_size); grid = -1; return; }
        int dev = 0, cus = 0, per_cu = 0;
        if (hipGetDevice(&dev) != hipSuccess || hipDeviceGetAttribute(&cus, hipDeviceAttributeMultiprocessorCount, dev) != hipSuccess) { grid = -1; return; }
        if (hipFuncSetAttribute((const void*)fwd, hipFuncAttributeMaxDynamicSharedMemorySize, LDS_BYTES) != hipSuccess) { fprintf(stderr, "kernel_launch: hipFuncSetAttribute failed\n"); grid = -1; return; }
        if (hipOccupancyMaxActiveBlocksPerMultiprocessor(&per_cu, (const void*)fwd, NWAVES * 64, LDS_BYTES) != hipSuccess || per_cu < 1) { fprintf(stderr, "kernel_launch: occupancy query reports %d\n", per_cu); }
        (void)hipGetLastError();
        grid = cus;
    }
    if (grid < 0) return;
    if (hipMemsetAsync((char*)d_ws + WS_CTL, 0, CTL_ZERO_BYTES, stream) != hipSuccess) return;
    Args a{};
    for (int i = 0; i < 28; ++i) a.in[i] = (const float*)d_in[i];
    a.out = (float*)d_out; a.ws = (unsigned char*)d_ws;
    for (int li = 0; li < N_LAUNCHES; ++li) {
        a.ph_lo = (N_LAUNCHES == NPH) ? li : 0; a.ph_hi = (N_LAUNCHES == NPH) ? li + 1 : NPH;
        hipLaunchKernelGGL(fwd, dim3(grid), dim3(NWAVES * 64), LDS_BYTES, stream, a);
        if (hipPeekAtLastError() != hipSuccess) { fprintf(stderr, "kernel_launch: launch %d failed\n", li); break; }
    }
}
```

```cpp
#include <hip/hip_runtime.h>
#include <cstdio>
#include <cstdint>

#ifndef MK_N_LAUNCHES
#define MK_N_LAUNCHES 1
#endif

constexpr int NB = 8, SEQ = 2048, D = 1024, M = NB * SEQ;
constexpr int NH = 8, HD = 64, FW = 512;
constexpr int SW = 512, NG = 32, NS = 64;
constexpr int INC = 4104;
constexpr int NE = 32, DE = 512;
constexpr int CAP = 16384;
constexpr float RMS_EPS = 1e-6f;
constexpr float LOG2E = 1.4426950408889634f;
constexpr float QSCALE = 0.125f * 1.4426950408889634f;

__device__ __forceinline__ int tid_opaque() { int t = (int)threadIdx.x; asm volatile("" : "+v"(t)); return t; }

namespace pg8 {
#define PG8_LAS __attribute__((address_space(3)))
typedef unsigned short bf16_t;
typedef short bf16x8 __attribute__((ext_vector_type(8)));
typedef float f32x4 __attribute__((ext_vector_type(4)));
typedef unsigned u32x4 __attribute__((ext_vector_type(4)));
constexpr int BM = 256, BK = 64, HALF = 128, HTB = HALF * BK * 2, STAGE_BYTES = 8 * HTB, NXCD = 8, WGM = 8;

__host__ __device__ __forceinline__ int lds_byte(int r, int c) { const int st = (r >> 4) * 2 + (c >> 5), rr = r & 15, cc = c & 31, ob = rr * 64 + cc * 2; return st * 1024 + (ob ^ (((ob >> 9) & 1) << 5)); }
__host__ __device__ __forceinline__ void stage_rc(int b, int& R, int& C) { const int st = b / 1024, sb = b % 1024, swz = sb ^ (((sb >> 9) & 1) << 5); R = (st >> 1) * 16 + swz / 64; C = (st & 1) * 32 + (swz % 64) / 2; }
__host__ __device__ __forceinline__ int perm32(int rho) { const int n = rho >> 4, i = rho & 15; return 8 * (i >> 2) + 4 * n + (i & 3); }

struct Unit { int pm, pn, e, rows, lbase; };
struct Gemm { const bf16_t* A; const bf16_t* Bt; int K; };

struct StaticOrder {
    static constexpr bool GATHER = false;
    int nM, nN, nwg, G, c;
    __host__ __device__ void init(int M_, int N_, int G_, int c_) { nM = M_ / BM; nN = N_ / BM; nwg = nM * nN; G = G_; c = c_; }
    __host__ __device__ bool next(int i, Unit& u) const {
        const long L = (long)i * G + c; if (L >= nwg) return false;
        int wgid = (int)L; { const int q = nwg / NXCD, r = nwg % NXCD, xcd = wgid % NXCD, off = wgid / NXCD; wgid = (xcd < r ? xcd * (q + 1) : r * (q + 1) + (xcd - r) * q) + off; }
        const int nig = WGM * nN, gid = wgid / nig, fm = gid * WGM, gsz = (nM - fm) < WGM ? (nM - fm) : WGM;
        u.pm = fm + ((wgid % nig) % gsz); u.pn = (wgid % nig) / gsz; u.e = 0; u.rows = 256; u.lbase = 0; return true;
    }
    __device__ __forceinline__ size_t a_base(const Unit& u, int K) const { return (size_t)u.pm * BM * K * 2; }
    __device__ __forceinline__ size_t b_base(const Unit& u, int K) const { return (size_t)u.pn * BM * K * 2; }
    __device__ __forceinline__ void a_offsets(const Unit&, const int*, const int*, int, unsigned (&)[2][2]) const {}
};

__device__ __forceinline__ unsigned cvt_pk_bf16(float lo, float hi) { unsigned r; asm volatile("v_cvt_pk_bf16_f32 %0, %1, %2" : "=v"(r) : "v"(lo), "v"(hi)); return r; }

template <class Epi, class Sched, bool ALIGN_EPI>
__device__ __forceinline__ void gemm_phase(PG8_LAS unsigned char* lds, const Gemm g, const Sched& S, const Epi& E) {
    constexpr bool GATHER = Sched::GATHER;
    const int tid = tid_opaque(), wid = __builtin_amdgcn_readfirstlane(tid >> 6), lane = tid & 63, wr = wid >> 2, wc = wid & 3, fr = lane & 15, fq = lane >> 4;
    const int K = g.K, nt = K / BK;
    unsigned voffB[2], voC[2][2], voN[2][2]; int Rr[2], Cc[2];
#pragma unroll
    for (int i = 0; i < 2; ++i) { int R, C; stage_rc(tid * 16 + i * 8192, R, C); Rr[i] = R; Cc[i] = C; const int Rb = Epi::PERM ? ((R & ~31) + perm32(R & 31)) : R;
        voffB[i] = (unsigned)(Rb * K + C) * 2u; }
    const size_t kstep = (size_t)(BK * 2);
    const size_t hstep = (size_t)HALF * K * 2;
    const unsigned ldsw = (unsigned)wid * 1024u;
    const int aoff = lds_byte(wr * 64 + fr, fq * 8), boff = lds_byte(wc * 32 + fr, fq * 8);
#define PG8_SA(b, h) (((b) * 2 + (h)) * HTB)
#define PG8_SB(b, h) ((4 + (b) * 2 + (h)) * HTB)
#define PG8_STAGE(bufoff, gbase, voff) do { _Pragma("unroll") for (int _i = 0; _i < 2; ++_i) \
        __builtin_amdgcn_global_load_lds((const unsigned*)((const char*)(gbase) + (voff)[_i]), (PG8_LAS unsigned*)(lds + (bufoff) + ldsw + _i * 8192), 16, 0, 0); } while (0)
#define PG8_LDA(dst, b, h) do { _Pragma("unroll") for (int m = 0; m < 4; ++m) _Pragma("unroll") for (int k = 0; k < 2; ++k) dst[m][k] = *(const PG8_LAS bf16x8*)(lds + PG8_SA(b, h) + aoff + m * 2048 + k * 1024); } while (0)
#define PG8_LDB(dst, b, h) do { _Pragma("unroll") for (int n = 0; n < 2; ++n) _Pragma("unroll") for (int k = 0; k < 2; ++k) dst[n][k] = *(const PG8_LAS bf16x8*)(lds + PG8_SB(b, h) + boff + n * 2048 + k * 1024); } while (0)
#define PG8_MMA(ai, bj, At, Bt) do { __builtin_amdgcn_s_setprio(1); _Pragma("unroll") for (int m = 0; m < 4; ++m) _Pragma("unroll") for (int n = 0; n < 2; ++n) _Pragma("unroll") for (int k = 0; k < 2; ++k) \
        acc[ai][bj][m][n] = __builtin_amdgcn_mfma_f32_16x16x32_bf16(Bt[n][k], At[m][k], acc[ai][bj][m][n], 0, 0, 0); __builtin_amdgcn_s_setprio(0); } while (0)
#define PG8_WAIT_V(n) asm volatile("s_waitcnt vmcnt(" #n ")" ::: "memory")
#define PG8_WAIT_L(n) asm volatile("s_waitcnt lgkmcnt(" #n ")" ::: "memory")
#define PG8_BAR __builtin_amdgcn_s_barrier()
#define PG8_SCHED __builtin_amdgcn_sched_barrier(0)
    Unit cur, nxt; int ui = 0;
    if (!S.next(0, cur)) return;
    f32x4 acc[2][2][4][2];
#pragma unroll
    for (int a = 0; a < 2; ++a)
#pragma unroll
        for (int b = 0; b < 2; ++b)
#pragma unroll
            for (int m = 0; m < 4; ++m)
#pragma unroll
                for (int n = 0; n < 2; ++n) acc[a][b][m][n] = (f32x4){0.f, 0.f, 0.f, 0.f};
    bf16x8 At[4][2], B0[2][2], B1[2][2];
    if constexpr (GATHER) S.a_offsets(cur, Rr, Cc, K, voC);
    else {
#pragma unroll
        for (int h = 0; h < 2; ++h)
#pragma unroll
            for (int i = 0; i < 2; ++i) voC[h][i] = (unsigned)((Rr[i] + h * HALF) * K + Cc[i]) * 2u;
    }
    const char* cA = (const char*)g.A + S.a_base(cur, K); const char* cB = (const char*)g.Bt + S.b_base(cur, K);
    PG8_STAGE(PG8_SB(0, 0), cB, voffB); PG8_STAGE(PG8_SB(0, 1), cB + hstep, voffB); PG8_STAGE(PG8_SA(0, 0), cA, voC[0]); PG8_STAGE(PG8_SA(0, 1), cA, voC[1]);
    if (wr == 1) PG8_BAR;
    PG8_WAIT_V(2); PG8_BAR;
    PG8_STAGE(PG8_SB(1, 0), cB + kstep, voffB); PG8_STAGE(PG8_SA(1, 0), cA + kstep, voC[0]); PG8_STAGE(PG8_SB(1, 1), cB + hstep + kstep, voffB);
    PG8_WAIT_V(6); PG8_BAR;
    for (;;) {
        const bool has_next = S.next(ui + 1, nxt);
        const char* nA = has_next ? (const char*)g.A + S.a_base(nxt, K) : cA; const char* nB = has_next ? (const char*)g.Bt + S.b_base(nxt, K) : cB;
        if constexpr (GATHER) {
            if (has_next) S.a_offsets(nxt, Rr, Cc, K, voN);
            else {
#pragma unroll
                for (int h = 0; h < 2; ++h)
#pragma unroll
                    for (int i = 0; i < 2; ++i) voN[h][i] = voC[h][i];
            }
        }
        for (int t = 0; t < nt; t += 2) {
            const bool last = (t == nt - 2);
            const char* a1 = cA + (size_t)(t + 1) * kstep;
            const char* a2 = last ? nA : cA + (size_t)(t + 2) * kstep; const char* b2 = last ? nB : cB + (size_t)(t + 2) * kstep;
            const char* a3 = a2 + kstep; const char* b3 = b2 + kstep;
            unsigned vo2[2][2];
#pragma unroll
            for (int h = 0; h < 2; ++h)
#pragma unroll
                for (int i = 0; i < 2; ++i) vo2[h][i] = GATHER ? (last ? voN[h][i] : voC[h][i]) : voC[h][i];
            PG8_LDB(B0, 0, 0); PG8_LDB(B1, 0, 1); PG8_SCHED; PG8_LDA(At, 0, 0); PG8_STAGE(PG8_SA(1, 1), a1, voC[1]);
            PG8_WAIT_V(8); PG8_WAIT_L(0); PG8_BAR; PG8_MMA(0, 0, At, B0); PG8_MMA(0, 1, At, B1); PG8_BAR; PG8_SCHED;
            PG8_LDA(At, 0, 1); PG8_STAGE(PG8_SB(0, 0), b2, voffB); PG8_STAGE(PG8_SB(0, 1), b2 + hstep, voffB); PG8_STAGE(PG8_SA(0, 0), a2, vo2[0]);
            PG8_WAIT_V(8); PG8_WAIT_L(0); PG8_BAR; PG8_MMA(1, 0, At, B0); PG8_MMA(1, 1, At, B1); PG8_BAR; PG8_SCHED;
            PG8_LDB(B0, 1, 0); PG8_LDB(B1, 1, 1); PG8_SCHED; PG8_LDA(At, 1, 0); PG8_STAGE(PG8_SA(0, 1), a2, vo2[1]);
            PG8_WAIT_V(8); PG8_WAIT_L(0); PG8_BAR; PG8_MMA(0, 0, At, B0); PG8_MMA(0, 1, At, B1); PG8_BAR; PG8_SCHED;
            PG8_LDA(At, 1, 1); PG8_STAGE(PG8_SB(1, 0), b3, voffB); PG8_STAGE(PG8_SB(1, 1), b3 + hstep, voffB); PG8_STAGE(PG8_SA(1, 0), a3, vo2[0]);
            PG8_WAIT_V(8); PG8_WAIT_L(0); PG8_BAR; PG8_MMA(1, 0, At, B0); PG8_MMA(1, 1, At, B1); PG8_BAR; PG8_SCHED;
        }
        if constexpr (ALIGN_EPI) { if (wr == 0) PG8_BAR; }
        E(acc, cur, wr, wc, fr, fq);
        if (!has_next) break;
#pragma unroll
        for (int a = 0; a < 2; ++a)
#pragma unroll
            for (int b = 0; b < 2; ++b)
#pragma unroll
                for (int m = 0; m < 4; ++m)
#pragma unroll
                    for (int n = 0; n < 2; ++n) acc[a][b][m][n] = (f32x4){0.f, 0.f, 0.f, 0.f};
        cur = nxt; cA = nA; cB = nB; ++ui;
        if constexpr (GATHER) {
#pragma unroll
            for (int h = 0; h < 2; ++h)
#pragma unroll
                for (int i = 0; i < 2; ++i) voC[h][i] = voN[h][i];
        }
        if constexpr (ALIGN_EPI) { if (wr == 1) PG8_BAR; }
    }
    PG8_WAIT_V(0);
    if constexpr (!ALIGN_EPI) { if (wr == 0) PG8_BAR; }
    PG8_BAR;
#undef PG8_SA
#undef PG8_SB
#undef PG8_STAGE
#undef PG8_LDA
#undef PG8_LDB
#undef PG8_MMA
#undef PG8_WAIT_V
#undef PG8_WAIT_L
#undef PG8_BAR
#undef PG8_SCHED
}
}

#include <hip/hip_bf16.h>
#include <cmath>
namespace attn_body {
using bf16=__hip_bfloat16;
using bf16x8=__attribute__((ext_vector_type(8)))short;
using s16x4=__attribute__((ext_vector_type(4)))short;
using f32x16=__attribute__((ext_vector_type(16)))float;
using u32x4=__attribute__((ext_vector_type(4)))unsigned;
using f32x4v=__attribute__((ext_vector_type(4)))float;
constexpr int BATCH=8,NHEAD=8,SEQ=2048,D=64,DM=NHEAD*D;
constexpr int NW=8,QBLK=32,QB=QBLK*NW,KVBLK=64,NQB=SEQ/QB;
constexpr int ATTN_PITCH=DM, ATTN_UNIT_ROWS=QB;
__device__ __forceinline__ int crow(int r,int hi){return (r&3)+8*(r>>2)+4*hi;}
#define SBAR() __builtin_amdgcn_sched_barrier(0)
__device__ __forceinline__ void cmask(f32x16&p0,f32x16&p1,int jb,int qrel,int hi){
  const float NEG=-INFINITY; int kb=64*jb+4*hi;
  #pragma unroll
  for(int r=0;r<16;++r){int kv=kb+(r&3)+8*(r>>2); if(kv>qrel)p0[r]=NEG; if(kv+32>qrel)p1[r]=NEG;}
}

constexpr int NSLOT=3, SLOTB=8192;
constexpr int LDS_K=0, LDS_V=NSLOT*SLOTB, LDS_WS=2*NSLOT*SLOTB, LDS_OST=LDS_WS+NW*64*4, LDS_CB=LDS_OST+NW*4096, LDS_BYTES=LDS_CB+SEQ*4;
constexpr float C2=0.125f*1.4426950408889634f;
__device__ __forceinline__ void glds16(const void*gsrc,unsigned lds_dst){unsigned keep;
  asm volatile("s_mov_b32 %0, m0\n\ts_mov_b32 m0, %2\n\ts_nop 0\n\tglobal_load_lds_dwordx4 %1, off\n\ts_mov_b32 m0, %0":"=&s"(keep):"v"(gsrc),"s"(lds_dst):"memory");}
__device__ __forceinline__ float max3f(float a,float b,float c){float r;asm("v_max3_f32 %0, %1, %2, %3":"=v"(r):"v"(a),"v"(b),"v"(c));return r;}
__device__ __forceinline__ float max2f(float a,float b){float r;asm("v_max_f32_e32 %0, %1, %2":"=v"(r):"v"(a),"v"(b));return r;}
__device__ __forceinline__ float fadd_s(float a,float b){float r;asm("v_add_f32_e32 %0, %1, %2":"=v"(r):"v"(a),"v"(b));return r;}
__device__ __forceinline__ float fsub_s(float a,float b){float r;asm("v_sub_f32_e32 %0, %1, %2":"=v"(r):"v"(a),"v"(b));return r;}
typedef float f32x2_t __attribute__((ext_vector_type(2))); typedef __bf16 bf16x2_t __attribute__((ext_vector_type(2)));
__device__ __forceinline__ unsigned cvtpk_s(float lo,float hi){f32x2_t v={lo,hi};bf16x2_t b=__builtin_convertvector(v,bf16x2_t);return __builtin_bit_cast(unsigned,b);}
#define WAIT_BAR(N) asm volatile("s_waitcnt vmcnt(" #N ") lgkmcnt(0)\n\ts_barrier":::"memory")

__device__ __forceinline__ void qkt(f32x16&p0,f32x16&p1,const char*Kslot,const bf16x8*qr,int r32,int hi){
  const char*kb=Kslot+hi*1024+r32*16;
  #pragma unroll
  for(int d0=0;d0<4;++d0){
    const bf16x8 b0=*reinterpret_cast<const bf16x8*>(kb+d0*2048);
    const bf16x8 b1=*reinterpret_cast<const bf16x8*>(kb+d0*2048+512);
    p0=__builtin_amdgcn_mfma_f32_32x32x16_bf16(b0,qr[d0],p0,0,0,0);p1=__builtin_amdgcn_mfma_f32_32x32x16_bf16(b1,qr[d0],p1,0,0,0);}
}
typedef __attribute__((address_space(3))) const char* lds_cptr;
typedef short v4i16_t __attribute__((ext_vector_type(4)));
__device__ __forceinline__ void kload8(bf16x8*kf,lds_cptr kp){
  kf[0]=*(const __attribute__((address_space(3))) bf16x8*)(kp);      kf[1]=*(const __attribute__((address_space(3))) bf16x8*)(kp+512);
  kf[2]=*(const __attribute__((address_space(3))) bf16x8*)(kp+2048); kf[3]=*(const __attribute__((address_space(3))) bf16x8*)(kp+2560);
  kf[4]=*(const __attribute__((address_space(3))) bf16x8*)(kp+4096); kf[5]=*(const __attribute__((address_space(3))) bf16x8*)(kp+4608);
  kf[6]=*(const __attribute__((address_space(3))) bf16x8*)(kp+6144); kf[7]=*(const __attribute__((address_space(3))) bf16x8*)(kp+6656);
}
__device__ __forceinline__ void kload2(bf16x8*kf,lds_cptr kp,int j){ kf[2*j]=*(const __attribute__((address_space(3))) bf16x8*)(kp+j*2048); kf[2*j+1]=*(const __attribute__((address_space(3))) bf16x8*)(kp+j*2048+512); }
__device__ __forceinline__ s16x4 vtr(lds_cptr p){ return __builtin_bit_cast(s16x4,__builtin_amdgcn_ds_read_tr16_b64_v4i16((__attribute__((address_space(3))) v4i16_t*)p)); }
__device__ __forceinline__ float rowmax(const f32x16&p0,const f32x16&p1){
  float a=max3f(p0[0],p0[1],p1[0]),b=max3f(p0[2],p0[3],p1[1]);a=max3f(a,p1[2],p1[3]);
  #pragma unroll
  for(int r=4;r<16;r+=4){a=max3f(a,p0[r],p0[r+1]);b=max3f(b,p0[r+2],p0[r+3]);a=max3f(a,p1[r],p1[r+1]);b=max3f(b,p1[r+2],p1[r+3]);}
  const float m=max2f(a,b);
  auto rr=__builtin_amdgcn_permlane32_swap(__float_as_uint(m),__float_as_uint(m),false,false);
  return max2f(__uint_as_float(rr[0]),__uint_as_float(rr[1]));
}
__device__ __forceinline__ void pv(f32x16*o,int vb,bf16x8 pa0,bf16x8 pa1,bf16x8 pa2,bf16x8 pa3){
  #pragma unroll
  for(int d0=0;d0<2;++d0){s16x4 lo[4],hi[4];
    #pragma unroll
    for(int ks=0;ks<4;++ks){
      asm volatile("ds_read_b64_tr_b16 %0,%1 offset:%c2":"=&v"(lo[ks]):"v"(vb),"i"(d0*4096+ks*1024):"memory");
      asm volatile("ds_read_b64_tr_b16 %0,%1 offset:%c2":"=&v"(hi[ks]):"v"(vb),"i"(d0*4096+ks*1024+512):"memory");}
    asm volatile("s_waitcnt lgkmcnt(0)":::"memory");SBAR();
    #define PK(k) (bf16x8){lo[k][0],lo[k][1],lo[k][2],lo[k][3],hi[k][0],hi[k][1],hi[k][2],hi[k][3]}
    o[d0]=__builtin_amdgcn_mfma_f32_32x32x16_bf16(pa0,PK(0),o[d0],0,0,0);
    o[d0]=__builtin_amdgcn_mfma_f32_32x32x16_bf16(pa1,PK(1),o[d0],0,0,0);
    o[d0]=__builtin_amdgcn_mfma_f32_32x32x16_bf16(pa2,PK(2),o[d0],0,0,0);
    o[d0]=__builtin_amdgcn_mfma_f32_32x32x16_bf16(pa3,PK(3),o[d0],0,0,0);
    #undef PK
  }
}

#ifndef ATTN_STORE16
#define ATTN_STORE16(p,v) (*(u32x4*)(p)=(v))
#endif
template<int THRL> __device__ __forceinline__ void attn_unit(int b,int h,int qb,const bf16*Q,const bf16*__restrict__ K,const bf16*__restrict__ V,bf16*O,const float*__restrict__ CB,char*shm){
  const int tid=tid_opaque(),lane=tid&63,r32=lane&31,hi=lane>>5; const int wid=__builtin_amdgcn_readfirstlane(tid>>6);
  const long rowbase=(long)b*SEQ; const int q0=qb*QB;
  const bf16*Qw=Q+(rowbase+q0+wid*QBLK)*DM+h*D;
  const bf16*Kh=K+rowbase*DM+h*D,*Vh=V+rowbase*DM+h*D;
  const lds_cptr shm3=(lds_cptr)shm;
  const unsigned lds0=(unsigned)(uintptr_t)shm;
  float*wsf=(float*)(shm+LDS_WS)+wid*64;
  const bf16*ksrc=Kh+(long)lane*DM+wid*8;
  const bf16*vsrc=Vh+(long)(16*(wid&3)+(lane>>2))*DM+(wid>>2)*32+(lane&3)*8;
  const unsigned kdst=lds0+LDS_K+wid*1024, vdst=lds0+LDS_V+wid*1024;
  #define DMA_K(t,slot) glds16(ksrc+(long)(t)*KVBLK*DM,(unsigned)__builtin_amdgcn_readfirstlane(kdst+(slot)))
  #define DMA_V(t,slot) glds16(vsrc+(long)(t)*KVBLK*DM,(unsigned)__builtin_amdgcn_readfirstlane(vdst+(slot)))
  const int vb0=(int)(lds0+LDS_V)+((lane>>4)&1)*32+(lane&3)*8+(4*hi+((lane&15)>>2))*64;
  const char*Kbase=shm+LDS_K; bf16x8 kf[8];
  const lds_cptr kp0=shm3+LDS_K+hi*1024+r32*16; const lds_cptr vp0=shm3+LDS_V+((lane>>4)&1)*32+(lane&3)*8+(4*hi+((lane&15)>>2))*64;
  const int NT=(q0+QB)/KVBLK;
  typedef __attribute__((address_space(3))) const f32x4v* lds_cf4; const lds_cf4 cb4=(lds_cf4)(shm3+LDS_CB)+hi;
  { __attribute__((address_space(3))) float* cbw=(__attribute__((address_space(3))) float*)(shm3+LDS_CB); for(int i=tid;i<q0+QB;i+=NW*64)cbw[i]=CB[i]*1.4426950408889634f; }
  #define CINIT1(C,t,o_) do{ _Pragma("unroll") for(int g_=0;g_<4;++g_){ const f32x4v a_=cb4[(t)*16+2*g_+(o_)]; \
      C[4*g_]=nm-a_[0]; C[4*g_+1]=nm-a_[1]; C[4*g_+2]=nm-a_[2]; C[4*g_+3]=nm-a_[3]; } }while(0)
  #define CINIT(C0,C1,t) do{ CINIT1(C0,t,0); CINIT1(C1,t,8); }while(0)
  DMA_K(0,0);DMA_V(0,0);DMA_K(1,SLOTB);
  bf16x8 qr[4];
  #pragma unroll
  for(int d0=0;d0<4;++d0)qr[d0]=*reinterpret_cast<const bf16x8*>(&Qw[(long)r32*DM+d0*16+hi*8]);
  float l_reg=0.f,nm=0.f;f32x16 o[2];o[0]=f32x16{};o[1]=f32x16{};
  const int qrel=wid*QBLK+r32;
  #define CMASK(P0,P1,t) do{int jb_=(t)-(NT-4); if(jb_>=0)cmask(P0,P1,jb_,qrel,hi);}while(0)
  bool resc=false;
  #define START(P0,P1) do{ const float rm=rowmax(P0,P1); resc=false; \
    { const float dl=rm; nm=fsub_s(nm,dl); \
      _Pragma("unroll") for(int r=0;r<16;++r){P0[r]=fsub_s(P0[r],dl);P1[r]=fsub_s(P1[r],dl);} \
      } \
    _Pragma("unroll") for(int r=0;r<16;++r)P0[r]=__builtin_amdgcn_exp2f(P0[r]); }while(0)
  #define RESC() do{ if(resc){ asm volatile("s_waitcnt lgkmcnt(0)":::"memory"); \
      _Pragma("unroll") for(int d_=0;d_<2;++d_) _Pragma("unroll") for(int r=0;r<16;++r)o[d_][r]*=wsf[crow(r,hi)]; } }while(0)
  f32x16 pA0,pA1,pB0,pB1;
  int sl_prev=0,sl_cur=0,sl_next=SLOTB;
  #define ROT() do{sl_prev=sl_cur;sl_cur=sl_next;sl_next=(sl_next==(NSLOT-1)*SLOTB)?0:sl_next+SLOTB;}while(0)
  DMA_K(2,2*SLOTB);
  WAIT_BAR(3);
  CINIT(pA0,pA1,0); qkt(pA0,pA1,Kbase,qr,r32,hi);asm volatile("s_nop 15\n\ts_nop 7":"+v"(pA0),"+v"(pA1));CMASK(pA0,pA1,0);
  START(pA0,pA1);
  _Pragma("unroll") for(int r=0;r<16;++r)pA1[r]=__builtin_amdgcn_exp2f(pA1[r]);
  WAIT_BAR(0);
  DMA_K(3,0);DMA_V(1,SLOTB);
  ROT();
  kload8(kf,kp0+sl_cur);
  WAIT_BAR(2);
  s16x4 vlo[8],vhi[8]; u32x4 pw0,pw1,pw2,pw3;
  #define PKW(P,B) cvtpk_s(P[B],P[B+1])
  #define PAF(k) __builtin_bit_cast(bf16x8,pw##k)
  #define VFR(i) (bf16x8){vlo[i][0],vlo[i][1],vlo[i][2],vlo[i][3],vhi[i][0],vhi[i][1],vhi[i][2],vhi[i][3]}
  #define PIN(x) asm volatile("":"+v"(x))
  #define MX3(a,b,c) __builtin_fmaxf(__builtin_fmaxf((a),(b)),(c))
  #define GAPA(MF,A0,A1,A2,A3,W0,W1,PW) do{ MF; sacc+=A0; sacc+=A1; sacc+=A2; sacc+=A3; PIN(sacc); W0; W1; PIN(PW); SBAR(); }while(0)
  #define EX(v) __builtin_amdgcn_exp2f(v)
  #define GAPB(MF,X,B) do{ MF; X[B]=EX(X[B]); X[B+1]=EX(X[B+1]); X[B+2]=EX(X[B+2]); X[B+3]=EX(X[B+3]); PIN(X); SBAR(); }while(0)
  #define VRD(i) do{ vlo[i]=vtr(vp_+(((i)>>2)*4096+((i)&3)*1024)); vhi[i]=vtr(vp_+(((i)>>2)*4096+((i)&3)*1024+512)); }while(0)
  #define KRD(G,j) do{ if(G){ kload2(kf,kp0+sl_next,j); SBAR(); } }while(0)
  #define STEP(C0,C1,P0,P1,t,GK,GV,GL) do{ SBAR(); \
    const lds_cptr vp_=vp0+sl_prev; \
    CINIT1(C0,t,0); SBAR(); \
    VRD(0); SBAR(); float sacc=(P0[0]+P0[1]); \
    GAPA(C0=__builtin_amdgcn_mfma_f32_32x32x16_bf16(kf[0],qr[0],C0,0,0,0), P0[2],P0[3],P0[4],P0[5],     pw0[0]=PKW(P0,0), pw0[1]=PKW(P0,2), pw0); \
    CINIT1(C1,t,8); SBAR(); VRD(4); SBAR(); GAPA(C1=__builtin_amdgcn_mfma_f32_32x32x16_bf16(kf[1],qr[0],C1,0,0,0), P0[6],P0[7],P0[8],P0[9],     pw0[2]=PKW(P0,4), pw0[3]=PKW(P0,6), pw0); \
    VRD(1); SBAR(); GAPA(C0=__builtin_amdgcn_mfma_f32_32x32x16_bf16(kf[2],qr[1],C0,0,0,0),   P0[10],P0[11],P0[12],P0[13], pw1[0]=PKW(P0,8), pw1[1]=PKW(P0,10), pw1); \
    VRD(5); SBAR(); GAPA(C1=__builtin_amdgcn_mfma_f32_32x32x16_bf16(kf[3],qr[1],C1,0,0,0),   P0[14],P0[15],P1[0],P1[1],   pw1[2]=PKW(P0,12),pw1[3]=PKW(P0,14), pw1); \
    VRD(2); SBAR(); GAPA(C0=__builtin_amdgcn_mfma_f32_32x32x16_bf16(kf[4],qr[2],C0,0,0,0),   P1[2],P1[3],P1[4],P1[5],     pw2[0]=PKW(P1,0), pw2[1]=PKW(P1,2), pw2); \
    VRD(6); SBAR(); GAPA(C1=__builtin_amdgcn_mfma_f32_32x32x16_bf16(kf[5],qr[2],C1,0,0,0),   P1[6],P1[7],P1[8],P1[9],     pw2[2]=PKW(P1,4), pw2[3]=PKW(P1,6), pw2); \
    VRD(3); SBAR(); GAPA(C0=__builtin_amdgcn_mfma_f32_32x32x16_bf16(kf[6],qr[3],C0,0,0,0),   P1[10],P1[11],P1[12],P1[13], pw3[0]=PKW(P1,8), pw3[1]=PKW(P1,10), pw3); \
    VRD(7); SBAR(); GAPA(C1=__builtin_amdgcn_mfma_f32_32x32x16_bf16(kf[7],qr[3],C1,0,0,0),   P1[14],P1[15],0.f,0.f,       pw3[2]=PKW(P1,12),pw3[3]=PKW(P1,14), pw3); \
    l_reg+=sacc; \
    if(GK){DMA_K((t)+3,sl_cur);} if(GV){DMA_V((t)+1,sl_next);} \
    CMASK(C0,C1,t); \
    { float a=MX3(C0[0],C0[1],C1[0]),b=MX3(C0[2],C0[3],C1[1]); a=MX3(a,C1[2],C1[3]); \
      _Pragma("unroll") for(int r=4;r<16;r+=4){a=MX3(a,C0[r],C0[r+1]);b=MX3(b,C0[r+2],C0[r+3]);a=MX3(a,C1[r],C1[r+1]);b=MX3(b,C1[r+2],C1[r+3]);} \
      float rm=__builtin_fmaxf(a,b); { auto rr=__builtin_amdgcn_permlane32_swap(__float_as_uint(rm),__float_as_uint(rm),false,false); rm=__builtin_fmaxf(__uint_as_float(rr[0]),__uint_as_float(rr[1])); } \
      resc=false; \
      if(__builtin_expect(__any(rm>(float)THRL),0)){ const float dl=__builtin_fmaxf(rm,0.f); nm-=dl; \
        _Pragma("unroll") for(int r=0;r<16;++r){C0[r]-=dl;C1[r]-=dl;} \
        const float f=__builtin_amdgcn_exp2f(-dl); l_reg*=f; if(hi==0)wsf[r32]=f; resc=true; } } \
    SBAR(); \
    GAPB(o[0]=__builtin_amdgcn_mfma_f32_32x32x16_bf16(PAF(0),VFR(0),o[0],0,0,0), C0,0); \
    GAPB(o[1]=__builtin_amdgcn_mfma_f32_32x32x16_bf16(PAF(0),VFR(4),o[1],0,0,0), C0,4); \
    KRD(GL,0); GAPB(o[0]=__builtin_amdgcn_mfma_f32_32x32x16_bf16(PAF(1),VFR(1),o[0],0,0,0), C0,8); \
    KRD(GL,1); GAPB(o[1]=__builtin_amdgcn_mfma_f32_32x32x16_bf16(PAF(1),VFR(5),o[1],0,0,0), C0,12); \
    KRD(GL,2); GAPB(o[0]=__builtin_amdgcn_mfma_f32_32x32x16_bf16(PAF(2),VFR(2),o[0],0,0,0), C1,0); \
    KRD(GL,3); GAPB(o[1]=__builtin_amdgcn_mfma_f32_32x32x16_bf16(PAF(2),VFR(6),o[1],0,0,0), C1,4); \
    GAPB(o[0]=__builtin_amdgcn_mfma_f32_32x32x16_bf16(PAF(3),VFR(3),o[0],0,0,0), C1,8); \
    GAPB(o[1]=__builtin_amdgcn_mfma_f32_32x32x16_bf16(PAF(3),VFR(7),o[1],0,0,0), C1,12); \
    }while(0)
  int t=1;
  #undef CMASK
  #define CMASK(P0,P1,t) do{}while(0)
  for(;t+5<NT;t+=2){
    STEP(pB0,pB1,pA0,pA1,t,true,true,true);     WAIT_BAR(2); RESC(); ROT();
    STEP(pA0,pA1,pB0,pB1,t+1,true,true,true);   WAIT_BAR(2); RESC(); ROT();
  }
  #undef CMASK
  #define CMASK(P0,P1,t) do{int jb_=(t)-(NT-4); if(jb_>=0)cmask(P0,P1,jb_,qrel,hi);}while(0)
  #define ENDW(tt) do{ if((tt)+3<NT){WAIT_BAR(2);} else if((tt)+2<NT){WAIT_BAR(1);} else {WAIT_BAR(0);} }while(0)
  for(;t+1<NT;t+=2){
    STEP(pB0,pB1,pA0,pA1,t,(t+3<NT),(t+1<NT),(t+1<NT));       ENDW(t);   RESC(); ROT();
    STEP(pA0,pA1,pB0,pB1,t+1,(t+4<NT),(t+2<NT),(t+2<NT));     ENDW(t+1); RESC(); ROT();
  }
  STEP(pB0,pB1,pA0,pA1,NT-1,false,false,false); RESC();
  { float sacc=pB0[0]+pB0[1]; _Pragma("unroll") for(int r=2;r<16;++r)sacc+=pB0[r]; _Pragma("unroll") for(int r=0;r<16;++r)sacc+=pB1[r]; l_reg+=sacc;
    pw0=(u32x4){PKW(pB0,0),PKW(pB0,2),PKW(pB0,4),PKW(pB0,6)};pw1=(u32x4){PKW(pB0,8),PKW(pB0,10),PKW(pB0,12),PKW(pB0,14)};pw2=(u32x4){PKW(pB1,0),PKW(pB1,2),PKW(pB1,4),PKW(pB1,6)};pw3=(u32x4){PKW(pB1,8),PKW(pB1,10),PKW(pB1,12),PKW(pB1,14)};
    SBAR(); pv(o,vb0+sl_cur,PAF(0),PAF(1),PAF(2),PAF(3)); }
  #undef PKW
  #undef PAF
  #undef VFR
  #undef PIN
  #undef MX3
  #undef GAPA
  #undef GAPB
  #undef EX
  #undef VRD
  #undef KRD
  #undef STEP
  #undef ENDW
  {auto rr=__builtin_amdgcn_permlane32_swap(__float_as_uint(l_reg),__float_as_uint(l_reg),false,false);l_reg=__uint_as_float(rr[0])+__uint_as_float(rr[1]);}
  if(hi==0)wsf[32+r32]=l_reg;asm volatile("s_waitcnt lgkmcnt(0)":::"memory");
  float rli[16];
  #pragma unroll
  for(int r=0;r<16;++r)rli[r]=__builtin_amdgcn_rcpf(wsf[32+crow(r,hi)]);
  bf16*Ow=O+(rowbase+q0+wid*QBLK)*DM+h*D;
  { bf16*stg=(bf16*)(shm+LDS_OST)+wid*2048;
    #pragma unroll
    for(int r=0;r<16;++r){const int orow=crow(r,hi);
      #pragma unroll
      for(int d0=0;d0<2;++d0)stg[orow*64+d0*32+r32]=__float2bfloat16(o[d0][r]*rli[r]);}
    asm volatile("s_waitcnt lgkmcnt(0)":::"memory");
    #pragma unroll
    for(int i=0;i<4;++i){const int row=i*8+(lane>>3),ch=lane&7; const u32x4 v=*(const u32x4*)(stg+row*64+ch*8); ATTN_STORE16(Ow+(long)row*DM+ch*8,v);} }
  asm volatile("s_waitcnt lgkmcnt(0)\n\ts_barrier":::"memory");
  #undef DMA_K
  #undef DMA_V
  #undef CMASK
  #undef START
  #undef RESC
  #undef ROT
  #undef CINIT
  #undef CINIT1
}
constexpr int ATTN_LDS_BYTES=LDS_BYTES;
struct AttnTensors { const bf16* Q; const bf16* K; const bf16* V; bf16* O; const float* CB; };
struct AttnUnit { int bh; int qb; };
struct StaticOrder {
  int vcu, G;
  __device__ __forceinline__ StaticOrder(int grid,int v):vcu(v),G(grid){}
  __device__ __forceinline__ bool next(int i,AttnUnit&u)const{
    if(G==256){ if(i>=2)return false; const int s=vcu&3; u.bh=vcu>>2; u.qb=(i==0)?7-s:s; return true; }
    const int L=i*G+vcu; if(L>=BATCH*NHEAD*NQB)return false; u.bh=L>>3; u.qb=7-(L&7); return true; }
  __device__ __forceinline__ void a_ready(const AttnUnit&)const{}
  __device__ __forceinline__ void done(const AttnUnit&)const{}
};
template<class Sched,int THRL=8> __device__ __forceinline__ void attn_phase(char*lds,const AttnTensors&T,const Sched&S){
  AttnUnit u;
  for(int i=0;S.next(i,u);++i){ S.a_ready(u); attn_unit<THRL>(u.bh/NHEAD,u.bh%NHEAD,u.qb,T.Q,T.K,T.V,T.O,T.CB+(long)u.bh*SEQ,lds); S.done(u); }
}
#undef SBAR
#undef WAIT_BAR
}

constexpr int NWAVES = 8;
constexpr int NPH = 11;
constexpr int N_LAUNCHES = MK_N_LAUNCHES;
static_assert(N_LAUNCHES == 1 || N_LAUNCHES == NPH, "MK_N_LAUNCHES is 1 (one launch) or NPH (one launch per phase)");

constexpr size_t MiB = 1u << 20;
constexpr size_t WS_CTL = 0, CTL_ZERO_BYTES = 1 * MiB;
constexpr size_t WS_MOD = 1 * MiB;
constexpr size_t WS_LOGF = 1 * MiB + 256 * 1024;
constexpr size_t WS_ROUTE = 2 * MiB;
constexpr size_t WS_RW = 2 * MiB + 256 * 1024;
constexpr size_t WS_CUM = 2 * MiB + 512 * 1024;
constexpr size_t WS_LIST = 3 * MiB;
constexpr size_t WS_CUMP = 5 * MiB;
constexpr size_t WS_WIN = 6 * MiB;
constexpr size_t WS_WGLU = 14 * MiB, WS_WOF = 15 * MiB, WS_WOS = 16 * MiB, WS_WO = 17 * MiB;
constexpr size_t WS_WGU = 20 * MiB;
constexpr size_t WS_WD = 84 * MiB;
constexpr size_t WS_H = 116 * MiB;
constexpr size_t WS_Y = 148 * MiB;
constexpr size_t WS_MIX = 164 * MiB;
constexpr size_t WS_Q = WS_MIX, WS_K = WS_MIX + 16 * MiB, WS_V = WS_MIX + 32 * MiB, WS_U = WS_MIX + 48 * MiB, WS_SGA = WS_MIX + 64 * MiB, WS_SGB = WS_MIX + 96 * MiB;
constexpr size_t WS_HID = WS_MIX;
constexpr size_t WS_YROWS = WS_MIX + 40 * MiB;
constexpr size_t WS_END = 292 * MiB;
static_assert(WS_YROWS + (size_t)M * 2 * 1024 * 2 <= WS_END && WS_SGB + (size_t)M * 1024 * 2 <= WS_END, "d_ws map");

constexpr int CW_TMO = 0;
constexpr int CW_CNT = 2048;
constexpr int CW_CHK = 4096;
constexpr int CW_BAR = 8192;

constexpr int RING_OFF = 0, RING_BYTES = 131072;
constexpr int LDSCTL_OFF = RING_BYTES, MISC_OFF = LDSCTL_OFF + 320, MOE_OFF = LDSCTL_OFF + 1024;
constexpr int LDS_BYTES = 147456;

#define GAS __attribute__((address_space(1)))
#define LAS __attribute__((address_space(3)))
typedef unsigned short bf16;
typedef unsigned v4u __attribute__((ext_vector_type(4)));
typedef unsigned v2u __attribute__((ext_vector_type(2)));
typedef float f32x4 __attribute__((ext_vector_type(4)));
typedef float f32x2 __attribute__((ext_vector_type(2)));
typedef GAS unsigned gu32;
#define RLX_AGENT __ATOMIC_RELAXED, __HIP_MEMORY_SCOPE_AGENT
#define LDS_WAIT() asm volatile("s_waitcnt lgkmcnt(0)" ::: "memory")
#define VM_WAIT() asm volatile("s_waitcnt vmcnt(0)" ::: "memory")
__device__ __forceinline__ unsigned f2bf(float f) { unsigned u = __builtin_bit_cast(unsigned, f); return (u + 0x7fffu + ((u >> 16) & 1u)) >> 16; }
__device__ __forceinline__ unsigned pk2(float lo, float hi) { return f2bf(lo) | (f2bf(hi) << 16); }
__device__ __forceinline__ float bflo(unsigned w) { return __uint_as_float(w << 16); }
__device__ __forceinline__ float bfhi(unsigned w) { return __uint_as_float(w & 0xffff0000u); }
__device__ __forceinline__ float fast_sigmoid(float v) { return __builtin_amdgcn_rcpf(1.f + __builtin_amdgcn_exp2f(-LOG2E * v)); }

#define XB_TMO      128
#define XB_XCNT(j)  (256  + 64 * (j))
#define XB_XSUB(j)  (1280 + 64 * (j))
#define XB_XGEN(j)  (2304 + 64 * (j))
#define XB_TOP      3328
#define XB_TOPGEN   3392
#define XCD_BAR_WORDS 3456
#define XB_SPIN_CAP (1u << 18)
__device__ __forceinline__ unsigned xb_ld(unsigned* p)              { return __hip_atomic_load(p, __ATOMIC_RELAXED, __HIP_MEMORY_SCOPE_AGENT); }
__device__ __forceinline__ unsigned xb_add(unsigned* p, unsigned v) { return __hip_atomic_fetch_add(p, v, __ATOMIC_RELAXED, __HIP_MEMORY_SCOPE_AGENT); }
__device__ __forceinline__ unsigned xb_xcc_id() { return (unsigned)__builtin_amdgcn_s_getreg((3 << 11) | 20) & 0xFu; }
#define XB_SPIN(cond, bar) do { unsigned _sp = 0; while (cond) { __builtin_amdgcn_s_sleep(1); \
    if ((++_sp & 255u) == 0u) { if (xb_ld(&(bar)[XB_TMO])) break; if (_sp > XB_SPIN_CAP) { atomicAdd(&(bar)[XB_TMO], 1u); break; } } } } while (0)
struct XcdBarrier { unsigned* bar; unsigned x; volatile LAS unsigned* st; };
__device__ __forceinline__ XcdBarrier xcd_barrier_post(unsigned* bar, volatile LAS unsigned* st) {
    XcdBarrier b; b.bar = bar; b.x = xb_xcc_id(); b.st = st;
    if (threadIdx.x == 0) (void)xb_add(&bar[XB_XCNT(b.x)], 1u);
    return b;
}
__device__ __forceinline__ void xcd_barrier_complete(unsigned* bar, unsigned x, unsigned& nloc, unsigned& nx) {
    const unsigned G = gridDim.x * gridDim.y * gridDim.z;
    unsigned sum, cnt, mine, sp = 0u;
    for (;;) {
        sum = 0u; cnt = 0u; mine = 0u;
#pragma unroll
        for (unsigned j = 0; j < 16; ++j) { const unsigned c = xb_ld(&bar[XB_XCNT(j)]); sum += c; cnt += (c > 0u) ? 1u : 0u; mine = (j == x) ? c : mine; }
        if (sum == G) break;
        __builtin_amdgcn_s_sleep(1);
        if ((++sp & 255u) == 0u) { if (xb_ld(&bar[XB_TMO])) break; if (sp > XB_SPIN_CAP) { atomicAdd(&bar[XB_TMO], 1u); break; } }
    }
    nloc = mine > 0u ? mine : 1u; nx = cnt > 0u ? cnt : 1u;
}
__device__ __forceinline__ void xcd_barrier(const XcdBarrier& b) {
    asm volatile("s_waitcnt vmcnt(0)" ::: "memory");
    __syncthreads();
    if (threadIdx.x == 0) {
        unsigned* bar = b.bar;
        __builtin_amdgcn_s_waitcnt(0);
        unsigned nloc = b.st[0], nx = b.st[1];
        if (nloc == 0u) { xcd_barrier_complete(bar, b.x, nloc, nx); b.st[0] = nloc; b.st[1] = nx; }
        const unsigned old = xb_add(&bar[XB_XSUB(b.x)], 1u);
        const unsigned gen = old / nloc;
        if (old + 1u == (gen + 1u) * nloc) {
            __builtin_amdgcn_fence(__ATOMIC_RELEASE, "agent");
            asm volatile("s_waitcnt vmcnt(0)" ::: "memory");
            const unsigned og = xb_add(&bar[XB_TOP], 1u);
            const unsigned tg = og / nx;
            if (og + 1u == (tg + 1u) * nx) xb_add(&bar[XB_TOPGEN], 1u);
            else XB_SPIN(xb_ld(&bar[XB_TOPGEN]) == tg, bar);
            __builtin_amdgcn_fence(__ATOMIC_ACQUIRE, "agent");
            xb_add(&bar[XB_XGEN(b.x)], 1u);
            asm volatile("s_waitcnt vmcnt(0)" ::: "memory");
        } else {
            XB_SPIN(xb_ld(&bar[XB_XGEN(b.x)]) == gen, bar);
            __builtin_amdgcn_fence(__ATOMIC_ACQUIRE, "agent");
            asm volatile("s_waitcnt vmcnt(0)" ::: "memory");
        }
    }
    __syncthreads();
}

struct Frame {
    LAS unsigned char* lds;
    volatile LAS unsigned* MISC;
    gu32* ctl;
    int tid, lane, wave, vcu, G;
    const float *x, *c, *w_ada, *b_ada, *norm_mix_g, *w_in, *b_forget, *w_out_fox, *lambda_re, *lambda_im, *log_dt, *b_re, *b_im, *c_re, *c_im, *d_skip, *w_glu, *w_out_ssm, *w_o,
        *norm_ffn_g, *w_rg, *b_rg, *w_rexp, *b_rexp, *w_gate, *w_up, *w_down, *final_g;
    float* out;
    float *MOD, *LOGF, *CUM, *RW; int* ROUTE; unsigned* LIST; unsigned* CUMP;
    bf16 *WIN, *WGLU, *WOF, *WOS, *WO, *WGU, *WD, *H, *Y, *Q, *K, *V, *U, *SGA, *SGB, *HID, *YROWS;
};

__device__ __forceinline__ float wave_sum(float v) {
#pragma unroll
    for (int o = 1; o < 64; o <<= 1) v += __shfl_xor(v, o);
    return v;
}

__device__ __forceinline__ void transpose_item(const float* src, int ld_src, bf16* dst, int ld_dst, LAS float* scr, int lane) {
#pragma unroll 8
    for (int i = 0; i < 32; ++i) { const int kk = 2 * i + (lane >> 5); scr[kk * 33 + (lane & 31)] = src[(size_t)kk * ld_src + (lane & 31)]; }
    LDS_WAIT(); asm volatile("" ::: "memory");
    const int c = lane & 7;
#pragma unroll
    for (int j = 0; j < 4; ++j) { const int n = (lane >> 3) + 8 * j; const LAS float* s = scr + (8 * c) * 33 + n;
        v4u o; o.x = pk2(s[0 * 33], s[1 * 33]); o.y = pk2(s[2 * 33], s[3 * 33]); o.z = pk2(s[4 * 33], s[5 * 33]); o.w = pk2(s[6 * 33], s[7 * 33]);
        *(GAS v4u*)(dst + (size_t)n * ld_dst + 8 * c) = o; }
    LDS_WAIT(); asm volatile("" ::: "memory");
}

__device__ __forceinline__ void p0_prologue(Frame& F) {
    {
        LAS float* cact = (LAS float*)(F.lds);
        LAS float* red = (LAS float*)(F.lds + 32768);
        for (int i = F.tid; i < 8192; i += 512) { const float v = F.c[i]; cact[i] = v / (1.f + __expf(-v)); }
        __syncthreads();
        for (int it = F.vcu; it < 192; it += F.G) {
            const int cl = F.lane & 31, hf = F.lane >> 5, col = it * 32 + cl;
            float a[8];
#pragma unroll
            for (int b = 0; b < 8; ++b) a[b] = 0.f;
            for (int i = 0; i < 64; ++i) {
                const int k = 16 * i + 2 * F.wave + hf;
                const float w = F.w_ada[(size_t)k * 6144 + col];
#pragma unroll
                for (int b = 0; b < 8; ++b) a[b] += cact[b * 1024 + k] * w;
            }
#pragma unroll
            for (int b = 0; b < 8; ++b) { a[b] += __shfl_xor(a[b], 32); if (hf == 0) red[(F.wave * 8 + b) * 32 + cl] = a[b]; }
            __syncthreads();
            if (F.tid < 256) { const int b = F.tid >> 5, c2 = F.tid & 31; float s = 0.f;
#pragma unroll
                for (int w = 0; w < 8; ++w) s += red[(w * 8 + b) * 32 + c2];
                F.MOD[b * 6144 + it * 32 + c2] = s + F.b_ada[it * 32 + c2]; }
            __syncthreads();
        }
        __syncthreads();
    }
    LAS float* scr = (LAS float*)(F.lds + RING_OFF + F.wave * 16384);
    const int gw = F.vcu * NWAVES + F.wave, NGW = F.G * NWAVES;
    constexpr int I_A = 16 * 48, I_B = 16 * 80, I_C = 8 * 32, I_D = 8 * 32, I_E = 8 * 32, I_F = 16 * 32, I_G = 32 * 256, I_H = 32 * 256, I_I = 32 * 256;
    constexpr int NITEMS = I_A + I_B + I_C + I_D + I_E + I_F + I_G + I_H + I_I;
    for (int it = gw; it < NITEMS; it += NGW) {
        int r = it;
        if (r < I_A) { const int kb = r / 48, nb = r % 48; transpose_item(F.w_in + (size_t)(64 * kb) * INC + 32 * nb, INC, F.WIN + (size_t)(32 * nb) * 1024 + 64 * kb, 1024, scr, F.lane); continue; } r -= I_A;
        if (r < I_B) { const int kb = r / 80, nb = r % 80; transpose_item(F.w_in + (size_t)(64 * kb) * INC + 1544 + 32 * nb, INC, F.WIN + (size_t)(1536 + 32 * nb) * 1024 + 64 * kb, 1024, scr, F.lane); continue; } r -= I_B;
        if (r < I_C) { const int kb = r / 32, nb = r % 32, n0 = 32 * nb, half = n0 >> 9, within = n0 & 511, pn = within >> 7, q = within & 127;
            transpose_item(F.w_glu + (size_t)(64 * kb) * 1024 + n0, 1024, F.WGLU + (size_t)(pn * 256 + half * 128 + q) * 512 + 64 * kb, 512, scr, F.lane); continue; } r -= I_C;
        if (r < I_D) { const int kb = r / 32, nb = r % 32; transpose_item(F.w_out_fox + (size_t)(64 * kb) * 1024 + 32 * nb, 1024, F.WOF + (size_t)(32 * nb) * 512 + 64 * kb, 512, scr, F.lane); continue; } r -= I_D;
        if (r < I_E) { const int kb = r / 32, nb = r % 32; transpose_item(F.w_out_ssm + (size_t)(64 * kb) * 1024 + 32 * nb, 1024, F.WOS + (size_t)(32 * nb) * 512 + 64 * kb, 512, scr, F.lane); continue; } r -= I_E;
        if (r < I_F) { const int kb = r / 32, nb = r % 32; transpose_item(F.w_o + (size_t)(64 * kb) * 1024 + 32 * nb, 1024, F.WO + (size_t)(32 * nb) * 1024 + 64 * kb, 1024, scr, F.lane); continue; } r -= I_F;
        if (r < I_G + I_H) { const int up = r >= I_G; if (up) r -= I_G; const int e = r >> 8, rr = r & 255, kb = rr >> 4, nb = rr & 15, n0 = 32 * nb, pn = n0 >> 7, q = n0 & 127;
            const float* src = (up ? F.w_up : F.w_gate) + (size_t)e * 1024 * 512 + (size_t)(64 * kb) * 512 + n0;
            transpose_item(src, 512, F.WGU + (size_t)e * 1024 * 1024 + (size_t)(pn * 256 + up * 128 + q) * 1024 + 64 * kb, 1024, scr, F.lane); continue; } r -= I_G + I_H;
        { const int e = r >> 8, rr = r & 255, kb = rr >> 5, nb = rr & 31;
            transpose_item(F.w_down + (size_t)e * 512 * 1024 + (size_t)(64 * kb) * 1024 + 32 * nb, 1024, F.WD + (size_t)e * 1024 * 512 + (size_t)(32 * nb) * 512 + 64 * kb, 512, scr, F.lane); }
    }
}


__device__ __forceinline__ void p1_rows(Frame& F) {
    LAS float* wfT = (LAS float*)(F.lds);
    for (int idx = F.tid; idx < 8192; idx += 512) { const int k = idx >> 3, j = idx & 7; wfT[j * 1024 + k] = F.w_in[(size_t)k * INC + 1536 + j]; }
    __syncthreads();
    const int gw = F.vcu * NWAVES + F.wave, NGW = F.G * NWAVES;
    for (int ch = gw; ch < M / 8; ch += NGW) {
        const int b = (ch * 8) / SEQ;
        const float* mod = F.MOD + b * 6144;
        f32x4 es[4], sh[4];
#pragma unroll
        for (int j = 0; j < 4; ++j) { const int c = 4 * F.lane + 256 * j; const f32x4 g4 = *(const f32x4*)(F.norm_mix_g + c), sc = *(const f32x4*)(mod + 1024 + c); es[j] = g4 * (sc + 1.f); sh[j] = *(const f32x4*)(mod + c); }
        for (int r = 0; r < 8; ++r) {
            const int m = ch * 8 + r;
            const GAS f32x4* xr = (const GAS f32x4*)(F.x + (size_t)m * D) + F.lane;
            f32x4 v[4]; float ss = 0.f;
#pragma unroll
            for (int j = 0; j < 4; ++j) { v[j] = xr[64 * j]; ss += (v[j].x * v[j].x + v[j].y * v[j].y) + (v[j].z * v[j].z + v[j].w * v[j].w); }
            const float rstd = 1.f / sqrtf(wave_sum(ss) * (1.f / D) + RMS_EPS);
            GAS v2u* o8 = (GAS v2u*)(F.H + (size_t)m * D) + F.lane;
#pragma unroll
            for (int j = 0; j < 4; ++j) { v[j] = v[j] * rstd * es[j] + sh[j]; v2u w; w.x = pk2(v[j].x, v[j].y); w.y = pk2(v[j].z, v[j].w); o8[64 * j] = w; }
            float f[8];
#pragma unroll
            for (int jj = 0; jj < 8; ++jj) { float a = 0.f;
#pragma unroll
                for (int j = 0; j < 4; ++j) { const f32x4 w4 = *(const LAS f32x4*)(wfT + jj * 1024 + 4 * F.lane + 256 * j); a += (v[j].x * w4.x + v[j].y * w4.y) + (v[j].z * w4.z + v[j].w * w4.w); }
                f[jj] = wave_sum(a); }
            if (F.lane < 8) {
                float z = f[0];
#pragma unroll
                for (int jj = 1; jj < 8; ++jj) z = (F.lane == jj) ? f[jj] : z;
                z += F.b_forget[F.lane];
                F.LOGF[(size_t)m * 8 + F.lane] = fminf(z, 0.f) - log1pf(expf(-fabsf(z)));
            }
        }
    }
}

__device__ __forceinline__ void p2_cumscan(Frame& F) {
    const int gw = F.wave * F.G + F.vcu, NGW = F.G * NWAVES;
    for (int u = gw; u < NB * NH; u += NGW) {
        const int b = u >> 3, h = u & 7;
        float v[32]; float run = 0.f;
#pragma unroll
        for (int i = 0; i < 32; ++i) { run += F.LOGF[((size_t)b * SEQ + 32 * F.lane + i) * 8 + h]; v[i] = run; }
        float incl = run;
#pragma unroll
        for (int o = 1; o < 64; o <<= 1) { const float t = __shfl_up(incl, o); if (F.lane >= o) incl += t; }
        const float excl = incl - run;
#pragma unroll
        for (int i = 0; i < 32; ++i) { const float cv = v[i] + excl; F.CUM[(size_t)u * SEQ + 32 * F.lane + i] = cv;
            const float nb = -cv * LOG2E; const unsigned hb = f2bf(nb); const float lo = nb - __uint_as_float(hb << 16); F.CUMP[(size_t)u * SEQ + 32 * F.lane + i] = hb | (f2bf(lo) << 16); }
    }
}

using pg8::Unit;
struct EpiInProj {
    static constexpr bool PERM = true;
    bf16* mix;
    __device__ __forceinline__ void operator()(const f32x4 (&acc)[2][2][4][2], const Unit& u, int wr, int wc, int fr, int fq) const {
        const int pn = u.pn; bf16* base; int ldc, colt, mode;
        if (pn < 8) { base = mix + (size_t)(pn >> 1) * ((size_t)M * 512); ldc = 512; colt = (pn & 1) * 256; mode = pn < 2 ? 1 : 0; }
        else { const int g = (pn - 8) >> 2; base = mix + (size_t)4 * M * 512 + (size_t)g * ((size_t)M * 1024); ldc = 1024; colt = ((pn - 8) & 3) * 256; mode = 2; }
        const int row0 = u.pm * 256 + wr * 64 + fr, col0 = colt + wc * 32 + 8 * fq;
#pragma unroll
        for (int ai = 0; ai < 2; ++ai)
#pragma unroll
            for (int m = 0; m < 4; ++m) { bf16* rowp = base + (size_t)(row0 + ai * 128 + m * 16) * ldc + col0;
#pragma unroll
                for (int bj = 0; bj < 2; ++bj) { f32x4 v0 = acc[ai][bj][m][0], v1 = acc[ai][bj][m][1];
                    if (mode == 1) { v0 = v0 * QSCALE; v1 = v1 * QSCALE; }
                    else if (mode == 2) {
#pragma unroll
                        for (int e = 0; e < 4; ++e) { v0[e] = fast_sigmoid(v0[e]); v1[e] = fast_sigmoid(v1[e]); } }
                    v4u w; w.x = pg8::cvt_pk_bf16(v0[0], v0[1]); w.y = pg8::cvt_pk_bf16(v0[2], v0[3]); w.z = pg8::cvt_pk_bf16(v1[0], v1[1]); w.w = pg8::cvt_pk_bf16(v1[2], v1[3]);
                    *(v4u*)(rowp + bj * 128) = w; } }
    }
};
template <int MODE> struct EpiGate {
    static constexpr bool PERM = true;
    bf16* T; const bf16* Gt;
    __device__ __forceinline__ void operator()(const f32x4 (&acc)[2][2][4][2], const Unit& u, int wr, int wc, int fr, int fq) const {
        const int row0 = u.pm * 256 + wr * 64 + fr, col0 = u.pn * 256 + wc * 32 + 8 * fq;
#pragma unroll
        for (int ai = 0; ai < 2; ++ai)
#pragma unroll
            for (int m = 0; m < 4; ++m) { const size_t off = (size_t)(row0 + ai * 128 + m * 16) * 1024 + col0;
#pragma unroll
                for (int bj = 0; bj < 2; ++bj) { const f32x4 v0 = acc[ai][bj][m][0], v1 = acc[ai][bj][m][1];
                    const v4u t = *(const v4u*)(T + off + bj * 128); v4u w;
                    if (MODE == 0) {
                        w.x = pg8::cvt_pk_bf16(bflo(t.x) * v0[0], bfhi(t.x) * v0[1]); w.y = pg8::cvt_pk_bf16(bflo(t.y) * v0[2], bfhi(t.y) * v0[3]);
                        w.z = pg8::cvt_pk_bf16(bflo(t.z) * v1[0], bfhi(t.z) * v1[1]); w.w = pg8::cvt_pk_bf16(bflo(t.w) * v1[2], bfhi(t.w) * v1[3]);
                    } else {
                        const v4u gg = *(const v4u*)(Gt + off + bj * 128);
                        w.x = pg8::cvt_pk_bf16(bflo(t.x) + bflo(gg.x) * v0[0], bfhi(t.x) + bfhi(gg.x) * v0[1]); w.y = pg8::cvt_pk_bf16(bflo(t.y) + bflo(gg.y) * v0[2], bfhi(t.y) + bfhi(gg.y) * v0[3]);
                        w.z = pg8::cvt_pk_bf16(bflo(t.z) + bflo(gg.z) * v1[0], bfhi(t.z) + bfhi(gg.z) * v1[1]); w.w = pg8::cvt_pk_bf16(bflo(t.w) + bflo(gg.w) * v1[2], bfhi(t.w) + bfhi(gg.w) * v1[3]);
                    }
                    *(v4u*)(T + off + bj * 128) = w; } }
    }
};
template <int MODE> struct EpiPair {
    static constexpr bool PERM = true;
    bf16* O;
    __device__ __forceinline__ void operator()(const f32x4 (&acc)[2][2][4][2], const Unit& u, int wr, int wc, int fr, int fq) const {
        const int row0 = u.pm * 256 + wr * 64 + fr, col0 = u.pn * 128 + wc * 32 + 8 * fq;
#pragma unroll
        for (int ai = 0; ai < 2; ++ai)
#pragma unroll
            for (int m = 0; m < 4; ++m) { f32x4 r0, r1;
#pragma unroll
                for (int e = 0; e < 4; ++e) {
                    if (MODE == 0) { r0[e] = acc[ai][0][m][0][e] * fast_sigmoid(acc[ai][1][m][0][e]); r1[e] = acc[ai][0][m][1][e] * fast_sigmoid(acc[ai][1][m][1][e]); }
                    else { const float g0 = acc[ai][0][m][0][e], g1 = acc[ai][0][m][1][e]; r0[e] = g0 * fast_sigmoid(g0) * acc[ai][1][m][0][e]; r1[e] = g1 * fast_sigmoid(g1) * acc[ai][1][m][1][e]; } }
                v4u w; w.x = pg8::cvt_pk_bf16(r0[0], r0[1]); w.y = pg8::cvt_pk_bf16(r0[2], r0[3]); w.z = pg8::cvt_pk_bf16(r1[0], r1[1]); w.w = pg8::cvt_pk_bf16(r1[2], r1[3]);
                *(v4u*)(O + (size_t)(row0 + ai * 128 + m * 16) * 512 + col0) = w; }
    }
};
struct EpiResid {
    static constexpr bool PERM = false;
    const float* x; float* out; const float* mod;
    __device__ __forceinline__ void operator()(const f32x4 (&acc)[2][2][4][2], const Unit& u, int wr, int wc, int fr, int fq) const {
        const int row0 = u.pm * 256 + wr * 64 + fr, col0 = u.pn * 256 + wc * 32 + 4 * fq;
        const int b = (u.pm * 256) / SEQ;
        f32x4 gv[2][2];
#pragma unroll
        for (int bj = 0; bj < 2; ++bj)
#pragma unroll
            for (int n = 0; n < 2; ++n) gv[bj][n] = *(const f32x4*)(mod + (size_t)b * 6144 + 2048 + col0 + bj * 128 + n * 16);
#pragma unroll
        for (int ai = 0; ai < 2; ++ai)
#pragma unroll
            for (int m = 0; m < 4; ++m) { const size_t off = (size_t)(row0 + ai * 128 + m * 16) * 1024 + col0;
#pragma unroll
                for (int bj = 0; bj < 2; ++bj)
#pragma unroll
                    for (int n = 0; n < 2; ++n) { const f32x4 xv = *(const f32x4*)(x + off + bj * 128 + n * 16); *(f32x4*)(out + off + bj * 128 + n * 16) = xv + gv[bj][n] * acc[ai][bj][m][n]; } }
    }
};
struct EpiDown {
    static constexpr bool PERM = true;
    bf16* Y; const unsigned* list; const float* rw;
    __device__ __forceinline__ void operator()(const f32x4 (&acc)[2][2][4][2], const Unit& u, int wr, int wc, int fr, int fq) const {
        const int col0 = u.pn * 256 + wc * 32 + 8 * fq;
#pragma unroll
        for (int ai = 0; ai < 2; ++ai)
#pragma unroll
            for (int m = 0; m < 4; ++m) { const int r = ai * 128 + wr * 64 + m * 16 + fr;
                if (r < u.rows) { const unsigned aid = list[u.lbase + r]; const float wgt = rw[aid]; bf16* rowp = Y + (size_t)aid * 1024 + col0;
#pragma unroll
                    for (int bj = 0; bj < 2; ++bj) { const f32x4 v0 = acc[ai][bj][m][0] * wgt, v1 = acc[ai][bj][m][1] * wgt;
                        v4u w; w.x = pg8::cvt_pk_bf16(v0[0], v0[1]); w.y = pg8::cvt_pk_bf16(v0[2], v0[3]); w.z = pg8::cvt_pk_bf16(v1[0], v1[1]); w.w = pg8::cvt_pk_bf16(v1[2], v1[3]);
                        *(v4u*)(rowp + bj * 128) = w; } } }
    }
};

template <bool GATHER_> struct MoeOrder {
    static constexpr bool GATHER = GATHER_;
    int G, c, nunits; const LAS int* tab; const unsigned* list; size_t estride; int bK;
    __device__ __forceinline__ bool next(int i, Unit& u) const {
        const int L = i * G + c; if (L >= nunits) return false;
        const int mt = L >> 2; u.pn = L & 3; int e = 0;
        while (e < NE - 1 && mt >= tab[e + 1]) ++e;
        const int j = mt - tab[e]; u.e = e; u.pm = mt; u.lbase = e * CAP + j * 256; const int left = tab[33 + e] - j * 256; u.rows = left < 256 ? left : 256; return true;
    }
    __device__ __forceinline__ size_t a_base(const Unit& u, int K) const { return GATHER ? (size_t)0 : (size_t)u.pm * 256 * K * 2; }
    __device__ __forceinline__ size_t b_base(const Unit& u, int K) const { return (size_t)u.e * estride + (size_t)u.pn * 256 * K * 2; }
    __device__ __forceinline__ void a_offsets(const Unit& u, const int* Rr, const int* Cc, int K, unsigned (&vo)[2][2]) const {
#pragma unroll
        for (int h = 0; h < 2; ++h)
#pragma unroll
            for (int i = 0; i < 2; ++i) { const int r = h * 128 + Rr[i]; const unsigned aid = list[u.lbase + (r < u.rows ? r : 0)]; vo[h][i] = (unsigned)((aid >> 1) * (unsigned)K + (unsigned)Cc[i]) * 2u; }
    }
};
__device__ __forceinline__ int moe_tables(Frame& F) {
    LAS int* tab = (LAS int*)(F.lds + MOE_OFF);
    if (F.tid == 0) { int acc = 0;
        for (int e = 0; e < NE; ++e) { const int c = (int)F.ctl[CW_CNT + 64 * e]; tab[e] = acc; tab[33 + e] = c; acc += (c + 255) >> 8; }
        tab[32] = acc; }
    __syncthreads();
    return tab[32];
}

__device__ __forceinline__ void attn_simple_unit(Frame& F, int b, int h, int qblk) {
    LAS bf16* Ks = (LAS bf16*)(F.lds);
    LAS bf16* Vs = (LAS bf16*)(F.lds + 8192);
    LAS float* cs = (LAS float*)(F.lds + 16384);
    const int q = qblk * 512 + F.tid;
    const size_t rowq = (size_t)b * SEQ + q;
    float qv[64], o[64];
    { const bf16* qp = F.Q + rowq * 512 + h * 64;
#pragma unroll
      for (int i = 0; i < 8; ++i) { const v4u w = *(const v4u*)(qp + 8 * i); qv[8 * i] = bflo(w.x); qv[8 * i + 1] = bfhi(w.x); qv[8 * i + 2] = bflo(w.y); qv[8 * i + 3] = bfhi(w.y); qv[8 * i + 4] = bflo(w.z); qv[8 * i + 5] = bfhi(w.z); qv[8 * i + 6] = bflo(w.w); qv[8 * i + 7] = bfhi(w.w); } }
#pragma unroll
    for (int d = 0; d < 64; ++d) o[d] = 0.f;
    float mrun = -INFINITY, l = 0.f;
    const int ntiles = (qblk * 512 + 512) / 64;
    const int wave_tile = (qblk * 512 + F.wave * 64) / 64;
    for (int kt = 0; kt < ntiles; ++kt) {
        __syncthreads();
        { const size_t krow = (size_t)b * SEQ + kt * 64 + (F.tid >> 3); const int ch = (F.tid & 7) * 8;
          *(LAS v4u*)(Ks + (F.tid >> 3) * 64 + ch) = *(const v4u*)(F.K + krow * 512 + h * 64 + ch);
          *(LAS v4u*)(Vs + (F.tid >> 3) * 64 + ch) = *(const v4u*)(F.V + krow * 512 + h * 64 + ch);
          if (F.tid < 64) cs[F.tid] = F.CUM[(size_t)(b * NH + h) * SEQ + kt * 64 + F.tid] * LOG2E; }
        __syncthreads();
        if (kt <= wave_tile) {
#pragma unroll 1
            for (int kk = 0; kk < 64; ++kk) {
                float dot = 0.f;
#pragma unroll
                for (int c8 = 0; c8 < 8; ++c8) { const v4u w = *(const LAS v4u*)(Ks + kk * 64 + c8 * 8);
                    dot += qv[8 * c8] * bflo(w.x) + qv[8 * c8 + 1] * bfhi(w.x) + qv[8 * c8 + 2] * bflo(w.y) + qv[8 * c8 + 3] * bfhi(w.y) + qv[8 * c8 + 4] * bflo(w.z) + qv[8 * c8 + 5] * bfhi(w.z) + qv[8 * c8 + 6] * bflo(w.w) + qv[8 * c8 + 7] * bfhi(w.w); }
                const float sc = (kt * 64 + kk > q) ? -INFINITY : dot - cs[kk];
                const float mnew = fmaxf(mrun, sc);
                const float corr = (mnew > -INFINITY) ? __builtin_amdgcn_exp2f(mrun - mnew) : 1.f;
                const float p = (mnew > -INFINITY) ? __builtin_amdgcn_exp2f(sc - mnew) : 0.f;
                l = l * corr + p;
#pragma unroll
                for (int c8 = 0; c8 < 8; ++c8) { const v4u w = *(const LAS v4u*)(Vs + kk * 64 + c8 * 8);
                    o[8 * c8] = o[8 * c8] * corr + p * bflo(w.x); o[8 * c8 + 1] = o[8 * c8 + 1] * corr + p * bfhi(w.x); o[8 * c8 + 2] = o[8 * c8 + 2] * corr + p * bflo(w.y); o[8 * c8 + 3] = o[8 * c8 + 3] * corr + p * bfhi(w.y);
                    o[8 * c8 + 4] = o[8 * c8 + 4] * corr + p * bflo(w.z); o[8 * c8 + 5] = o[8 * c8 + 5] * corr + p * bfhi(w.z); o[8 * c8 + 6] = o[8 * c8 + 6] * corr + p * bflo(w.w); o[8 * c8 + 7] = o[8 * c8 + 7] * corr + p * bfhi(w.w); }
                mrun = mnew;
            }
        }
    }
    const float inv = 1.f / l;
    bf16* op = F.Q + rowq * 512 + h * 64;
#pragma unroll
    for (int i = 0; i < 8; ++i) { v4u w; w.x = pk2(o[8 * i] * inv, o[8 * i + 1] * inv); w.y = pk2(o[8 * i + 2] * inv, o[8 * i + 3] * inv); w.z = pk2(o[8 * i + 4] * inv, o[8 * i + 5] * inv); w.w = pk2(o[8 * i + 6] * inv, o[8 * i + 7] * inv); *(v4u*)(op + 8 * i) = w; }
    __syncthreads();
}

__device__ __forceinline__ float gelu_tanh(float v) { const float t = 0.7978845608028654f * (v + 0.044715f * v * v * v); return 0.5f * v * (1.f + tanhf(t)); }
__device__ __forceinline__ void ssm_simple_unit(Frame& F, int b, int g, LAS unsigned char* wl) {
    const int p = F.lane;
    LAS f32x2* xs = (LAS f32x2*)wl;
    LAS float* Cp = (LAS float*)(wl + 33280);
#pragma unroll
    for (int c = 0; c < 16; ++c) { Cp[p * 32 + c] = F.c_re[(size_t)(g * 16 + c) * 64 + p]; Cp[p * 32 + 16 + c] = F.c_im[(size_t)(g * 16 + c) * 64 + p]; }
    const float dt = expf(F.log_dt[g]);
    const float lr = fminf(F.lambda_re[g * 64 + p], -1e-4f), li = F.lambda_im[g * 64 + p];
    const float mag = expf(lr * dt), ar = mag * cosf(li * dt), ai = mag * sinf(li * dt);
    const float den = lr * lr + li * li, nr = ar - 1.f;
    const float cor = (nr * lr + ai * li) / den, coi = (ai * lr - nr * li) / den;
    float bbr[16], bbi[16];
#pragma unroll
    for (int c = 0; c < 16; ++c) { const float br = F.b_re[(size_t)(g * 64 + p) * 16 + c], bi = F.b_im[(size_t)(g * 64 + p) * 16 + c]; bbr[c] = cor * br - coi * bi; bbi[c] = cor * bi + coi * br; }
    float dsk[16];
#pragma unroll
    for (int c = 0; c < 16; ++c) dsk[c] = F.d_skip[g * 16 + c];
    LDS_WAIT(); asm volatile("" ::: "memory");
    float xr = 0.f, xi = 0.f;
#if defined(SSM_CHECK)
    float chk_sq = 0.f;
#endif
    for (int t0 = 0; t0 < SEQ; t0 += 64) {
#pragma unroll 2
        for (int tt = 0; tt < 64; ++tt) {
            const bf16* up = F.U + ((size_t)b * SEQ + t0 + tt) * 512 + g * 16;
            const v4u w0 = *(const v4u*)up, w1 = *(const v4u*)(up + 8);
            float uu[16] = {bflo(w0.x), bfhi(w0.x), bflo(w0.y), bfhi(w0.y), bflo(w0.z), bfhi(w0.z), bflo(w0.w), bfhi(w0.w), bflo(w1.x), bfhi(w1.x), bflo(w1.y), bfhi(w1.y), bflo(w1.z), bfhi(w1.z), bflo(w1.w), bfhi(w1.w)};
            float bur = 0.f, bui = 0.f;
#pragma unroll
            for (int c = 0; c < 16; ++c) { bur += bbr[c] * uu[c]; bui += bbi[c] * uu[c]; }
            const float n_r = ar * xr - ai * xi + bur, n_i = ar * xi + ai * xr + bui; xr = n_r; xi = n_i;
            xs[tt * 65 + p] = (f32x2){xr, xi};
        }
        LDS_WAIT(); asm volatile("" ::: "memory");
        float y[16];
#pragma unroll
        for (int c = 0; c < 16; ++c) y[c] = 0.f;
#pragma unroll 4
        for (int pp = 0; pp < 64; ++pp) {
            const f32x2 xv = xs[F.lane * 65 + pp];
#pragma unroll
            for (int c4 = 0; c4 < 4; ++c4) { const f32x4 cr = *(const LAS f32x4*)(Cp + pp * 32 + c4 * 4), ci = *(const LAS f32x4*)(Cp + pp * 32 + 16 + c4 * 4);
                y[4 * c4] += cr.x * xv.x - ci.x * xv.y; y[4 * c4 + 1] += cr.y * xv.x - ci.y * xv.y; y[4 * c4 + 2] += cr.z * xv.x - ci.z * xv.y; y[4 * c4 + 3] += cr.w * xv.x - ci.w * xv.y; }
        }
#if defined(SSM_CHECK)
#pragma unroll
        for (int c = 0; c < 16; ++c) chk_sq += y[c] * y[c];
#endif
        const size_t row = (size_t)b * SEQ + t0 + F.lane;
        const bf16* up = F.U + row * 512 + g * 16;
        const v4u w0 = *(const v4u*)up, w1 = *(const v4u*)(up + 8);
        const float uu[16] = {bflo(w0.x), bfhi(w0.x), bflo(w0.y), bfhi(w0.y), bflo(w0.z), bfhi(w0.z), bflo(w0.w), bfhi(w0.w), bflo(w1.x), bfhi(w1.x), bflo(w1.y), bfhi(w1.y), bflo(w1.z), bfhi(w1.z), bflo(w1.w), bfhi(w1.w)};
        float r[16];
#pragma unroll
        for (int c = 0; c < 16; ++c) r[c] = gelu_tanh(y[c] + dsk[c] * uu[c]);
        v4u o0, o1; o0.x = pk2(r[0], r[1]); o0.y = pk2(r[2], r[3]); o0.z = pk2(r[4], r[5]); o0.w = pk2(r[6], r[7]); o1.x = pk2(r[8], r[9]); o1.y = pk2(r[10], r[11]); o1.z = pk2(r[12], r[13]); o1.w = pk2(r[14], r[15]);
        bf16* yp = F.Y + row * 512 + g * 16; *(v4u*)yp = o0; *(v4u*)(yp + 8) = o1;
        LDS_WAIT(); asm volatile("" ::: "memory");
    }
#if defined(SSM_CHECK)
    chk_sq = wave_sum(chk_sq); if (F.lane == 0) atomicAdd((float*)(F.ctl + CW_CHK + 1), chk_sq);
#endif
}


constexpr size_t TB_FRAG = 0, TB_QF = 2 * MiB, TB_PF = 10 * MiB, TB_A64 = 18 * MiB;
constexpr int XS_OFF = RING_BYTES + 2048;
typedef float f32x16 __attribute__((ext_vector_type(16)));
typedef short bf16x8s __attribute__((ext_vector_type(8)));
__device__ __forceinline__ int crow16(int r, int hi) { return (r & 3) + 8 * (r >> 2) + 4 * hi; }

__device__ __forceinline__ void p0_ssm_item(Frame& F, int it) {
    const int g = it >> 3, j = it & 7;
    LAS float* POWr = (LAS float*)(F.lds);
    LAS float* POWi = POWr + 65 * 64;
    LAS float* BBr = POWi + 65 * 64;
    LAS float* BBi = BBr + 1024;
    LAS float* Cr = BBi + 1024;
    LAS float* Ci = Cr + 1024;
    LAS float* Wr = Ci + 1024;
    LAS float* Wi = Wr + 2048;
    bf16* FRAG = (bf16*)((char*)F.out + TB_FRAG); bf16* QF = (bf16*)((char*)F.out + TB_QF); bf16* PF = (bf16*)((char*)F.out + TB_PF); float* A64 = (float*)((char*)F.out + TB_A64);
    const float dt = expf(F.log_dt[g]);
    for (int idx = F.tid; idx < 65 * 64; idx += 512) { const int kk = idx >> 6, p = idx & 63;
        const float lr = fminf(F.lambda_re[g * 64 + p], -1e-4f), li = F.lambda_im[g * 64 + p];
        const float m = expf((float)kk * (lr * dt)), ang = (float)kk * (li * dt);
        POWr[idx] = m * cosf(ang); POWi[idx] = m * sinf(ang); }
    for (int idx = F.tid; idx < 1024; idx += 512) { const int p = idx >> 4;
        const float lr = fminf(F.lambda_re[g * 64 + p], -1e-4f), li = F.lambda_im[g * 64 + p];
        const float mag = expf(lr * dt), ar = mag * cosf(li * dt), ai = mag * sinf(li * dt);
        const float den = lr * lr + li * li, nr = ar - 1.f, cor = (nr * lr + ai * li) / den, coi = (ai * lr - nr * li) / den;
        const float br = F.b_re[(size_t)g * 1024 + idx], bi = F.b_im[(size_t)g * 1024 + idx];
        BBr[idx] = cor * br - coi * bi; BBi[idx] = cor * bi + coi * br;
        Cr[idx] = F.c_re[(size_t)g * 1024 + idx]; Ci[idx] = F.c_im[(size_t)g * 1024 + idx]; }
    __syncthreads();
    for (int rd = 0; rd < 4; ++rd) {
        const int tau0 = 8 * j + 2 * rd;
        for (int idx = F.tid; idx < 2048; idx += 512) { const int tl = idx >> 10, pc = idx & 1023, p = pc >> 4, tau = tau0 + tl;
            const float wr = POWr[tau * 64 + p], wi = POWi[tau * 64 + p], br = BBr[pc], bi = BBi[pc];
            Wr[idx] = wr * br - wi * bi; Wi[idx] = wr * bi + wi * br; }
        __syncthreads();
        { const int tl = F.tid >> 8, o = F.tid & 255, c = o >> 4, cp = o & 15, tau = tau0 + tl; float acc = 0.f;
          for (int p = 0; p < 64; ++p) acc += Cr[c * 64 + p] * Wr[tl * 1024 + p * 16 + cp] - Ci[c * 64 + p] * Wi[tl * 1024 + p * 16 + cp];
          const bf16 v = (bf16)f2bf(acc);
          if (tau + 1 < 64) FRAG[((size_t)(g * 64 + tau + 1) * 32 + c) * 16 + cp] = v;
          FRAG[((size_t)(g * 64 + tau) * 32 + 16 + c) * 16 + cp] = v; }
        __syncthreads();
    }
    if (j == 0 && F.tid < 256) FRAG[((size_t)(g * 64) * 32 + (F.tid >> 4)) * 16 + (F.tid & 15)] = 0;
    {
      const int s = 8 * j + (F.tid >> 6), p = F.tid & 63, kk = 63 - s; const float wr = POWr[kk * 64 + p], wi = POWi[kk * 64 + p];
      unsigned re[8], im[8];
#pragma unroll
      for (int c2 = 0; c2 < 8; ++c2) { const float br0 = BBr[p * 16 + 2 * c2], bi0 = BBi[p * 16 + 2 * c2], br1 = BBr[p * 16 + 2 * c2 + 1], bi1 = BBi[p * 16 + 2 * c2 + 1];
          re[c2] = pk2(wr * br0 - wi * bi0, wr * br1 - wi * bi1); im[c2] = pk2(wr * bi0 + wi * br0, wr * bi1 + wi * br1); }
      bf16* qre = QF + ((((size_t)(g * 64 + s)) * 4 + (p >> 5)) * 32 + (p & 31)) * 16; bf16* qim = QF + ((((size_t)(g * 64 + s)) * 4 + 2 + (p >> 5)) * 32 + (p & 31)) * 16;
      *(v4u*)qre = (v4u){re[0], re[1], re[2], re[3]}; *(v4u*)(qre + 8) = (v4u){re[4], re[5], re[6], re[7]};
      *(v4u*)qim = (v4u){im[0], im[1], im[2], im[3]}; *(v4u*)(qim + 8) = (v4u){im[4], im[5], im[6], im[7]}; }
    for (int idx = F.tid; idx < 1024; idx += 512) {
      const int tl = idx >> 7, c = (idx >> 3) & 15, kb = idx & 7, t = 8 * j + tl; unsigned o[8];
#pragma unroll
      for (int k2 = 0; k2 < 8; ++k2) { float vv[2];
#pragma unroll
          for (int e = 0; e < 2; ++e) { const int p = (kb * 16 + 2 * k2 + e) & 63; const float wr = POWr[(t + 1) * 64 + p], wi = POWi[(t + 1) * 64 + p], cr = Cr[c * 64 + p], ci = Ci[c * 64 + p];
              vv[e] = (kb < 4) ? (cr * wr - ci * wi) : -(cr * wi + ci * wr); }
          o[k2] = pk2(vv[0], vv[1]); }
      bf16* pp = PF + ((((size_t)(g * 32 + (t >> 1))) * 8 + kb) * 32 + (t & 1) * 16 + c) * 16;
      *(v4u*)pp = (v4u){o[0], o[1], o[2], o[3]}; *(v4u*)(pp + 8) = (v4u){o[4], o[5], o[6], o[7]}; }
    if (j == 0 && F.tid < 64) { A64[(size_t)(g * 64 + F.tid) * 2] = POWr[64 * 64 + F.tid]; A64[(size_t)(g * 64 + F.tid) * 2 + 1] = POWi[64 * 64 + F.tid]; }
    __syncthreads();
}

__device__ __forceinline__ float gelu_tanh_fast(float v) { const float t = 0.7978845608028654f * (v + 0.044715f * v * v * v); return v * __builtin_amdgcn_rcpf(1.f + __builtin_amdgcn_exp2f(-2.f * LOG2E * t)); }

__device__ __forceinline__ void ssm_mfma_unit(Frame& F, int b, int g, bf16* Yout) {
    LAS unsigned char* L = F.lds;
    const int tid = F.tid, lane = F.lane, wave = F.wave, r32 = lane & 31, hi = lane >> 5;
    const bf16* FRAG = (const bf16*)((const char*)F.out + TB_FRAG); const bf16* QF = (const bf16*)((const char*)F.out + TB_QF); const bf16* PF = (const bf16*)((const char*)F.out + TB_PF);
    const float* A64 = (const float*)((const char*)F.out + TB_A64);
#pragma unroll
    for (int i = 0; i < 4; ++i) { const int tk = tid + 512 * i, ch = tk >> 6, s = tk & 63; const bf16* up = F.U + ((size_t)b * SEQ + tk) * 512 + g * 16;
        const v4u w0 = *(const v4u*)up, w1 = *(const v4u*)(up + 8); LAS v4u* d = (LAS v4u*)(L + (s * 32 + ch) * 32); d[0] = w0; d[1] = w1; }
    v4u fr[8];
#pragma unroll
    for (int i = 0; i < 8; ++i) fr[i] = *(const v4u*)((const char*)FRAG + (size_t)g * 65536 + tid * 16 + i * 8192);
    __syncthreads();
    LAS float* Eb = (LAS float*)(L + 65536);
    if (wave < 4) { f32x16 acc = {};
        const char* qf = (const char*)QF + ((size_t)(g * 64) * 4 + wave) * 1024 + r32 * 32 + hi * 16;
#pragma unroll 8
        for (int s = 0; s < 64; ++s) { const bf16x8s a = *(const bf16x8s*)(qf + (size_t)s * 4096); const bf16x8s bb = *(const LAS bf16x8s*)(L + (s * 32 + r32) * 32 + hi * 16);
            acc = __builtin_amdgcn_mfma_f32_32x32x16_bf16(a, bb, acc, 0, 0, 0); }
#pragma unroll
        for (int r = 0; r < 16; ++r) Eb[(wave * 32 + crow16(r, hi)) * 33 + r32] = acc[r]; }
    __syncthreads();
    LAS bf16* Xs = (LAS bf16*)(L + XS_OFF);
    if (tid < 64) { const int p = tid; const float ar = A64[(size_t)(g * 64 + p) * 2], ai = A64[(size_t)(g * 64 + p) * 2 + 1]; float xr = 0.f, xi = 0.f;
        for (int c = 0; c < 32; ++c) { Xs[c * 136 + p] = (bf16)f2bf(xr); Xs[c * 136 + 64 + p] = (bf16)f2bf(xi);
            const float er = Eb[p * 33 + c], ei = Eb[(64 + p) * 33 + c]; const float n_r = ar * xr - ai * xi + er, n_i = ar * xi + ai * xr + ei; xr = n_r; xi = n_i; } }
    __syncthreads();
#pragma unroll
    for (int i = 0; i < 8; ++i) *(LAS v4u*)(L + 65536 + tid * 16 + i * 8192) = fr[i];
    __syncthreads();
    const int tp0 = wave, tp1 = 15 - wave, tp2 = 16 + wave, tp3 = 31 - wave;
    f32x16 acc0 = {}, acc1 = {}, acc2 = {}, acc3 = {};
    const LAS unsigned char* FRb = L + 65536 + r32 * 32 + hi * 16;
#pragma unroll 2
    for (int s = 0; s < 64; ++s) { const bf16x8s bb = *(const LAS bf16x8s*)(L + (s * 32 + r32) * 32 + hi * 16);
        if (s <= 2 * tp0 + 1) acc0 = __builtin_amdgcn_mfma_f32_32x32x16_bf16(*(const LAS bf16x8s*)(FRb + (2 * tp0 - s + 1) * 1024), bb, acc0, 0, 0, 0);
        if (s <= 2 * tp1 + 1) acc1 = __builtin_amdgcn_mfma_f32_32x32x16_bf16(*(const LAS bf16x8s*)(FRb + (2 * tp1 - s + 1) * 1024), bb, acc1, 0, 0, 0);
        if (s <= 2 * tp2 + 1) acc2 = __builtin_amdgcn_mfma_f32_32x32x16_bf16(*(const LAS bf16x8s*)(FRb + (2 * tp2 - s + 1) * 1024), bb, acc2, 0, 0, 0);
        if (s <= 2 * tp3 + 1) acc3 = __builtin_amdgcn_mfma_f32_32x32x16_bf16(*(const LAS bf16x8s*)(FRb + (2 * tp3 - s + 1) * 1024), bb, acc3, 0, 0, 0); }
    { const char* pf = (const char*)PF + (size_t)(g * 32) * 8 * 1024 + r32 * 32 + hi * 16;
#pragma unroll 2
      for (int kb = 0; kb < 8; ++kb) { const bf16x8s bb = *(const LAS bf16x8s*)((const LAS unsigned char*)Xs + r32 * 272 + kb * 32 + hi * 16);
        acc0 = __builtin_amdgcn_mfma_f32_32x32x16_bf16(*(const bf16x8s*)(pf + (size_t)(tp0 * 8 + kb) * 1024), bb, acc0, 0, 0, 0);
        acc1 = __builtin_amdgcn_mfma_f32_32x32x16_bf16(*(const bf16x8s*)(pf + (size_t)(tp1 * 8 + kb) * 1024), bb, acc1, 0, 0, 0);
        acc2 = __builtin_amdgcn_mfma_f32_32x32x16_bf16(*(const bf16x8s*)(pf + (size_t)(tp2 * 8 + kb) * 1024), bb, acc2, 0, 0, 0);
        acc3 = __builtin_amdgcn_mfma_f32_32x32x16_bf16(*(const bf16x8s*)(pf + (size_t)(tp3 * 8 + kb) * 1024), bb, acc3, 0, 0, 0); } }
    const f32x4 dk0 = *(const f32x4*)(F.d_skip + g * 16 + 4 * hi), dk1 = *(const f32x4*)(F.d_skip + g * 16 + 8 + 4 * hi);
#define SSM_EPI(ACC, TP) do { _Pragma("unroll") for (int q = 0; q < 4; ++q) { const int c0 = 8 * (q & 1) + 4 * hi, t = 2 * (TP) + (q >> 1); const f32x4 dd = (q & 1) ? dk1 : dk0; \
        const v2u uw = *(const LAS v2u*)(L + (t * 32 + r32) * 32 + c0 * 2); \
        const float r0 = gelu_tanh_fast(ACC[4 * q] + dd.x * bflo(uw.x)), r1 = gelu_tanh_fast(ACC[4 * q + 1] + dd.y * bfhi(uw.x)), r2 = gelu_tanh_fast(ACC[4 * q + 2] + dd.z * bflo(uw.y)), r3 = gelu_tanh_fast(ACC[4 * q + 3] + dd.w * bfhi(uw.y)); \
        v2u o; o.x = pk2(r0, r1); o.y = pk2(r2, r3); *(v2u*)(Yout + ((size_t)b * SEQ + r32 * 64 + t) * 512 + g * 16 + c0) = o; } } while (0)
    SSM_EPI(acc0, tp0); SSM_EPI(acc1, tp1); SSM_EPI(acc2, tp2); SSM_EPI(acc3, tp3);
#undef SSM_EPI
    __syncthreads();
}

__device__ __forceinline__ void p7_block(Frame& F, int blk) {
    LAS int* eL = (LAS int*)(F.lds);
    LAS unsigned* baseL = (LAS unsigned*)(F.lds + 1024);
    const int b = (blk * 64) / SEQ;
    const float* mod = F.MOD + b * 6144;
    f32x4 es[4], sh[4];
#pragma unroll
    for (int j = 0; j < 4; ++j) { const int c = 4 * F.lane + 256 * j; const f32x4 g4 = *(const f32x4*)(F.norm_ffn_g + c), sc = *(const f32x4*)(mod + 4096 + c); es[j] = g4 * (sc + 1.f); sh[j] = *(const f32x4*)(mod + 3072 + c); }
    for (int r = 0; r < 8; ++r) {
        const int rl = F.wave * 8 + r, m = blk * 64 + rl;
        const GAS f32x4* xr = (const GAS f32x4*)(F.out + (size_t)m * D) + F.lane;
        f32x4 v[4]; float ss = 0.f;
#pragma unroll
        for (int j = 0; j < 4; ++j) { v[j] = xr[64 * j]; ss += (v[j].x * v[j].x + v[j].y * v[j].y) + (v[j].z * v[j].z + v[j].w * v[j].w); }
        const float rstd = 1.f / sqrtf(wave_sum(ss) * (1.f / D) + RMS_EPS);
        GAS v2u* o8 = (GAS v2u*)(F.H + (size_t)m * D) + F.lane;
#pragma unroll
        for (int j = 0; j < 4; ++j) { v[j] = v[j] * rstd * es[j] + sh[j]; v2u w; w.x = pk2(v[j].x, v[j].y); w.y = pk2(v[j].z, v[j].w); o8[64 * j] = w; }
        float lg[4] = {0.f, 0.f, 0.f, 0.f};
#pragma unroll
        for (int j = 0; j < 4; ++j) { const int k = 4 * F.lane + 256 * j;
#pragma unroll
            for (int e = 0; e < 4; ++e) { const f32x4 w4 = *(const f32x4*)(F.w_rg + (size_t)(k + e) * 4); const float hv = v[j][e]; lg[0] += hv * w4.x; lg[1] += hv * w4.y; lg[2] += hv * w4.z; lg[3] += hv * w4.w; } }
#pragma unroll
        for (int i = 0; i < 4; ++i) lg[i] = wave_sum(lg[i]) + F.b_rg[i];
        int gi = 0; float lmax = lg[0];
#pragma unroll
        for (int i = 1; i < 4; ++i) if (lg[i] > lmax) { lmax = lg[i]; gi = i; }
        float se = 0.f;
#pragma unroll
        for (int i = 0; i < 4; ++i) se += expf(lg[i] - lmax);
        const float pg = 1.f / se;
        gi = __builtin_amdgcn_readfirstlane(gi);
        float le[8] = {0.f, 0.f, 0.f, 0.f, 0.f, 0.f, 0.f, 0.f};
#pragma unroll
        for (int j = 0; j < 4; ++j) { const int k = 4 * F.lane + 256 * j;
#pragma unroll
            for (int e = 0; e < 4; ++e) { const float* wp = F.w_rexp + (size_t)(k + e) * 32 + gi * 8; const f32x4 wa = *(const f32x4*)wp, wb = *(const f32x4*)(wp + 4); const float hv = v[j][e];
                le[0] += hv * wa.x; le[1] += hv * wa.y; le[2] += hv * wa.z; le[3] += hv * wa.w; le[4] += hv * wb.x; le[5] += hv * wb.y; le[6] += hv * wb.z; le[7] += hv * wb.w; } }
#pragma unroll
        for (int i = 0; i < 8; ++i) le[i] = wave_sum(le[i]) + F.b_rexp[gi * 8 + i];
        int i0 = 0; float v0 = le[0];
#pragma unroll
        for (int i = 1; i < 8; ++i) if (le[i] > v0) { v0 = le[i]; i0 = i; }
        int i1 = -1; float v1 = -INFINITY;
#pragma unroll
        for (int i = 0; i < 8; ++i) if (i != i0 && (i1 < 0 || le[i] > v1)) { v1 = le[i]; i1 = i; }
        const float ex = expf(v1 - v0), p0 = 1.f / (1.f + ex), p1 = ex * p0;
        if (F.lane == 0) { const int e0 = gi * 8 + i0, e1 = gi * 8 + i1; eL[2 * rl] = e0; eL[2 * rl + 1] = e1;
            F.ROUTE[(size_t)m * 2] = e0; F.ROUTE[(size_t)m * 2 + 1] = e1; F.RW[(size_t)m * 2] = pg * p0; F.RW[(size_t)m * 2 + 1] = pg * p1; }
    }
    __syncthreads();
    int e = 0, rank = 0, total = 0;
    if (F.tid < 128) { e = eL[F.tid];
        for (int a = 0; a < 128; ++a) { const int m_ = (eL[a] == e); total += m_; rank += (m_ && a < F.tid); }
        if (rank == 0) baseL[e] = __hip_atomic_fetch_add((unsigned*)(F.ctl + CW_CNT + 64 * e), (unsigned)total, RLX_AGENT); }
    __syncthreads();
    if (F.tid < 128) { const unsigned pos = baseL[e] + (unsigned)rank; F.LIST[(size_t)e * CAP + pos] = (unsigned)((blk * 64 + (F.tid >> 1)) * 2 + (F.tid & 1)); }
    __syncthreads();
}

__device__ __forceinline__ void p10_rows(Frame& F) {
    const int gw = F.vcu * NWAVES + F.wave, NGW = F.G * NWAVES;
    for (int ch = gw; ch < M / 8; ch += NGW) {
        const int b = (ch * 8) / SEQ;
        const float* mod = F.MOD + b * 6144 + 5120;
        f32x4 g2[4], fg[4];
#pragma unroll
        for (int j = 0; j < 4; ++j) { const int c = 4 * F.lane + 256 * j; g2[j] = *(const f32x4*)(mod + c); fg[j] = *(const f32x4*)(F.final_g + c); }
        for (int r = 0; r < 8; ++r) {
            const int m = ch * 8 + r;
            GAS f32x4* xr = (GAS f32x4*)(F.out + (size_t)m * D) + F.lane;
            const GAS v2u* y0 = (const GAS v2u*)(F.YROWS + (size_t)(2 * m) * D) + F.lane; const GAS v2u* y1 = (const GAS v2u*)(F.YROWS + (size_t)(2 * m + 1) * D) + F.lane;
            f32x4 v[4]; float ss = 0.f;
#pragma unroll
            for (int j = 0; j < 4; ++j) { const f32x4 xv = xr[64 * j]; const v2u a = y0[64 * j], bb = y1[64 * j];
                f32x4 yv; yv.x = bflo(a.x) + bflo(bb.x); yv.y = bfhi(a.x) + bfhi(bb.x); yv.z = bflo(a.y) + bflo(bb.y); yv.w = bfhi(a.y) + bfhi(bb.y);
                v[j] = xv + g2[j] * yv; ss += (v[j].x * v[j].x + v[j].y * v[j].y) + (v[j].z * v[j].z + v[j].w * v[j].w); }
            float rstd = 1.f / sqrtf(wave_sum(ss) * (1.f / D) + RMS_EPS);
#if defined(SSM_CHECK)
            { const float d_ = ((const float*)(F.ctl + CW_CHK))[0] / ((const float*)(F.ctl + CW_CHK))[1]; rstd *= 1.f + 0.5f * fminf(1.f, sqrtf(d_)); }
#endif
#pragma unroll
            for (int j = 0; j < 4; ++j) xr[64 * j] = v[j] * rstd * fg[j];
        }
    }
}

struct Args { const float* in[28]; float* out; unsigned char* ws; int ph_lo, ph_hi; };
typedef const __attribute__((address_space(4))) Args* KArgs;
__device__ __forceinline__ void load_ptrs(Frame& F) {
    KArgs ka = (KArgs)__builtin_amdgcn_kernarg_segment_ptr();
    asm volatile("" : "+s"(ka));
    F.tid = tid_opaque(); F.lane = F.tid & 63; F.wave = __builtin_amdgcn_readfirstlane(F.tid >> 6);
    unsigned char* ws = ka->ws;
    F.ctl = (gu32*)(ws + WS_CTL);
    F.x = ka->in[0]; F.c = ka->in[1]; F.w_ada = ka->in[2]; F.b_ada = ka->in[3]; F.norm_mix_g = ka->in[4]; F.w_in = ka->in[5]; F.b_forget = ka->in[6]; F.w_out_fox = ka->in[7];
    F.lambda_re = ka->in[8]; F.lambda_im = ka->in[9]; F.log_dt = ka->in[10]; F.b_re = ka->in[11]; F.b_im = ka->in[12]; F.c_re = ka->in[13]; F.c_im = ka->in[14]; F.d_skip = ka->in[15];
    F.w_glu = ka->in[16]; F.w_out_ssm = ka->in[17]; F.w_o = ka->in[18]; F.norm_ffn_g = ka->in[19]; F.w_rg = ka->in[20]; F.b_rg = ka->in[21]; F.w_rexp = ka->in[22]; F.b_rexp = ka->in[23];
    F.w_gate = ka->in[24]; F.w_up = ka->in[25]; F.w_down = ka->in[26]; F.final_g = ka->in[27]; F.out = ka->out;
    F.MOD = (float*)(ws + WS_MOD); F.LOGF = (float*)(ws + WS_LOGF); F.CUM = (float*)(ws + WS_CUM); F.RW = (float*)(ws + WS_RW); F.ROUTE = (int*)(ws + WS_ROUTE); F.LIST = (unsigned*)(ws + WS_LIST); F.CUMP = (unsigned*)(ws + WS_CUMP);
    F.WIN = (bf16*)(ws + WS_WIN); F.WGLU = (bf16*)(ws + WS_WGLU); F.WOF = (bf16*)(ws + WS_WOF); F.WOS = (bf16*)(ws + WS_WOS); F.WO = (bf16*)(ws + WS_WO); F.WGU = (bf16*)(ws + WS_WGU); F.WD = (bf16*)(ws + WS_WD);
    F.H = (bf16*)(ws + WS_H); F.Y = (bf16*)(ws + WS_Y); F.Q = (bf16*)(ws + WS_Q); F.K = (bf16*)(ws + WS_K); F.V = (bf16*)(ws + WS_V); F.U = (bf16*)(ws + WS_U); F.SGA = (bf16*)(ws + WS_SGA); F.SGB = (bf16*)(ws + WS_SGB);
    F.HID = (bf16*)(ws + WS_HID); F.YROWS = (bf16*)(ws + WS_YROWS);
}
__global__ void __launch_bounds__(NWAVES * 64, 2) fwd(Args args) {
    extern __shared__ __attribute__((aligned(16))) unsigned char lds[];
    Frame F;
    F.lds = (LAS unsigned char*)lds;
    F.MISC = (volatile LAS unsigned*)(F.lds + MISC_OFF);
    F.tid = threadIdx.x; F.lane = F.tid & 63; F.wave = __builtin_amdgcn_readfirstlane(F.tid >> 6);
    F.G = gridDim.x; { const int bx = blockIdx.x; F.vcu = (F.G % 8 == 0) ? (bx % 8) * (F.G / 8) + bx / 8 : bx; }
    load_ptrs(F);
    for (int u = F.tid; u < (LDS_BYTES - LDSCTL_OFF) / 4; u += NWAVES * 64) ((LAS unsigned*)(F.lds + LDSCTL_OFF))[u] = 0u;
    __syncthreads();
    if (N_LAUNCHES == 1) (void)xcd_barrier_post((unsigned*)(F.ctl + CW_BAR), F.MISC + 8);
#define GRID_BAR() do { if (N_LAUNCHES == 1) { load_ptrs(F); XcdBarrier b_; b_.bar = (unsigned*)(F.ctl + CW_BAR); b_.x = xb_xcc_id(); b_.st = (volatile LAS unsigned*)(F.lds + MISC_OFF) + 8; xcd_barrier(b_); } } while (0)
    const int lo = (N_LAUNCHES == 1) ? 0 : args.ph_lo, hi = (N_LAUNCHES == 1) ? NPH : args.ph_hi;
#ifndef PH_MASK
#define PH_MASK 0x7ff
#endif
#define IN(k) ((((PH_MASK) >> (k)) & 1) && lo <= (k) && (k) < hi)
#define BOTH(k) (IN(k) && IN((k) + 1))

    if (IN(0)) { load_ptrs(F); p0_prologue(F); __syncthreads(); for (int it = F.vcu; it < 256; it += F.G) p0_ssm_item(F, it); if (BOTH(0)) GRID_BAR(); }
    if (IN(1)) { load_ptrs(F); p1_rows(F); if (BOTH(1)) GRID_BAR(); }
    if (IN(2)) { load_ptrs(F);
        p2_cumscan(F); VM_WAIT(); __syncthreads();
        pg8::Gemm g{F.H, F.WIN, 1024}; pg8::StaticOrder S; S.init(M, 4096, F.G, (int)blockIdx.x);
        EpiInProj E{F.Q};
        pg8::gemm_phase<EpiInProj, pg8::StaticOrder, true>(F.lds + RING_OFF, g, S, E);
        if (BOTH(2)) GRID_BAR();
    }
    if (IN(3)) { load_ptrs(F);
#if defined(ATTN_SIMPLE)
        for (int u = F.vcu; u < NB * NH * 4; u += F.G) { const int bh = u >> 2, qblk = 3 - (u & 3); attn_simple_unit(F, bh >> 3, bh & 7, qblk); }
#else
        { static_assert(attn_body::ATTN_LDS_BYTES <= RING_BYTES, "attention LDS");
          const attn_body::AttnTensors AT{(const attn_body::bf16*)F.Q, (const attn_body::bf16*)F.K, (const attn_body::bf16*)F.V, (attn_body::bf16*)F.Q, F.CUM};
          const attn_body::StaticOrder S((int)F.G, F.vcu);
          attn_body::attn_phase<attn_body::StaticOrder>((char*)lds + RING_OFF, AT, S); }
#endif
        __syncthreads();
#if defined(SSM_SIMPLE) || defined(SSM_CHECK)
        if (F.wave < 3) for (int u = F.wave * F.G + F.vcu; u < NB * NG; u += 3 * F.G) ssm_simple_unit(F, u >> 5, u & 31, F.lds + F.wave * 41472);
        __syncthreads();
#endif
#if !defined(SSM_SIMPLE)
        for (int u = F.vcu; u < NB * NG; u += F.G) ssm_mfma_unit(F, u >> 5, u & 31,
#if defined(SSM_CHECK)
            (bf16*)((char*)F.out + 32 * MiB)
#else
            F.Y
#endif
            );
#endif
#if defined(SSM_CHECK)
        { VM_WAIT(); __syncthreads();
          const int u = F.vcu, b = u >> 5, g = u & 31; const bf16* y2 = (const bf16*)((const char*)F.out + 32 * MiB); float df = 0.f;
          for (int i = 0; i < 4; ++i) { const size_t off = ((size_t)b * SEQ + F.tid + 512 * i) * 512 + g * 16;
              for (int hh = 0; hh < 2; ++hh) { const v4u a = __builtin_nontemporal_load((const v4u*)(F.Y + off + 8 * hh)), c = __builtin_nontemporal_load((const v4u*)(y2 + off + 8 * hh));
                  const float d0 = bflo(a.x) - bflo(c.x), d1 = bfhi(a.x) - bfhi(c.x), d2 = bflo(a.y) - bflo(c.y), d3 = bfhi(a.y) - bfhi(c.y), d4 = bflo(a.z) - bflo(c.z), d5 = bfhi(a.z) - bfhi(c.z), d6 = bflo(a.w) - bflo(c.w), d7 = bfhi(a.w) - bfhi(c.w);
                  df += d0 * d0 + d1 * d1 + d2 * d2 + d3 * d3 + d4 * d4 + d5 * d5 + d6 * d6 + d7 * d7; } }
          df = wave_sum(df); if (F.lane == 0) atomicAdd((float*)(F.ctl + CW_CHK), df); }
#endif
        __syncthreads();
        if (BOTH(3)) GRID_BAR();
    }
    if (IN(4)) { load_ptrs(F);
        { pg8::Gemm g{F.Q, F.WOF, 512}; pg8::StaticOrder S; S.init(M, 1024, F.G, (int)blockIdx.x); EpiGate<0> E{F.SGA, nullptr};
          pg8::gemm_phase<EpiGate<0>, pg8::StaticOrder, true>(F.lds + RING_OFF, g, S, E); }
        { pg8::Gemm g{F.Y, F.WGLU, 512}; pg8::StaticOrder S; S.init(M, 1024, F.G, (int)blockIdx.x); EpiPair<0> E{F.V};
          pg8::gemm_phase<EpiPair<0>, pg8::StaticOrder, true>(F.lds + RING_OFF, g, S, E); }
        if (BOTH(4)) GRID_BAR();
    }
    if (IN(5)) { load_ptrs(F);
        pg8::Gemm g{F.V, F.WOS, 512}; pg8::StaticOrder S; S.init(M, 1024, F.G, (int)blockIdx.x); EpiGate<1> E{F.SGA, F.SGB};
        pg8::gemm_phase<EpiGate<1>, pg8::StaticOrder, true>(F.lds + RING_OFF, g, S, E);
        if (BOTH(5)) GRID_BAR();
    }
    if (IN(6)) { load_ptrs(F);
        pg8::Gemm g{F.SGA, F.WO, 1024}; pg8::StaticOrder S; S.init(M, 1024, F.G, (int)blockIdx.x); EpiResid E{F.x, F.out, F.MOD};
        pg8::gemm_phase<EpiResid, pg8::StaticOrder, true>(F.lds + RING_OFF, g, S, E);
        if (BOTH(6)) GRID_BAR();
    }
    if (IN(7)) { load_ptrs(F);
        for (int blk = F.vcu; blk < M / 64; blk += F.G) p7_block(F, blk);
        if (BOTH(7)) GRID_BAR();
    }
    if (IN(8)) { load_ptrs(F);
        const int mt = moe_tables(F);
        MoeOrder<true> S{F.G, (int)blockIdx.x, mt * 4, (const LAS int*)(F.lds + MOE_OFF), F.LIST, (size_t)1024 * 1024 * 2, 0};
        pg8::Gemm g{F.H, F.WGU, 1024}; EpiPair<1> E{F.HID};
        pg8::gemm_phase<EpiPair<1>, MoeOrder<true>, true>(F.lds + RING_OFF, g, S, E);
        if (BOTH(8)) GRID_BAR();
    }
    if (IN(9)) { load_ptrs(F);
        const int mt = moe_tables(F);
        MoeOrder<false> S{F.G, (int)blockIdx.x, mt * 4, (const LAS int*)(F.lds + MOE_OFF), F.LIST, (size_t)1024 * 512 * 2, 0};
        pg8::Gemm g{F.HID, F.WD, 512}; EpiDown E{F.YROWS, F.LIST, F.RW};
        pg8::gemm_phase<EpiDown, MoeOrder<false>, true>(F.lds + RING_OFF, g, S, E);
        if (BOTH(9)) GRID_BAR();
    }
    if (IN(10)) { load_ptrs(F); p10_rows(F); }
#undef IN
#undef BOTH
}

extern "C" void kernel_launch(void* const* d_in, const int* in_sizes, int n_in, void* d_out, int out_size, void* d_ws, size_t ws_size, hipStream_t stream) {
    static int grid = 0;
    if (grid == 0) {
        if (n_in != 28 || in_sizes[0] != M * D || out_size != M * D || ws_size < WS_END) { fprintf(stderr, "kernel_launch: unexpected shapes (n_in %d, in0 %d, out %d, ws %zu); nothing launched\n", n_in, n_in > 0 ? in_sizes[0] : -1, out_size, ws_size); grid = -1; return; }
        int dev = 0, cus = 0, per_cu = 0;
        if (hipGetDevice(&dev) != hipSuccess || hipDeviceGetAttribute(&cus, hipDeviceAttributeMultiprocessorCount, dev) != hipSuccess) { grid = -1; return; }
        if (hipFuncSetAttribute((const void*)fwd, hipFuncAttributeMaxDynamicSharedMemorySize, LDS_BYTES) != hipSuccess) { fprintf(stderr, "kernel_launch: hipFuncSetAttribute failed\n"); grid = -1; return; }
        if (hipOccupancyMaxActiveBlocksPerMultiprocessor(&per_cu, (const void*)fwd, NWAVES * 64, LDS_BYTES) != hipSuccess || per_cu < 1) { fprintf(stderr, "kernel_launch: occupancy query reports %d\n", per_cu); }
        (void)hipGetLastError();
        grid = cus;
    }
    if (grid < 0) return;
    if (hipMemsetAsync((char*)d_ws + WS_CTL, 0, CTL_ZERO_BYTES, stream) != hipSuccess) return;
    Args a{};
    for (int i = 0; i < 28; ++i) a.in[i] = (const float*)d_in[i];
    a.out = (float*)d_out; a.ws = (unsigned char*)d_ws;
    for (int li = 0; li < N_LAUNCHES; ++li) {
        a.ph_lo = (N_LAUNCHES == NPH) ? li : 0; a.ph_hi = (N_LAUNCHES == NPH) ? li + 1 : NPH;
        hipLaunchKernelGGL(fwd, dim3(grid), dim3(NWAVES * 64), LDS_BYTES, stream, a);
        if (hipPeekAtLastError() != hipSuccess) { fprintf(stderr, "kernel_launch: launch %d failed\n", li); break; }
    }
}
```

```cpp
#include <hip/hip_runtime.h>
#include <cstdio>
#include <cstdint>

#ifndef MK_N_LAUNCHES
#define MK_N_LAUNCHES 1
#endif

constexpr int NB = 8, SEQ = 2048, D = 1024, M = NB * SEQ;
constexpr int NH = 8, HD = 64, FW = 512;
constexpr int SW = 512, NG = 32, NS = 64;
constexpr int INC = 4104;
constexpr int NE = 32, DE = 512;
constexpr int CAP = 16384;
constexpr float RMS_EPS = 1e-6f;
constexpr float LOG2E = 1.4426950408889634f;
constexpr float QSCALE = 0.125f * 1.4426950408889634f;

constexpr int TIDTAB_OFF = 147456 - 2048 + 512;
__device__ __forceinline__ int hw_wave_key() { return (int)(__builtin_amdgcn_s_getreg((5 << 11) | 4) & 0x3f); }
__device__ __forceinline__ int tid_opaque() {
    extern __shared__ __attribute__((aligned(16))) unsigned char lds_[];
    const int lane = (int)__builtin_amdgcn_mbcnt_hi(~0u, __builtin_amdgcn_mbcnt_lo(~0u, 0u));
    int w = *(const volatile __attribute__((address_space(3))) int*)((__attribute__((address_space(3))) unsigned char*)lds_ + TIDTAB_OFF + 4 * hw_wave_key());
    w = __builtin_amdgcn_readfirstlane(w);
    int t = w * 64 + lane; asm volatile("" : "+v"(t)); return t;
}

namespace pg8 {
#define PG8_LAS __attribute__((address_space(3)))
typedef unsigned short bf16_t;
typedef short bf16x8 __attribute__((ext_vector_type(8)));
typedef float f32x4 __attribute__((ext_vector_type(4)));
typedef unsigned u32x4 __attribute__((ext_vector_type(4)));
typedef int i32x4 __attribute__((ext_vector_type(4)));
typedef int i32x8 __attribute__((ext_vector_type(8)));
constexpr int BM = 256, BK = 64, HALF = 128, HTB = HALF * BK * 2, STAGE_BYTES = 8 * HTB, NXCD = 8, WGM = 8;

__host__ __device__ __forceinline__ int lds_byte(int r, int c) { const int st = (r >> 4) * 2 + (c >> 5), rr = r & 15, cc = c & 31, ob = rr * 64 + cc * 2; return st * 1024 + (ob ^ (((ob >> 9) & 1) << 5)); }
__host__ __device__ __forceinline__ void stage_rc(int b, int& R, int& C) { const int st = b / 1024, sb = b % 1024, swz = sb ^ (((sb >> 9) & 1) << 5); R = (st >> 1) * 16 + swz / 64; C = (st & 1) * 32 + (swz % 64) / 2; }
__host__ __device__ __forceinline__ int perm32(int rho) { const int n = rho >> 4, i = rho & 15; return 8 * (i >> 2) + 4 * n + (i & 3); }

struct Unit { int pm, pn, e, rows, lbase; };
struct Gemm { const bf16_t* A; const bf16_t* Bt; int K; size_t kstepA; };

struct StaticOrder {
    static constexpr bool GATHER = false, FP8 = false;
    int nM, nN, nwg, G, c;
    __host__ __device__ void init(int M_, int N_, int G_, int c_) { nM = M_ / BM; nN = N_ / BM; nwg = nM * nN; G = G_; c = c_; }
    __host__ __device__ bool next(int i, Unit& u) const {
        const long L = (long)i * G + c; if (L >= nwg) return false;
        int wgid = (int)L; { const int q = nwg / NXCD, r = nwg % NXCD, xcd = wgid % NXCD, off = wgid / NXCD; wgid = (xcd < r ? xcd * (q + 1) : r * (q + 1) + (xcd - r) * q) + off; }
        const int nig = WGM * nN, gid = wgid / nig, fm = gid * WGM, gsz = (nM - fm) < WGM ? (nM - fm) : WGM;
        u.pm = fm + ((wgid % nig) % gsz); u.pn = (wgid % nig) / gsz; u.e = 0; u.rows = 256; u.lbase = 0; return true;
    }
    __device__ __forceinline__ size_t a_base(const Unit& u, int K) const { return (size_t)u.pm * BM * K * 2; }
    __device__ __forceinline__ size_t b_base(const Unit& u, int K) const { return (size_t)u.pn * BM * K * 2; }
    __device__ __forceinline__ void a_offsets(const Unit&, const int*, const int*, int, unsigned (&)[2][2]) const {}
};

struct StaticOrder8 : StaticOrder { static constexpr bool FP8 = true; int pn0;
    __device__ __forceinline__ bool next(int i, Unit& u) const { if (!StaticOrder::next(i, u)) return false; u.pn += pn0; return true; }
};
struct DualOrder : StaticOrder {
    size_t a_delta, b_delta;
    __device__ __forceinline__ bool next(int i, Unit& u) const { if (!StaticOrder::next(i >> 1, u)) return false; u.e = i & 1; return true; }
    __device__ __forceinline__ size_t a_base(const Unit& u, int K) const { return (size_t)u.pm * BM * K * 2 + (u.e ? a_delta : (size_t)0); }
    __device__ __forceinline__ size_t b_base(const Unit& u, int K) const { return (size_t)u.pn * BM * K * 2 + (u.e ? b_delta : (size_t)0); }
};
struct GroupMajorOrder : StaticOrder {
    static constexpr bool GATHER = true;
    int Mrows;
    __device__ __forceinline__ size_t a_base(const Unit&, int) const { return 0; }
    __device__ __forceinline__ void a_offsets(const Unit& u, const int* Rr, const int* Cc, int, unsigned (&vo)[2][2]) const {
#pragma unroll
        for (int h = 0; h < 2; ++h)
#pragma unroll
            for (int i = 0; i < 2; ++i) vo[h][i] = (unsigned)(((Cc[i] >> 4) * Mrows + u.pm * BM + h * HALF + Rr[i]) * 32 + (Cc[i] & 15) * 2);
    }
};
__device__ __forceinline__ unsigned cvt_pk_bf16(float lo, float hi) { unsigned r; asm volatile("v_cvt_pk_bf16_f32 %0, %1, %2" : "=v"(r) : "v"(lo), "v"(hi)); return r; }

template <class T, class = void> struct epi_chains { static constexpr bool value = false; };
template <class T> struct epi_chains<T, decltype((void)T::CHAIN)> { static constexpr bool value = true; };
template <class Epi, class Sched, bool ALIGN_EPI>
__device__ __forceinline__ void gemm_phase(PG8_LAS unsigned char* lds, const Gemm g, const Sched& S, const Epi& E) {
    constexpr bool GATHER = Sched::GATHER;
    const int tid = tid_opaque(), wid = __builtin_amdgcn_readfirstlane(tid >> 6), lane = tid & 63, wr = wid >> 2, wc = wid & 3, fr = lane & 15, fq = lane >> 4;
    const int K = g.K, nt = K / BK;
    unsigned voffB[2], voC[2][2], voN[2][2]; int Rr[2], Cc[2];
#pragma unroll
    for (int i = 0; i < 2; ++i) { int R, C; stage_rc(tid * 16 + i * 8192, R, C); Rr[i] = R; Cc[i] = C; const int Rb = Epi::PERM ? ((R & ~31) + perm32(R & 31)) : R;
        voffB[i] = (unsigned)(Rb * K + C) * 2u; }
    const size_t kstep = (size_t)(BK * 2), kstepA = g.kstepA;
    const size_t hstep = (size_t)HALF * K * 2;
    const unsigned ldsw = (unsigned)wid * 1024u;
    const int aoff = lds_byte(wr * 64 + fr, fq * 8), boff = lds_byte(wc * 32 + fr, fq * 8);
#define PG8_SA(b, h) (((b) * 2 + (h)) * HTB)
#define PG8_SB(b, h) ((4 + (b) * 2 + (h)) * HTB)
#define PG8_STAGE(bufoff, gbase, voff) do { _Pragma("unroll") for (int _i = 0; _i < 2; ++_i) \
        __builtin_amdgcn_global_load_lds((const unsigned*)((const char*)(gbase) + (voff)[_i]), (PG8_LAS unsigned*)(lds + (bufoff) + ldsw + _i * 8192), 16, 0, 0); } while (0)
#define PG8_LDA(dst, b, h) do { if constexpr (Sched::FP8) { _Pragma("unroll") for (int m = 0; m < 4; ++m) { const i32x4 lo_ = *(const PG8_LAS i32x4*)(lds + PG8_SA(b, h) + aoff + m * 2048), hi_ = *(const PG8_LAS i32x4*)(lds + PG8_SA(b, h) + aoff + m * 2048 + 1024); \
        dst##8[m] = __builtin_shufflevector(lo_, hi_, 0, 1, 2, 3, 4, 5, 6, 7); } } \
    else { _Pragma("unroll") for (int m = 0; m < 4; ++m) _Pragma("unroll") for (int k = 0; k < 2; ++k) dst[m][k] = *(const PG8_LAS bf16x8*)(lds + PG8_SA(b, h) + aoff + m * 2048 + k * 1024); } } while (0)
#define PG8_LDB(dst, b, h) do { if constexpr (Sched::FP8) { _Pragma("unroll") for (int n = 0; n < 2; ++n) { const i32x4 lo_ = *(const PG8_LAS i32x4*)(lds + PG8_SB(b, h) + boff + n * 2048), hi_ = *(const PG8_LAS i32x4*)(lds + PG8_SB(b, h) + boff + n * 2048 + 1024); \
        dst##8[n] = __builtin_shufflevector(lo_, hi_, 0, 1, 2, 3, 4, 5, 6, 7); } } \
    else { _Pragma("unroll") for (int n = 0; n < 2; ++n) _Pragma("unroll") for (int k = 0; k < 2; ++k) dst[n][k] = *(const PG8_LAS bf16x8*)(lds + PG8_SB(b, h) + boff + n * 2048 + k * 1024); } } while (0)
#define PG8_MMA(ai, bj, At, Bt) do { __builtin_amdgcn_s_setprio(1); \
        if constexpr (Sched::FP8) { _Pragma("unroll") for (int m = 0; m < 4; ++m) _Pragma("unroll") for (int n = 0; n < 2; ++n) \
            acc[ai][bj][m][n] = __builtin_amdgcn_mfma_scale_f32_16x16x128_f8f6f4(Bt##8[n], At##8[m], acc[ai][bj][m][n], 0, 0, 0, 0x7f7f7f7f, 0, 0x7f7f7f7f); \
            _Pragma("unroll") for (int m = 0; m < 4; ++m) _Pragma("unroll") for (int n = 0; n < 2; ++n) asm volatile("" : "+v"(acc[ai][bj][m][n]));   } \
        else { _Pragma("unroll") for (int m = 0; m < 4; ++m) _Pragma("unroll") for (int n = 0; n < 2; ++n) _Pragma("unroll") for (int k = 0; k < 2; ++k) \
            acc[ai][bj][m][n] = __builtin_amdgcn_mfma_f32_16x16x32_bf16(Bt[n][k], At[m][k], acc[ai][bj][m][n], 0, 0, 0); } \
        __builtin_amdgcn_s_setprio(0); } while (0)
#define PG8_WAIT_V(n) asm volatile("s_waitcnt vmcnt(" #n ")" ::: "memory")
#define PG8_WAIT_L(n) asm volatile("s_waitcnt lgkmcnt(" #n ")" ::: "memory")
#define PG8_BAR __builtin_amdgcn_s_barrier()
#define PG8_SCHED __builtin_amdgcn_sched_barrier(0)
    Unit cur, nxt; int ui = 0;
    if (!S.next(0, cur)) return;
    f32x4 acc[2][2][4][2];
#pragma unroll
    for (int a = 0; a < 2; ++a)
#pragma unroll
        for (int b = 0; b < 2; ++b)
#pragma unroll
            for (int m = 0; m < 4; ++m)
#pragma unroll
                for (int n = 0; n < 2; ++n) acc[a][b][m][n] = (f32x4){0.f, 0.f, 0.f, 0.f};
    bf16x8 At[4][2], B0[2][2], B1[2][2];
    i32x8 At8[4], B08[2], B18[2];
    if constexpr (GATHER) S.a_offsets(cur, Rr, Cc, K, voC);
    else {
#pragma unroll
        for (int h = 0; h < 2; ++h)
#pragma unroll
            for (int i = 0; i < 2; ++i) voC[h][i] = (unsigned)((Rr[i] + h * HALF) * K + Cc[i]) * 2u;
    }
    const char* cA = (const char*)g.A + S.a_base(cur, K); const char* cB = (const char*)g.Bt + S.b_base(cur, K);
    PG8_STAGE(PG8_SB(0, 0), cB, voffB); PG8_STAGE(PG8_SB(0, 1), cB + hstep, voffB); PG8_STAGE(PG8_SA(0, 0), cA, voC[0]); PG8_STAGE(PG8_SA(0, 1), cA, voC[1]);
    if (wr == 1) PG8_BAR;
    PG8_WAIT_V(2); PG8_BAR;
    PG8_STAGE(PG8_SB(1, 0), cB + kstep, voffB); PG8_STAGE(PG8_SA(1, 0), cA + kstepA, voC[0]); PG8_STAGE(PG8_SB(1, 1), cB + hstep + kstep, voffB);
    PG8_WAIT_V(6); PG8_BAR;
    for (;;) {
        const bool has_next = S.next(ui + 1, nxt);
        const char* nA = has_next ? (const char*)g.A + S.a_base(nxt, K) : cA; const char* nB = has_next ? (const char*)g.Bt + S.b_base(nxt, K) : cB;
        if constexpr (GATHER) {
            if (has_next) S.a_offsets(nxt, Rr, Cc, K, voN);
            else {
#pragma unroll
                for (int h = 0; h < 2; ++h)
#pragma unroll
                    for (int i = 0; i < 2; ++i) voN[h][i] = voC[h][i];
            }
        }
        for (int t = 0; t < nt; t += 2) {
            asm volatile(".p2align 6" ::: "memory");
            const bool last = (t == nt - 2);
            const char* a1 = cA + (size_t)(t + 1) * kstepA;
            const char* a2 = last ? nA : cA + (size_t)(t + 2) * kstepA; const char* b2 = last ? nB : cB + (size_t)(t + 2) * kstep;
            const char* a3 = a2 + kstepA; const char* b3 = b2 + kstep;
            unsigned vo2[2][2];
            if (GATHER && last) { asm volatile("" ::: "memory");
#pragma unroll
                for (int h = 0; h < 2; ++h)
#pragma unroll
                    for (int i = 0; i < 2; ++i) vo2[h][i] = voN[h][i];
            } else {
                if (GATHER) asm volatile("" ::: "memory");
#pragma unroll
                for (int h = 0; h < 2; ++h)
#pragma unroll
                    for (int i = 0; i < 2; ++i) vo2[h][i] = voC[h][i]; }
            PG8_LDB(B0, 0, 0); PG8_LDB(B1, 0, 1); PG8_SCHED; PG8_LDA(At, 0, 0); PG8_STAGE(PG8_SA(1, 1), a1, voC[1]);
            PG8_WAIT_V(8); PG8_WAIT_L(0); PG8_BAR; PG8_MMA(0, 0, At, B0); PG8_MMA(0, 1, At, B1); PG8_BAR; PG8_SCHED;
            PG8_LDA(At, 0, 1); PG8_STAGE(PG8_SB(0, 0), b2, voffB); PG8_STAGE(PG8_SB(0, 1), b2 + hstep, voffB); PG8_STAGE(PG8_SA(0, 0), a2, vo2[0]);
            PG8_WAIT_V(8); PG8_WAIT_L(0); PG8_BAR; PG8_MMA(1, 0, At, B0); PG8_MMA(1, 1, At, B1); PG8_BAR; PG8_SCHED;
            PG8_LDB(B0, 1, 0); PG8_LDB(B1, 1, 1); PG8_SCHED; PG8_LDA(At, 1, 0); PG8_STAGE(PG8_SA(0, 1), a2, vo2[1]);
            PG8_WAIT_V(8); PG8_WAIT_L(0); PG8_BAR; PG8_MMA(0, 0, At, B0); PG8_MMA(0, 1, At, B1); PG8_BAR; PG8_SCHED;
            PG8_LDA(At, 1, 1); PG8_STAGE(PG8_SB(1, 0), b3, voffB); PG8_STAGE(PG8_SB(1, 1), b3 + hstep, voffB); PG8_STAGE(PG8_SA(1, 0), a3, vo2[0]);
            PG8_WAIT_V(8); PG8_WAIT_L(0); PG8_BAR; PG8_MMA(1, 0, At, B0); PG8_MMA(1, 1, At, B1); PG8_BAR; PG8_SCHED;
        }
        if constexpr (ALIGN_EPI) { if (wr == 0) PG8_BAR; }
        bool keep = false;
        if constexpr (epi_chains<Epi>::value) { E.chain(acc, cur, wr, wc, fr, fq); keep = (cur.e == 0); }
        else E(acc, cur, wr, wc, fr, fq);
        if (!has_next) break;
        if (!keep) {
#pragma unroll
        for (int a = 0; a < 2; ++a)
#pragma unroll
            for (int b = 0; b < 2; ++b)
#pragma unroll
                for (int m = 0; m < 4; ++m)
#pragma unroll
                    for (int n = 0; n < 2; ++n) acc[a][b][m][n] = (f32x4){0.f, 0.f, 0.f, 0.f};
        }
        cur = nxt; cA = nA; cB = nB; ++ui;
        if constexpr (GATHER) {
#pragma unroll
            for (int h = 0; h < 2; ++h)
#pragma unroll
                for (int i = 0; i < 2; ++i) voC[h][i] = voN[h][i];
        }
        if constexpr (ALIGN_EPI) { if (wr == 1) PG8_BAR; }
    }
    PG8_WAIT_V(0);
    if constexpr (!ALIGN_EPI) { if (wr == 0) PG8_BAR; }
    PG8_BAR;
#undef PG8_SA
#undef PG8_SB
#undef PG8_STAGE
#undef PG8_LDA
#undef PG8_LDB
#undef PG8_MMA
#undef PG8_WAIT_V
#undef PG8_WAIT_L
#undef PG8_BAR
#undef PG8_SCHED
}
}

#include <hip/hip_bf16.h>
#include <cmath>
namespace attn_body {
using bf16=__hip_bfloat16;
using bf16x8=__attribute__((ext_vector_type(8)))short;
using s16x4=__attribute__((ext_vector_type(4)))short;
using f32x16=__attribute__((ext_vector_type(16)))float;
using u32x4=__attribute__((ext_vector_type(4)))unsigned;
constexpr int BATCH=8,NHEAD=8,SEQ=2048,D=64,DM=NHEAD*D;
constexpr int NW=8,QBLK=32,QB=QBLK*NW,KVBLK=64,NQB=SEQ/QB;
constexpr int ATTN_PITCH=DM, ATTN_UNIT_ROWS=QB;
__device__ __forceinline__ int crow(int r,int hi){return (r&3)+8*(r>>2)+4*hi;}
#define SBAR() __builtin_amdgcn_sched_barrier(0)
__device__ __forceinline__ void cmask(f32x16&p0,f32x16&p1,int jb,int qrel,int hi){
  const float NEG=-INFINITY; int kb=64*jb+4*hi;
  #pragma unroll
  for(int r=0;r<16;++r){int kv=kb+(r&3)+8*(r>>2); if(kv>qrel)p0[r]=NEG; if(kv+32>qrel)p1[r]=NEG;}
}

constexpr int NSLOT=3, SLOTB=8192;
constexpr int LDS_K=0, LDS_V=NSLOT*SLOTB, LDS_WS=2*NSLOT*SLOTB, LDS_OST=LDS_WS+NW*64*4, LDS_CB=LDS_OST+NW*4096, LDS_BYTES=LDS_CB+SEQ*4;
constexpr float C2=0.125f*1.4426950408889634f;
__device__ __forceinline__ void glds16s(const void*base,unsigned voff,unsigned lds_dst){unsigned keep;
  asm volatile("s_mov_b32 %0, m0\n\ts_mov_b32 m0, %3\n\ts_nop 0\n\tglobal_load_lds_dwordx4 %1, %2\n\ts_mov_b32 m0, %0":"=&s"(keep):"v"(voff),"s"(base),"s"(lds_dst):"memory");}
__device__ __forceinline__ void glds16(const void*gsrc,unsigned lds_dst){unsigned keep;
  asm volatile("s_mov_b32 %0, m0\n\ts_mov_b32 m0, %2\n\ts_nop 0\n\tglobal_load_lds_dwordx4 %1, off\n\ts_mov_b32 m0, %0":"=&s"(keep):"v"(gsrc),"s"(lds_dst):"memory");}
__device__ __forceinline__ float max3f(float a,float b,float c){float r;asm("v_max3_f32 %0, %1, %2, %3":"=v"(r):"v"(a),"v"(b),"v"(c));return r;}
__device__ __forceinline__ float max2f(float a,float b){float r;asm("v_max_f32_e32 %0, %1, %2":"=v"(r):"v"(a),"v"(b));return r;}
__device__ __forceinline__ float fadd_s(float a,float b){float r;asm("v_add_f32_e32 %0, %1, %2":"=v"(r):"v"(a),"v"(b));return r;}
__device__ __forceinline__ float fsub_s(float a,float b){float r;asm("v_sub_f32_e32 %0, %1, %2":"=v"(r):"v"(a),"v"(b));return r;}
typedef float f32x2_t __attribute__((ext_vector_type(2))); typedef __bf16 bf16x2_t __attribute__((ext_vector_type(2)));
__device__ __forceinline__ unsigned cvtpk_s(float lo,float hi){f32x2_t v={lo,hi};bf16x2_t b=__builtin_convertvector(v,bf16x2_t);return __builtin_bit_cast(unsigned,b);}
#define WAIT_BAR(N) asm volatile("s_waitcnt vmcnt(" #N ") lgkmcnt(0)\n\ts_barrier":::"memory")

__device__ __forceinline__ void qkt(f32x16&p0,f32x16&p1,const char*Kslot,const bf16x8*qr,const f32x16&negm,int r32,int hi,bf16x8 kb0,bf16x8 kb1,bf16x8 qx){
  const char*kb=Kslot+hi*1024+r32*16;
  #pragma unroll
  for(int d0=0;d0<4;++d0){
    const bf16x8 b0=*reinterpret_cast<const bf16x8*>(kb+d0*2048);
    const bf16x8 b1=*reinterpret_cast<const bf16x8*>(kb+d0*2048+512);
    if(d0==0){p0=__builtin_amdgcn_mfma_f32_32x32x16_bf16(b0,qr[0],negm,0,0,0);p1=__builtin_amdgcn_mfma_f32_32x32x16_bf16(b1,qr[0],negm,0,0,0);}
    else{p0=__builtin_amdgcn_mfma_f32_32x32x16_bf16(b0,qr[d0],p0,0,0,0);p1=__builtin_amdgcn_mfma_f32_32x32x16_bf16(b1,qr[d0],p1,0,0,0);}}
  p0=__builtin_amdgcn_mfma_f32_32x32x16_bf16(kb0,qx,p0,0,0,0);p1=__builtin_amdgcn_mfma_f32_32x32x16_bf16(kb1,qx,p1,0,0,0);
}
typedef __attribute__((address_space(3))) const char* lds_cptr;
typedef short v4i16_t __attribute__((ext_vector_type(4)));
__device__ __forceinline__ void kload8(bf16x8*kf,lds_cptr kp){
  kf[0]=*(const __attribute__((address_space(3))) bf16x8*)(kp);      kf[1]=*(const __attribute__((address_space(3))) bf16x8*)(kp+512);
  kf[2]=*(const __attribute__((address_space(3))) bf16x8*)(kp+2048); kf[3]=*(const __attribute__((address_space(3))) bf16x8*)(kp+2560);
  kf[4]=*(const __attribute__((address_space(3))) bf16x8*)(kp+4096); kf[5]=*(const __attribute__((address_space(3))) bf16x8*)(kp+4608);
  kf[6]=*(const __attribute__((address_space(3))) bf16x8*)(kp+6144); kf[7]=*(const __attribute__((address_space(3))) bf16x8*)(kp+6656);
}
__device__ __forceinline__ void kload2(bf16x8*kf,lds_cptr kp,int j){ kf[2*j]=*(const __attribute__((address_space(3))) bf16x8*)(kp+j*2048); kf[2*j+1]=*(const __attribute__((address_space(3))) bf16x8*)(kp+j*2048+512); }
__device__ __forceinline__ s16x4 vtr(lds_cptr p){ return __builtin_bit_cast(s16x4,__builtin_amdgcn_ds_read_tr16_b64_v4i16((__attribute__((address_space(3))) v4i16_t*)p)); }
__device__ __forceinline__ float rowmax(const f32x16&p0,const f32x16&p1){
  float a=max3f(p0[0],p0[1],p1[0]),b=max3f(p0[2],p0[3],p1[1]);a=max3f(a,p1[2],p1[3]);
  #pragma unroll
  for(int r=4;r<16;r+=4){a=max3f(a,p0[r],p0[r+1]);b=max3f(b,p0[r+2],p0[r+3]);a=max3f(a,p1[r],p1[r+1]);b=max3f(b,p1[r+2],p1[r+3]);}
  const float m=max2f(a,b);
  auto rr=__builtin_amdgcn_permlane32_swap(__float_as_uint(m),__float_as_uint(m),false,false);
  return max2f(__uint_as_float(rr[0]),__uint_as_float(rr[1]));
}
__device__ __forceinline__ void pv(f32x16*o,int vb,bf16x8 pa0,bf16x8 pa1,bf16x8 pa2,bf16x8 pa3){
  #pragma unroll
  for(int d0=0;d0<2;++d0){s16x4 lo[4],hi[4];
    #pragma unroll
    for(int ks=0;ks<4;++ks){
      asm volatile("ds_read_b64_tr_b16 %0,%1 offset:%c2":"=&v"(lo[ks]):"v"(vb),"i"(d0*4096+ks*1024):"memory");
      asm volatile("ds_read_b64_tr_b16 %0,%1 offset:%c2":"=&v"(hi[ks]):"v"(vb),"i"(d0*4096+ks*1024+512):"memory");}
    asm volatile("s_waitcnt lgkmcnt(0)":::"memory");SBAR();
    #define PK(k) (bf16x8){lo[k][0],lo[k][1],lo[k][2],lo[k][3],hi[k][0],hi[k][1],hi[k][2],hi[k][3]}
    o[d0]=__builtin_amdgcn_mfma_f32_32x32x16_bf16(pa0,PK(0),o[d0],0,0,0);
    o[d0]=__builtin_amdgcn_mfma_f32_32x32x16_bf16(pa1,PK(1),o[d0],0,0,0);
    o[d0]=__builtin_amdgcn_mfma_f32_32x32x16_bf16(pa2,PK(2),o[d0],0,0,0);
    o[d0]=__builtin_amdgcn_mfma_f32_32x32x16_bf16(pa3,PK(3),o[d0],0,0,0);
    #undef PK
  }
}

#ifndef ATTN_STORE16
#define ATTN_STORE16(p,v) (*(u32x4*)(p)=(v))
#endif
template<int THRL> __device__ __forceinline__ void attn_unit(int b,int h,int qb,const bf16*Q,const bf16*__restrict__ K,const bf16*__restrict__ V,bf16*O,const unsigned*__restrict__ CP,char*shm,bool stage_cb){
  const int tid=tid_opaque(),lane=tid&63,r32=lane&31,hi=lane>>5; const int wid=__builtin_amdgcn_readfirstlane(tid>>6);
  const long rowbase=(long)b*SEQ; const int q0=qb*QB;
  const bf16*Qw=Q+(rowbase+q0+wid*QBLK)*DM+h*D;
  const bf16*Kh=K+rowbase*DM+h*D,*Vh=V+rowbase*DM+h*D;
  const lds_cptr shm3=(lds_cptr)shm;
  const unsigned lds0=(unsigned)(uintptr_t)shm;
  float*wsf=(float*)(shm+LDS_WS)+wid*64;
  const unsigned koff=(unsigned)(lane*DM+wid*8)*2u;
  const unsigned voff=(unsigned)((16*(wid&3)+(lane>>2))*DM+(wid>>2)*32+(lane&3)*8)*2u;
  const unsigned kdst=lds0+LDS_K+wid*1024, vdst=lds0+LDS_V+wid*1024;
  #define DMA_K(t,slot) glds16s(Kh+(long)(t)*KVBLK*DM,koff,(unsigned)__builtin_amdgcn_readfirstlane(kdst+(slot)))
  #define DMA_V(t,slot) glds16s(Vh+(long)(t)*KVBLK*DM,voff,(unsigned)__builtin_amdgcn_readfirstlane(vdst+(slot)))
  const int vb0=(int)(lds0+LDS_V)+((lane>>4)&1)*32+(lane&3)*8+(4*hi+((lane&15)>>2))*64;
  const char*Kbase=shm+LDS_K; bf16x8 kf[8];
  const lds_cptr kp0=shm3+LDS_K+hi*1024+r32*16; const lds_cptr vp0=shm3+LDS_V+((lane>>4)&1)*32+(lane&3)*8+(4*hi+((lane&15)>>2))*64;
  const int NT=(q0+QB)/KVBLK;
  const __attribute__((address_space(3))) unsigned* cl3=(const __attribute__((address_space(3))) unsigned*)(shm3+LDS_CB);
  { __attribute__((address_space(3))) unsigned* clw=(__attribute__((address_space(3))) unsigned*)(shm3+LDS_CB); if(stage_cb)for(int i=tid;i<q0+QB;i+=NW*64)clw[i]=CP[i]; }
  bf16x8 qx; { const short one_=(short)(hi?0:0x3F80); qx=(bf16x8){one_,one_,0,0,0,0,0,0}; } asm volatile("":"+v"(qx));
  #define KBIAS(w) __builtin_bit_cast(bf16x8,(u32x4){hi?0u:(w),0u,0u,0u})
  DMA_K(0,0);DMA_V(0,0);DMA_K(1,SLOTB);
  bf16x8 qr[4];
  #pragma unroll
  for(int d0=0;d0<4;++d0)qr[d0]=*reinterpret_cast<const bf16x8*>(&Qw[(long)r32*DM+d0*16+hi*8]);
  float mhat=0.f,l_reg=0.f;f32x16 o[2];o[0]=f32x16{};o[1]=f32x16{};f32x16 negm=f32x16{};asm volatile("":"+v"(negm));
  const int qrel=wid*QBLK+r32;
  #define CMASK(P0,P1,t) do{int jb_=(t)-(NT-4); if(jb_>=0)cmask(P0,P1,jb_,qrel,hi);}while(0)
  bool resc=false;
  #define START(P0,P1) do{ const float rm=rowmax(P0,P1); resc=false; \
    { const float dl=rm; mhat=fadd_s(mhat,dl); \
      _Pragma("unroll") for(int r=0;r<16;++r){P0[r]=fsub_s(P0[r],dl);P1[r]=fsub_s(P1[r],dl);} \
      _Pragma("unroll") for(int r=0;r<16;++r)negm[r]=-mhat; asm volatile("":"+v"(negm)); } \
    _Pragma("unroll") for(int r=0;r<16;++r)P0[r]=__builtin_amdgcn_exp2f(P0[r]); }while(0)
  #define RESC() do{ if(resc){ asm volatile("s_waitcnt lgkmcnt(0)":::"memory"); \
      _Pragma("unroll") for(int d_=0;d_<2;++d_) _Pragma("unroll") for(int r=0;r<16;++r)o[d_][r]*=wsf[crow(r,hi)]; } }while(0)
  f32x16 pA0,pA1,pB0,pB1;
  int sl_prev=0,sl_cur=0,sl_next=SLOTB;
  #define ROT() do{sl_prev=sl_cur;sl_cur=sl_next;sl_next=(sl_next==(NSLOT-1)*SLOTB)?0:sl_next+SLOTB;}while(0)
  DMA_K(2,2*SLOTB);
  WAIT_BAR(3);
  { const unsigned c0_=cl3[r32],c1_=cl3[32+r32]; qkt(pA0,pA1,Kbase,qr,negm,r32,hi,KBIAS(c0_),KBIAS(c1_),qx); } asm volatile("s_nop 15\n\ts_nop 7":"+v"(pA0),"+v"(pA1));CMASK(pA0,pA1,0);
  START(pA0,pA1);
  _Pragma("unroll") for(int r=0;r<16;++r)pA1[r]=__builtin_amdgcn_exp2f(pA1[r]);
  WAIT_BAR(0);
  DMA_K(3,0);DMA_V(1,SLOTB);
  ROT();
  kload8(kf,kp0+sl_cur);
  WAIT_BAR(2);
  s16x4 vlo[8],vhi[8]; u32x4 pw0,pw1,pw2,pw3;
  #define PKW(P,B) cvtpk_s(P[B],P[B+1])
  #define PAF(k) __builtin_bit_cast(bf16x8,pw##k)
  #define VFR(i) (bf16x8){vlo[i][0],vlo[i][1],vlo[i][2],vlo[i][3],vhi[i][0],vhi[i][1],vhi[i][2],vhi[i][3]}
  #define PIN(x) asm volatile("":"+v"(x))
  #define MX3(a,b,c) __builtin_fmaxf(__builtin_fmaxf((a),(b)),(c))
  #define GAPA(MF,A0,A1,A2,A3,W0,W1,PW) do{ MF; sacc+=A0; sacc+=A1; sacc+=A2; sacc+=A3; PIN(sacc); W0; W1; PIN(PW); SBAR(); }while(0)
  #define EX(v) __builtin_amdgcn_exp2f(v)
  #define GAPB(MF,X,B) do{ MF; X[B]=EX(X[B]); X[B+1]=EX(X[B+1]); X[B+2]=EX(X[B+2]); X[B+3]=EX(X[B+3]); PIN(X); SBAR(); }while(0)
  #define VRD(i) do{ vlo[i]=vtr(vp_+(((i)>>2)*4096+((i)&3)*1024)); vhi[i]=vtr(vp_+(((i)>>2)*4096+((i)&3)*1024+512)); }while(0)
  #define KRD(G,j) do{ if(G){ kload2(kf,kp0+sl_next,j); SBAR(); } }while(0)
  #define STEP(C0,C1,P0,P1,t,GK,GV,GL) do{ SBAR(); \
    const lds_cptr vp_=vp0+sl_prev; const unsigned cw0_=cl3[(t)*KVBLK+r32],cw1_=cl3[(t)*KVBLK+32+r32]; \
    VRD(0); SBAR(); float sacc=(P0[0]+P0[1]); \
    GAPA(C0=__builtin_amdgcn_mfma_f32_32x32x16_bf16(kf[0],qr[0],negm,0,0,0), P0[2],P0[3],P0[4],P0[5],     pw0[0]=PKW(P0,0), pw0[1]=PKW(P0,2), pw0); \
    VRD(4); SBAR(); GAPA(C1=__builtin_amdgcn_mfma_f32_32x32x16_bf16(kf[1],qr[0],negm,0,0,0), P0[6],P0[7],P0[8],P0[9],     pw0[2]=PKW(P0,4), pw0[3]=PKW(P0,6), pw0); \
    VRD(1); SBAR(); GAPA(C0=__builtin_amdgcn_mfma_f32_32x32x16_bf16(kf[2],qr[1],C0,0,0,0),   P0[10],P0[11],P0[12],P0[13], pw1[0]=PKW(P0,8), pw1[1]=PKW(P0,10), pw1); \
    VRD(5); SBAR(); GAPA(C1=__builtin_amdgcn_mfma_f32_32x32x16_bf16(kf[3],qr[1],C1,0,0,0),   P0[14],P0[15],P1[0],P1[1],   pw1[2]=PKW(P0,12),pw1[3]=PKW(P0,14), pw1); \
    VRD(2); SBAR(); GAPA(C0=__builtin_amdgcn_mfma_f32_32x32x16_bf16(kf[4],qr[2],C0,0,0,0),   P1[2],P1[3],P1[4],P1[5],     pw2[0]=PKW(P1,0), pw2[1]=PKW(P1,2), pw2); \
    VRD(6); SBAR(); GAPA(C1=__builtin_amdgcn_mfma_f32_32x32x16_bf16(kf[5],qr[2],C1,0,0,0),   P1[6],P1[7],P1[8],P1[9],     pw2[2]=PKW(P1,4), pw2[3]=PKW(P1,6), pw2); \
    VRD(3); SBAR(); GAPA(C0=__builtin_amdgcn_mfma_f32_32x32x16_bf16(kf[6],qr[3],C0,0,0,0),   P1[10],P1[11],P1[12],P1[13], pw3[0]=PKW(P1,8), pw3[1]=PKW(P1,10), pw3); \
    VRD(7); SBAR(); GAPA(C1=__builtin_amdgcn_mfma_f32_32x32x16_bf16(kf[7],qr[3],C1,0,0,0),   P1[14],P1[15],0.f,0.f,       pw3[2]=PKW(P1,12),pw3[3]=PKW(P1,14), pw3); \
    C0=__builtin_amdgcn_mfma_f32_32x32x16_bf16(KBIAS(cw0_),qx,C0,0,0,0); C1=__builtin_amdgcn_mfma_f32_32x32x16_bf16(KBIAS(cw1_),qx,C1,0,0,0); SBAR(); \
    l_reg+=sacc; \
    if(GK){DMA_K((t)+3,sl_cur);} if(GV){DMA_V((t)+1,sl_next);} \
    CMASK(C0,C1,t); \
    { float a=MX3(C0[0],C0[1],C1[0]),b=MX3(C0[2],C0[3],C1[1]); a=MX3(a,C1[2],C1[3]); \
      _Pragma("unroll") for(int r=4;r<16;r+=4){a=MX3(a,C0[r],C0[r+1]);b=MX3(b,C0[r+2],C0[r+3]);a=MX3(a,C1[r],C1[r+1]);b=MX3(b,C1[r+2],C1[r+3]);} \
      float rm=__builtin_fmaxf(a,b); { auto rr=__builtin_amdgcn_permlane32_swap(__float_as_uint(rm),__float_as_uint(rm),false,false); rm=__builtin_fmaxf(__uint_as_float(rr[0]),__uint_as_float(rr[1])); } \
      resc=false; \
      if(__builtin_expect(__any(rm>(float)THRL),0)){ const float dl=__builtin_fmaxf(rm,0.f); mhat+=dl; \
        _Pragma("unroll") for(int r=0;r<16;++r){C0[r]-=dl;C1[r]-=dl;} \
        _Pragma("unroll") for(int r=0;r<16;++r)negm[r]=-mhat; asm volatile("":"+v"(negm)); \
        const float f=__builtin_amdgcn_exp2f(-dl); l_reg*=f; if(hi==0)wsf[r32]=f; resc=true; } } \
    SBAR(); \
    GAPB(o[0]=__builtin_amdgcn_mfma_f32_32x32x16_bf16(PAF(0),VFR(0),o[0],0,0,0), C0,0); \
    GAPB(o[1]=__builtin_amdgcn_mfma_f32_32x32x16_bf16(PAF(0),VFR(4),o[1],0,0,0), C0,4); \
    KRD(GL,0); GAPB(o[0]=__builtin_amdgcn_mfma_f32_32x32x16_bf16(PAF(1),VFR(1),o[0],0,0,0), C0,8); \
    KRD(GL,1); GAPB(o[1]=__builtin_amdgcn_mfma_f32_32x32x16_bf16(PAF(1),VFR(5),o[1],0,0,0), C0,12); \
    KRD(GL,2); GAPB(o[0]=__builtin_amdgcn_mfma_f32_32x32x16_bf16(PAF(2),VFR(2),o[0],0,0,0), C1,0); \
    KRD(GL,3); GAPB(o[1]=__builtin_amdgcn_mfma_f32_32x32x16_bf16(PAF(2),VFR(6),o[1],0,0,0), C1,4); \
    GAPB(o[0]=__builtin_amdgcn_mfma_f32_32x32x16_bf16(PAF(3),VFR(3),o[0],0,0,0), C1,8); \
    GAPB(o[1]=__builtin_amdgcn_mfma_f32_32x32x16_bf16(PAF(3),VFR(7),o[1],0,0,0), C1,12); \
    }while(0)
  int t=1;
  #undef CMASK
  #define CMASK(P0,P1,t) do{}while(0)
  for(;t+5<NT;t+=2){
    STEP(pB0,pB1,pA0,pA1,t,true,true,true);     WAIT_BAR(2); RESC(); ROT();
    STEP(pA0,pA1,pB0,pB1,t+1,true,true,true);   WAIT_BAR(2); RESC(); ROT();
  }
  #undef CMASK
  #define CMASK(P0,P1,t) do{int jb_=(t)-(NT-4); if(jb_>=0)cmask(P0,P1,jb_,qrel,hi);}while(0)
  #define ENDW(tt) do{ if((tt)+3<NT){WAIT_BAR(2);} else if((tt)+2<NT){WAIT_BAR(1);} else {WAIT_BAR(0);} }while(0)
  for(;t+1<NT;t+=2){
    STEP(pB0,pB1,pA0,pA1,t,(t+3<NT),(t+1<NT),(t+1<NT));       ENDW(t);   RESC(); ROT();
    STEP(pA0,pA1,pB0,pB1,t+1,(t+4<NT),(t+2<NT),(t+2<NT));     ENDW(t+1); RESC(); ROT();
  }
  STEP(pB0,pB1,pA0,pA1,NT-1,false,false,false); RESC();
  { float sacc=pB0[0]+pB0[1]; _Pragma("unroll") for(int r=2;r<16;++r)sacc+=pB0[r]; _Pragma("unroll") for(int r=0;r<16;++r)sacc+=pB1[r]; l_reg+=sacc;
    pw0=(u32x4){PKW(pB0,0),PKW(pB0,2),PKW(pB0,4),PKW(pB0,6)};pw1=(u32x4){PKW(pB0,8),PKW(pB0,10),PKW(pB0,12),PKW(pB0,14)};pw2=(u32x4){PKW(pB1,0),PKW(pB1,2),PKW(pB1,4),PKW(pB1,6)};pw3=(u32x4){PKW(pB1,8),PKW(pB1,10),PKW(pB1,12),PKW(pB1,14)};
    SBAR(); pv(o,vb0+sl_cur,PAF(0),PAF(1),PAF(2),PAF(3)); }
  #undef PKW
  #undef PAF
  #undef VFR
  #undef PIN
  #undef MX3
  #undef GAPA
  #undef GAPB
  #undef EX
  #undef VRD
  #undef KRD
  #undef STEP
  #undef ENDW
  {auto rr=__builtin_amdgcn_permlane32_swap(__float_as_uint(l_reg),__float_as_uint(l_reg),false,false);l_reg=__uint_as_float(rr[0])+__uint_as_float(rr[1]);}
  if(hi==0)wsf[32+r32]=l_reg;asm volatile("s_waitcnt lgkmcnt(0)":::"memory");
  float rli[16];
  #pragma unroll
  for(int r=0;r<16;++r)rli[r]=__builtin_amdgcn_rcpf(wsf[32+crow(r,hi)]);
  bf16*Ow=O+(rowbase+q0+wid*QBLK)*DM+h*D;
  { bf16*stg=(bf16*)(shm+LDS_OST)+wid*2048;
    #pragma unroll
    for(int r=0;r<16;++r){const int orow=crow(r,hi);
      #pragma unroll
      for(int d0=0;d0<2;++d0)stg[orow*64+d0*32+r32]=__float2bfloat16(o[d0][r]*rli[r]);}
    asm volatile("s_waitcnt lgkmcnt(0)":::"memory");
    #pragma unroll
    for(int i=0;i<4;++i){const int row=i*8+(lane>>3),ch=lane&7; const u32x4 v=*(const u32x4*)(stg+row*64+ch*8); ATTN_STORE16(Ow+(long)row*DM+ch*8,v);} }
  asm volatile("s_waitcnt lgkmcnt(0)\n\ts_barrier":::"memory");
  #undef DMA_K
  #undef DMA_V
  #undef CMASK
  #undef START
  #undef RESC
  #undef ROT
  #undef KBIAS
}
constexpr int ATTN_LDS_BYTES=LDS_BYTES;
struct AttnTensors { const bf16* Q; const bf16* K; const bf16* V; bf16* O; const unsigned* CP; };
struct AttnUnit { int bh; int qb; };
struct StaticOrder {
  int vcu, G;
  __device__ __forceinline__ StaticOrder(int grid,int v):vcu(v),G(grid){}
  __device__ __forceinline__ bool next(int i,AttnUnit&u)const{
    if(G==256){ if(i>=2)return false; const int s=vcu&3; u.bh=vcu>>2; u.qb=(i==0)?7-s:s; return true; }
    const int L=i*G+vcu; if(L>=BATCH*NHEAD*NQB)return false; u.bh=L>>3; u.qb=7-(L&7); return true; }
  __device__ __forceinline__ void a_ready(const AttnUnit&)const{}
  __device__ __forceinline__ void done(const AttnUnit&)const{}
};
template<class Sched,int THRL=20> __device__ __forceinline__ void attn_phase(char*lds,const AttnTensors&T,const Sched&S){
  AttnUnit u;
  int pbh=-1,pqb=-1;
  for(int i=0;S.next(i,u);++i){ S.a_ready(u); const bool st=!(u.bh==pbh&&u.qb<=pqb); attn_unit<THRL>(u.bh/NHEAD,u.bh%NHEAD,u.qb,T.Q,T.K,T.V,T.O,T.CP+(long)u.bh*SEQ,lds,st); if(st){pbh=u.bh;pqb=u.qb;} S.done(u); }
}
#undef SBAR
#undef WAIT_BAR
}

constexpr int NWAVES = 8;
constexpr int NPH = 11;
constexpr int N_LAUNCHES = MK_N_LAUNCHES;
static_assert(N_LAUNCHES == 1 || N_LAUNCHES == NPH, "MK_N_LAUNCHES is 1 (one launch) or NPH (one launch per phase)");

constexpr size_t MiB = 1u << 20;
constexpr size_t WS_CTL = 0, CTL_ZERO_BYTES = 1 * MiB;
constexpr size_t WS_MOD = 1 * MiB;
constexpr size_t WS_LOGF = 1 * MiB + 256 * 1024;
constexpr size_t WS_ROUTE = 2 * MiB;
constexpr size_t WS_RW = 2 * MiB + 256 * 1024;
constexpr size_t WS_CUM = 2 * MiB + 512 * 1024;
constexpr size_t WS_LIST = 3 * MiB;
constexpr size_t WS_CUMP = 5 * MiB;
constexpr size_t WS_WIN = 6 * MiB;
constexpr size_t WS_WGLU = 14 * MiB, WS_WOF = 15 * MiB, WS_WOS = 16 * MiB, WS_WO = 17 * MiB;
constexpr size_t WS_WGU = 20 * MiB;
constexpr size_t WS_WD = 84 * MiB;
constexpr size_t WS_H = 116 * MiB;
constexpr size_t WS_Y = 148 * MiB;
constexpr size_t WS_MIX = 164 * MiB;
constexpr size_t WS_Q = WS_MIX, WS_K = WS_MIX + 16 * MiB, WS_V = WS_MIX + 32 * MiB, WS_U = WS_MIX + 48 * MiB, WS_SGA = WS_MIX + 64 * MiB, WS_SGB = WS_MIX + 96 * MiB;
constexpr size_t WS_HID = WS_MIX;
constexpr size_t WS_YROWS = WS_MIX + 40 * MiB;
constexpr size_t WS_X1B = 132 * MiB;
constexpr size_t WS_LISTW = 292 * MiB;
constexpr size_t WS_END = 294 * MiB;
static_assert(WS_YROWS + (size_t)M * 2 * 1024 * 2 <= WS_END && WS_SGB + (size_t)M * 1024 * 2 <= WS_END, "d_ws map");

constexpr int CW_TMO = 0;
constexpr int CW_CNT = 2048;
constexpr int CW_CHK = 4096;
constexpr int CW_TS = 4200;
constexpr int CW_MOD = 4160;
constexpr int CW_BAR = 8192;

constexpr int RING_OFF = 0, RING_BYTES = 131072;
constexpr int LDS_BYTES = 147456;
constexpr int LDSCTL_OFF = LDS_BYTES - 2048, MISC_OFF = LDSCTL_OFF + 320, MOE_OFF = LDSCTL_OFF + 1024;

#define GAS __attribute__((address_space(1)))
#define LAS __attribute__((address_space(3)))
typedef unsigned short bf16;
typedef unsigned v4u __attribute__((ext_vector_type(4)));
typedef unsigned v2u __attribute__((ext_vector_type(2)));
typedef float f32x4 __attribute__((ext_vector_type(4)));
typedef float f32x2 __attribute__((ext_vector_type(2)));
typedef GAS unsigned gu32;
#define RLX_AGENT __ATOMIC_RELAXED, __HIP_MEMORY_SCOPE_AGENT
#define LDS_WAIT() asm volatile("s_waitcnt lgkmcnt(0)" ::: "memory")
#define VM_WAIT() asm volatile("s_waitcnt vmcnt(0)" ::: "memory")
__device__ __forceinline__ unsigned f2bf(float f) { unsigned u = __builtin_bit_cast(unsigned, f); return (u + 0x7fffu + ((u >> 16) & 1u)) >> 16; }
__device__ __forceinline__ unsigned pk2(float lo, float hi) { unsigned r; asm("v_cvt_pk_bf16_f32 %0, %1, %2" : "=v"(r) : "v"(lo), "v"(hi)); return r; }
__device__ __forceinline__ float bflo(unsigned w) { return __uint_as_float(w << 16); }
__device__ __forceinline__ float bfhi(unsigned w) { return __uint_as_float(w & 0xffff0000u); }
__device__ __forceinline__ float fast_sigmoid(float v) { return __builtin_amdgcn_rcpf(1.f + __builtin_amdgcn_exp2f(-LOG2E * v)); }

#define XB_TMO      128
#define XB_XCNT(j)  (256  + 64 * (j))
#define XB_XSUB(j)  (1280 + 64 * (j))
#define XB_XGEN(j)  (2304 + 64 * (j))
#define XB_TOP      3328
#define XB_TOPGEN   3392
#define XCD_BAR_WORDS 3456
#define XB_SPIN_CAP (1u << 18)
__device__ __forceinline__ unsigned xb_ld(unsigned* p)              { return __hip_atomic_load(p, __ATOMIC_RELAXED, __HIP_MEMORY_SCOPE_AGENT); }
__device__ __forceinline__ unsigned xb_add(unsigned* p, unsigned v) { return __hip_atomic_fetch_add(p, v, __ATOMIC_RELAXED, __HIP_MEMORY_SCOPE_AGENT); }
__device__ __forceinline__ unsigned xb_xcc_id() { return (unsigned)__builtin_amdgcn_s_getreg((3 << 11) | 20) & 0xFu; }
#define XB_SPIN(cond, bar) do { unsigned _sp = 0; while (cond) { __builtin_amdgcn_s_sleep(1); \
    if ((++_sp & 255u) == 0u) { if (xb_ld(&(bar)[XB_TMO])) break; if (_sp > XB_SPIN_CAP) { atomicAdd(&(bar)[XB_TMO], 1u); break; } } } } while (0)
struct XcdBarrier { unsigned* bar; unsigned x; volatile LAS unsigned* st; };
__device__ __forceinline__ XcdBarrier xcd_barrier_post(unsigned* bar, volatile LAS unsigned* st) {
    XcdBarrier b; b.bar = bar; b.x = xb_xcc_id(); b.st = st;
    if (tid_opaque() == 0) (void)xb_add(&bar[XB_XCNT(b.x)], 1u);
    return b;
}
__device__ __forceinline__ void xcd_barrier_complete(unsigned* bar, unsigned x, unsigned& nloc, unsigned& nx) {
    const unsigned G = gridDim.x * gridDim.y * gridDim.z;
    unsigned sum, cnt, mine, sp = 0u;
    for (;;) {
        sum = 0u; cnt = 0u; mine = 0u;
#pragma unroll
        for (unsigned j = 0; j < 16; ++j) { const unsigned c = xb_ld(&bar[XB_XCNT(j)]); sum += c; cnt += (c > 0u) ? 1u : 0u; mine = (j == x) ? c : mine; }
        if (sum == G) break;
        __builtin_amdgcn_s_sleep(1);
        if ((++sp & 255u) == 0u) { if (xb_ld(&bar[XB_TMO])) break; if (sp > XB_SPIN_CAP) { atomicAdd(&bar[XB_TMO], 1u); break; } }
    }
    nloc = mine > 0u ? mine : 1u; nx = cnt > 0u ? cnt : 1u;
}
struct NoShadow { __device__ __forceinline__ void operator()() const {} };
template <class Shadow = NoShadow>
__device__ __forceinline__ void xcd_barrier(const XcdBarrier& b, const Shadow& shadow = Shadow()) {
    asm volatile("s_waitcnt vmcnt(0)" ::: "memory");
    __syncthreads();
    const int tid_ = tid_opaque();
    if (tid_ >= 64) { shadow(); }
    else if (tid_ == 0) {
        unsigned* bar = b.bar;
        __builtin_amdgcn_s_waitcnt(0);
        unsigned nloc = b.st[0], nx = b.st[1];
        if (nloc == 0u) { xcd_barrier_complete(bar, b.x, nloc, nx); b.st[0] = nloc; b.st[1] = nx; }
        const unsigned old = xb_add(&bar[XB_XSUB(b.x)], 1u);
        const unsigned gen = old / nloc;
        if (old + 1u == (gen + 1u) * nloc) {
            __builtin_amdgcn_fence(__ATOMIC_RELEASE, "agent");
            asm volatile("s_waitcnt vmcnt(0)" ::: "memory");
            const unsigned og = xb_add(&bar[XB_TOP], 1u);
            const unsigned tg = og / nx;
            if (og + 1u == (tg + 1u) * nx) xb_add(&bar[XB_TOPGEN], 1u);
            else XB_SPIN(xb_ld(&bar[XB_TOPGEN]) == tg, bar);
            __builtin_amdgcn_fence(__ATOMIC_ACQUIRE, "agent");
            asm volatile("s_waitcnt vmcnt(0)" ::: "memory");
        } else {
            XB_SPIN(xb_ld(&bar[XB_TOPGEN]) == gen, bar);
            __builtin_amdgcn_fence(__ATOMIC_ACQUIRE, "agent");
            asm volatile("s_waitcnt vmcnt(0)" ::: "memory");
        }
    }
    __syncthreads();
}

struct Frame {
    LAS unsigned char* lds;
    volatile LAS unsigned* MISC;
    gu32* ctl;
    int tid, lane, wave, vcu, G;
    const float *x, *c, *w_ada, *b_ada, *norm_mix_g, *w_in, *b_forget, *w_out_fox, *lambda_re, *lambda_im, *log_dt, *b_re, *b_im, *c_re, *c_im, *d_skip, *w_glu, *w_out_ssm, *w_o,
        *norm_ffn_g, *w_rg, *b_rg, *w_rexp, *b_rexp, *w_gate, *w_up, *w_down, *final_g;
    float* out;
    float *MOD, *LOGF, *CUM, *RW, *LISTW; int* ROUTE; unsigned* LIST; unsigned* CUMP;
    bf16 *WIN, *WGLU, *WOF, *WOS, *WO, *WGU, *WD, *H, *Y, *Q, *K, *V, *U, *SGA, *SGB, *HID, *YROWS, *X1B;
};

template <int CTRL, int RMASK> __device__ __forceinline__ float dpp_addstep(float v) {
    return v + __builtin_bit_cast(float, __builtin_amdgcn_update_dpp(0, __builtin_bit_cast(int, v), CTRL, RMASK, 0xf, false));
}
__device__ __forceinline__ float wave_sum(float v) {
    v = dpp_addstep<0x111, 0xf>(v); v = dpp_addstep<0x112, 0xf>(v); v = dpp_addstep<0x114, 0xf>(v); v = dpp_addstep<0x118, 0xf>(v);
    v = dpp_addstep<0x142, 0xa>(v); v = dpp_addstep<0x143, 0xc>(v);
    return __builtin_bit_cast(float, __builtin_amdgcn_readlane(__builtin_bit_cast(int, v), 63));
}

__device__ __forceinline__ unsigned pk4_fp8(float a, float b, float c, float d) {
    a = __builtin_amdgcn_fmed3f(a, -448.f, 448.f); b = __builtin_amdgcn_fmed3f(b, -448.f, 448.f); c = __builtin_amdgcn_fmed3f(c, -448.f, 448.f); d = __builtin_amdgcn_fmed3f(d, -448.f, 448.f);
    int r = __builtin_amdgcn_cvt_pk_fp8_f32(a, b, 0, false); r = __builtin_amdgcn_cvt_pk_fp8_f32(c, d, r, true); return (unsigned)r;
}
constexpr float FP8_GW = 256.f, FP8_GH = 16.f;
constexpr float FP8_WSCALE = 32.f, FP8_HSCALE = 4.f, FP8_YSCALE = 8.f;
constexpr int TR_LD = 65, TR_WAVE_BYTES = 64 * TR_LD * 4;
__device__ __forceinline__ void transpose_item(const float* src, int ld_src, bf16* dst, int ld_dst, LAS float* scr, int lane) {
    f32x4 v[16];
    const int kr = lane >> 4, n4 = (lane & 15) * 4;
#pragma unroll
    for (int i = 0; i < 16; ++i) v[i] = __builtin_nontemporal_load((const GAS f32x4*)(src + (size_t)(4 * i + kr) * ld_src + n4));
#pragma unroll
    for (int i = 0; i < 16; ++i) { const int kk = 4 * i + kr; scr[(n4 + 0) * TR_LD + kk] = v[i].x; scr[(n4 + 1) * TR_LD + kk] = v[i].y; scr[(n4 + 2) * TR_LD + kk] = v[i].z; scr[(n4 + 3) * TR_LD + kk] = v[i].w; }
    LDS_WAIT(); asm volatile("" ::: "memory");
    const int c = lane & 7;
#pragma unroll
    for (int j = 0; j < 8; ++j) { const int n = (lane >> 3) + 8 * j; const LAS float* s = scr + n * TR_LD + 8 * c;
        v4u o; o.x = pk2(s[0], s[1]); o.y = pk2(s[2], s[3]); o.z = pk2(s[4], s[5]); o.w = pk2(s[6], s[7]);
        *(GAS v4u*)(dst + (size_t)n * ld_dst + 8 * c) = o; }
    LDS_WAIT(); asm volatile("" ::: "memory");
}

__device__ __forceinline__ void transpose_item_fp8(const float* src, int ld_src, unsigned char* dst, int ld_dst, LAS float* scr, int lane, float scale) {
    f32x4 v[16];
    const int kr = lane >> 4, n4 = (lane & 15) * 4;
#pragma unroll
    for (int i = 0; i < 16; ++i) v[i] = __builtin_nontemporal_load((const GAS f32x4*)(src + (size_t)(4 * i + kr) * ld_src + n4));
#pragma unroll
    for (int i = 0; i < 16; ++i) { const int kk = 4 * i + kr; scr[(n4 + 0) * TR_LD + kk] = v[i].x; scr[(n4 + 1) * TR_LD + kk] = v[i].y; scr[(n4 + 2) * TR_LD + kk] = v[i].z; scr[(n4 + 3) * TR_LD + kk] = v[i].w; }
    LDS_WAIT(); asm volatile("" ::: "memory");
    const int c = lane & 7;
#pragma unroll
    for (int j = 0; j < 8; ++j) { const int n = (lane >> 3) + 8 * j; const LAS float* s = scr + n * TR_LD + 8 * c;
        v2u o; o.x = pk4_fp8(s[0] * scale, s[1] * scale, s[2] * scale, s[3] * scale); o.y = pk4_fp8(s[4] * scale, s[5] * scale, s[6] * scale, s[7] * scale);
        *(GAS v2u*)(dst + (size_t)n * ld_dst + 8 * c) = o; }
    LDS_WAIT(); asm volatile("" ::: "memory");
}
__device__ __forceinline__ void p0_mod(Frame& F) {
    {
        int nmine = 0;
        LAS float* cact = (LAS float*)(F.lds);
        LAS float* red = (LAS float*)(F.lds + 32768);
        for (int i = F.tid; i < 8192; i += 512) { const float v = F.c[i]; cact[i] = v / (1.f + __expf(-v)); }
        __syncthreads();
        for (int it = F.vcu; it < 192; it += F.G) {
            const int cl = F.lane & 31, hf = F.lane >> 5, col = it * 32 + cl;
            float a[8];
#pragma unroll
            for (int b = 0; b < 8; ++b) a[b] = 0.f;
#pragma unroll 1
            for (int i0 = 0; i0 < 64; i0 += 16) {
                float w[16];
#pragma unroll
                for (int i = 0; i < 16; ++i) w[i] = __builtin_nontemporal_load(F.w_ada + (size_t)(16 * (i0 + i) + 2 * F.wave + hf) * 6144 + col);
#pragma unroll
                for (int i = 0; i < 16; ++i) { const int kk = 16 * (i0 + i) + 2 * F.wave + hf;
#pragma unroll
                    for (int b = 0; b < 8; ++b) a[b] += cact[b * 1024 + kk] * w[i]; }
            }
#pragma unroll
            for (int b = 0; b < 8; ++b) { a[b] += __shfl_xor(a[b], 32); if (hf == 0) red[(F.wave * 8 + b) * 32 + cl] = a[b]; }
            __syncthreads();
            if (F.tid < 256) { const int b = F.tid >> 5, c2 = F.tid & 31; float s = 0.f;
#pragma unroll
                for (int w = 0; w < 8; ++w) s += red[(w * 8 + b) * 32 + c2];
                F.MOD[b * 6144 + it * 32 + c2] = s + F.b_ada[it * 32 + c2]; }
            __syncthreads(); ++nmine;
        }
        asm volatile("s_waitcnt vmcnt(0)" ::: "memory"); __syncthreads();
        if (F.tid == 0 && nmine > 0) { __builtin_amdgcn_fence(__ATOMIC_RELEASE, "agent"); asm volatile("s_waitcnt vmcnt(0)" ::: "memory");
            __hip_atomic_fetch_add((unsigned*)(F.ctl + CW_MOD), (unsigned)nmine, RLX_AGENT); }
        __syncthreads();
    }
}
__device__ __forceinline__ void p0_copies(Frame& F, int wg_rank, int n_wg) {
    LAS float* scr = (LAS float*)(F.lds + RING_OFF + F.wave * TR_WAVE_BYTES);
    const int gw = wg_rank * NWAVES + F.wave, NGW = n_wg * NWAVES;
    constexpr int I_A = 16 * 24, I_B = 16 * 40, I_C = 8 * 16, I_D = 8 * 16, I_E = 8 * 16, I_F = 16 * 16, I_G = 32 * 128, I_H = 32 * 128, I_I = 32 * 128;
    constexpr int NITEMS = I_A + I_B + I_C + I_D + I_E + I_F;
    for (int it = gw; it < NITEMS; it += NGW) {
        int r = it;
        if (r < I_A) { const int kb = r / 24, nb = r % 24; transpose_item(F.w_in + (size_t)(64 * kb) * INC + 64 * nb, INC, F.WIN + (size_t)(64 * nb) * 1024 + 64 * kb, 1024, scr, F.lane); continue; } r -= I_A;
        if (r < I_B) { const int kb = r / 40, nb = r % 40;
            if (nb < 8) transpose_item(F.w_in + (size_t)(64 * kb) * INC + 1544 + 64 * nb, INC, F.WIN + (size_t)(1536 + 64 * nb) * 1024 + 64 * kb, 1024, scr, F.lane);
            else transpose_item_fp8(F.w_in + (size_t)(64 * kb) * INC + 1544 + 64 * nb, INC, (unsigned char*)(F.WIN + (size_t)2048 * 1024) + (size_t)(64 * (nb - 8)) * 1024 + 64 * kb, 1024, scr, F.lane, FP8_GW);
            continue; } r -= I_B;
        if (r < I_C) { const int kb = r / 16, nb = r % 16, n0 = 64 * nb, half = n0 >> 9, within = n0 & 511, pn = within >> 7, q = within & 127;
            transpose_item(F.w_glu + (size_t)(64 * kb) * 1024 + n0, 1024, F.WGLU + (size_t)(pn * 256 + half * 128 + q) * 512 + 64 * kb, 512, scr, F.lane); continue; } r -= I_C;
        if (r < I_D) { const int kb = r / 16, nb = r % 16; transpose_item(F.w_out_fox + (size_t)(64 * kb) * 1024 + 64 * nb, 1024, F.WOF + (size_t)(64 * nb) * 512 + 64 * kb, 512, scr, F.lane); continue; } r -= I_D;
        if (r < I_E) { const int kb = r / 16, nb = r % 16; transpose_item(F.w_out_ssm + (size_t)(64 * kb) * 1024 + 64 * nb, 1024, F.WOS + (size_t)(64 * nb) * 512 + 64 * kb, 512, scr, F.lane); continue; } r -= I_E;
        if (r < I_F) { const int kb = r / 16, nb = r % 16; transpose_item(F.w_o + (size_t)(64 * kb) * 1024 + 64 * nb, 1024, F.WO + (size_t)(64 * nb) * 1024 + 64 * kb, 1024, scr, F.lane); continue; } r -= I_F;
    }
}
struct ShadowGateUp {
    const float* w_gate; const float* w_up; bf16* WGU; LAS unsigned char* lds; int seam, wg;
    __device__ __forceinline__ void operator()() const {
        const int tid_ = tid_opaque(); const int wave = __builtin_amdgcn_readfirstlane(tid_ >> 6), lane = tid_ & 63;
        const int kq = wg * 7 + (wave - 1); int r = 6 * kq + (seam - 1);
        if (r >= 8192) return;
        LAS float* scr = (LAS float*)(lds + RING_OFF + wave * TR_WAVE_BYTES);
        const int up = r >= 4096; if (up) r -= 4096; const int e = r >> 7, rr = r & 127, kb = rr >> 3, nb = rr & 7, n0 = 64 * nb, pn = n0 >> 7, q = n0 & 127;
        const float* src = (up ? w_up : w_gate) + (size_t)e * 1024 * 512 + (size_t)(64 * kb) * 512 + n0;
        transpose_item_fp8(src, 512, (unsigned char*)WGU + (size_t)e * 1024 * 1024 + (size_t)(pn * 256 + up * 128 + q) * 1024 + 64 * kb, 1024, scr, lane, FP8_WSCALE);
    }
};
__device__ __forceinline__ void convert_wdown(Frame& F, int wg_lo) {
    LAS float* scr = (LAS float*)(F.lds + RING_OFF + F.wave * TR_WAVE_BYTES);
    const int lo = (wg_lo >= F.G || wg_lo < 0) ? 0 : wg_lo; const int bx = F.vcu;
    if (bx < lo) return;
    const int gw = (bx - lo) * NWAVES + F.wave, NGW = (F.G - lo) * NWAVES;
    for (int r = gw; r < 32 * 128; r += NGW) { const int e = r >> 7, rr = r & 127, kb = rr >> 4, nb = rr & 15;
        transpose_item_fp8(F.w_down + (size_t)e * 512 * 1024 + (size_t)(64 * kb) * 1024 + 64 * nb, 1024, (unsigned char*)F.WD + (size_t)e * 1024 * 512 + (size_t)(64 * nb) * 512 + 64 * kb, 512, scr, F.lane, FP8_WSCALE); }
}

__device__ __forceinline__ void p1_rows(Frame& F) {
    LAS float* wfT = (LAS float*)(F.lds);
    for (int idx = F.tid; idx < 8192; idx += 512) { const int k = idx >> 3, j = idx & 7; wfT[j * 1024 + k] = F.w_in[(size_t)k * INC + 1536 + j]; }
    __syncthreads();
    const int gw = F.vcu * NWAVES + F.wave, NGW = F.G * NWAVES;
    for (int ch = gw; ch < M / 8; ch += NGW) {
        const int b = (ch * 8) / SEQ;
        const float* mod = F.MOD + b * 6144;
        f32x4 es[4], sh[4];
#pragma unroll
        for (int j = 0; j < 4; ++j) { const int c = 4 * F.lane + 256 * j; const f32x4 g4 = *(const f32x4*)(F.norm_mix_g + c), sc = *(const f32x4*)(mod + 1024 + c); es[j] = g4 * (sc + 1.f); sh[j] = *(const f32x4*)(mod + c); }
#pragma unroll 1
        for (int rb = 0; rb < 8; rb += 4) {
            f32x4 v[4][4];
#pragma unroll
            for (int r = 0; r < 4; ++r) { const GAS f32x4* xr = (const GAS f32x4*)(F.x + (size_t)(ch * 8 + rb + r) * D) + F.lane;
#pragma unroll
                for (int j = 0; j < 4; ++j) v[r][j] = __builtin_nontemporal_load(xr + 64 * j); }
            float ss[4];
#pragma unroll
            for (int r = 0; r < 4; ++r) { float s = 0.f;
#pragma unroll
                for (int j = 0; j < 4; ++j) s += (v[r][j].x * v[r][j].x + v[r][j].y * v[r][j].y) + (v[r][j].z * v[r][j].z + v[r][j].w * v[r][j].w);
                ss[r] = s; }
#pragma unroll
            for (int r = 0; r < 4; ++r) ss[r] = wave_sum(ss[r]);
#pragma unroll
            for (int r = 0; r < 4; ++r) { const int m = ch * 8 + rb + r;
                const float rstd = __builtin_amdgcn_rsqf(ss[r] * (1.f / D) + RMS_EPS);
                GAS v2u* o8 = (GAS v2u*)(F.H + (size_t)m * D) + F.lane;
#pragma unroll
                for (int j = 0; j < 4; ++j) { v[r][j] = v[r][j] * rstd * es[j] + sh[j]; v2u w; w.x = pk2(v[r][j].x, v[r][j].y); w.y = pk2(v[r][j].z, v[r][j].w); o8[64 * j] = w;
                    ((GAS unsigned*)((unsigned char*)F.WD + (size_t)m * D) + F.lane)[64 * j] = pk4_fp8(v[r][j].x * FP8_GH, v[r][j].y * FP8_GH, v[r][j].z * FP8_GH, v[r][j].w * FP8_GH); }
                float f[8];
#pragma unroll
                for (int jj = 0; jj < 8; ++jj) { f32x4 a4 = (f32x4){0.f, 0.f, 0.f, 0.f};
#pragma unroll
                    for (int j = 0; j < 4; ++j) a4 += v[r][j] * *(const LAS f32x4*)(wfT + jj * 1024 + 4 * F.lane + 256 * j);
                    f[jj] = (a4.x + a4.y) + (a4.z + a4.w); if (jj & 1) __builtin_amdgcn_sched_barrier(0); }
                { const bool h5 = (F.lane & 32) != 0, h4 = (F.lane & 16) != 0, h3 = (F.lane & 8) != 0;
                  float k4[4], k2[2];
#pragma unroll
                  for (int i = 0; i < 4; ++i) { const float keep = h5 ? f[i + 4] : f[i], send = h5 ? f[i] : f[i + 4]; k4[i] = keep + __shfl_xor(send, 32); }
#pragma unroll
                  for (int i = 0; i < 2; ++i) { const float keep = h4 ? k4[i + 2] : k4[i], send = h4 ? k4[i] : k4[i + 2]; k2[i] = keep + __shfl_xor(send, 16); }
                  float z = (h3 ? k2[1] : k2[0]) + __shfl_xor(h3 ? k2[0] : k2[1], 8);
                  z += __shfl_xor(z, 4); z += __shfl_xor(z, 2); z += __shfl_xor(z, 1);
                  if ((F.lane & 7) == 0) { const int jj = F.lane >> 3; z += F.b_forget[jj];
                      F.LOGF[(size_t)m * 8 + jj] = fminf(z, 0.f) - __logf(1.f + __expf(-fabsf(z))); } }
            }
        }
    }
}

__device__ __forceinline__ void p2_cumscan(Frame& F) {
    const int gw = F.wave * F.G + F.vcu, NGW = F.G * NWAVES;
    for (int u = gw; u < NB * NH; u += NGW) {
        const int b = u >> 3, h = u & 7;
        float v[32]; float run = 0.f;
#pragma unroll
        for (int i = 0; i < 32; ++i) { run += F.LOGF[((size_t)b * SEQ + 32 * F.lane + i) * 8 + h]; v[i] = run; }
        float incl = run;
#pragma unroll
        for (int o = 1; o < 64; o <<= 1) { const float t = __shfl_up(incl, o); if (F.lane >= o) incl += t; }
        const float excl = incl - run;
#pragma unroll
        for (int i = 0; i < 32; ++i) { const float cv = v[i] + excl; F.CUM[(size_t)u * SEQ + 32 * F.lane + i] = cv;
            const float nb = -cv * LOG2E; const unsigned hb = f2bf(nb); const float lo = nb - __uint_as_float(hb << 16); F.CUMP[(size_t)u * SEQ + 32 * F.lane + i] = hb | (f2bf(lo) << 16); }
    }
}

using pg8::Unit;
struct EpiInProj {
    static constexpr bool PERM = true;
    bf16* mix; float gs = 1.f;
    __device__ __forceinline__ void operator()(const f32x4 (&acc)[2][2][4][2], const Unit& u, int wr, int wc, int fr, int fq) const {
        const int pn = u.pn; bf16* base; int ldc, colt, mode;
        if (pn < 8) { base = mix + (size_t)(pn >> 1) * ((size_t)M * 512); ldc = 512; colt = (pn & 1) * 256; mode = pn < 2 ? 1 : 0; }
        else { const int g = (pn - 8) >> 2; base = mix + (size_t)4 * M * 512 + (size_t)g * ((size_t)M * 1024); ldc = 1024; colt = ((pn - 8) & 3) * 256; mode = 2; }
        const int row0 = u.pm * 256 + wr * 64 + fr, col0 = colt + wc * 32 + 8 * fq;
#pragma unroll
        for (int ai = 0; ai < 2; ++ai)
#pragma unroll
            for (int m = 0; m < 4; ++m) { bf16* rowp = base + (size_t)(row0 + ai * 128 + m * 16) * ldc + col0;
#pragma unroll
                for (int bj = 0; bj < 2; ++bj) { f32x4 v0 = acc[ai][bj][m][0], v1 = acc[ai][bj][m][1];
                    if (mode == 1) { v0 = v0 * QSCALE; v1 = v1 * QSCALE; }
                    else if (mode == 2) {
#pragma unroll
                        for (int e = 0; e < 4; ++e) { v0[e] = fast_sigmoid(v0[e] * gs); v1[e] = fast_sigmoid(v1[e] * gs); } }
                    v4u w; w.x = pg8::cvt_pk_bf16(v0[0], v0[1]); w.y = pg8::cvt_pk_bf16(v0[2], v0[3]); w.z = pg8::cvt_pk_bf16(v1[0], v1[1]); w.w = pg8::cvt_pk_bf16(v1[2], v1[3]);
                    if ((pn >> 1) == 3) { const int col = col0 + bj * 128; *(v4u*)(base + ((size_t)(col >> 4) * M + (row0 + ai * 128 + m * 16)) * 16 + (col & 15)) = w; }
                    else *(v4u*)(rowp + bj * 128) = w; } }
    }
};
template <int MODE> struct EpiGate {
    static constexpr bool PERM = true;
    bf16* T; const bf16* Gt;
    __device__ __forceinline__ void operator()(const f32x4 (&acc)[2][2][4][2], const Unit& u, int wr, int wc, int fr, int fq) const {
        const int row0 = u.pm * 256 + wr * 64 + fr, col0 = u.pn * 256 + wc * 32 + 8 * fq;
#pragma unroll
        for (int ai = 0; ai < 2; ++ai)
#pragma unroll
            for (int m = 0; m < 4; ++m) { const size_t off = (size_t)(row0 + ai * 128 + m * 16) * 1024 + col0;
#pragma unroll
                for (int bj = 0; bj < 2; ++bj) { const f32x4 v0 = acc[ai][bj][m][0], v1 = acc[ai][bj][m][1];
                    const v4u t = *(const v4u*)(T + off + bj * 128); v4u w;
                    if (MODE == 0) {
                        w.x = pg8::cvt_pk_bf16(bflo(t.x) * v0[0], bfhi(t.x) * v0[1]); w.y = pg8::cvt_pk_bf16(bflo(t.y) * v0[2], bfhi(t.y) * v0[3]);
                        w.z = pg8::cvt_pk_bf16(bflo(t.z) * v1[0], bfhi(t.z) * v1[1]); w.w = pg8::cvt_pk_bf16(bflo(t.w) * v1[2], bfhi(t.w) * v1[3]);
                    } else {
                        const v4u gg = *(const v4u*)(Gt + off + bj * 128);
                        w.x = pg8::cvt_pk_bf16(bflo(t.x) + bflo(gg.x) * v0[0], bfhi(t.x) + bfhi(gg.x) * v0[1]); w.y = pg8::cvt_pk_bf16(bflo(t.y) + bflo(gg.y) * v0[2], bfhi(t.y) + bfhi(gg.y) * v0[3]);
                        w.z = pg8::cvt_pk_bf16(bflo(t.z) + bflo(gg.z) * v1[0], bfhi(t.z) + bfhi(gg.z) * v1[1]); w.w = pg8::cvt_pk_bf16(bflo(t.w) + bflo(gg.w) * v1[2], bfhi(t.w) + bfhi(gg.w) * v1[3]);
                    }
                    *(v4u*)(T + off + bj * 128) = w; } }
    }
};
struct EpiGate2 {
    static constexpr bool PERM = true;
    EpiGate<0> e0; EpiGate<1> e1;
    __device__ __forceinline__ void operator()(const f32x4 (&acc)[2][2][4][2], const Unit& u, int wr, int wc, int fr, int fq) const { if (u.e == 0) e0(acc, u, wr, wc, fr, fq); else e1(acc, u, wr, wc, fr, fq); }
};
struct EpiGateChain {
    static constexpr bool PERM = true, CHAIN = true;
    bf16* T; const bf16* Gt;
    __device__ __forceinline__ void chain(f32x4 (&acc)[2][2][4][2], const Unit& u, int wr, int wc, int fr, int fq) const {
        const int row0 = u.pm * 256 + wr * 64 + fr, col0 = u.pn * 256 + wc * 32 + 8 * fq;
        if (u.e == 0) {
#pragma unroll
            for (int ai = 0; ai < 2; ++ai)
#pragma unroll
                for (int m = 0; m < 4; ++m) { const size_t off = (size_t)(row0 + ai * 128 + m * 16) * 1024 + col0;
#pragma unroll
                    for (int bj = 0; bj < 2; ++bj) { const v4u t = *(const v4u*)(T + off + bj * 128), gg = *(const v4u*)(Gt + off + bj * 128);
                        f32x4& v0 = acc[ai][bj][m][0]; f32x4& v1 = acc[ai][bj][m][1];
                        v0[0] *= bflo(t.x) * __builtin_amdgcn_rcpf(bflo(gg.x)); v0[1] *= bfhi(t.x) * __builtin_amdgcn_rcpf(bfhi(gg.x)); v0[2] *= bflo(t.y) * __builtin_amdgcn_rcpf(bflo(gg.y)); v0[3] *= bfhi(t.y) * __builtin_amdgcn_rcpf(bfhi(gg.y));
                        v1[0] *= bflo(t.z) * __builtin_amdgcn_rcpf(bflo(gg.z)); v1[1] *= bfhi(t.z) * __builtin_amdgcn_rcpf(bfhi(gg.z)); v1[2] *= bflo(t.w) * __builtin_amdgcn_rcpf(bflo(gg.w)); v1[3] *= bfhi(t.w) * __builtin_amdgcn_rcpf(bfhi(gg.w)); } }
        } else {
#pragma unroll
            for (int ai = 0; ai < 2; ++ai)
#pragma unroll
                for (int m = 0; m < 4; ++m) { const size_t off = (size_t)(row0 + ai * 128 + m * 16) * 1024 + col0;
#pragma unroll
                    for (int bj = 0; bj < 2; ++bj) { const v4u gg = *(const v4u*)(Gt + off + bj * 128); const f32x4 v0 = acc[ai][bj][m][0], v1 = acc[ai][bj][m][1]; v4u w;
                        w.x = pg8::cvt_pk_bf16(bflo(gg.x) * v0[0], bfhi(gg.x) * v0[1]); w.y = pg8::cvt_pk_bf16(bflo(gg.y) * v0[2], bfhi(gg.y) * v0[3]);
                        w.z = pg8::cvt_pk_bf16(bflo(gg.z) * v1[0], bfhi(gg.z) * v1[1]); w.w = pg8::cvt_pk_bf16(bflo(gg.w) * v1[2], bfhi(gg.w) * v1[3]);
                        *(v4u*)(T + off + bj * 128) = w; } }
        }
    }
};
template <int MODE> struct EpiPair {
    static constexpr bool PERM = true;
    bf16* O;
    __device__ __forceinline__ void operator()(const f32x4 (&acc)[2][2][4][2], const Unit& u, int wr, int wc, int fr, int fq) const {
        const int row0 = u.pm * 256 + wr * 64 + fr, col0 = u.pn * 128 + wc * 32 + 8 * fq;
#pragma unroll
        for (int ai = 0; ai < 2; ++ai)
#pragma unroll
            for (int m = 0; m < 4; ++m) { f32x4 r0, r1;
#pragma unroll
                for (int e = 0; e < 4; ++e) {
                    if (MODE == 0) { r0[e] = acc[ai][0][m][0][e] * fast_sigmoid(acc[ai][1][m][0][e]); r1[e] = acc[ai][0][m][1][e] * fast_sigmoid(acc[ai][1][m][1][e]); }
                    else { const float g0 = acc[ai][0][m][0][e], g1 = acc[ai][0][m][1][e]; r0[e] = g0 * fast_sigmoid(g0) * acc[ai][1][m][0][e]; r1[e] = g1 * fast_sigmoid(g1) * acc[ai][1][m][1][e]; } }
                v4u w; w.x = pg8::cvt_pk_bf16(r0[0], r0[1]); w.y = pg8::cvt_pk_bf16(r0[2], r0[3]); w.z = pg8::cvt_pk_bf16(r1[0], r1[1]); w.w = pg8::cvt_pk_bf16(r1[2], r1[3]);
                *(v4u*)(O + (size_t)(row0 + ai * 128 + m * 16) * 512 + col0) = w; }
    }
};
struct EpiResid {
    static constexpr bool PERM = true;
    const float* x; bf16* out; const float* mod;
    __device__ __forceinline__ void operator()(const f32x4 (&acc)[2][2][4][2], const Unit& u, int wr, int wc, int fr, int fq) const {
        const int row0 = u.pm * 256 + wr * 64 + fr, col0 = u.pn * 256 + wc * 32 + 8 * fq;
        const int b = (u.pm * 256) / SEQ;
        f32x4 gv[2][2];
#pragma unroll
        for (int bj = 0; bj < 2; ++bj)
#pragma unroll
            for (int n = 0; n < 2; ++n) gv[bj][n] = *(const f32x4*)(mod + (size_t)b * 6144 + 2048 + col0 + bj * 128 + n * 4);
#pragma unroll
        for (int ai = 0; ai < 2; ++ai)
#pragma unroll
            for (int m = 0; m < 4; ++m) { const size_t off = (size_t)(row0 + ai * 128 + m * 16) * 1024 + col0;
#pragma unroll
                for (int bj = 0; bj < 2; ++bj) { const f32x4 x0 = *(const f32x4*)(x + off + bj * 128), x1 = *(const f32x4*)(x + off + bj * 128 + 4);
                    const f32x4 r0 = x0 + gv[bj][0] * acc[ai][bj][m][0], r1 = x1 + gv[bj][1] * acc[ai][bj][m][1];
                    v4u w; w.x = pg8::cvt_pk_bf16(r0[0], r0[1]); w.y = pg8::cvt_pk_bf16(r0[2], r0[3]); w.z = pg8::cvt_pk_bf16(r1[0], r1[1]); w.w = pg8::cvt_pk_bf16(r1[2], r1[3]);
                    *(v4u*)(out + off + bj * 128) = w; } }
    }
};
struct EpiSwiGLU8 {
    static constexpr bool PERM = true;
    unsigned char* O;
    __device__ __forceinline__ void operator()(const f32x4 (&acc)[2][2][4][2], const Unit& u, int wr, int wc, int fr, int fq) const {
        const int row0 = u.pm * 256 + wr * 64 + fr, col0 = u.pn * 128 + wc * 32 + 8 * fq; constexpr float inv = 1.f / FP8_WSCALE;
#pragma unroll
        for (int ai = 0; ai < 2; ++ai)
#pragma unroll
            for (int m = 0; m < 4; ++m) { f32x4 r0, r1;
#pragma unroll
                for (int e = 0; e < 4; ++e) { const float g0 = acc[ai][0][m][0][e] * inv, g1 = acc[ai][0][m][1][e] * inv;
                    r0[e] = g0 * fast_sigmoid(g0) * acc[ai][1][m][0][e] * (inv * FP8_HSCALE); r1[e] = g1 * fast_sigmoid(g1) * acc[ai][1][m][1][e] * (inv * FP8_HSCALE); }
                v2u w; w.x = pk4_fp8(r0[0], r0[1], r0[2], r0[3]); w.y = pk4_fp8(r1[0], r1[1], r1[2], r1[3]);
                *(v2u*)(O + (size_t)(row0 + ai * 128 + m * 16) * 512 + col0) = w; }
    }
};
struct EpiDown {
    static constexpr bool PERM = true;
    bf16* Y; const unsigned* list; const float* rw;
    __device__ __forceinline__ void operator()(const f32x4 (&acc)[2][2][4][2], const Unit& u, int wr, int wc, int fr, int fq) const {
        const int col0 = u.pn * 256 + wc * 32 + 8 * fq;
#pragma unroll
        for (int ai = 0; ai < 2; ++ai)
#pragma unroll
            for (int m = 0; m < 4; ++m) { const int r = ai * 128 + wr * 64 + m * 16 + fr;
                if (r < u.rows) { const unsigned aid = list[u.lbase + r]; const float wgt = rw[u.lbase + r] * (FP8_YSCALE / (FP8_WSCALE * FP8_HSCALE)); unsigned char* rowp = (unsigned char*)Y + (size_t)aid * 1024 + col0;
#pragma unroll
                    for (int bj = 0; bj < 2; ++bj) { const f32x4 v0 = acc[ai][bj][m][0] * wgt, v1 = acc[ai][bj][m][1] * wgt;
                        v2u w; w.x = pk4_fp8(v0[0], v0[1], v0[2], v0[3]); w.y = pk4_fp8(v1[0], v1[1], v1[2], v1[3]);
                        *(v2u*)(rowp + bj * 128) = w; } } }
    }
};

template <bool GATHER_> struct MoeOrder {
    static constexpr bool GATHER = GATHER_, FP8 = true;
    int G, c, nunits; const LAS int* tab; const unsigned* list; size_t estride; int bK;
    __device__ __forceinline__ bool next(int i, Unit& u) const {
        const int L = i * G + c; if (L >= nunits) return false;
        const int mt = L >> 2; u.pn = L & 3; int e = 0;
        while (e < NE - 1 && mt >= tab[e + 1]) ++e;
        const int j = mt - tab[e]; u.e = e; u.pm = mt; u.lbase = e * CAP + j * 256; const int left = tab[33 + e] - j * 256; u.rows = left < 256 ? left : 256; return true;
    }
    __device__ __forceinline__ size_t a_base(const Unit& u, int K) const { return GATHER ? (size_t)0 : (size_t)u.pm * 256 * K * 2; }
    __device__ __forceinline__ size_t b_base(const Unit& u, int K) const { return (size_t)u.e * estride + (size_t)u.pn * 256 * K * 2; }
    __device__ __forceinline__ void a_offsets(const Unit& u, const int* Rr, const int* Cc, int K, unsigned (&vo)[2][2]) const {
#pragma unroll
        for (int h = 0; h < 2; ++h)
#pragma unroll
            for (int i = 0; i < 2; ++i) { const int r = h * 128 + Rr[i]; const unsigned aid = list[u.lbase + (r < u.rows ? r : 0)]; vo[h][i] = (unsigned)((aid >> 1) * (unsigned)K + (unsigned)Cc[i]) * 2u; }
    }
};
__device__ __forceinline__ int moe_tables(Frame& F) {
    LAS int* tab = (LAS int*)(F.lds + MOE_OFF);
    if (F.tid == 0) { int acc = 0;
        for (int e = 0; e < NE; ++e) { const int c = (int)F.ctl[CW_CNT + 64 * e]; tab[e] = acc; tab[33 + e] = c; acc += (c + 255) >> 8; }
        tab[32] = acc; }
    __syncthreads();
    return tab[32];
}

__device__ __forceinline__ void attn_simple_unit(Frame& F, int b, int h, int qblk) {
    LAS bf16* Ks = (LAS bf16*)(F.lds);
    LAS bf16* Vs = (LAS bf16*)(F.lds + 8192);
    LAS float* cs = (LAS float*)(F.lds + 16384);
    const int q = qblk * 512 + F.tid;
    const size_t rowq = (size_t)b * SEQ + q;
    float qv[64], o[64];
    { const bf16* qp = F.Q + rowq * 512 + h * 64;
#pragma unroll
      for (int i = 0; i < 8; ++i) { const v4u w = *(const v4u*)(qp + 8 * i); qv[8 * i] = bflo(w.x); qv[8 * i + 1] = bfhi(w.x); qv[8 * i + 2] = bflo(w.y); qv[8 * i + 3] = bfhi(w.y); qv[8 * i + 4] = bflo(w.z); qv[8 * i + 5] = bfhi(w.z); qv[8 * i + 6] = bflo(w.w); qv[8 * i + 7] = bfhi(w.w); } }
#pragma unroll
    for (int d = 0; d < 64; ++d) o[d] = 0.f;
    float mrun = -INFINITY, l = 0.f;
    const int ntiles = (qblk * 512 + 512) / 64;
    const int wave_tile = (qblk * 512 + F.wave * 64) / 64;
    for (int kt = 0; kt < ntiles; ++kt) {
        __syncthreads();
        { const size_t krow = (size_t)b * SEQ + kt * 64 + (F.tid >> 3); const int ch = (F.tid & 7) * 8;
          *(LAS v4u*)(Ks + (F.tid >> 3) * 64 + ch) = *(const v4u*)(F.K + krow * 512 + h * 64 + ch);
          *(LAS v4u*)(Vs + (F.tid >> 3) * 64 + ch) = *(const v4u*)(F.V + krow * 512 + h * 64 + ch);
          if (F.tid < 64) cs[F.tid] = F.CUM[(size_t)(b * NH + h) * SEQ + kt * 64 + F.tid] * LOG2E; }
        __syncthreads();
        if (kt <= wave_tile) {
#pragma unroll 1
            for (int kk = 0; kk < 64; ++kk) {
                float dot = 0.f;
#pragma unroll
                for (int c8 = 0; c8 < 8; ++c8) { const v4u w = *(const LAS v4u*)(Ks + kk * 64 + c8 * 8);
                    dot += qv[8 * c8] * bflo(w.x) + qv[8 * c8 + 1] * bfhi(w.x) + qv[8 * c8 + 2] * bflo(w.y) + qv[8 * c8 + 3] * bfhi(w.y) + qv[8 * c8 + 4] * bflo(w.z) + qv[8 * c8 + 5] * bfhi(w.z) + qv[8 * c8 + 6] * bflo(w.w) + qv[8 * c8 + 7] * bfhi(w.w); }
                const float sc = (kt * 64 + kk > q) ? -INFINITY : dot - cs[kk];
                const float mnew = fmaxf(mrun, sc);
                const float corr = (mnew > -INFINITY) ? __builtin_amdgcn_exp2f(mrun - mnew) : 1.f;
                const float p = (mnew > -INFINITY) ? __builtin_amdgcn_exp2f(sc - mnew) : 0.f;
                l = l * corr + p;
#pragma unroll
                for (int c8 = 0; c8 < 8; ++c8) { const v4u w = *(const LAS v4u*)(Vs + kk * 64 + c8 * 8);
                    o[8 * c8] = o[8 * c8] * corr + p * bflo(w.x); o[8 * c8 + 1] = o[8 * c8 + 1] * corr + p * bfhi(w.x); o[8 * c8 + 2] = o[8 * c8 + 2] * corr + p * bflo(w.y); o[8 * c8 + 3] = o[8 * c8 + 3] * corr + p * bfhi(w.y);
                    o[8 * c8 + 4] = o[8 * c8 + 4] * corr + p * bflo(w.z); o[8 * c8 + 5] = o[8 * c8 + 5] * corr + p * bfhi(w.z); o[8 * c8 + 6] = o[8 * c8 + 6] * corr + p * bflo(w.w); o[8 * c8 + 7] = o[8 * c8 + 7] * corr + p * bfhi(w.w); }
                mrun = mnew;
            }
        }
    }
    const float inv = 1.f / l;
    bf16* op = F.Q + rowq * 512 + h * 64;
#pragma unroll
    for (int i = 0; i < 8; ++i) { v4u w; w.x = pk2(o[8 * i] * inv, o[8 * i + 1] * inv); w.y = pk2(o[8 * i + 2] * inv, o[8 * i + 3] * inv); w.z = pk2(o[8 * i + 4] * inv, o[8 * i + 5] * inv); w.w = pk2(o[8 * i + 6] * inv, o[8 * i + 7] * inv); *(v4u*)(op + 8 * i) = w; }
    __syncthreads();
}

__device__ __forceinline__ float gelu_tanh(float v) { const float t = 0.7978845608028654f * (v + 0.044715f * v * v * v); return 0.5f * v * (1.f + tanhf(t)); }
__device__ __forceinline__ void ssm_simple_unit(Frame& F, int b, int g, LAS unsigned char* wl) {
    const int p = F.lane;
    LAS f32x2* xs = (LAS f32x2*)wl;
    LAS float* Cp = (LAS float*)(wl + 33280);
#pragma unroll
    for (int c = 0; c < 16; ++c) { Cp[p * 32 + c] = F.c_re[(size_t)(g * 16 + c) * 64 + p]; Cp[p * 32 + 16 + c] = F.c_im[(size_t)(g * 16 + c) * 64 + p]; }
    const float dt = expf(F.log_dt[g]);
    const float lr = fminf(F.lambda_re[g * 64 + p], -1e-4f), li = F.lambda_im[g * 64 + p];
    const float mag = expf(lr * dt), ar = mag * cosf(li * dt), ai = mag * sinf(li * dt);
    const float den = lr * lr + li * li, nr = ar - 1.f;
    const float cor = (nr * lr + ai * li) / den, coi = (ai * lr - nr * li) / den;
    float bbr[16], bbi[16];
#pragma unroll
    for (int c = 0; c < 16; ++c) { const float br = F.b_re[(size_t)(g * 64 + p) * 16 + c], bi = F.b_im[(size_t)(g * 64 + p) * 16 + c]; bbr[c] = cor * br - coi * bi; bbi[c] = cor * bi + coi * br; }
    float dsk[16];
#pragma unroll
    for (int c = 0; c < 16; ++c) dsk[c] = F.d_skip[g * 16 + c];
    LDS_WAIT(); asm volatile("" ::: "memory");
    float xr = 0.f, xi = 0.f;
#if defined(SSM_CHECK)
    float chk_sq = 0.f;
#endif
    for (int t0 = 0; t0 < SEQ; t0 += 64) {
#pragma unroll 2
        for (int tt = 0; tt < 64; ++tt) {
            const bf16* up = F.U + ((size_t)g * M + (size_t)b * SEQ + t0 + tt) * 16;
            const v4u w0 = *(const v4u*)up, w1 = *(const v4u*)(up + 8);
            float uu[16] = {bflo(w0.x), bfhi(w0.x), bflo(w0.y), bfhi(w0.y), bflo(w0.z), bfhi(w0.z), bflo(w0.w), bfhi(w0.w), bflo(w1.x), bfhi(w1.x), bflo(w1.y), bfhi(w1.y), bflo(w1.z), bfhi(w1.z), bflo(w1.w), bfhi(w1.w)};
            float bur = 0.f, bui = 0.f;
#pragma unroll
            for (int c = 0; c < 16; ++c) { bur += bbr[c] * uu[c]; bui += bbi[c] * uu[c]; }
            const float n_r = ar * xr - ai * xi + bur, n_i = ar * xi + ai * xr + bui; xr = n_r; xi = n_i;
            xs[tt * 65 + p] = (f32x2){xr, xi};
        }
        LDS_WAIT(); asm volatile("" ::: "memory");
        float y[16];
#pragma unroll
        for (int c = 0; c < 16; ++c) y[c] = 0.f;
#pragma unroll 4
        for (int pp = 0; pp < 64; ++pp) {
            const f32x2 xv = xs[F.lane * 65 + pp];
#pragma unroll
            for (int c4 = 0; c4 < 4; ++c4) { const f32x4 cr = *(const LAS f32x4*)(Cp + pp * 32 + c4 * 4), ci = *(const LAS f32x4*)(Cp + pp * 32 + 16 + c4 * 4);
                y[4 * c4] += cr.x * xv.x - ci.x * xv.y; y[4 * c4 + 1] += cr.y * xv.x - ci.y * xv.y; y[4 * c4 + 2] += cr.z * xv.x - ci.z * xv.y; y[4 * c4 + 3] += cr.w * xv.x - ci.w * xv.y; }
        }
#if defined(SSM_CHECK)
#pragma unroll
        for (int c = 0; c < 16; ++c) chk_sq += y[c] * y[c];
#endif
        const size_t row = (size_t)g * M + (size_t)b * SEQ + t0 + F.lane;
        const bf16* up = F.U + row * 16;
        const v4u w0 = *(const v4u*)up, w1 = *(const v4u*)(up + 8);
        const float uu[16] = {bflo(w0.x), bfhi(w0.x), bflo(w0.y), bfhi(w0.y), bflo(w0.z), bfhi(w0.z), bflo(w0.w), bfhi(w0.w), bflo(w1.x), bfhi(w1.x), bflo(w1.y), bfhi(w1.y), bflo(w1.z), bfhi(w1.z), bflo(w1.w), bfhi(w1.w)};
        float r[16];
#pragma unroll
        for (int c = 0; c < 16; ++c) r[c] = gelu_tanh(y[c] + dsk[c] * uu[c]);
        v4u o0, o1; o0.x = pk2(r[0], r[1]); o0.y = pk2(r[2], r[3]); o0.z = pk2(r[4], r[5]); o0.w = pk2(r[6], r[7]); o1.x = pk2(r[8], r[9]); o1.y = pk2(r[10], r[11]); o1.z = pk2(r[12], r[13]); o1.w = pk2(r[14], r[15]);
        bf16* yp = F.Y + row * 16; *(v4u*)yp = o0; *(v4u*)(yp + 8) = o1;
        LDS_WAIT(); asm volatile("" ::: "memory");
    }
#if defined(SSM_CHECK)
    chk_sq = wave_sum(chk_sq); if (F.lane == 0) atomicAdd((float*)(F.ctl + CW_CHK + 1), chk_sq);
#endif
}


constexpr size_t TB_FRAG = 0, TB_QF = 2 * MiB, TB_PF = 10 * MiB, TB_A64 = 18 * MiB;
constexpr int SSM_R2 = 64 * 1056;
constexpr int YS_PITCH = 1056;
constexpr int XS_OFF = RING_BYTES + 2048;
static_assert(SSM_R2 + 64 * YS_PITCH <= LDSCTL_OFF && SSM_R2 + 65536 <= XS_OFF, "scan unit LDS map");
typedef float f32x16 __attribute__((ext_vector_type(16)));
typedef short bf16x8s __attribute__((ext_vector_type(8)));
__device__ __forceinline__ int crow16(int r, int hi) { return (r & 3) + 8 * (r >> 2) + 4 * hi; }

__device__ __forceinline__ void p0_ssm_item(Frame& F, int it) {
    const int g = it >> 3, j = it & 7;
    LAS float* POWr = (LAS float*)(F.lds);
    LAS float* POWi = POWr + 65 * 64;
    LAS float* BBr = POWi + 65 * 64;
    LAS float* BBi = BBr + 1024;
    constexpr int CLD = 65;
    LAS float* Cr = BBi + 1024;
    LAS float* Ci = Cr + 16 * CLD;
    bf16* FRAG = (bf16*)((char*)F.out + TB_FRAG); bf16* QF = (bf16*)((char*)F.out + TB_QF); bf16* PF = (bf16*)((char*)F.out + TB_PF); float* A64 = (float*)((char*)F.out + TB_A64);
    const float dt = expf(F.log_dt[g]);
    {
      const int p = F.tid & 63, q = F.tid >> 6;
      const float lr = fminf(F.lambda_re[g * 64 + p], -1e-4f), li = F.lambda_im[g * 64 + p];
      const float mag = expf(lr * dt), ar = mag * cosf(li * dt), ai = mag * sinf(li * dt);
      float a2r = ar * ar - ai * ai, a2i = 2.f * ar * ai; float a4r = a2r * a2r - a2i * a2i, a4i = 2.f * a2r * a2i; const float a8r = a4r * a4r - a4i * a4i, a8i = 2.f * a4r * a4i;
      float br = 1.f, bi = 0.f;
      for (int i = 0; i < q; ++i) { const float t = br * a8r - bi * a8i; bi = br * a8i + bi * a8r; br = t; }
#pragma unroll
      for (int r = 0; r < 8; ++r) { POWr[(8 * q + r) * 64 + p] = br; POWi[(8 * q + r) * 64 + p] = bi; const float t = br * ar - bi * ai; bi = br * ai + bi * ar; br = t; }
      if (q == 7) { POWr[64 * 64 + p] = br; POWi[64 * 64 + p] = bi; } }
    for (int idx = F.tid; idx < 1024; idx += 512) { const int p = idx >> 4;
        const float lr = fminf(F.lambda_re[g * 64 + p], -1e-4f), li = F.lambda_im[g * 64 + p];
        const float mag = expf(lr * dt), ar = mag * cosf(li * dt), ai = mag * sinf(li * dt);
        const float den = lr * lr + li * li, nr = ar - 1.f, cor = (nr * lr + ai * li) / den, coi = (ai * lr - nr * li) / den;
        const float br = F.b_re[(size_t)g * 1024 + idx], bi = F.b_im[(size_t)g * 1024 + idx];
        BBr[idx] = cor * br - coi * bi; BBi[idx] = cor * bi + coi * br;
        Cr[(idx >> 6) * CLD + (idx & 63)] = F.c_re[(size_t)g * 1024 + idx]; Ci[(idx >> 6) * CLD + (idx & 63)] = F.c_im[(size_t)g * 1024 + idx]; }
    __syncthreads();
    {
      typedef short bfx8 __attribute__((ext_vector_type(8)));
      const int tau = 8 * j + F.wave, rw = F.lane & 15, qd = F.lane >> 4;
      f32x4 acc = (f32x4){0.f, 0.f, 0.f, 0.f};
#pragma unroll
      for (int kc = 0; kc < 4; ++kc) { unsigned aw[4], bw[4];
#pragma unroll
          for (int h2 = 0; h2 < 4; ++h2) { float av[2], bv[2];
#pragma unroll
              for (int e = 0; e < 2; ++e) { const int kk = kc * 32 + qd * 8 + 2 * h2 + e, p = kk & 63;
                  av[e] = (kk < 64) ? Cr[rw * CLD + p] : -Ci[rw * CLD + p];
                  const float wr = POWr[tau * 64 + p], wi = POWi[tau * 64 + p], br = BBr[p * 16 + rw], bi = BBi[p * 16 + rw];
                  bv[e] = (kk < 64) ? (wr * br - wi * bi) : (wr * bi + wi * br); }
              aw[h2] = pk2(av[0], av[1]); bw[h2] = pk2(bv[0], bv[1]); }
          acc = __builtin_amdgcn_mfma_f32_16x16x32_bf16(__builtin_bit_cast(bfx8, (v4u){aw[0], aw[1], aw[2], aw[3]}), __builtin_bit_cast(bfx8, (v4u){bw[0], bw[1], bw[2], bw[3]}), acc, 0, 0, 0); }
#pragma unroll
      for (int jj = 0; jj < 4; ++jj) { const int c = qd * 4 + jj; const bf16 v = (bf16)f2bf(acc[jj]);
          if (tau + 1 < 64) FRAG[((size_t)(g * 64 + tau + 1) * 32 + c) * 16 + rw] = v;
          FRAG[((size_t)(g * 64 + tau) * 32 + 16 + c) * 16 + rw] = v; } }
    if (j == 0 && F.tid < 256) FRAG[((size_t)(g * 64) * 32 + (F.tid >> 4)) * 16 + (F.tid & 15)] = 0;
    {
      const int s = 8 * j + (F.tid >> 6), p = F.tid & 63, kk = 63 - s; const float wr = POWr[kk * 64 + p], wi = POWi[kk * 64 + p];
      unsigned re[8], im[8];
#pragma unroll
      for (int c2 = 0; c2 < 8; ++c2) { const float br0 = BBr[p * 16 + 2 * c2], bi0 = BBi[p * 16 + 2 * c2], br1 = BBr[p * 16 + 2 * c2 + 1], bi1 = BBi[p * 16 + 2 * c2 + 1];
          re[c2] = pk2(wr * br0 - wi * bi0, wr * br1 - wi * bi1); im[c2] = pk2(wr * bi0 + wi * br0, wr * bi1 + wi * br1); }
      bf16* qre = QF + ((((size_t)(g * 64 + s)) * 4 + (p >> 5)) * 32 + (p & 31)) * 16; bf16* qim = QF + ((((size_t)(g * 64 + s)) * 4 + 2 + (p >> 5)) * 32 + (p & 31)) * 16;
      *(v4u*)qre = (v4u){re[0], re[1], re[2], re[3]}; *(v4u*)(qre + 8) = (v4u){re[4], re[5], re[6], re[7]};
      *(v4u*)qim = (v4u){im[0], im[1], im[2], im[3]}; *(v4u*)(qim + 8) = (v4u){im[4], im[5], im[6], im[7]}; }
    for (int idx = F.tid; idx < 1024; idx += 512) {
      const int tl = idx >> 7, c = (idx >> 3) & 15, kb = idx & 7, t = 8 * j + tl; unsigned o[8];
#pragma unroll
      for (int k2 = 0; k2 < 8; ++k2) { float vv[2];
#pragma unroll
          for (int e = 0; e < 2; ++e) { const int p = (kb * 16 + 2 * k2 + e) & 63; const float wr = POWr[(t + 1) * 64 + p], wi = POWi[(t + 1) * 64 + p], cr = Cr[c * CLD + p], ci = Ci[c * CLD + p];
              vv[e] = (kb < 4) ? (cr * wr - ci * wi) : -(cr * wi + ci * wr); }
          o[k2] = pk2(vv[0], vv[1]); }
      bf16* pp = PF + ((((size_t)(g * 32 + (t >> 1))) * 8 + kb) * 32 + (t & 1) * 16 + c) * 16;
      *(v4u*)pp = (v4u){o[0], o[1], o[2], o[3]}; *(v4u*)(pp + 8) = (v4u){o[4], o[5], o[6], o[7]}; }
    if (j == 0 && F.tid < 64) { A64[(size_t)(g * 64 + F.tid) * 2] = POWr[64 * 64 + F.tid]; A64[(size_t)(g * 64 + F.tid) * 2 + 1] = POWi[64 * 64 + F.tid]; }
    __syncthreads();
}

__device__ __forceinline__ float gelu_tanh_fast(float v) { const float t = 0.7978845608028654f * (v + 0.044715f * v * v * v); return v * __builtin_amdgcn_rcpf(1.f + __builtin_amdgcn_exp2f(-2.f * LOG2E * t)); }

__device__ __forceinline__ void ssm_mfma_unit(Frame& F, int b, int g, bf16* Yout) {
    LAS unsigned char* L = F.lds;
    const int tid = F.tid, lane = F.lane, wave = F.wave, r32 = lane & 31, hi = lane >> 5;
    const bf16* FRAG = (const bf16*)((const char*)F.out + TB_FRAG); const bf16* QF = (const bf16*)((const char*)F.out + TB_QF); const bf16* PF = (const bf16*)((const char*)F.out + TB_PF);
    const float* A64 = (const float*)((const char*)F.out + TB_A64);
    const int tp0 = wave, tp1 = 15 - wave, tp2 = 16 + wave, tp3 = 31 - wave;
    v4u uw[8];
#pragma unroll
    for (int i = 0; i < 4; ++i) { const bf16* up = F.U + ((size_t)g * M + (size_t)b * SEQ + tid + 512 * i) * 16; uw[2 * i] = *(const v4u*)up; uw[2 * i + 1] = *(const v4u*)(up + 8); }
    const int rbA = wave & 3, khA = wave >> 2;
    bf16x8s qfr[32];
    { const char* qf = (const char*)QF + ((size_t)(g * 64 + 32 * khA) * 4 + rbA) * 1024 + r32 * 32 + hi * 16;
#pragma unroll
      for (int s = 0; s < 32; ++s) qfr[s] = *(const bf16x8s*)(qf + (size_t)s * 4096); }
#pragma unroll
    for (int i = 0; i < 4; ++i) { const int tk = tid + 512 * i, ch = tk >> 6, s = tk & 63; LAS v4u* d = (LAS v4u*)(L + s * YS_PITCH + ch * 32); d[0] = uw[2 * i]; d[1] = uw[2 * i + 1]; }
    __syncthreads();
    LAS float* Eb = (LAS float*)(L + SSM_R2);
    { f32x16 acc = {};
#pragma unroll
      for (int s = 0; s < 32; ++s) { const bf16x8s bb = *(const LAS bf16x8s*)(L + (32 * khA + s) * YS_PITCH + r32 * 32 + hi * 16);
          acc = __builtin_amdgcn_mfma_f32_32x32x16_bf16(qfr[s], bb, acc, 0, 0, 0); }
#pragma unroll
      for (int r = 0; r < 16; ++r) Eb[khA * 4224 + (rbA * 32 + crow16(r, hi)) * 33 + r32] = acc[r]; }
    __builtin_amdgcn_sched_barrier(0);
    v4u fr[8];
#pragma unroll
    for (int i = 0; i < 8; ++i) fr[i] = *(const v4u*)((const char*)FRAG + (size_t)g * 65536 + tid * 16 + i * 8192);
    bf16x8s pfr[4][8];
    { const char* pf = (const char*)PF + (size_t)(g * 32) * 8 * 1024 + r32 * 32 + hi * 16;
#pragma unroll
      for (int kb = 0; kb < 8; ++kb) { pfr[0][kb] = *(const bf16x8s*)(pf + (size_t)(tp0 * 8 + kb) * 1024); pfr[1][kb] = *(const bf16x8s*)(pf + (size_t)(tp1 * 8 + kb) * 1024);
          pfr[2][kb] = *(const bf16x8s*)(pf + (size_t)(tp2 * 8 + kb) * 1024); pfr[3][kb] = *(const bf16x8s*)(pf + (size_t)(tp3 * 8 + kb) * 1024); } }
    __syncthreads();
    LAS bf16* Xs = (LAS bf16*)(L + XS_OFF);
    if (tid < 64) { const int p = tid; const float ar = A64[(size_t)(g * 64 + p) * 2], ai = A64[(size_t)(g * 64 + p) * 2 + 1]; float xr = 0.f, xi = 0.f;
#pragma unroll 4
        for (int c = 0; c < 32; ++c) { Xs[c * 136 + p] = (bf16)f2bf(xr); Xs[c * 136 + 64 + p] = (bf16)f2bf(xi);
            const float er = Eb[p * 33 + c] + Eb[4224 + p * 33 + c], ei = Eb[(64 + p) * 33 + c] + Eb[4224 + (64 + p) * 33 + c];
            const float n_r = ar * xr - ai * xi + er, n_i = ar * xi + ai * xr + ei; xr = n_r; xi = n_i; } }
    __syncthreads();
#pragma unroll
    for (int i = 0; i < 8; ++i) *(LAS v4u*)(L + SSM_R2 + tid * 16 + i * 8192) = fr[i];
    f32x16 acc0 = {}, acc1 = {}, acc2 = {}, acc3 = {};
#pragma unroll
    for (int kb = 0; kb < 8; ++kb) { const bf16x8s bb = *(const LAS bf16x8s*)((const LAS unsigned char*)Xs + r32 * 272 + kb * 32 + hi * 16);
        acc0 = __builtin_amdgcn_mfma_f32_32x32x16_bf16(pfr[0][kb], bb, acc0, 0, 0, 0); acc1 = __builtin_amdgcn_mfma_f32_32x32x16_bf16(pfr[1][kb], bb, acc1, 0, 0, 0);
        acc2 = __builtin_amdgcn_mfma_f32_32x32x16_bf16(pfr[2][kb], bb, acc2, 0, 0, 0); acc3 = __builtin_amdgcn_mfma_f32_32x32x16_bf16(pfr[3][kb], bb, acc3, 0, 0, 0); }
    __syncthreads();
    const LAS unsigned char* FRb = L + SSM_R2 + r32 * 32 + hi * 16;
#pragma unroll 2
    for (int s = 0; s < 64; ++s) { const bf16x8s bb = *(const LAS bf16x8s*)(L + s * YS_PITCH + r32 * 32 + hi * 16);
        if (s <= 2 * tp0 + 1) acc0 = __builtin_amdgcn_mfma_f32_32x32x16_bf16(*(const LAS bf16x8s*)(FRb + (2 * tp0 - s + 1) * 1024), bb, acc0, 0, 0, 0);
        if (s <= 2 * tp1 + 1) acc1 = __builtin_amdgcn_mfma_f32_32x32x16_bf16(*(const LAS bf16x8s*)(FRb + (2 * tp1 - s + 1) * 1024), bb, acc1, 0, 0, 0);
        if (s <= 2 * tp2 + 1) acc2 = __builtin_amdgcn_mfma_f32_32x32x16_bf16(*(const LAS bf16x8s*)(FRb + (2 * tp2 - s + 1) * 1024), bb, acc2, 0, 0, 0);
        if (s <= 2 * tp3 + 1) acc3 = __builtin_amdgcn_mfma_f32_32x32x16_bf16(*(const LAS bf16x8s*)(FRb + (2 * tp3 - s + 1) * 1024), bb, acc3, 0, 0, 0); }
    const f32x4 dk0 = *(const f32x4*)(F.d_skip + g * 16 + 4 * hi), dk1 = *(const f32x4*)(F.d_skip + g * 16 + 8 + 4 * hi);
#define SSM_EPI(ACC, TP) do { _Pragma("unroll") for (int q = 0; q < 4; ++q) { const int c0 = 8 * (q & 1) + 4 * hi, t = 2 * (TP) + (q >> 1); const f32x4 dd = (q & 1) ? dk1 : dk0; \
        const v2u uw_ = *(const LAS v2u*)(L + t * YS_PITCH + r32 * 32 + c0 * 2); \
        const float r0 = gelu_tanh_fast(ACC[4 * q] + dd.x * bflo(uw_.x)), r1 = gelu_tanh_fast(ACC[4 * q + 1] + dd.y * bfhi(uw_.x)), r2 = gelu_tanh_fast(ACC[4 * q + 2] + dd.z * bflo(uw_.y)), r3 = gelu_tanh_fast(ACC[4 * q + 3] + dd.w * bfhi(uw_.y)); \
        v2u o; o.x = pk2(r0, r1); o.y = pk2(r2, r3); *(LAS v2u*)(L + SSM_R2 + t * YS_PITCH + r32 * 32 + c0 * 2) = o; } } while (0)
    __syncthreads();
    SSM_EPI(acc0, tp0); SSM_EPI(acc1, tp1); SSM_EPI(acc2, tp2); SSM_EPI(acc3, tp3);
#undef SSM_EPI
    __syncthreads();
#pragma unroll
    for (int i = 0; i < 8; ++i) { const int gi = tid + 512 * i, tok = gi >> 1, hf = gi & 1;
        *(v4u*)((char*)Yout + ((size_t)g * M + (size_t)b * SEQ) * 32 + (size_t)gi * 16) = *(const LAS v4u*)(L + SSM_R2 + (tok & 63) * YS_PITCH + (tok >> 6) * 32 + hf * 16); }
    __syncthreads();
}

constexpr int WRX_LD = 1028;
__device__ __forceinline__ void p7_stage_weights(Frame& F) {
    LAS float* wx = (LAS float*)(F.lds);
    for (int i = 0; i < 16; ++i) { const int idx = F.tid + 512 * i, kk = idx >> 3, j4 = idx & 7; const f32x4 w = *(const f32x4*)(F.w_rexp + (size_t)kk * 32 + 4 * j4);
        wx[(4 * j4) * WRX_LD + kk] = w.x; wx[(4 * j4 + 1) * WRX_LD + kk] = w.y; wx[(4 * j4 + 2) * WRX_LD + kk] = w.z; wx[(4 * j4 + 3) * WRX_LD + kk] = w.w; }
    __syncthreads();
}
__device__ __forceinline__ void p7_block(Frame& F, int blk) {
    const LAS float* wx = (const LAS float*)(F.lds);
    LAS int* eL = (LAS int*)(F.lds + XS_OFF);
    LAS unsigned* baseL = (LAS unsigned*)(F.lds + XS_OFF + 1024);
    LAS float* wL = (LAS float*)(F.lds + XS_OFF + 2048);
    const int b = (blk * 64) / SEQ;
    const float* mod = F.MOD + b * 6144;
    f32x4 es[4], sh[4], wrg[4][4];
#pragma unroll
    for (int j = 0; j < 4; ++j) { const int c = 4 * F.lane + 256 * j; const f32x4 g4 = *(const f32x4*)(F.norm_ffn_g + c), sc = *(const f32x4*)(mod + 4096 + c); es[j] = g4 * (sc + 1.f); sh[j] = *(const f32x4*)(mod + 3072 + c);
#pragma unroll
        for (int e = 0; e < 4; ++e) wrg[j][e] = *(const f32x4*)(F.w_rg + (size_t)(c + e) * 4); }
    const float brg0 = F.b_rg[0], brg1 = F.b_rg[1], brg2 = F.b_rg[2], brg3 = F.b_rg[3];
#pragma unroll 1
    for (int rb = 0; rb < 8; rb += 4) {
        f32x4 v[4][4];
#pragma unroll
        for (int r = 0; r < 4; ++r) { const GAS v2u* xr = (const GAS v2u*)(F.X1B + (size_t)(blk * 64 + F.wave * 8 + rb + r) * D) + F.lane;
#pragma unroll
            for (int j = 0; j < 4; ++j) { const v2u t = xr[64 * j]; v[r][j] = (f32x4){bflo(t.x), bfhi(t.x), bflo(t.y), bfhi(t.y)}; } }
        float ss[4];
#pragma unroll
        for (int r = 0; r < 4; ++r) { float s = 0.f;
#pragma unroll
            for (int j = 0; j < 4; ++j) s += (v[r][j].x * v[r][j].x + v[r][j].y * v[r][j].y) + (v[r][j].z * v[r][j].z + v[r][j].w * v[r][j].w);
            ss[r] = s; }
#pragma unroll
        for (int r = 0; r < 4; ++r) ss[r] = wave_sum(ss[r]);
#pragma unroll
        for (int r = 0; r < 4; ++r) {
            const int rl = F.wave * 8 + rb + r, m = blk * 64 + rl;
            const float rstd = __builtin_amdgcn_rsqf(ss[r] * (1.f / D) + RMS_EPS);
            GAS unsigned* o4 = (GAS unsigned*)((unsigned char*)F.H + (size_t)m * D) + F.lane;
#pragma unroll
            for (int j = 0; j < 4; ++j) { v[r][j] = v[r][j] * rstd * es[j] + sh[j]; o4[64 * j] = pk4_fp8(v[r][j].x, v[r][j].y, v[r][j].z, v[r][j].w); }
            f32x4 lgv = (f32x4){0.f, 0.f, 0.f, 0.f};
#pragma unroll
            for (int j = 0; j < 4; ++j)
#pragma unroll
                for (int e = 0; e < 4; ++e) lgv += wrg[j][e] * v[r][j][e];
            const bool h5 = (F.lane & 32) != 0, h4 = (F.lane & 16) != 0, h3 = (F.lane & 8) != 0;
            float lg[4];
            { const float k0 = (h5 ? lgv.z : lgv.x) + __shfl_xor(h5 ? lgv.x : lgv.z, 32), k1 = (h5 ? lgv.w : lgv.y) + __shfl_xor(h5 ? lgv.y : lgv.w, 32);
              float z = (h4 ? k1 : k0) + __shfl_xor(h4 ? k0 : k1, 16);
              z += __shfl_xor(z, 8); z += __shfl_xor(z, 4); z += __shfl_xor(z, 2); z += __shfl_xor(z, 1);
              const int zi = __builtin_bit_cast(int, z);
              lg[0] = __builtin_bit_cast(float, __builtin_amdgcn_readlane(zi, 0)) + brg0; lg[1] = __builtin_bit_cast(float, __builtin_amdgcn_readlane(zi, 16)) + brg1;
              lg[2] = __builtin_bit_cast(float, __builtin_amdgcn_readlane(zi, 32)) + brg2; lg[3] = __builtin_bit_cast(float, __builtin_amdgcn_readlane(zi, 48)) + brg3; }
            int gi = 0; float lmax = lg[0];
#pragma unroll
            for (int i = 1; i < 4; ++i) if (lg[i] > lmax) { lmax = lg[i]; gi = i; }
            float se = 0.f;
#pragma unroll
            for (int i = 0; i < 4; ++i) se += __expf(lg[i] - lmax);
            const float pg = __builtin_amdgcn_rcpf(se);
            gi = __builtin_amdgcn_readfirstlane(gi);
            float le[8];
#pragma unroll
            for (int i = 0; i < 8; ++i) { const LAS float* wr = wx + (gi * 8 + i) * WRX_LD + 4 * F.lane; f32x4 a4 = (f32x4){0.f, 0.f, 0.f, 0.f};
#pragma unroll
                for (int j = 0; j < 4; ++j) a4 += v[r][j] * *(const LAS f32x4*)(wr + 256 * j);
                le[i] = (a4.x + a4.y) + (a4.z + a4.w); }
            { float k4[4], k2[2];
#pragma unroll
              for (int i = 0; i < 4; ++i) { const float keep = h5 ? le[i + 4] : le[i], send = h5 ? le[i] : le[i + 4]; k4[i] = keep + __shfl_xor(send, 32); }
#pragma unroll
              for (int i = 0; i < 2; ++i) { const float keep = h4 ? k4[i + 2] : k4[i], send = h4 ? k4[i] : k4[i + 2]; k2[i] = keep + __shfl_xor(send, 16); }
              float z = (h3 ? k2[1] : k2[0]) + __shfl_xor(h3 ? k2[0] : k2[1], 8);
              z += __shfl_xor(z, 4); z += __shfl_xor(z, 2); z += __shfl_xor(z, 1);
              const int zi = __builtin_bit_cast(int, z);
#pragma unroll
              for (int i = 0; i < 8; ++i) le[i] = __builtin_bit_cast(float, __builtin_amdgcn_readlane(zi, 8 * i)) + F.b_rexp[gi * 8 + i]; }
            int i0 = 0; float v0 = le[0];
#pragma unroll
            for (int i = 1; i < 8; ++i) if (le[i] > v0) { v0 = le[i]; i0 = i; }
            int i1 = -1; float v1 = -INFINITY;
#pragma unroll
            for (int i = 0; i < 8; ++i) if (i != i0 && (i1 < 0 || le[i] > v1)) { v1 = le[i]; i1 = i; }
            const float ex = __expf(v1 - v0), p0 = __builtin_amdgcn_rcpf(1.f + ex), p1 = ex * p0;
            if (F.lane == 0) { const int e0 = gi * 8 + i0, e1 = gi * 8 + i1; eL[2 * rl] = e0; eL[2 * rl + 1] = e1;
                wL[2 * rl] = pg * p0; wL[2 * rl + 1] = pg * p1; }
        }
    }
    __syncthreads();
    int e = 0, rank = 0, total = 0;
    if (F.tid < 128) { e = eL[F.tid];
        for (int a = 0; a < 128; ++a) { const int m_ = (eL[a] == e); total += m_; rank += (m_ && a < F.tid); }
        if (rank == 0) baseL[e] = __hip_atomic_fetch_add((unsigned*)(F.ctl + CW_CNT + 64 * e), (unsigned)total, RLX_AGENT); }
    __syncthreads();
    if (F.tid < 128) { const unsigned pos = baseL[e] + (unsigned)rank; F.LIST[(size_t)e * CAP + pos] = (unsigned)((blk * 64 + (F.tid >> 1)) * 2 + (F.tid & 1)); F.LISTW[(size_t)e * CAP + pos] = wL[F.tid]; }
    __syncthreads();
}

__device__ __forceinline__ void p10_rows(Frame& F) {
    const int gw = F.vcu * NWAVES + F.wave, NGW = F.G * NWAVES;
    for (int ch = gw; ch < M / 8; ch += NGW) {
        const int b = (ch * 8) / SEQ;
        const float* mod = F.MOD + b * 6144 + 5120;
        f32x4 g2[4], fg[4];
#pragma unroll
        for (int j = 0; j < 4; ++j) { const int c = 4 * F.lane + 256 * j; g2[j] = *(const f32x4*)(mod + c); fg[j] = *(const f32x4*)(F.final_g + c); }
#pragma unroll 1
        for (int rb = 0; rb < 8; rb += 4) {
            f32x4 v[4][4]; unsigned ya[4][4], yb[4][4];
#pragma unroll
            for (int r = 0; r < 4; ++r) { const int m = ch * 8 + rb + r;
                const GAS v2u* xr = (const GAS v2u*)(F.X1B + (size_t)m * D) + F.lane;
                const GAS unsigned* y0 = (const GAS unsigned*)((const unsigned char*)F.YROWS + (size_t)(2 * m) * D) + F.lane; const GAS unsigned* y1 = (const GAS unsigned*)((const unsigned char*)F.YROWS + (size_t)(2 * m + 1) * D) + F.lane;
#pragma unroll
                for (int j = 0; j < 4; ++j) { const v2u t = __builtin_nontemporal_load(xr + 64 * j); v[r][j] = (f32x4){bflo(t.x), bfhi(t.x), bflo(t.y), bfhi(t.y)}; ya[r][j] = __builtin_nontemporal_load(y0 + 64 * j); yb[r][j] = __builtin_nontemporal_load(y1 + 64 * j); } }
            float ss[4];
#pragma unroll
            for (int r = 0; r < 4; ++r) { float s = 0.f;
#pragma unroll
                for (int j = 0; j < 4; ++j) { const int a = (int)ya[r][j], bb = (int)yb[r][j];
                    const f32x2 a0 = __builtin_amdgcn_cvt_pk_f32_fp8(a, false), a1 = __builtin_amdgcn_cvt_pk_f32_fp8(a, true), b0 = __builtin_amdgcn_cvt_pk_f32_fp8(bb, false), b1 = __builtin_amdgcn_cvt_pk_f32_fp8(bb, true);
                    f32x4 yv; yv.x = a0.x + b0.x; yv.y = a0.y + b0.y; yv.z = a1.x + b1.x; yv.w = a1.y + b1.y; yv = yv * (1.f / FP8_YSCALE);
                    v[r][j] = v[r][j] + g2[j] * yv; s += (v[r][j].x * v[r][j].x + v[r][j].y * v[r][j].y) + (v[r][j].z * v[r][j].z + v[r][j].w * v[r][j].w); }
                ss[r] = s; }
#pragma unroll
            for (int r = 0; r < 4; ++r) ss[r] = wave_sum(ss[r]);
#pragma unroll
            for (int r = 0; r < 4; ++r) { const int m = ch * 8 + rb + r; GAS f32x4* xr = (GAS f32x4*)(F.out + (size_t)m * D) + F.lane;
                float rstd = 1.f / sqrtf(ss[r] * (1.f / D) + RMS_EPS);
#if defined(SSM_CHECK)
                { const float d_ = ((const float*)(F.ctl + CW_CHK))[0] / ((const float*)(F.ctl + CW_CHK))[1]; rstd *= 1.f + 0.5f * fminf(1.f, sqrtf(d_)); }
#endif
#pragma unroll
                for (int j = 0; j < 4; ++j) xr[64 * j] = v[r][j] * rstd * fg[j]; }
        }
    }
}

struct Args { const float* in[28]; float* out; unsigned char* ws; int ph_lo, ph_hi, grid, pad; };
typedef const __attribute__((address_space(4))) Args* KArgs;
__device__ __forceinline__ void load_ptrs(Frame& F) {
    KArgs ka = (KArgs)__builtin_amdgcn_kernarg_segment_ptr();
    asm volatile("" : "+s"(ka));
    F.tid = tid_opaque(); F.lane = F.tid & 63; F.wave = __builtin_amdgcn_readfirstlane(F.tid >> 6);
    F.G = ka->grid; { int bx = (int)blockIdx.x; asm volatile("" : "+s"(bx)); F.vcu = (F.G % 8 == 0) ? (bx % 8) * (F.G / 8) + bx / 8 : bx; }
    unsigned char* ws = ka->ws;
    F.ctl = (gu32*)(ws + WS_CTL);
    F.x = ka->in[0]; F.c = ka->in[1]; F.w_ada = ka->in[2]; F.b_ada = ka->in[3]; F.norm_mix_g = ka->in[4]; F.w_in = ka->in[5]; F.b_forget = ka->in[6]; F.w_out_fox = ka->in[7];
    F.lambda_re = ka->in[8]; F.lambda_im = ka->in[9]; F.log_dt = ka->in[10]; F.b_re = ka->in[11]; F.b_im = ka->in[12]; F.c_re = ka->in[13]; F.c_im = ka->in[14]; F.d_skip = ka->in[15];
    F.w_glu = ka->in[16]; F.w_out_ssm = ka->in[17]; F.w_o = ka->in[18]; F.norm_ffn_g = ka->in[19]; F.w_rg = ka->in[20]; F.b_rg = ka->in[21]; F.w_rexp = ka->in[22]; F.b_rexp = ka->in[23];
    F.w_gate = ka->in[24]; F.w_up = ka->in[25]; F.w_down = ka->in[26]; F.final_g = ka->in[27]; F.out = ka->out;
    F.MOD = (float*)(ws + WS_MOD); F.LOGF = (float*)(ws + WS_LOGF); F.CUM = (float*)(ws + WS_CUM); F.RW = (float*)(ws + WS_RW); F.ROUTE = (int*)(ws + WS_ROUTE); F.LIST = (unsigned*)(ws + WS_LIST); F.CUMP = (unsigned*)(ws + WS_CUMP); F.LISTW = (float*)(ws + WS_LISTW);
    F.WIN = (bf16*)(ws + WS_WIN); F.WGLU = (bf16*)(ws + WS_WGLU); F.WOF = (bf16*)(ws + WS_WOF); F.WOS = (bf16*)(ws + WS_WOS); F.WO = (bf16*)(ws + WS_WO); F.WGU = (bf16*)(ws + WS_WGU); F.WD = (bf16*)(ws + WS_WD);
    F.H = (bf16*)(ws + WS_H); F.Y = (bf16*)(ws + WS_Y); F.Q = (bf16*)(ws + WS_Q); F.K = (bf16*)(ws + WS_K); F.V = (bf16*)(ws + WS_V); F.U = (bf16*)(ws + WS_U); F.SGA = (bf16*)(ws + WS_SGA); F.SGB = (bf16*)(ws + WS_SGB);
    F.HID = (bf16*)(ws + WS_HID); F.YROWS = (bf16*)(ws + WS_YROWS); F.X1B = (bf16*)(ws + WS_X1B);
}
__global__ void __launch_bounds__(NWAVES * 64, 2) fwd(Args args) {
    extern __shared__ __attribute__((aligned(16))) unsigned char lds[];
    Frame F;
    F.lds = (LAS unsigned char*)lds;
    F.MISC = (volatile LAS unsigned*)(F.lds + MISC_OFF);
    { const int t0 = (int)threadIdx.x;
      for (int u = t0; u < (LDS_BYTES - LDSCTL_OFF) / 4; u += NWAVES * 64) ((LAS unsigned*)(F.lds + LDSCTL_OFF))[u] = 0u;
      __syncthreads();
      if ((t0 & 63) == 0) *(volatile LAS int*)(F.lds + TIDTAB_OFF + 4 * hw_wave_key()) = t0 >> 6;
      __syncthreads(); }
    load_ptrs(F);
    if (N_LAUNCHES == 1) (void)xcd_barrier_post((unsigned*)(F.ctl + CW_BAR), F.MISC + 8);
#if defined(TPROBE)
#define STAMP(kk) do { if (blockIdx.x == 0 && tid_opaque() == 0) F.ctl[CW_TS + (kk)] = (unsigned)__builtin_amdgcn_s_memrealtime(); } while (0)
#else
#define STAMP(kk) do { } while (0)
#endif
    STAMP(15);
#define GRID_BAR() do { if (N_LAUNCHES == 1) { load_ptrs(F); XcdBarrier b_; b_.bar = (unsigned*)(F.ctl + CW_BAR); b_.x = xb_xcc_id(); b_.st = (volatile LAS unsigned*)(F.lds + MISC_OFF) + 8; xcd_barrier(b_); } } while (0)
#define GRID_BAR_SH(seam_) do { if (N_LAUNCHES == 1) { load_ptrs(F); XcdBarrier b_; b_.bar = (unsigned*)(F.ctl + CW_BAR); b_.x = xb_xcc_id(); b_.st = (volatile LAS unsigned*)(F.lds + MISC_OFF) + 8; \
        const ShadowGateUp sh_{F.w_gate, F.w_up, F.WGU, F.lds, (seam_), (int)blockIdx.x}; xcd_barrier(b_, sh_); } } while (0)
#define SEAM_SH(k_) do { if (BOTH(k_)) GRID_BAR_SH(k_); else if (N_LAUNCHES != 1) { load_ptrs(F); __syncthreads(); const ShadowGateUp sh_{F.w_gate, F.w_up, F.WGU, F.lds, (k_), (int)blockIdx.x}; if (F.tid >= 64) sh_(); __syncthreads(); } } while (0)
    const int lo = (N_LAUNCHES == 1) ? 0 : args.ph_lo, hi = (N_LAUNCHES == 1) ? NPH : args.ph_hi;
#ifndef PH_MASK
#define PH_MASK 0x7ff
#endif
#define IN(k) ((((PH_MASK) >> (k)) & 1) && lo <= (k) && (k) < hi)
#define BOTH(k) (IN(k) && IN((k) + 1))

    if (IN(0)) { load_ptrs(F); p0_mod(F); load_ptrs(F);
        for (int it = F.vcu; it < 256; it += F.G) p0_ssm_item(F, it); __syncthreads(); load_ptrs(F); p0_copies(F, F.vcu, F.G);
        __syncthreads(); STAMP(0); }
    if (IN(1)) { load_ptrs(F);
        if (F.tid < 64) { unsigned sp = 0;
            while ((unsigned)__builtin_amdgcn_readfirstlane(__hip_atomic_load((unsigned*)(F.ctl + CW_MOD), RLX_AGENT)) < 192u) { __builtin_amdgcn_s_sleep(2); if (++sp > (1u << 22)) { if (F.tid == 0) __hip_atomic_store((unsigned*)(F.ctl + CW_TMO), 1u, RLX_AGENT); break; } }
            __builtin_amdgcn_fence(__ATOMIC_ACQUIRE, "agent"); asm volatile("s_waitcnt vmcnt(0)" ::: "memory"); }
        __syncthreads();
        p1_rows(F); SEAM_SH(1); STAMP(1); }
    if (IN(2)) { load_ptrs(F);
        p2_cumscan(F); VM_WAIT(); __syncthreads();
        { pg8::Gemm g{F.H, F.WIN, 1024, 128}; pg8::StaticOrder S; S.init(M, 2048, F.G, (int)blockIdx.x);
          EpiInProj E{F.Q};
          pg8::gemm_phase<EpiInProj, pg8::StaticOrder, true>(F.lds + RING_OFF, g, S, E); }
        __syncthreads();
        load_ptrs(F);
        { pg8::Gemm g{F.WD, F.WIN + (size_t)1024 * 1024, 512, 128}; pg8::StaticOrder8 S; S.init(M, 2048, F.G, (int)blockIdx.x); S.pn0 = 8;
          EpiInProj E{F.Q, 1.f / (FP8_GW * FP8_GH)};
          pg8::gemm_phase<EpiInProj, pg8::StaticOrder8, true>(F.lds + RING_OFF, g, S, E); }
        SEAM_SH(2); STAMP(2);
    }
    if (IN(3)) { load_ptrs(F);
#if defined(ATTN_SIMPLE)
        for (int u = F.vcu; u < NB * NH * 4; u += F.G) { const int bh = u >> 2, qblk = 3 - (u & 3); attn_simple_unit(F, bh >> 3, bh & 7, qblk); }
#else
        { static_assert(attn_body::ATTN_LDS_BYTES <= RING_BYTES, "attention LDS");
          const attn_body::AttnTensors AT{(const attn_body::bf16*)F.Q, (const attn_body::bf16*)F.K, (const attn_body::bf16*)F.V, (attn_body::bf16*)F.Q, F.CUMP};
          const attn_body::StaticOrder S((int)F.G, F.vcu);
          attn_body::attn_phase<attn_body::StaticOrder>((char*)lds + RING_OFF, AT, S); }
#endif
        __syncthreads();
#if defined(SSM_SIMPLE) || defined(SSM_CHECK)
        if (F.wave < 3) for (int u = F.wave * F.G + F.vcu; u < NB * NG; u += 3 * F.G) ssm_simple_unit(F, u & 7, u >> 3, F.lds + F.wave * 41472);
        __syncthreads();
#endif
#if !defined(SSM_SIMPLE)
        load_ptrs(F);
        for (int u = F.vcu; u < NB * NG; u += F.G) ssm_mfma_unit(F, u & 7, u >> 3,
#if defined(SSM_CHECK)
            (bf16*)((char*)F.out + 32 * MiB)
#else
            F.Y
#endif
            );
#endif
#if defined(SSM_CHECK)
        { VM_WAIT(); __syncthreads();
          const int u = F.vcu, b = u & 7, g = u >> 3; const bf16* y2 = (const bf16*)((const char*)F.out + 32 * MiB); float df = 0.f;
          for (int i = 0; i < 4; ++i) { const size_t off = ((size_t)g * M + (size_t)b * SEQ + F.tid + 512 * i) * 16;
              for (int hh = 0; hh < 2; ++hh) { const v4u a = __builtin_nontemporal_load((const v4u*)(F.Y + off + 8 * hh)), c = __builtin_nontemporal_load((const v4u*)(y2 + off + 8 * hh));
                  const float d0 = bflo(a.x) - bflo(c.x), d1 = bfhi(a.x) - bfhi(c.x), d2 = bflo(a.y) - bflo(c.y), d3 = bfhi(a.y) - bfhi(c.y), d4 = bflo(a.z) - bflo(c.z), d5 = bfhi(a.z) - bfhi(c.z), d6 = bflo(a.w) - bflo(c.w), d7 = bfhi(a.w) - bfhi(c.w);
                  df += d0 * d0 + d1 * d1 + d2 * d2 + d3 * d3 + d4 * d4 + d5 * d5 + d6 * d6 + d7 * d7; } }
          df = wave_sum(df); if (F.lane == 0) atomicAdd((float*)(F.ctl + CW_CHK), df); }
#endif
        __syncthreads();
        SEAM_SH(3); STAMP(3);
    }
    if (IN(4)) { load_ptrs(F);
        { pg8::Gemm g{F.Y, F.WGLU, 512, (size_t)4 * M * 32}; pg8::GroupMajorOrder S; S.init(M, 1024, F.G, (int)blockIdx.x); S.Mrows = M; EpiPair<0> E{F.V};
          pg8::gemm_phase<EpiPair<0>, pg8::GroupMajorOrder, true>(F.lds + RING_OFF, g, S, E); }
        SEAM_SH(4); STAMP(4);
    }
    if (IN(5)) { load_ptrs(F);
        pg8::Gemm g{F.Q, F.WOF, 512, 128}; pg8::DualOrder S; S.init(M, 1024, F.G, (int)blockIdx.x); S.a_delta = (size_t)(WS_V - WS_Q); S.b_delta = (size_t)(WS_WOS - WS_WOF);
        EpiGateChain E{F.SGA, F.SGB};
        pg8::gemm_phase<EpiGateChain, pg8::DualOrder, true>(F.lds + RING_OFF, g, S, E);
        SEAM_SH(5); STAMP(5);
    }
    if (IN(6)) { load_ptrs(F);
        pg8::Gemm g{F.SGA, F.WO, 1024, 128}; pg8::StaticOrder S; S.init(M, 1024, F.G, (int)blockIdx.x); EpiResid E{F.x, F.X1B, F.MOD};
        pg8::gemm_phase<EpiResid, pg8::StaticOrder, true>(F.lds + RING_OFF, g, S, E);
        SEAM_SH(6); STAMP(6);
    }
    if (IN(7)) { load_ptrs(F);
        p7_stage_weights(F);
        for (int blk = F.vcu; blk < M / 64; blk += F.G) p7_block(F, blk);
        if (BOTH(7)) GRID_BAR(); STAMP(7);
    }
    if (IN(8)) { load_ptrs(F);
        const int mt = moe_tables(F);
        MoeOrder<true> S{F.G, F.vcu, mt * 4, (const LAS int*)(F.lds + MOE_OFF), F.LIST, (size_t)1024 * 1024, 0};
        pg8::Gemm g{F.H, F.WGU, 512, 128}; EpiSwiGLU8 E{(unsigned char*)F.HID};
        pg8::gemm_phase<EpiSwiGLU8, MoeOrder<true>, true>(F.lds + RING_OFF, g, S, E);
        __syncthreads();
        { const int full = (mt * 4) / F.G, extra = (mt * 4) - full * F.G;
          load_ptrs(F); convert_wdown(F, extra); }
        if (BOTH(8)) GRID_BAR(); STAMP(8);
    }
    if (IN(9)) { load_ptrs(F);
        const int mt = moe_tables(F);
        MoeOrder<false> S{F.G, F.vcu, mt * 4, (const LAS int*)(F.lds + MOE_OFF), F.LIST, (size_t)1024 * 512, 0};
        pg8::Gemm g{F.HID, F.WD, 256, 128}; EpiDown E{F.YROWS, F.LIST, F.LISTW};
        pg8::gemm_phase<EpiDown, MoeOrder<false>, true>(F.lds + RING_OFF, g, S, E);
        if (BOTH(9)) GRID_BAR(); STAMP(9);
    }
    if (IN(10)) { load_ptrs(F); p10_rows(F); }
#undef IN
#undef BOTH
}

extern "C" void kernel_launch(void* const* d_in, const int* in_sizes, int n_in, void* d_out, int out_size, void* d_ws, size_t ws_size, hipStream_t stream) {
    static int grid = 0;
    if (grid == 0) {
        if (n_in != 28 || in_sizes[0] != M * D || out_size != M * D || ws_size < WS_END) { fprintf(stderr, "kernel_launch: unexpected shapes (n_in %d, in0 %d, out %d, ws %zu); nothing launched\n", n_in, n_in > 0 ? in_sizes[0] : -1, out_size, ws_size); grid = -1; return; }
        int dev = 0, cus = 0, per_cu = 0;
        if (hipGetDevice(&dev) != hipSuccess || hipDeviceGetAttribute(&cus, hipDeviceAttributeMultiprocessorCount, dev) != hipSuccess) { grid = -1; return; }
        if (hipFuncSetAttribute((const void*)fwd, hipFuncAttributeMaxDynamicSharedMemorySize, LDS_BYTES) != hipSuccess) { fprintf(stderr, "kernel_launch: hipFuncSetAttribute failed\n"); grid = -1; return; }
        if (hipOccupancyMaxActiveBlocksPerMultiprocessor(&per_cu, (const void*)fwd, NWAVES * 64, LDS_BYTES) != hipSuccess || per_cu < 1) { fprintf(stderr, "kernel_launch: occupancy query reports %d\n", per_cu); }
        (void)hipGetLastError();
        grid = cus;
    }
    if (grid < 0) return;
    if (hipMemsetAsync((char*)d_ws + WS_CTL, 0, CTL_ZERO_BYTES, stream) != hipSuccess) return;
    Args a{};
    for (int i = 0; i < 28; ++i) a.in[i] = (const float*)d_in[i];
    a.out = (float*)d_out; a.ws = (unsigned char*)d_ws;
    for (int li = 0; li < N_LAUNCHES; ++li) {
        a.ph_lo = (N_LAUNCHES == NPH) ? li : 0; a.ph_hi = (N_LAUNCHES == NPH) ? li + 1 : NPH; a.grid = grid; a.pad = 0;
        hipLaunchKernelGGL(fwd, dim3(grid), dim3(NWAVES * 64), LDS_BYTES, stream, a);
        if (hipPeekAtLastError() != hipSuccess) { fprintf(stderr, "kernel_launch: launch %d failed\n", li); break; }
    }
}
```

```cpp
#include <hip/hip_runtime.h>
#include <cstdio>
#include <cstdint>

#ifndef MK_N_LAUNCHES
#define MK_N_LAUNCHES 1
#endif

constexpr int NB = 8, SEQ = 2048, D = 1024, M = NB * SEQ;
constexpr int NH = 8, HD = 64, FW = 512;
constexpr int SW = 512, NG = 32, NS = 64;
constexpr int INC = 4104;
constexpr int NE = 32, DE = 512;
constexpr int CAP = 16384;
constexpr float RMS_EPS = 1e-6f;
constexpr float LOG2E = 1.4426950408889634f;
constexpr float QSCALE = 0.125f * 1.4426950408889634f;

constexpr int TIDTAB_OFF = 147456 - 2048 + 512;
__device__ __forceinline__ int hw_wave_key() { return (int)(__builtin_amdgcn_s_getreg((5 << 11) | 4) & 0x3f); }
__device__ __forceinline__ int tid_opaque() {
    extern __shared__ __attribute__((aligned(16))) unsigned char lds_[];
    const int lane = (int)__builtin_amdgcn_mbcnt_hi(~0u, __builtin_amdgcn_mbcnt_lo(~0u, 0u));
    int w = *(const volatile __attribute__((address_space(3))) int*)((__attribute__((address_space(3))) unsigned char*)lds_ + TIDTAB_OFF + 4 * hw_wave_key());
    w = __builtin_amdgcn_readfirstlane(w);
    int t = w * 64 + lane; asm volatile("" : "+v"(t)); return t;
}

namespace pg8 {
#define PG8_LAS __attribute__((address_space(3)))
typedef unsigned short bf16_t;
typedef short bf16x8 __attribute__((ext_vector_type(8)));
typedef float f32x4 __attribute__((ext_vector_type(4)));
typedef unsigned u32x4 __attribute__((ext_vector_type(4)));
typedef int i32x4 __attribute__((ext_vector_type(4)));
typedef int i32x8 __attribute__((ext_vector_type(8)));
constexpr int BM = 256, BK = 64, HALF = 128, HTB = HALF * BK * 2, STAGE_BYTES = 8 * HTB, NXCD = 8, WGM = 8;

__host__ __device__ __forceinline__ int lds_byte(int r, int c) { const int st = (r >> 4) * 2 + (c >> 5), rr = r & 15, cc = c & 31, ob = rr * 64 + cc * 2; return st * 1024 + (ob ^ (((ob >> 9) & 1) << 5)); }
__host__ __device__ __forceinline__ void stage_rc(int b, int& R, int& C) { const int st = b / 1024, sb = b % 1024, swz = sb ^ (((sb >> 9) & 1) << 5); R = (st >> 1) * 16 + swz / 64; C = (st & 1) * 32 + (swz % 64) / 2; }
__host__ __device__ __forceinline__ int perm32(int rho) { const int n = rho >> 4, i = rho & 15; return 8 * (i >> 2) + 4 * n + (i & 3); }

struct Unit { int pm, pn, e, rows, lbase; };
struct Gemm { const bf16_t* A; const bf16_t* Bt; int K; size_t kstepA; };

struct StaticOrder {
    static constexpr bool GATHER = false, FP8 = false;
    int nM, nN, nwg, G, c;
    __host__ __device__ void init(int M_, int N_, int G_, int c_) { nM = M_ / BM; nN = N_ / BM; nwg = nM * nN; G = G_; c = c_; }
    __host__ __device__ bool next(int i, Unit& u) const {
        const long L = (long)i * G + c; if (L >= nwg) return false;
        int wgid = (int)L; { const int q = nwg / NXCD, r = nwg % NXCD, xcd = wgid % NXCD, off = wgid / NXCD; wgid = (xcd < r ? xcd * (q + 1) : r * (q + 1) + (xcd - r) * q) + off; }
        const int nig = WGM * nN, gid = wgid / nig, fm = gid * WGM, gsz = (nM - fm) < WGM ? (nM - fm) : WGM;
        u.pm = fm + ((wgid % nig) % gsz); u.pn = (wgid % nig) / gsz; u.e = 0; u.rows = 256; u.lbase = 0; return true;
    }
    __device__ __forceinline__ size_t a_base(const Unit& u, int K) const { return (size_t)u.pm * BM * K * 2; }
    __device__ __forceinline__ size_t b_base(const Unit& u, int K) const { return (size_t)u.pn * BM * K * 2; }
    __device__ __forceinline__ void a_offsets(const Unit&, const int*, const int*, int, unsigned (&)[2][2]) const {}
};

struct StaticOrder8 : StaticOrder { static constexpr bool FP8 = true; int pn0;
    __device__ __forceinline__ bool next(int i, Unit& u) const { if (!StaticOrder::next(i, u)) return false; u.pn += pn0; return true; }
};
struct DualOrder : StaticOrder {
    size_t a_delta, b_delta;
    __device__ __forceinline__ bool next(int i, Unit& u) const { if (!StaticOrder::next(i >> 1, u)) return false; u.e = i & 1; return true; }
    __device__ __forceinline__ size_t a_base(const Unit& u, int K) const { return (size_t)u.pm * BM * K * 2 + (u.e ? a_delta : (size_t)0); }
    __device__ __forceinline__ size_t b_base(const Unit& u, int K) const { return (size_t)u.pn * BM * K * 2 + (u.e ? b_delta : (size_t)0); }
};
struct GroupMajorOrder : StaticOrder {
    static constexpr bool GATHER = true;
    int Mrows;
    __device__ __forceinline__ size_t a_base(const Unit&, int) const { return 0; }
    __device__ __forceinline__ void a_offsets(const Unit& u, const int* Rr, const int* Cc, int, unsigned (&vo)[2][2]) const {
#pragma unroll
        for (int h = 0; h < 2; ++h)
#pragma unroll
            for (int i = 0; i < 2; ++i) vo[h][i] = (unsigned)(((Cc[i] >> 4) * Mrows + u.pm * BM + h * HALF + Rr[i]) * 32 + (Cc[i] & 15) * 2);
    }
};
__device__ __forceinline__ unsigned cvt_pk_bf16(float lo, float hi) { unsigned r; asm volatile("v_cvt_pk_bf16_f32 %0, %1, %2" : "=v"(r) : "v"(lo), "v"(hi)); return r; }

template <class T, class = void> struct epi_chains { static constexpr bool value = false; };
template <class T> struct epi_chains<T, decltype((void)T::CHAIN)> { static constexpr bool value = true; };
template <class Epi, class Sched, bool ALIGN_EPI>
__device__ __forceinline__ void gemm_phase(PG8_LAS unsigned char* lds, const Gemm g, const Sched& S, const Epi& E) {
    constexpr bool GATHER = Sched::GATHER;
    const int tid = tid_opaque(), wid = __builtin_amdgcn_readfirstlane(tid >> 6), lane = tid & 63, wr = wid >> 2, wc = wid & 3, fr = lane & 15, fq = lane >> 4;
    const int K = g.K, nt = K / BK;
    unsigned voffB[2], voC[2][2], voN[2][2]; int Rr[2], Cc[2];
#pragma unroll
    for (int i = 0; i < 2; ++i) { int R, C; stage_rc(tid * 16 + i * 8192, R, C); Rr[i] = R; Cc[i] = C; const int Rb = Epi::PERM ? ((R & ~31) + perm32(R & 31)) : R;
        voffB[i] = (unsigned)(Rb * K + C) * 2u; }
    const size_t kstep = (size_t)(BK * 2), kstepA = g.kstepA;
    const size_t hstep = (size_t)HALF * K * 2;
    const unsigned ldsw = (unsigned)wid * 1024u;
    const int aoff = lds_byte(wr * 64 + fr, fq * 8), boff = lds_byte(wc * 32 + fr, fq * 8);
#define PG8_SA(b, h) (((b) * 2 + (h)) * HTB)
#define PG8_SB(b, h) ((4 + (b) * 2 + (h)) * HTB)
#define PG8_STAGE(bufoff, gbase, voff) do { _Pragma("unroll") for (int _i = 0; _i < 2; ++_i) \
        __builtin_amdgcn_global_load_lds((const unsigned*)((const char*)(gbase) + (voff)[_i]), (PG8_LAS unsigned*)(lds + (bufoff) + ldsw + _i * 8192), 16, 0, 0); } while (0)
#define PG8_LDA(dst, b, h) do { if constexpr (Sched::FP8) { _Pragma("unroll") for (int m = 0; m < 4; ++m) { const i32x4 lo_ = *(const PG8_LAS i32x4*)(lds + PG8_SA(b, h) + aoff + m * 2048), hi_ = *(const PG8_LAS i32x4*)(lds + PG8_SA(b, h) + aoff + m * 2048 + 1024); \
        dst##8[m] = __builtin_shufflevector(lo_, hi_, 0, 1, 2, 3, 4, 5, 6, 7); } } \
    else { _Pragma("unroll") for (int m = 0; m < 4; ++m) _Pragma("unroll") for (int k = 0; k < 2; ++k) dst[m][k] = *(const PG8_LAS bf16x8*)(lds + PG8_SA(b, h) + aoff + m * 2048 + k * 1024); } } while (0)
#define PG8_LDB(dst, b, h) do { if constexpr (Sched::FP8) { _Pragma("unroll") for (int n = 0; n < 2; ++n) { const i32x4 lo_ = *(const PG8_LAS i32x4*)(lds + PG8_SB(b, h) + boff + n * 2048), hi_ = *(const PG8_LAS i32x4*)(lds + PG8_SB(b, h) + boff + n * 2048 + 1024); \
        dst##8[n] = __builtin_shufflevector(lo_, hi_, 0, 1, 2, 3, 4, 5, 6, 7); } } \
    else { _Pragma("unroll") for (int n = 0; n < 2; ++n) _Pragma("unroll") for (int k = 0; k < 2; ++k) dst[n][k] = *(const PG8_LAS bf16x8*)(lds + PG8_SB(b, h) + boff + n * 2048 + k * 1024); } } while (0)
#define PG8_MMA(ai, bj, At, Bt) do { __builtin_amdgcn_s_setprio(1); \
        if constexpr (Sched::FP8) { _Pragma("unroll") for (int m = 0; m < 4; ++m) _Pragma("unroll") for (int n = 0; n < 2; ++n) \
            acc[ai][bj][m][n] = __builtin_amdgcn_mfma_scale_f32_16x16x128_f8f6f4(Bt##8[n], At##8[m], acc[ai][bj][m][n], 0, 0, 0, 0x7f7f7f7f, 0, 0x7f7f7f7f); \
            _Pragma("unroll") for (int m = 0; m < 4; ++m) _Pragma("unroll") for (int n = 0; n < 2; ++n) asm volatile("" : "+v"(acc[ai][bj][m][n]));   } \
        else { _Pragma("unroll") for (int m = 0; m < 4; ++m) _Pragma("unroll") for (int n = 0; n < 2; ++n) _Pragma("unroll") for (int k = 0; k < 2; ++k) \
            acc[ai][bj][m][n] = __builtin_amdgcn_mfma_f32_16x16x32_bf16(Bt[n][k], At[m][k], acc[ai][bj][m][n], 0, 0, 0); } \
        __builtin_amdgcn_s_setprio(0); } while (0)
#define PG8_WAIT_V(n) asm volatile("s_waitcnt vmcnt(" #n ")" ::: "memory")
#define PG8_WAIT_L(n) asm volatile("s_waitcnt lgkmcnt(" #n ")" ::: "memory")
#define PG8_BAR __builtin_amdgcn_s_barrier()
#define PG8_SCHED __builtin_amdgcn_sched_barrier(0)
    Unit cur, nxt; int ui = 0;
    if (!S.next(0, cur)) return;
    f32x4 acc[2][2][4][2];
#pragma unroll
    for (int a = 0; a < 2; ++a)
#pragma unroll
        for (int b = 0; b < 2; ++b)
#pragma unroll
            for (int m = 0; m < 4; ++m)
#pragma unroll
                for (int n = 0; n < 2; ++n) acc[a][b][m][n] = (f32x4){0.f, 0.f, 0.f, 0.f};
    bf16x8 At[4][2], B0[2][2], B1[2][2];
    i32x8 At8[4], B08[2], B18[2];
    if constexpr (GATHER) S.a_offsets(cur, Rr, Cc, K, voC);
    else {
#pragma unroll
        for (int h = 0; h < 2; ++h)
#pragma unroll
            for (int i = 0; i < 2; ++i) voC[h][i] = (unsigned)((Rr[i] + h * HALF) * K + Cc[i]) * 2u;
    }
    const char* cA = (const char*)g.A + S.a_base(cur, K); const char* cB = (const char*)g.Bt + S.b_base(cur, K);
    PG8_STAGE(PG8_SB(0, 0), cB, voffB); PG8_STAGE(PG8_SB(0, 1), cB + hstep, voffB); PG8_STAGE(PG8_SA(0, 0), cA, voC[0]); PG8_STAGE(PG8_SA(0, 1), cA, voC[1]);
    if (wr == 1) PG8_BAR;
    PG8_WAIT_V(2); PG8_BAR;
    PG8_STAGE(PG8_SB(1, 0), cB + kstep, voffB); PG8_STAGE(PG8_SA(1, 0), cA + kstepA, voC[0]); PG8_STAGE(PG8_SB(1, 1), cB + hstep + kstep, voffB);
    PG8_WAIT_V(6); PG8_BAR;
    for (;;) {
        const bool has_next = S.next(ui + 1, nxt);
        const char* nA = has_next ? (const char*)g.A + S.a_base(nxt, K) : cA; const char* nB = has_next ? (const char*)g.Bt + S.b_base(nxt, K) : cB;
        if constexpr (GATHER) {
            if (has_next) S.a_offsets(nxt, Rr, Cc, K, voN);
            else {
#pragma unroll
                for (int h = 0; h < 2; ++h)
#pragma unroll
                    for (int i = 0; i < 2; ++i) voN[h][i] = voC[h][i];
            }
        }
        for (int t = 0; t < nt; t += 2) {
            asm volatile(".p2align 6" ::: "memory");
            const bool last = (t == nt - 2);
            const char* a1 = cA + (size_t)(t + 1) * kstepA;
            const char* a2 = last ? nA : cA + (size_t)(t + 2) * kstepA; const char* b2 = last ? nB : cB + (size_t)(t + 2) * kstep;
            const char* a3 = a2 + kstepA; const char* b3 = b2 + kstep;
            unsigned vo2[2][2];
            if (GATHER && last) { asm volatile("" ::: "memory");
#pragma unroll
                for (int h = 0; h < 2; ++h)
#pragma unroll
                    for (int i = 0; i < 2; ++i) vo2[h][i] = voN[h][i];
            } else {
                if (GATHER) asm volatile("" ::: "memory");
#pragma unroll
                for (int h = 0; h < 2; ++h)
#pragma unroll
                    for (int i = 0; i < 2; ++i) vo2[h][i] = voC[h][i]; }
            PG8_LDB(B0, 0, 0); PG8_LDB(B1, 0, 1); PG8_SCHED; PG8_LDA(At, 0, 0); PG8_STAGE(PG8_SA(1, 1), a1, voC[1]);
            PG8_WAIT_V(8); PG8_WAIT_L(0); PG8_BAR; PG8_MMA(0, 0, At, B0); PG8_MMA(0, 1, At, B1); PG8_BAR; PG8_SCHED;
            PG8_LDA(At, 0, 1); PG8_STAGE(PG8_SB(0, 0), b2, voffB); PG8_STAGE(PG8_SB(0, 1), b2 + hstep, voffB); PG8_STAGE(PG8_SA(0, 0), a2, vo2[0]);
            PG8_WAIT_V(8); PG8_WAIT_L(0); PG8_BAR; PG8_MMA(1, 0, At, B0); PG8_MMA(1, 1, At, B1); PG8_BAR; PG8_SCHED;
            PG8_LDB(B0, 1, 0); PG8_LDB(B1, 1, 1); PG8_SCHED; PG8_LDA(At, 1, 0); PG8_STAGE(PG8_SA(0, 1), a2, vo2[1]);
            PG8_WAIT_V(8); PG8_WAIT_L(0); PG8_BAR; PG8_MMA(0, 0, At, B0); PG8_MMA(0, 1, At, B1); PG8_BAR; PG8_SCHED;
            PG8_LDA(At, 1, 1); PG8_STAGE(PG8_SB(1, 0), b3, voffB); PG8_STAGE(PG8_SB(1, 1), b3 + hstep, voffB); PG8_STAGE(PG8_SA(1, 0), a3, vo2[0]);
            PG8_WAIT_V(8); PG8_WAIT_L(0); PG8_BAR; PG8_MMA(1, 0, At, B0); PG8_MMA(1, 1, At, B1); PG8_BAR; PG8_SCHED;
        }
        if constexpr (ALIGN_EPI) { if (wr == 0) PG8_BAR; }
        bool keep = false;
        if constexpr (epi_chains<Epi>::value) { E.chain(acc, cur, wr, wc, fr, fq); keep = (cur.e == 0); }
        else E(acc, cur, wr, wc, fr, fq);
        if (!has_next) break;
        if (!keep) {
#pragma unroll
        for (int a = 0; a < 2; ++a)
#pragma unroll
            for (int b = 0; b < 2; ++b)
#pragma unroll
                for (int m = 0; m < 4; ++m)
#pragma unroll
                    for (int n = 0; n < 2; ++n) acc[a][b][m][n] = (f32x4){0.f, 0.f, 0.f, 0.f};
        }
        cur = nxt; cA = nA; cB = nB; ++ui;
        if constexpr (GATHER) {
#pragma unroll
            for (int h = 0; h < 2; ++h)
#pragma unroll
                for (int i = 0; i < 2; ++i) voC[h][i] = voN[h][i];
        }
        if constexpr (ALIGN_EPI) { if (wr == 1) PG8_BAR; }
    }
    PG8_WAIT_V(0);
    if constexpr (!ALIGN_EPI) { if (wr == 0) PG8_BAR; }
    PG8_BAR;
#undef PG8_SA
#undef PG8_SB
#undef PG8_STAGE
#undef PG8_LDA
#undef PG8_LDB
#undef PG8_MMA
#undef PG8_WAIT_V
#undef PG8_WAIT_L
#undef PG8_BAR
#undef PG8_SCHED
}
}

#include <hip/hip_bf16.h>
#include <cmath>
namespace attn_body {
using bf16=__hip_bfloat16;
using bf16x8=__attribute__((ext_vector_type(8)))short;
using s16x4=__attribute__((ext_vector_type(4)))short;
using f32x16=__attribute__((ext_vector_type(16)))float;
using u32x4=__attribute__((ext_vector_type(4)))unsigned;
constexpr int BATCH=8,NHEAD=8,SEQ=2048,D=64,DM=NHEAD*D;
constexpr int NW=8,QBLK=32,QB=QBLK*NW,KVBLK=64,NQB=SEQ/QB;
constexpr int ATTN_PITCH=DM, ATTN_UNIT_ROWS=QB;
__device__ __forceinline__ int crow(int r,int hi){return (r&3)+8*(r>>2)+4*hi;}
#define SBAR() __builtin_amdgcn_sched_barrier(0)
__device__ __forceinline__ void cmask(f32x16&p0,f32x16&p1,int jb,int qrel,int hi){
  const float NEG=-INFINITY; int kb=64*jb+4*hi;
  #pragma unroll
  for(int r=0;r<16;++r){int kv=kb+(r&3)+8*(r>>2); if(kv>qrel)p0[r]=NEG; if(kv+32>qrel)p1[r]=NEG;}
}

constexpr int NSLOT=3, SLOTB=8192;
constexpr int LDS_K=0, LDS_V=NSLOT*SLOTB, LDS_WS=2*NSLOT*SLOTB, LDS_OST=LDS_WS+NW*64*4, LDS_CB=LDS_OST+NW*4096, LDS_BYTES=LDS_CB+SEQ*4;
constexpr float C2=0.125f*1.4426950408889634f;
__device__ __forceinline__ void glds16s(const void*base,unsigned voff,unsigned lds_dst){unsigned keep;
  asm volatile("s_mov_b32 %0, m0\n\ts_mov_b32 m0, %3\n\ts_nop 0\n\tglobal_load_lds_dwordx4 %1, %2\n\ts_mov_b32 m0, %0":"=&s"(keep):"v"(voff),"s"(base),"s"(lds_dst):"memory");}
__device__ __forceinline__ void glds16(const void*gsrc,unsigned lds_dst){unsigned keep;
  asm volatile("s_mov_b32 %0, m0\n\ts_mov_b32 m0, %2\n\ts_nop 0\n\tglobal_load_lds_dwordx4 %1, off\n\ts_mov_b32 m0, %0":"=&s"(keep):"v"(gsrc),"s"(lds_dst):"memory");}
__device__ __forceinline__ float max3f(float a,float b,float c){float r;asm("v_max3_f32 %0, %1, %2, %3":"=v"(r):"v"(a),"v"(b),"v"(c));return r;}
__device__ __forceinline__ float max2f(float a,float b){float r;asm("v_max_f32_e32 %0, %1, %2":"=v"(r):"v"(a),"v"(b));return r;}
__device__ __forceinline__ float fadd_s(float a,float b){float r;asm("v_add_f32_e32 %0, %1, %2":"=v"(r):"v"(a),"v"(b));return r;}
__device__ __forceinline__ float fsub_s(float a,float b){float r;asm("v_sub_f32_e32 %0, %1, %2":"=v"(r):"v"(a),"v"(b));return r;}
typedef float f32x2_t __attribute__((ext_vector_type(2))); typedef __bf16 bf16x2_t __attribute__((ext_vector_type(2)));
__device__ __forceinline__ unsigned cvtpk_s(float lo,float hi){f32x2_t v={lo,hi};bf16x2_t b=__builtin_convertvector(v,bf16x2_t);return __builtin_bit_cast(unsigned,b);}
#define WAIT_BAR(N) asm volatile("s_waitcnt vmcnt(" #N ") lgkmcnt(0)\n\ts_barrier":::"memory")

__device__ __forceinline__ void qkt(f32x16&p0,f32x16&p1,const char*Kslot,const bf16x8*qr,const f32x16&negm,int r32,int hi,bf16x8 kb0,bf16x8 kb1,bf16x8 qx){
  const char*kb=Kslot+hi*1024+r32*16;
  #pragma unroll
  for(int d0=0;d0<4;++d0){
    const bf16x8 b0=*reinterpret_cast<const bf16x8*>(kb+d0*2048);
    const bf16x8 b1=*reinterpret_cast<const bf16x8*>(kb+d0*2048+512);
    if(d0==0){p0=__builtin_amdgcn_mfma_f32_32x32x16_bf16(b0,qr[0],negm,0,0,0);p1=__builtin_amdgcn_mfma_f32_32x32x16_bf16(b1,qr[0],negm,0,0,0);}
    else{p0=__builtin_amdgcn_mfma_f32_32x32x16_bf16(b0,qr[d0],p0,0,0,0);p1=__builtin_amdgcn_mfma_f32_32x32x16_bf16(b1,qr[d0],p1,0,0,0);}}
  p0=__builtin_amdgcn_mfma_f32_32x32x16_bf16(kb0,qx,p0,0,0,0);p1=__builtin_amdgcn_mfma_f32_32x32x16_bf16(kb1,qx,p1,0,0,0);
}
typedef __attribute__((address_space(3))) const char* lds_cptr;
typedef short v4i16_t __attribute__((ext_vector_type(4)));
__device__ __forceinline__ void kload8(bf16x8*kf,lds_cptr kp){
  kf[0]=*(const __attribute__((address_space(3))) bf16x8*)(kp);      kf[1]=*(const __attribute__((address_space(3))) bf16x8*)(kp+512);
  kf[2]=*(const __attribute__((address_space(3))) bf16x8*)(kp+2048); kf[3]=*(const __attribute__((address_space(3))) bf16x8*)(kp+2560);
  kf[4]=*(const __attribute__((address_space(3))) bf16x8*)(kp+4096); kf[5]=*(const __attribute__((address_space(3))) bf16x8*)(kp+4608);
  kf[6]=*(const __attribute__((address_space(3))) bf16x8*)(kp+6144); kf[7]=*(const __attribute__((address_space(3))) bf16x8*)(kp+6656);
}
__device__ __forceinline__ void kload2(bf16x8*kf,lds_cptr kp,int j){ kf[2*j]=*(const __attribute__((address_space(3))) bf16x8*)(kp+j*2048); kf[2*j+1]=*(const __attribute__((address_space(3))) bf16x8*)(kp+j*2048+512); }
__device__ __forceinline__ s16x4 vtr(lds_cptr p){ return __builtin_bit_cast(s16x4,__builtin_amdgcn_ds_read_tr16_b64_v4i16((__attribute__((address_space(3))) v4i16_t*)p)); }
__device__ __forceinline__ float rowmax(const f32x16&p0,const f32x16&p1){
  float a=max3f(p0[0],p0[1],p1[0]),b=max3f(p0[2],p0[3],p1[1]);a=max3f(a,p1[2],p1[3]);
  #pragma unroll
  for(int r=4;r<16;r+=4){a=max3f(a,p0[r],p0[r+1]);b=max3f(b,p0[r+2],p0[r+3]);a=max3f(a,p1[r],p1[r+1]);b=max3f(b,p1[r+2],p1[r+3]);}
  const float m=max2f(a,b);
  auto rr=__builtin_amdgcn_permlane32_swap(__float_as_uint(m),__float_as_uint(m),false,false);
  return max2f(__uint_as_float(rr[0]),__uint_as_float(rr[1]));
}
__device__ __forceinline__ void pv(f32x16*o,int vb,bf16x8 pa0,bf16x8 pa1,bf16x8 pa2,bf16x8 pa3){
  #pragma unroll
  for(int d0=0;d0<2;++d0){s16x4 lo[4],hi[4];
    #pragma unroll
    for(int ks=0;ks<4;++ks){
      asm volatile("ds_read_b64_tr_b16 %0,%1 offset:%c2":"=&v"(lo[ks]):"v"(vb),"i"(d0*4096+ks*1024):"memory");
      asm volatile("ds_read_b64_tr_b16 %0,%1 offset:%c2":"=&v"(hi[ks]):"v"(vb),"i"(d0*4096+ks*1024+512):"memory");}
    asm volatile("s_waitcnt lgkmcnt(0)":::"memory");SBAR();
    #define PK(k) (bf16x8){lo[k][0],lo[k][1],lo[k][2],lo[k][3],hi[k][0],hi[k][1],hi[k][2],hi[k][3]}
    o[d0]=__builtin_amdgcn_mfma_f32_32x32x16_bf16(pa0,PK(0),o[d0],0,0,0);
    o[d0]=__builtin_amdgcn_mfma_f32_32x32x16_bf16(pa1,PK(1),o[d0],0,0,0);
    o[d0]=__builtin_amdgcn_mfma_f32_32x32x16_bf16(pa2,PK(2),o[d0],0,0,0);
    o[d0]=__builtin_amdgcn_mfma_f32_32x32x16_bf16(pa3,PK(3),o[d0],0,0,0);
    #undef PK
  }
}

#ifndef ATTN_STORE16
#define ATTN_STORE16(p,v) (*(u32x4*)(p)=(v))
#endif
template<int THRL> __device__ __forceinline__ void attn_unit(int b,int h,int qb,const bf16*Q,const bf16*__restrict__ K,const bf16*__restrict__ V,bf16*O,const unsigned*__restrict__ CP,char*shm,bool stage_cb){
  const int tid=tid_opaque(),lane=tid&63,r32=lane&31,hi=lane>>5; const int wid=__builtin_amdgcn_readfirstlane(tid>>6);
  const long rowbase=(long)b*SEQ; const int q0=qb*QB;
  const bf16*Qw=Q+(rowbase+q0+wid*QBLK)*DM+h*D;
  const bf16*Kh=K+rowbase*DM+h*D,*Vh=V+rowbase*DM+h*D;
  const lds_cptr shm3=(lds_cptr)shm;
  const unsigned lds0=(unsigned)(uintptr_t)shm;
  float*wsf=(float*)(shm+LDS_WS)+wid*64;
  const unsigned koff=(unsigned)(lane*DM+wid*8)*2u;
  const unsigned voff=(unsigned)((16*(wid&3)+(lane>>2))*DM+(wid>>2)*32+(lane&3)*8)*2u;
  const unsigned kdst=lds0+LDS_K+wid*1024, vdst=lds0+LDS_V+wid*1024;
  #define DMA_K(t,slot) glds16s(Kh+(long)(t)*KVBLK*DM,koff,(unsigned)__builtin_amdgcn_readfirstlane(kdst+(slot)))
  #define DMA_V(t,slot) glds16s(Vh+(long)(t)*KVBLK*DM,voff,(unsigned)__builtin_amdgcn_readfirstlane(vdst+(slot)))
  const int vb0=(int)(lds0+LDS_V)+((lane>>4)&1)*32+(lane&3)*8+(4*hi+((lane&15)>>2))*64;
  const char*Kbase=shm+LDS_K; bf16x8 kf[8];
  const lds_cptr kp0=shm3+LDS_K+hi*1024+r32*16; const lds_cptr vp0=shm3+LDS_V+((lane>>4)&1)*32+(lane&3)*8+(4*hi+((lane&15)>>2))*64;
  const int NT=(q0+QB)/KVBLK;
  const __attribute__((address_space(3))) unsigned* cl3=(const __attribute__((address_space(3))) unsigned*)(shm3+LDS_CB);
  { __attribute__((address_space(3))) unsigned* clw=(__attribute__((address_space(3))) unsigned*)(shm3+LDS_CB); if(stage_cb)for(int i=tid;i<q0+QB;i+=NW*64)clw[i]=CP[i]; }
  bf16x8 qx; { const short one_=(short)(hi?0:0x3F80); qx=(bf16x8){one_,one_,0,0,0,0,0,0}; } asm volatile("":"+v"(qx));
  #define KBIAS(w) __builtin_bit_cast(bf16x8,(u32x4){hi?0u:(w),0u,0u,0u})
  DMA_K(0,0);DMA_V(0,0);DMA_K(1,SLOTB);
  bf16x8 qr[4];
  #pragma unroll
  for(int d0=0;d0<4;++d0)qr[d0]=*reinterpret_cast<const bf16x8*>(&Qw[(long)r32*DM+d0*16+hi*8]);
  float mhat=0.f,l_reg=0.f;f32x16 o[2];o[0]=f32x16{};o[1]=f32x16{};f32x16 negm=f32x16{};asm volatile("":"+v"(negm));
  const int qrel=wid*QBLK+r32;
  #define CMASK(P0,P1,t) do{int jb_=(t)-(NT-4); if(jb_>=0)cmask(P0,P1,jb_,qrel,hi);}while(0)
  bool resc=false;
  #define START(P0,P1) do{ const float rm=rowmax(P0,P1); resc=false; \
    { const float dl=rm; mhat=fadd_s(mhat,dl); \
      _Pragma("unroll") for(int r=0;r<16;++r){P0[r]=fsub_s(P0[r],dl);P1[r]=fsub_s(P1[r],dl);} \
      _Pragma("unroll") for(int r=0;r<16;++r)negm[r]=-mhat; asm volatile("":"+v"(negm)); } \
    _Pragma("unroll") for(int r=0;r<16;++r)P0[r]=__builtin_amdgcn_exp2f(P0[r]); }while(0)
  #define RESC() do{ if(resc){ asm volatile("s_waitcnt lgkmcnt(0)":::"memory"); \
      _Pragma("unroll") for(int d_=0;d_<2;++d_) _Pragma("unroll") for(int r=0;r<16;++r)o[d_][r]*=wsf[crow(r,hi)]; } }while(0)
  f32x16 pA0,pA1,pB0,pB1;
  int sl_prev=0,sl_cur=0,sl_next=SLOTB;
  #define ROT() do{sl_prev=sl_cur;sl_cur=sl_next;sl_next=(sl_next==(NSLOT-1)*SLOTB)?0:sl_next+SLOTB;}while(0)
  DMA_K(2,2*SLOTB);
  WAIT_BAR(3);
  { const unsigned c0_=cl3[r32],c1_=cl3[32+r32]; qkt(pA0,pA1,Kbase,qr,negm,r32,hi,KBIAS(c0_),KBIAS(c1_),qx); } asm volatile("s_nop 15\n\ts_nop 7":"+v"(pA0),"+v"(pA1));CMASK(pA0,pA1,0);
  START(pA0,pA1);
  _Pragma("unroll") for(int r=0;r<16;++r)pA1[r]=__builtin_amdgcn_exp2f(pA1[r]);
  WAIT_BAR(0);
  DMA_K(3,0);DMA_V(1,SLOTB);
  ROT();
  kload8(kf,kp0+sl_cur);
  WAIT_BAR(2);
  s16x4 vlo[8],vhi[8]; u32x4 pw0,pw1,pw2,pw3;
  #define PKW(P,B) cvtpk_s(P[B],P[B+1])
  #define PAF(k) __builtin_bit_cast(bf16x8,pw##k)
  #define VFR(i) (bf16x8){vlo[i][0],vlo[i][1],vlo[i][2],vlo[i][3],vhi[i][0],vhi[i][1],vhi[i][2],vhi[i][3]}
  #define PIN(x) asm volatile("":"+v"(x))
  #define MX3(a,b,c) __builtin_fmaxf(__builtin_fmaxf((a),(b)),(c))
  #define GAPA(MF,A0,A1,A2,A3,W0,W1,PW) do{ MF; sacc+=A0; sacc+=A1; sacc+=A2; sacc+=A3; PIN(sacc); W0; W1; PIN(PW); SBAR(); }while(0)
  #define EX(v) __builtin_amdgcn_exp2f(v)
  #define GAPB(MF,X,B) do{ MF; X[B]=EX(X[B]); X[B+1]=EX(X[B+1]); X[B+2]=EX(X[B+2]); X[B+3]=EX(X[B+3]); PIN(X); SBAR(); }while(0)
  #define VRD(i) do{ vlo[i]=vtr(vp_+(((i)>>2)*4096+((i)&3)*1024)); vhi[i]=vtr(vp_+(((i)>>2)*4096+((i)&3)*1024+512)); }while(0)
  #define KRD(G,j) do{ if(G){ kload2(kf,kp0+sl_next,j); SBAR(); } }while(0)
  #define STEP(C0,C1,P0,P1,t,GK,GV,GL) do{ SBAR(); \
    const lds_cptr vp_=vp0+sl_prev; const unsigned cw0_=cl3[(t)*KVBLK+r32],cw1_=cl3[(t)*KVBLK+32+r32]; \
    VRD(0); SBAR(); float sacc=(P0[0]+P0[1]); \
    GAPA(C0=__builtin_amdgcn_mfma_f32_32x32x16_bf16(kf[0],qr[0],negm,0,0,0), P0[2],P0[3],P0[4],P0[5],     pw0[0]=PKW(P0,0), pw0[1]=PKW(P0,2), pw0); \
    VRD(4); SBAR(); GAPA(C1=__builtin_amdgcn_mfma_f32_32x32x16_bf16(kf[1],qr[0],negm,0,0,0), P0[6],P0[7],P0[8],P0[9],     pw0[2]=PKW(P0,4), pw0[3]=PKW(P0,6), pw0); \
    VRD(1); SBAR(); GAPA(C0=__builtin_amdgcn_mfma_f32_32x32x16_bf16(kf[2],qr[1],C0,0,0,0),   P0[10],P0[11],P0[12],P0[13], pw1[0]=PKW(P0,8), pw1[1]=PKW(P0,10), pw1); \
    VRD(5); SBAR(); GAPA(C1=__builtin_amdgcn_mfma_f32_32x32x16_bf16(kf[3],qr[1],C1,0,0,0),   P0[14],P0[15],P1[0],P1[1],   pw1[2]=PKW(P0,12),pw1[3]=PKW(P0,14), pw1); \
    VRD(2); SBAR(); GAPA(C0=__builtin_amdgcn_mfma_f32_32x32x16_bf16(kf[4],qr[2],C0,0,0,0),   P1[2],P1[3],P1[4],P1[5],     pw2[0]=PKW(P1,0), pw2[1]=PKW(P1,2), pw2); \
    VRD(6); SBAR(); GAPA(C1=__builtin_amdgcn_mfma_f32_32x32x16_bf16(kf[5],qr[2],C1,0,0,0),   P1[6],P1[7],P1[8],P1[9],     pw2[2]=PKW(P1,4), pw2[3]=PKW(P1,6), pw2); \
    VRD(3); SBAR(); GAPA(C0=__builtin_amdgcn_mfma_f32_32x32x16_bf16(kf[6],qr[3],C0,0,0,0),   P1[10],P1[11],P1[12],P1[13], pw3[0]=PKW(P1,8), pw3[1]=PKW(P1,10), pw3); \
    VRD(7); SBAR(); GAPA(C1=__builtin_amdgcn_mfma_f32_32x32x16_bf16(kf[7],qr[3],C1,0,0,0),   P1[14],P1[15],0.f,0.f,       pw3[2]=PKW(P1,12),pw3[3]=PKW(P1,14), pw3); \
    C0=__builtin_amdgcn_mfma_f32_32x32x16_bf16(KBIAS(cw0_),qx,C0,0,0,0); C1=__builtin_amdgcn_mfma_f32_32x32x16_bf16(KBIAS(cw1_),qx,C1,0,0,0); SBAR(); \
    l_reg+=sacc; \
    if(GK){DMA_K((t)+3,sl_cur);} if(GV){DMA_V((t)+1,sl_next);} \
    CMASK(C0,C1,t); \
    { float a=MX3(C0[0],C0[1],C1[0]),b=MX3(C0[2],C0[3],C1[1]); a=MX3(a,C1[2],C1[3]); \
      _Pragma("unroll") for(int r=4;r<16;r+=4){a=MX3(a,C0[r],C0[r+1]);b=MX3(b,C0[r+2],C0[r+3]);a=MX3(a,C1[r],C1[r+1]);b=MX3(b,C1[r+2],C1[r+3]);} \
      float rm=__builtin_fmaxf(a,b); { auto rr=__builtin_amdgcn_permlane32_swap(__float_as_uint(rm),__float_as_uint(rm),false,false); rm=__builtin_fmaxf(__uint_as_float(rr[0]),__uint_as_float(rr[1])); } \
      resc=false; \
      if(__builtin_expect(__any(rm>(float)THRL),0)){ const float dl=__builtin_fmaxf(rm,0.f); mhat+=dl; \
        _Pragma("unroll") for(int r=0;r<16;++r){C0[r]-=dl;C1[r]-=dl;} \
        _Pragma("unroll") for(int r=0;r<16;++r)negm[r]=-mhat; asm volatile("":"+v"(negm)); \
        const float f=__builtin_amdgcn_exp2f(-dl); l_reg*=f; if(hi==0)wsf[r32]=f; resc=true; } } \
    SBAR(); \
    GAPB(o[0]=__builtin_amdgcn_mfma_f32_32x32x16_bf16(PAF(0),VFR(0),o[0],0,0,0), C0,0); \
    GAPB(o[1]=__builtin_amdgcn_mfma_f32_32x32x16_bf16(PAF(0),VFR(4),o[1],0,0,0), C0,4); \
    KRD(GL,0); GAPB(o[0]=__builtin_amdgcn_mfma_f32_32x32x16_bf16(PAF(1),VFR(1),o[0],0,0,0), C0,8); \
    KRD(GL,1); GAPB(o[1]=__builtin_amdgcn_mfma_f32_32x32x16_bf16(PAF(1),VFR(5),o[1],0,0,0), C0,12); \
    KRD(GL,2); GAPB(o[0]=__builtin_amdgcn_mfma_f32_32x32x16_bf16(PAF(2),VFR(2),o[0],0,0,0), C1,0); \
    KRD(GL,3); GAPB(o[1]=__builtin_amdgcn_mfma_f32_32x32x16_bf16(PAF(2),VFR(6),o[1],0,0,0), C1,4); \
    GAPB(o[0]=__builtin_amdgcn_mfma_f32_32x32x16_bf16(PAF(3),VFR(3),o[0],0,0,0), C1,8); \
    GAPB(o[1]=__builtin_amdgcn_mfma_f32_32x32x16_bf16(PAF(3),VFR(7),o[1],0,0,0), C1,12); \
    }while(0)
  int t=1;
  #undef CMASK
  #define CMASK(P0,P1,t) do{}while(0)
  for(;t+5<NT;t+=2){
    STEP(pB0,pB1,pA0,pA1,t,true,true,true);     WAIT_BAR(2); RESC(); ROT();
    STEP(pA0,pA1,pB0,pB1,t+1,true,true,true);   WAIT_BAR(2); RESC(); ROT();
  }
  #undef CMASK
  #define CMASK(P0,P1,t) do{int jb_=(t)-(NT-4); if(jb_>=0)cmask(P0,P1,jb_,qrel,hi);}while(0)
  #define ENDW(tt) do{ if((tt)+3<NT){WAIT_BAR(2);} else if((tt)+2<NT){WAIT_BAR(1);} else {WAIT_BAR(0);} }while(0)
  for(;t+1<NT;t+=2){
    STEP(pB0,pB1,pA0,pA1,t,(t+3<NT),(t+1<NT),(t+1<NT));       ENDW(t);   RESC(); ROT();
    STEP(pA0,pA1,pB0,pB1,t+1,(t+4<NT),(t+2<NT),(t+2<NT));     ENDW(t+1); RESC(); ROT();
  }
  STEP(pB0,pB1,pA0,pA1,NT-1,false,false,false); RESC();
  { float sacc=pB0[0]+pB0[1]; _Pragma("unroll") for(int r=2;r<16;++r)sacc+=pB0[r]; _Pragma("unroll") for(int r=0;r<16;++r)sacc+=pB1[r]; l_reg+=sacc;
    pw0=(u32x4){PKW(pB0,0),PKW(pB0,2),PKW(pB0,4),PKW(pB0,6)};pw1=(u32x4){PKW(pB0,8),PKW(pB0,10),PKW(pB0,12),PKW(pB0,14)};pw2=(u32x4){PKW(pB1,0),PKW(pB1,2),PKW(pB1,4),PKW(pB1,6)};pw3=(u32x4){PKW(pB1,8),PKW(pB1,10),PKW(pB1,12),PKW(pB1,14)};
    SBAR(); pv(o,vb0+sl_cur,PAF(0),PAF(1),PAF(2),PAF(3)); }
  #undef PKW
  #undef PAF
  #undef VFR
  #undef PIN
  #undef MX3
  #undef GAPA
  #undef GAPB
  #undef EX
  #undef VRD
  #undef KRD
  #undef STEP
  #undef ENDW
  {auto rr=__builtin_amdgcn_permlane32_swap(__float_as_uint(l_reg),__float_as_uint(l_reg),false,false);l_reg=__uint_as_float(rr[0])+__uint_as_float(rr[1]);}
  if(hi==0)wsf[32+r32]=l_reg;asm volatile("s_waitcnt lgkmcnt(0)":::"memory");
  float rli[16];
  #pragma unroll
  for(int r=0;r<16;++r)rli[r]=__builtin_amdgcn_rcpf(wsf[32+crow(r,hi)]);
  bf16*Ow=O+(rowbase+q0+wid*QBLK)*DM+h*D;
  { bf16*stg=(bf16*)(shm+LDS_OST)+wid*2048;
    #pragma unroll
    for(int r=0;r<16;++r){const int orow=crow(r,hi);
      #pragma unroll
      for(int d0=0;d0<2;++d0)stg[orow*64+d0*32+r32]=__float2bfloat16(o[d0][r]*rli[r]);}
    asm volatile("s_waitcnt lgkmcnt(0)":::"memory");
    #pragma unroll
    for(int i=0;i<4;++i){const int row=i*8+(lane>>3),ch=lane&7; const u32x4 v=*(const u32x4*)(stg+row*64+ch*8); ATTN_STORE16(Ow+(long)row*DM+ch*8,v);} }
  asm volatile("s_waitcnt lgkmcnt(0)\n\ts_barrier":::"memory");
  #undef DMA_K
  #undef DMA_V
  #undef CMASK
  #undef START
  #undef RESC
  #undef ROT
  #undef KBIAS
}
constexpr int ATTN_LDS_BYTES=LDS_BYTES;
struct AttnTensors { const bf16* Q; const bf16* K; const bf16* V; bf16* O; const unsigned* CP; };
struct AttnUnit { int bh; int qb; };
struct StaticOrder {
  int vcu, G;
  __device__ __forceinline__ StaticOrder(int grid,int v):vcu(v),G(grid){}
  __device__ __forceinline__ bool next(int i,AttnUnit&u)const{
    if(G==256){ if(i>=2)return false; const int s=vcu&3; u.bh=vcu>>2; u.qb=(i==0)?7-s:s; return true; }
    const int L=i*G+vcu; if(L>=BATCH*NHEAD*NQB)return false; u.bh=L>>3; u.qb=7-(L&7); return true; }
  __device__ __forceinline__ void a_ready(const AttnUnit&)const{}
  __device__ __forceinline__ void done(const AttnUnit&)const{}
};
template<class Sched,int THRL=20> __device__ __forceinline__ void attn_phase(char*lds,const AttnTensors&T,const Sched&S){
  AttnUnit u;
  int pbh=-1,pqb=-1;
  for(int i=0;S.next(i,u);++i){ S.a_ready(u); const bool st=!(u.bh==pbh&&u.qb<=pqb); attn_unit<THRL>(u.bh/NHEAD,u.bh%NHEAD,u.qb,T.Q,T.K,T.V,T.O,T.CP+(long)u.bh*SEQ,lds,st); if(st){pbh=u.bh;pqb=u.qb;} S.done(u); }
}
#undef SBAR
#undef WAIT_BAR
}

constexpr int NWAVES = 8;
constexpr int NPH = 11;
constexpr int N_LAUNCHES = MK_N_LAUNCHES;
static_assert(N_LAUNCHES == 1 || N_LAUNCHES == NPH, "MK_N_LAUNCHES is 1 (one launch) or NPH (one launch per phase)");

constexpr size_t MiB = 1u << 20;
constexpr size_t WS_CTL = 0, CTL_ZERO_BYTES = 1 * MiB;
constexpr size_t WS_MOD = 1 * MiB;
constexpr size_t WS_LOGF = 1 * MiB + 256 * 1024;
constexpr size_t WS_ROUTE = 2 * MiB;
constexpr size_t WS_RW = 2 * MiB + 256 * 1024;
constexpr size_t WS_CUM = 2 * MiB + 512 * 1024;
constexpr size_t WS_LIST = 3 * MiB;
constexpr size_t WS_CUMP = 5 * MiB;
constexpr size_t WS_WIN = 6 * MiB;
constexpr size_t WS_WGLU = 14 * MiB, WS_WOF = 15 * MiB, WS_WOS = 16 * MiB, WS_WO = 17 * MiB;
constexpr size_t WS_WGU = 20 * MiB;
constexpr size_t WS_WD = 84 * MiB;
constexpr size_t WS_H = 116 * MiB;
constexpr size_t WS_Y = 148 * MiB;
constexpr size_t WS_MIX = 164 * MiB;
constexpr size_t WS_Q = WS_MIX, WS_K = WS_MIX + 16 * MiB, WS_V = WS_MIX + 32 * MiB, WS_U = WS_MIX + 48 * MiB, WS_SGA = WS_MIX + 64 * MiB, WS_SGB = WS_MIX + 96 * MiB;
constexpr size_t WS_HID = WS_MIX;
constexpr size_t WS_YROWS = WS_MIX + 40 * MiB;
constexpr size_t WS_X1B = 132 * MiB;
constexpr size_t WS_LISTW = 292 * MiB;
constexpr size_t WS_END = 294 * MiB;
static_assert(WS_YROWS + (size_t)M * 2 * 1024 * 2 <= WS_END && WS_SGB + (size_t)M * 1024 * 2 <= WS_END, "d_ws map");

constexpr int CW_TMO = 0;
constexpr int CW_CNT = 2048;
constexpr int CW_CHK = 4096;
constexpr int CW_TS = 4200;
constexpr int CW_MOD = 4160;
constexpr int CW_BAR = 8192;

constexpr int RING_OFF = 0, RING_BYTES = 131072;
constexpr int LDS_BYTES = 147456;
constexpr int LDSCTL_OFF = LDS_BYTES - 2048, MISC_OFF = LDSCTL_OFF + 320, MOE_OFF = LDSCTL_OFF + 1024;

#define GAS __attribute__((address_space(1)))
#define LAS __attribute__((address_space(3)))
typedef unsigned short bf16;
typedef unsigned v4u __attribute__((ext_vector_type(4)));
typedef unsigned v2u __attribute__((ext_vector_type(2)));
typedef float f32x4 __attribute__((ext_vector_type(4)));
typedef float f32x2 __attribute__((ext_vector_type(2)));
typedef GAS unsigned gu32;
#define RLX_AGENT __ATOMIC_RELAXED, __HIP_MEMORY_SCOPE_AGENT
#define LDS_WAIT() asm volatile("s_waitcnt lgkmcnt(0)" ::: "memory")
#define VM_WAIT() asm volatile("s_waitcnt vmcnt(0)" ::: "memory")
__device__ __forceinline__ unsigned f2bf(float f) { unsigned u = __builtin_bit_cast(unsigned, f); return (u + 0x7fffu + ((u >> 16) & 1u)) >> 16; }
__device__ __forceinline__ unsigned pk2(float lo, float hi) { unsigned r; asm("v_cvt_pk_bf16_f32 %0, %1, %2" : "=v"(r) : "v"(lo), "v"(hi)); return r; }
__device__ __forceinline__ float bflo(unsigned w) { return __uint_as_float(w << 16); }
__device__ __forceinline__ float bfhi(unsigned w) { return __uint_as_float(w & 0xffff0000u); }
__device__ __forceinline__ float fast_sigmoid(float v) { return __builtin_amdgcn_rcpf(1.f + __builtin_amdgcn_exp2f(-LOG2E * v)); }

#define XB_TMO      128
#define XB_XCNT(j)  (256  + 64 * (j))
#define XB_XSUB(j)  (1280 + 64 * (j))
#define XB_XGEN(j)  (2304 + 64 * (j))
#define XB_TOP      3328
#define XB_TOPGEN   3392
#define XCD_BAR_WORDS 3456
#define XB_SPIN_CAP (1u << 18)
__device__ __forceinline__ unsigned xb_ld(unsigned* p)              { return __hip_atomic_load(p, __ATOMIC_RELAXED, __HIP_MEMORY_SCOPE_AGENT); }
__device__ __forceinline__ unsigned xb_add(unsigned* p, unsigned v) { return __hip_atomic_fetch_add(p, v, __ATOMIC_RELAXED, __HIP_MEMORY_SCOPE_AGENT); }
__device__ __forceinline__ unsigned xb_xcc_id() { return (unsigned)__builtin_amdgcn_s_getreg((3 << 11) | 20) & 0xFu; }
#define XB_SPIN(cond, bar) do { unsigned _sp = 0; while (cond) { __builtin_amdgcn_s_sleep(1); \
    if ((++_sp & 255u) == 0u) { if (xb_ld(&(bar)[XB_TMO])) break; if (_sp > XB_SPIN_CAP) { atomicAdd(&(bar)[XB_TMO], 1u); break; } } } } while (0)
struct XcdBarrier { unsigned* bar; unsigned x; volatile LAS unsigned* st; };
__device__ __forceinline__ XcdBarrier xcd_barrier_post(unsigned* bar, volatile LAS unsigned* st) {
    XcdBarrier b; b.bar = bar; b.x = xb_xcc_id(); b.st = st;
    if (tid_opaque() == 0) (void)xb_add(&bar[XB_XCNT(b.x)], 1u);
    return b;
}
__device__ __forceinline__ void xcd_barrier_complete(unsigned* bar, unsigned x, unsigned& nloc, unsigned& nx) {
    const unsigned G = gridDim.x * gridDim.y * gridDim.z;
    unsigned sum, cnt, mine, sp = 0u;
    for (;;) {
        sum = 0u; cnt = 0u; mine = 0u;
#pragma unroll
        for (unsigned j = 0; j < 16; ++j) { const unsigned c = xb_ld(&bar[XB_XCNT(j)]); sum += c; cnt += (c > 0u) ? 1u : 0u; mine = (j == x) ? c : mine; }
        if (sum == G) break;
        __builtin_amdgcn_s_sleep(1);
        if ((++sp & 255u) == 0u) { if (xb_ld(&bar[XB_TMO])) break; if (sp > XB_SPIN_CAP) { atomicAdd(&bar[XB_TMO], 1u); break; } }
    }
    nloc = mine > 0u ? mine : 1u; nx = cnt > 0u ? cnt : 1u;
}
struct NoShadow { __device__ __forceinline__ void operator()() const {} };
template <class Shadow = NoShadow>
__device__ __forceinline__ void xcd_barrier(const XcdBarrier& b, const Shadow& shadow = Shadow()) {
    asm volatile("s_waitcnt vmcnt(0)" ::: "memory");
    __syncthreads();
    const int tid_ = tid_opaque();
    if (tid_ >= 64) { shadow(); }
    else if (tid_ == 0) {
        unsigned* bar = b.bar;
        __builtin_amdgcn_s_waitcnt(0);
        unsigned nloc = b.st[0], nx = b.st[1];
        if (nloc == 0u) { xcd_barrier_complete(bar, b.x, nloc, nx); b.st[0] = nloc; b.st[1] = nx; }
        const unsigned old = xb_add(&bar[XB_XSUB(b.x)], 1u);
        const unsigned gen = old / nloc;
        if (old + 1u == (gen + 1u) * nloc) {
            __builtin_amdgcn_fence(__ATOMIC_RELEASE, "agent");
            asm volatile("s_waitcnt vmcnt(0)" ::: "memory");
            const unsigned og = xb_add(&bar[XB_TOP], 1u);
            const unsigned tg = og / nx;
            if (og + 1u == (tg + 1u) * nx) xb_add(&bar[XB_TOPGEN], 1u);
            else XB_SPIN(xb_ld(&bar[XB_TOPGEN]) == tg, bar);
            __builtin_amdgcn_fence(__ATOMIC_ACQUIRE, "agent");
            asm volatile("s_waitcnt vmcnt(0)" ::: "memory");
        } else {
            XB_SPIN(xb_ld(&bar[XB_TOPGEN]) == gen, bar);
            __builtin_amdgcn_fence(__ATOMIC_ACQUIRE, "agent");
            asm volatile("s_waitcnt vmcnt(0)" ::: "memory");
        }
    }
    __syncthreads();
}

struct Frame {
    LAS unsigned char* lds;
    volatile LAS unsigned* MISC;
    gu32* ctl;
    int tid, lane, wave, vcu, G;
    const float *x, *c, *w_ada, *b_ada, *norm_mix_g, *w_in, *b_forget, *w_out_fox, *lambda_re, *lambda_im, *log_dt, *b_re, *b_im, *c_re, *c_im, *d_skip, *w_glu, *w_out_ssm, *w_o,
        *norm_ffn_g, *w_rg, *b_rg, *w_rexp, *b_rexp, *w_gate, *w_up, *w_down, *final_g;
    float* out;
    float *MOD, *LOGF, *CUM, *RW, *LISTW; int* ROUTE; unsigned* LIST; unsigned* CUMP;
    bf16 *WIN, *WGLU, *WOF, *WOS, *WO, *WGU, *WD, *H, *Y, *Q, *K, *V, *U, *SGA, *SGB, *HID, *YROWS, *X1B;
};

template <int CTRL, int RMASK> __device__ __forceinline__ float dpp_addstep(float v) {
    return v + __builtin_bit_cast(float, __builtin_amdgcn_update_dpp(0, __builtin_bit_cast(int, v), CTRL, RMASK, 0xf, false));
}
__device__ __forceinline__ float wave_sum(float v) {
    v = dpp_addstep<0x111, 0xf>(v); v = dpp_addstep<0x112, 0xf>(v); v = dpp_addstep<0x114, 0xf>(v); v = dpp_addstep<0x118, 0xf>(v);
    v = dpp_addstep<0x142, 0xa>(v); v = dpp_addstep<0x143, 0xc>(v);
    return __builtin_bit_cast(float, __builtin_amdgcn_readlane(__builtin_bit_cast(int, v), 63));
}

__device__ __forceinline__ unsigned pk4_fp8(float a, float b, float c, float d) {
    a = __builtin_amdgcn_fmed3f(a, -448.f, 448.f); b = __builtin_amdgcn_fmed3f(b, -448.f, 448.f); c = __builtin_amdgcn_fmed3f(c, -448.f, 448.f); d = __builtin_amdgcn_fmed3f(d, -448.f, 448.f);
    int r = __builtin_amdgcn_cvt_pk_fp8_f32(a, b, 0, false); r = __builtin_amdgcn_cvt_pk_fp8_f32(c, d, r, true); return (unsigned)r;
}
constexpr float FP8_GW = 256.f, FP8_GH = 16.f;
constexpr float FP8_WSCALE = 32.f, FP8_HSCALE = 4.f, FP8_YSCALE = 8.f;
constexpr int TR_LD = 65, TR_WAVE_BYTES = 64 * TR_LD * 4;
__device__ __forceinline__ void transpose_item(const float* src, int ld_src, bf16* dst, int ld_dst, LAS float* scr, int lane) {
    f32x4 v[16];
    const int kr = lane >> 4, n4 = (lane & 15) * 4;
#pragma unroll
    for (int i = 0; i < 16; ++i) v[i] = __builtin_nontemporal_load((const GAS f32x4*)(src + (size_t)(4 * i + kr) * ld_src + n4));
#pragma unroll
    for (int i = 0; i < 16; ++i) { const int kk = 4 * i + kr; scr[(n4 + 0) * TR_LD + kk] = v[i].x; scr[(n4 + 1) * TR_LD + kk] = v[i].y; scr[(n4 + 2) * TR_LD + kk] = v[i].z; scr[(n4 + 3) * TR_LD + kk] = v[i].w; }
    LDS_WAIT(); asm volatile("" ::: "memory");
    const int c = lane & 7;
#pragma unroll
    for (int j = 0; j < 8; ++j) { const int n = (lane >> 3) + 8 * j; const LAS float* s = scr + n * TR_LD + 8 * c;
        v4u o; o.x = pk2(s[0], s[1]); o.y = pk2(s[2], s[3]); o.z = pk2(s[4], s[5]); o.w = pk2(s[6], s[7]);
        *(GAS v4u*)(dst + (size_t)n * ld_dst + 8 * c) = o; }
    LDS_WAIT(); asm volatile("" ::: "memory");
}

__device__ __forceinline__ void transpose_item_fp8(const float* src, int ld_src, unsigned char* dst, int ld_dst, LAS float* scr, int lane, float scale) {
    f32x4 v[16];
    const int kr = lane >> 4, n4 = (lane & 15) * 4;
#pragma unroll
    for (int i = 0; i < 16; ++i) v[i] = __builtin_nontemporal_load((const GAS f32x4*)(src + (size_t)(4 * i + kr) * ld_src + n4));
#pragma unroll
    for (int i = 0; i < 16; ++i) { const int kk = 4 * i + kr; scr[(n4 + 0) * TR_LD + kk] = v[i].x; scr[(n4 + 1) * TR_LD + kk] = v[i].y; scr[(n4 + 2) * TR_LD + kk] = v[i].z; scr[(n4 + 3) * TR_LD + kk] = v[i].w; }
    LDS_WAIT(); asm volatile("" ::: "memory");
    const int c = lane & 7;
#pragma unroll
    for (int j = 0; j < 8; ++j) { const int n = (lane >> 3) + 8 * j; const LAS float* s = scr + n * TR_LD + 8 * c;
        v2u o; o.x = pk4_fp8(s[0] * scale, s[1] * scale, s[2] * scale, s[3] * scale); o.y = pk4_fp8(s[4] * scale, s[5] * scale, s[6] * scale, s[7] * scale);
        *(GAS v2u*)(dst + (size_t)n * ld_dst + 8 * c) = o; }
    LDS_WAIT(); asm volatile("" ::: "memory");
}
__device__ __forceinline__ void p0_mod(Frame& F) {
    {
        int nmine = 0;
        LAS float* cact = (LAS float*)(F.lds);
        LAS float* red = (LAS float*)(F.lds + 32768);
        for (int i = F.tid; i < 8192; i += 512) { const float v = F.c[i]; cact[i] = v / (1.f + __expf(-v)); }
        __syncthreads();
        for (int it = F.vcu; it < 192; it += F.G) {
            const int cl = F.lane & 31, hf = F.lane >> 5, col = it * 32 + cl;
            float a[8];
#pragma unroll
            for (int b = 0; b < 8; ++b) a[b] = 0.f;
#pragma unroll 1
            for (int i0 = 0; i0 < 64; i0 += 16) {
                float w[16];
#pragma unroll
                for (int i = 0; i < 16; ++i) w[i] = __builtin_nontemporal_load(F.w_ada + (size_t)(16 * (i0 + i) + 2 * F.wave + hf) * 6144 + col);
#pragma unroll
                for (int i = 0; i < 16; ++i) { const int kk = 16 * (i0 + i) + 2 * F.wave + hf;
#pragma unroll
                    for (int b = 0; b < 8; ++b) a[b] += cact[b * 1024 + kk] * w[i]; }
            }
#pragma unroll
            for (int b = 0; b < 8; ++b) { a[b] += __shfl_xor(a[b], 32); if (hf == 0) red[(F.wave * 8 + b) * 32 + cl] = a[b]; }
            __syncthreads();
            if (F.tid < 256) { const int b = F.tid >> 5, c2 = F.tid & 31; float s = 0.f;
#pragma unroll
                for (int w = 0; w < 8; ++w) s += red[(w * 8 + b) * 32 + c2];
                F.MOD[b * 6144 + it * 32 + c2] = s + F.b_ada[it * 32 + c2]; }
            __syncthreads(); ++nmine;
        }
        asm volatile("s_waitcnt vmcnt(0)" ::: "memory"); __syncthreads();
        if (F.tid == 0 && nmine > 0) { __builtin_amdgcn_fence(__ATOMIC_RELEASE, "agent"); asm volatile("s_waitcnt vmcnt(0)" ::: "memory");
            __hip_atomic_fetch_add((unsigned*)(F.ctl + CW_MOD), (unsigned)nmine, RLX_AGENT); }
        __syncthreads();
    }
}
__device__ __forceinline__ void p0_copies(Frame& F, int wg_rank, int n_wg) {
    LAS float* scr = (LAS float*)(F.lds + RING_OFF + F.wave * TR_WAVE_BYTES);
    const int gw = wg_rank * NWAVES + F.wave, NGW = n_wg * NWAVES;
    constexpr int I_A = 16 * 24, I_B = 16 * 40, I_C = 8 * 16, I_D = 8 * 16, I_E = 8 * 16, I_F = 16 * 16, I_G = 32 * 128, I_H = 32 * 128, I_I = 32 * 128;
    constexpr int NITEMS = I_A + I_B + I_C + I_D + I_E + I_F;
    for (int it = gw; it < NITEMS; it += NGW) {
        int r = it;
        if (r < I_A) { const int kb = r / 24, nb = r % 24; transpose_item(F.w_in + (size_t)(64 * kb) * INC + 64 * nb, INC, F.WIN + (size_t)(64 * nb) * 1024 + 64 * kb, 1024, scr, F.lane); continue; } r -= I_A;
        if (r < I_B) { const int kb = r / 40, nb = r % 40;
            if (nb < 8) transpose_item(F.w_in + (size_t)(64 * kb) * INC + 1544 + 64 * nb, INC, F.WIN + (size_t)(1536 + 64 * nb) * 1024 + 64 * kb, 1024, scr, F.lane);
            else transpose_item_fp8(F.w_in + (size_t)(64 * kb) * INC + 1544 + 64 * nb, INC, (unsigned char*)(F.WIN + (size_t)2048 * 1024) + (size_t)(64 * (nb - 8)) * 1024 + 64 * kb, 1024, scr, F.lane, FP8_GW);
            continue; } r -= I_B;
        if (r < I_C) { const int kb = r / 16, nb = r % 16, n0 = 64 * nb, half = n0 >> 9, within = n0 & 511, pn = within >> 7, q = within & 127;
            transpose_item(F.w_glu + (size_t)(64 * kb) * 1024 + n0, 1024, F.WGLU + (size_t)(pn * 256 + half * 128 + q) * 512 + 64 * kb, 512, scr, F.lane); continue; } r -= I_C;
        if (r < I_D) { const int kb = r / 16, nb = r % 16; transpose_item(F.w_out_fox + (size_t)(64 * kb) * 1024 + 64 * nb, 1024, F.WOF + (size_t)(64 * nb) * 512 + 64 * kb, 512, scr, F.lane); continue; } r -= I_D;
        if (r < I_E) { const int kb = r / 16, nb = r % 16; transpose_item(F.w_out_ssm + (size_t)(64 * kb) * 1024 + 64 * nb, 1024, F.WOS + (size_t)(64 * nb) * 512 + 64 * kb, 512, scr, F.lane); continue; } r -= I_E;
        if (r < I_F) { const int kb = r / 16, nb = r % 16; transpose_item(F.w_o + (size_t)(64 * kb) * 1024 + 64 * nb, 1024, F.WO + (size_t)(64 * nb) * 1024 + 64 * kb, 1024, scr, F.lane); continue; } r -= I_F;
    }
}
struct ShadowGateUp {
    const float* w_gate; const float* w_up; bf16* WGU; LAS unsigned char* lds; int seam, wg;
    __device__ __forceinline__ void operator()() const {
        const int tid_ = tid_opaque(); const int wave = __builtin_amdgcn_readfirstlane(tid_ >> 6), lane = tid_ & 63;
        const int kq = wg * 7 + (wave - 1); int r = 6 * kq + (seam - 1);
        if (r >= 8192) return;
        LAS float* scr = (LAS float*)(lds + RING_OFF + wave * TR_WAVE_BYTES);
        const int up = r >= 4096; if (up) r -= 4096; const int e = r >> 7, rr = r & 127, kb = rr >> 3, nb = rr & 7, n0 = 64 * nb, pn = n0 >> 7, q = n0 & 127;
        const float* src = (up ? w_up : w_gate) + (size_t)e * 1024 * 512 + (size_t)(64 * kb) * 512 + n0;
        transpose_item_fp8(src, 512, (unsigned char*)WGU + (size_t)e * 1024 * 1024 + (size_t)(pn * 256 + up * 128 + q) * 1024 + 64 * kb, 1024, scr, lane, FP8_WSCALE);
    }
};
__device__ __forceinline__ void convert_wdown(Frame& F, int wg_lo) {
    LAS float* scr = (LAS float*)(F.lds + RING_OFF + F.wave * TR_WAVE_BYTES);
    const int lo = (wg_lo >= F.G || wg_lo < 0) ? 0 : wg_lo; const int bx = F.vcu;
    if (bx < lo) return;
    const int gw = (bx - lo) * NWAVES + F.wave, NGW = (F.G - lo) * NWAVES;
    for (int r = gw; r < 32 * 128; r += NGW) { const int e = r >> 7, rr = r & 127, kb = rr >> 4, nb = rr & 15;
        transpose_item_fp8(F.w_down + (size_t)e * 512 * 1024 + (size_t)(64 * kb) * 1024 + 64 * nb, 1024, (unsigned char*)F.WD + (size_t)e * 1024 * 512 + (size_t)(64 * nb) * 512 + 64 * kb, 512, scr, F.lane, FP8_WSCALE); }
}

__device__ __forceinline__ void p1_rows(Frame& F) {
    LAS float* wfT = (LAS float*)(F.lds);
    for (int idx = F.tid; idx < 8192; idx += 512) { const int k = idx >> 3, j = idx & 7; wfT[j * 1024 + k] = F.w_in[(size_t)k * INC + 1536 + j]; }
    __syncthreads();
    const int gw = F.vcu * NWAVES + F.wave, NGW = F.G * NWAVES;
    for (int ch = gw; ch < M / 8; ch += NGW) {
        const int b = (ch * 8) / SEQ;
        const float* mod = F.MOD + b * 6144;
        f32x4 es[4], sh[4];
#pragma unroll
        for (int j = 0; j < 4; ++j) { const int c = 4 * F.lane + 256 * j; const f32x4 g4 = *(const f32x4*)(F.norm_mix_g + c), sc = *(const f32x4*)(mod + 1024 + c); es[j] = g4 * (sc + 1.f); sh[j] = *(const f32x4*)(mod + c); }
#pragma unroll 1
        for (int rb = 0; rb < 8; rb += 4) {
            f32x4 v[4][4];
#pragma unroll
            for (int r = 0; r < 4; ++r) { const GAS f32x4* xr = (const GAS f32x4*)(F.x + (size_t)(ch * 8 + rb + r) * D) + F.lane;
#pragma unroll
                for (int j = 0; j < 4; ++j) v[r][j] = __builtin_nontemporal_load(xr + 64 * j); }
            float ss[4];
#pragma unroll
            for (int r = 0; r < 4; ++r) { float s = 0.f;
#pragma unroll
                for (int j = 0; j < 4; ++j) s += (v[r][j].x * v[r][j].x + v[r][j].y * v[r][j].y) + (v[r][j].z * v[r][j].z + v[r][j].w * v[r][j].w);
                ss[r] = s; }
#pragma unroll
            for (int r = 0; r < 4; ++r) ss[r] = wave_sum(ss[r]);
#pragma unroll
            for (int r = 0; r < 4; ++r) { const int m = ch * 8 + rb + r;
                const float rstd = __builtin_amdgcn_rsqf(ss[r] * (1.f / D) + RMS_EPS);
                GAS v2u* o8 = (GAS v2u*)(F.H + (size_t)m * D) + F.lane;
#pragma unroll
                for (int j = 0; j < 4; ++j) { v[r][j] = v[r][j] * rstd * es[j] + sh[j]; v2u w; w.x = pk2(v[r][j].x, v[r][j].y); w.y = pk2(v[r][j].z, v[r][j].w); o8[64 * j] = w;
                    ((GAS unsigned*)((unsigned char*)F.WD + (size_t)m * D) + F.lane)[64 * j] = pk4_fp8(v[r][j].x * FP8_GH, v[r][j].y * FP8_GH, v[r][j].z * FP8_GH, v[r][j].w * FP8_GH); }
                float f[8];
#pragma unroll
                for (int jj = 0; jj < 8; ++jj) { f32x4 a4 = (f32x4){0.f, 0.f, 0.f, 0.f};
#pragma unroll
                    for (int j = 0; j < 4; ++j) a4 += v[r][j] * *(const LAS f32x4*)(wfT + jj * 1024 + 4 * F.lane + 256 * j);
                    f[jj] = (a4.x + a4.y) + (a4.z + a4.w); if (jj & 1) __builtin_amdgcn_sched_barrier(0); }
                { const bool h5 = (F.lane & 32) != 0, h4 = (F.lane & 16) != 0, h3 = (F.lane & 8) != 0;
                  float k4[4], k2[2];
#pragma unroll
                  for (int i = 0; i < 4; ++i) { const float keep = h5 ? f[i + 4] : f[i], send = h5 ? f[i] : f[i + 4]; k4[i] = keep + __shfl_xor(send, 32); }
#pragma unroll
                  for (int i = 0; i < 2; ++i) { const float keep = h4 ? k4[i + 2] : k4[i], send = h4 ? k4[i] : k4[i + 2]; k2[i] = keep + __shfl_xor(send, 16); }
                  float z = (h3 ? k2[1] : k2[0]) + __shfl_xor(h3 ? k2[0] : k2[1], 8);
                  z += __shfl_xor(z, 4); z += __shfl_xor(z, 2); z += __shfl_xor(z, 1);
                  if ((F.lane & 7) == 0) { const int jj = F.lane >> 3; z += F.b_forget[jj];
                      F.LOGF[(size_t)m * 8 + jj] = fminf(z, 0.f) - __logf(1.f + __expf(-fabsf(z))); } }
            }
        }
    }
}

__device__ __forceinline__ void p2_cumscan(Frame& F) {
    const int gw = F.wave * F.G + F.vcu, NGW = F.G * NWAVES;
    for (int u = gw; u < NB * NH; u += NGW) {
        const int b = u >> 3, h = u & 7;
        float v[32]; float run = 0.f;
#pragma unroll
        for (int i = 0; i < 32; ++i) { run += F.LOGF[((size_t)b * SEQ + 32 * F.lane + i) * 8 + h]; v[i] = run; }
        float incl = run;
#pragma unroll
        for (int o = 1; o < 64; o <<= 1) { const float t = __shfl_up(incl, o); if (F.lane >= o) incl += t; }
        const float excl = incl - run;
#pragma unroll
        for (int i = 0; i < 32; ++i) { const float cv = v[i] + excl; F.CUM[(size_t)u * SEQ + 32 * F.lane + i] = cv;
            const float nb = -cv * LOG2E; const unsigned hb = f2bf(nb); const float lo = nb - __uint_as_float(hb << 16); F.CUMP[(size_t)u * SEQ + 32 * F.lane + i] = hb | (f2bf(lo) << 16); }
    }
}

using pg8::Unit;
struct EpiInProj {
    static constexpr bool PERM = true;
    bf16* mix; float gs = 1.f;
    __device__ __forceinline__ void operator()(const f32x4 (&acc)[2][2][4][2], const Unit& u, int wr, int wc, int fr, int fq) const {
        const int pn = u.pn; bf16* base; int ldc, colt, mode;
        if (pn < 8) { base = mix + (size_t)(pn >> 1) * ((size_t)M * 512); ldc = 512; colt = (pn & 1) * 256; mode = pn < 2 ? 1 : 0; }
        else { const int g = (pn - 8) >> 2; base = mix + (size_t)4 * M * 512 + (size_t)g * ((size_t)M * 1024); ldc = 1024; colt = ((pn - 8) & 3) * 256; mode = 2; }
        const int row0 = u.pm * 256 + wr * 64 + fr, col0 = colt + wc * 32 + 8 * fq;
#pragma unroll
        for (int ai = 0; ai < 2; ++ai)
#pragma unroll
            for (int m = 0; m < 4; ++m) { bf16* rowp = base + (size_t)(row0 + ai * 128 + m * 16) * ldc + col0;
#pragma unroll
                for (int bj = 0; bj < 2; ++bj) { f32x4 v0 = acc[ai][bj][m][0], v1 = acc[ai][bj][m][1];
                    if (mode == 1) { v0 = v0 * QSCALE; v1 = v1 * QSCALE; }
                    else if (mode == 2) {
#pragma unroll
                        for (int e = 0; e < 4; ++e) { v0[e] = fast_sigmoid(v0[e] * gs); v1[e] = fast_sigmoid(v1[e] * gs); } }
                    v4u w; w.x = pg8::cvt_pk_bf16(v0[0], v0[1]); w.y = pg8::cvt_pk_bf16(v0[2], v0[3]); w.z = pg8::cvt_pk_bf16(v1[0], v1[1]); w.w = pg8::cvt_pk_bf16(v1[2], v1[3]);
                    if ((pn >> 1) == 3) { const int col = col0 + bj * 128; *(v4u*)(base + ((size_t)(col >> 4) * M + (row0 + ai * 128 + m * 16)) * 16 + (col & 15)) = w; }
                    else *(v4u*)(rowp + bj * 128) = w; } }
    }
};
template <int MODE> struct EpiGate {
    static constexpr bool PERM = true;
    bf16* T; const bf16* Gt;
    __device__ __forceinline__ void operator()(const f32x4 (&acc)[2][2][4][2], const Unit& u, int wr, int wc, int fr, int fq) const {
        const int row0 = u.pm * 256 + wr * 64 + fr, col0 = u.pn * 256 + wc * 32 + 8 * fq;
#pragma unroll
        for (int ai = 0; ai < 2; ++ai)
#pragma unroll
            for (int m = 0; m < 4; ++m) { const size_t off = (size_t)(row0 + ai * 128 + m * 16) * 1024 + col0;
#pragma unroll
                for (int bj = 0; bj < 2; ++bj) { const f32x4 v0 = acc[ai][bj][m][0], v1 = acc[ai][bj][m][1];
                    const v4u t = *(const v4u*)(T + off + bj * 128); v4u w;
                    if (MODE == 0) {
                        w.x = pg8::cvt_pk_bf16(bflo(t.x) * v0[0], bfhi(t.x) * v0[1]); w.y = pg8::cvt_pk_bf16(bflo(t.y) * v0[2], bfhi(t.y) * v0[3]);
                        w.z = pg8::cvt_pk_bf16(bflo(t.z) * v1[0], bfhi(t.z) * v1[1]); w.w = pg8::cvt_pk_bf16(bflo(t.w) * v1[2], bfhi(t.w) * v1[3]);
                    } else {
                        const v4u gg = *(const v4u*)(Gt + off + bj * 128);
                        w.x = pg8::cvt_pk_bf16(bflo(t.x) + bflo(gg.x) * v0[0], bfhi(t.x) + bfhi(gg.x) * v0[1]); w.y = pg8::cvt_pk_bf16(bflo(t.y) + bflo(gg.y) * v0[2], bfhi(t.y) + bfhi(gg.y) * v0[3]);
                        w.z = pg8::cvt_pk_bf16(bflo(t.z) + bflo(gg.z) * v1[0], bfhi(t.z) + bfhi(gg.z) * v1[1]); w.w = pg8::cvt_pk_bf16(bflo(t.w) + bflo(gg.w) * v1[2], bfhi(t.w) + bfhi(gg.w) * v1[3]);
                    }
                    *(v4u*)(T + off + bj * 128) = w; } }
    }
};
struct EpiGate2 {
    static constexpr bool PERM = true;
    EpiGate<0> e0; EpiGate<1> e1;
    __device__ __forceinline__ void operator()(const f32x4 (&acc)[2][2][4][2], const Unit& u, int wr, int wc, int fr, int fq) const { if (u.e == 0) e0(acc, u, wr, wc, fr, fq); else e1(acc, u, wr, wc, fr, fq); }
};
struct EpiGateChain {
    static constexpr bool PERM = true, CHAIN = true;
    bf16* T; const bf16* Gt;
    __device__ __forceinline__ void chain(f32x4 (&acc)[2][2][4][2], const Unit& u, int wr, int wc, int fr, int fq) const {
        const int row0 = u.pm * 256 + wr * 64 + fr, col0 = u.pn * 256 + wc * 32 + 8 * fq;
        if (u.e == 0) {
#pragma unroll
            for (int ai = 0; ai < 2; ++ai)
#pragma unroll
                for (int m = 0; m < 4; ++m) { const size_t off = (size_t)(row0 + ai * 128 + m * 16) * 1024 + col0;
#pragma unroll
                    for (int bj = 0; bj < 2; ++bj) { const v4u t = *(const v4u*)(T + off + bj * 128), gg = *(const v4u*)(Gt + off + bj * 128);
                        f32x4& v0 = acc[ai][bj][m][0]; f32x4& v1 = acc[ai][bj][m][1];
                        v0[0] *= bflo(t.x) * __builtin_amdgcn_rcpf(bflo(gg.x)); v0[1] *= bfhi(t.x) * __builtin_amdgcn_rcpf(bfhi(gg.x)); v0[2] *= bflo(t.y) * __builtin_amdgcn_rcpf(bflo(gg.y)); v0[3] *= bfhi(t.y) * __builtin_amdgcn_rcpf(bfhi(gg.y));
                        v1[0] *= bflo(t.z) * __builtin_amdgcn_rcpf(bflo(gg.z)); v1[1] *= bfhi(t.z) * __builtin_amdgcn_rcpf(bfhi(gg.z)); v1[2] *= bflo(t.w) * __builtin_amdgcn_rcpf(bflo(gg.w)); v1[3] *= bfhi(t.w) * __builtin_amdgcn_rcpf(bfhi(gg.w)); } }
        } else {
#pragma unroll
            for (int ai = 0; ai < 2; ++ai)
#pragma unroll
                for (int m = 0; m < 4; ++m) { const size_t off = (size_t)(row0 + ai * 128 + m * 16) * 1024 + col0;
#pragma unroll
                    for (int bj = 0; bj < 2; ++bj) { const v4u gg = *(const v4u*)(Gt + off + bj * 128); const f32x4 v0 = acc[ai][bj][m][0], v1 = acc[ai][bj][m][1]; v4u w;
                        w.x = pg8::cvt_pk_bf16(bflo(gg.x) * v0[0], bfhi(gg.x) * v0[1]); w.y = pg8::cvt_pk_bf16(bflo(gg.y) * v0[2], bfhi(gg.y) * v0[3]);
                        w.z = pg8::cvt_pk_bf16(bflo(gg.z) * v1[0], bfhi(gg.z) * v1[1]); w.w = pg8::cvt_pk_bf16(bflo(gg.w) * v1[2], bfhi(gg.w) * v1[3]);
                        *(v4u*)(T + off + bj * 128) = w; } }
        }
    }
};
template <int MODE> struct EpiPair {
    static constexpr bool PERM = true;
    bf16* O;
    __device__ __forceinline__ void operator()(const f32x4 (&acc)[2][2][4][2], const Unit& u, int wr, int wc, int fr, int fq) const {
        const int row0 = u.pm * 256 + wr * 64 + fr, col0 = u.pn * 128 + wc * 32 + 8 * fq;
#pragma unroll
        for (int ai = 0; ai < 2; ++ai)
#pragma unroll
            for (int m = 0; m < 4; ++m) { f32x4 r0, r1;
#pragma unroll
                for (int e = 0; e < 4; ++e) {
                    if (MODE == 0) { r0[e] = acc[ai][0][m][0][e] * fast_sigmoid(acc[ai][1][m][0][e]); r1[e] = acc[ai][0][m][1][e] * fast_sigmoid(acc[ai][1][m][1][e]); }
                    else { const float g0 = acc[ai][0][m][0][e], g1 = acc[ai][0][m][1][e]; r0[e] = g0 * fast_sigmoid(g0) * acc[ai][1][m][0][e]; r1[e] = g1 * fast_sigmoid(g1) * acc[ai][1][m][1][e]; } }
                v4u w; w.x = pg8::cvt_pk_bf16(r0[0], r0[1]); w.y = pg8::cvt_pk_bf16(r0[2], r0[3]); w.z = pg8::cvt_pk_bf16(r1[0], r1[1]); w.w = pg8::cvt_pk_bf16(r1[2], r1[3]);
                *(v4u*)(O + (size_t)(row0 + ai * 128 + m * 16) * 512 + col0) = w; }
    }
};
struct EpiResid {
    static constexpr bool PERM = true;
    const float* x; bf16* out; const float* mod;
    __device__ __forceinline__ void operator()(const f32x4 (&acc)[2][2][4][2], const Unit& u, int wr, int wc, int fr, int fq) const {
        const int row0 = u.pm * 256 + wr * 64 + fr, col0 = u.pn * 256 + wc * 32 + 8 * fq;
        const int b = (u.pm * 256) / SEQ;
        f32x4 gv[2][2];
#pragma unroll
        for (int bj = 0; bj < 2; ++bj)
#pragma unroll
            for (int n = 0; n < 2; ++n) gv[bj][n] = *(const f32x4*)(mod + (size_t)b * 6144 + 2048 + col0 + bj * 128 + n * 4);
#pragma unroll
        for (int ai = 0; ai < 2; ++ai)
#pragma unroll
            for (int m = 0; m < 4; ++m) { const size_t off = (size_t)(row0 + ai * 128 + m * 16) * 1024 + col0;
#pragma unroll
                for (int bj = 0; bj < 2; ++bj) { const f32x4 x0 = *(const f32x4*)(x + off + bj * 128), x1 = *(const f32x4*)(x + off + bj * 128 + 4);
                    const f32x4 r0 = x0 + gv[bj][0] * acc[ai][bj][m][0], r1 = x1 + gv[bj][1] * acc[ai][bj][m][1];
                    v4u w; w.x = pg8::cvt_pk_bf16(r0[0], r0[1]); w.y = pg8::cvt_pk_bf16(r0[2], r0[3]); w.z = pg8::cvt_pk_bf16(r1[0], r1[1]); w.w = pg8::cvt_pk_bf16(r1[2], r1[3]);
                    *(v4u*)(out + off + bj * 128) = w; } }
    }
};
struct EpiSwiGLU8 {
    static constexpr bool PERM = true;
    unsigned char* O;
    __device__ __forceinline__ void operator()(const f32x4 (&acc)[2][2][4][2], const Unit& u, int wr, int wc, int fr, int fq) const {
        const int row0 = u.pm * 256 + wr * 64 + fr, col0 = u.pn * 128 + wc * 32 + 8 * fq; constexpr float inv = 1.f / FP8_WSCALE;
#pragma unroll
        for (int ai = 0; ai < 2; ++ai)
#pragma unroll
            for (int m = 0; m < 4; ++m) { f32x4 r0, r1;
#pragma unroll
                for (int e = 0; e < 4; ++e) { const float g0 = acc[ai][0][m][0][e] * inv, g1 = acc[ai][0][m][1][e] * inv;
                    r0[e] = g0 * fast_sigmoid(g0) * acc[ai][1][m][0][e] * (inv * FP8_HSCALE); r1[e] = g1 * fast_sigmoid(g1) * acc[ai][1][m][1][e] * (inv * FP8_HSCALE); }
                v2u w; w.x = pk4_fp8(r0[0], r0[1], r0[2], r0[3]); w.y = pk4_fp8(r1[0], r1[1], r1[2], r1[3]);
                *(v2u*)(O + (size_t)(row0 + ai * 128 + m * 16) * 512 + col0) = w; }
    }
};
struct EpiDown {
    static constexpr bool PERM = true;
    bf16* Y;
    __device__ __forceinline__ void operator()(const f32x4 (&acc)[2][2][4][2], const Unit& u, int wr, int wc, int fr, int fq) const {
        const int col0 = u.pn * 256 + wc * 32 + 8 * fq; constexpr float sc = FP8_YSCALE / (FP8_WSCALE * FP8_HSCALE);
#pragma unroll
        for (int ai = 0; ai < 2; ++ai)
#pragma unroll
            for (int m = 0; m < 4; ++m) { const int r = ai * 128 + wr * 64 + m * 16 + fr; unsigned char* rowp = (unsigned char*)Y + (size_t)(u.pm * 256 + r) * 1024 + col0;
#pragma unroll
                for (int bj = 0; bj < 2; ++bj) { const f32x4 v0 = acc[ai][bj][m][0] * sc, v1 = acc[ai][bj][m][1] * sc;
                    v2u w; w.x = pk4_fp8(v0[0], v0[1], v0[2], v0[3]); w.y = pk4_fp8(v1[0], v1[1], v1[2], v1[3]);
                    *(v2u*)(rowp + bj * 128) = w; } }
    }
};

template <bool GATHER_> struct MoeOrder {
    static constexpr bool GATHER = GATHER_, FP8 = true;
    int G, c, nunits; const LAS int* tab; const unsigned* list; size_t estride; int bK;
    __device__ __forceinline__ bool next(int i, Unit& u) const {
        const int L = i * G + c; if (L >= nunits) return false;
        const int mt = L >> 2; u.pn = L & 3; int e = 0;
        while (e < NE - 1 && mt >= tab[e + 1]) ++e;
        const int j = mt - tab[e]; u.e = e; u.pm = mt; u.lbase = e * CAP + j * 256; const int left = tab[33 + e] - j * 256; u.rows = left < 256 ? left : 256; return true;
    }
    __device__ __forceinline__ size_t a_base(const Unit& u, int K) const { return GATHER ? (size_t)0 : (size_t)u.pm * 256 * K * 2; }
    __device__ __forceinline__ size_t b_base(const Unit& u, int K) const { return (size_t)u.e * estride + (size_t)u.pn * 256 * K * 2; }
    __device__ __forceinline__ void a_offsets(const Unit& u, const int* Rr, const int* Cc, int K, unsigned (&vo)[2][2]) const {
#pragma unroll
        for (int h = 0; h < 2; ++h)
#pragma unroll
            for (int i = 0; i < 2; ++i) { const int r = h * 128 + Rr[i]; const unsigned aid = list[u.lbase + (r < u.rows ? r : 0)]; vo[h][i] = (unsigned)((aid >> 1) * (unsigned)K + (unsigned)Cc[i]) * 2u; }
    }
};
__device__ __forceinline__ int moe_tables(Frame& F) {
    LAS int* tab = (LAS int*)(F.lds + MOE_OFF);
    if (F.tid < 64) {
        const int c = F.lane < NE ? (int)F.ctl[CW_CNT + 64 * (F.lane & 31)] : 0; const int t = (c + 255) >> 8;
        int incl = t;
#pragma unroll
        for (int o = 1; o < 32; o <<= 1) { const int u_ = __shfl_up(incl, o); if (F.lane >= o) incl += u_; }
        if (F.lane < NE) { tab[F.lane] = incl - t; tab[33 + F.lane] = c; }
        if (F.lane == NE - 1) tab[32] = incl; }
    __syncthreads();
    return tab[32];
}

__device__ __forceinline__ void attn_simple_unit(Frame& F, int b, int h, int qblk) {
    LAS bf16* Ks = (LAS bf16*)(F.lds);
    LAS bf16* Vs = (LAS bf16*)(F.lds + 8192);
    LAS float* cs = (LAS float*)(F.lds + 16384);
    const int q = qblk * 512 + F.tid;
    const size_t rowq = (size_t)b * SEQ + q;
    float qv[64], o[64];
    { const bf16* qp = F.Q + rowq * 512 + h * 64;
#pragma unroll
      for (int i = 0; i < 8; ++i) { const v4u w = *(const v4u*)(qp + 8 * i); qv[8 * i] = bflo(w.x); qv[8 * i + 1] = bfhi(w.x); qv[8 * i + 2] = bflo(w.y); qv[8 * i + 3] = bfhi(w.y); qv[8 * i + 4] = bflo(w.z); qv[8 * i + 5] = bfhi(w.z); qv[8 * i + 6] = bflo(w.w); qv[8 * i + 7] = bfhi(w.w); } }
#pragma unroll
    for (int d = 0; d < 64; ++d) o[d] = 0.f;
    float mrun = -INFINITY, l = 0.f;
    const int ntiles = (qblk * 512 + 512) / 64;
    const int wave_tile = (qblk * 512 + F.wave * 64) / 64;
    for (int kt = 0; kt < ntiles; ++kt) {
        __syncthreads();
        { const size_t krow = (size_t)b * SEQ + kt * 64 + (F.tid >> 3); const int ch = (F.tid & 7) * 8;
          *(LAS v4u*)(Ks + (F.tid >> 3) * 64 + ch) = *(const v4u*)(F.K + krow * 512 + h * 64 + ch);
          *(LAS v4u*)(Vs + (F.tid >> 3) * 64 + ch) = *(const v4u*)(F.V + krow * 512 + h * 64 + ch);
          if (F.tid < 64) cs[F.tid] = F.CUM[(size_t)(b * NH + h) * SEQ + kt * 64 + F.tid] * LOG2E; }
        __syncthreads();
        if (kt <= wave_tile) {
#pragma unroll 1
            for (int kk = 0; kk < 64; ++kk) {
                float dot = 0.f;
#pragma unroll
                for (int c8 = 0; c8 < 8; ++c8) { const v4u w = *(const LAS v4u*)(Ks + kk * 64 + c8 * 8);
                    dot += qv[8 * c8] * bflo(w.x) + qv[8 * c8 + 1] * bfhi(w.x) + qv[8 * c8 + 2] * bflo(w.y) + qv[8 * c8 + 3] * bfhi(w.y) + qv[8 * c8 + 4] * bflo(w.z) + qv[8 * c8 + 5] * bfhi(w.z) + qv[8 * c8 + 6] * bflo(w.w) + qv[8 * c8 + 7] * bfhi(w.w); }
                const float sc = (kt * 64 + kk > q) ? -INFINITY : dot - cs[kk];
                const float mnew = fmaxf(mrun, sc);
                const float corr = (mnew > -INFINITY) ? __builtin_amdgcn_exp2f(mrun - mnew) : 1.f;
                const float p = (mnew > -INFINITY) ? __builtin_amdgcn_exp2f(sc - mnew) : 0.f;
                l = l * corr + p;
#pragma unroll
                for (int c8 = 0; c8 < 8; ++c8) { const v4u w = *(const LAS v4u*)(Vs + kk * 64 + c8 * 8);
                    o[8 * c8] = o[8 * c8] * corr + p * bflo(w.x); o[8 * c8 + 1] = o[8 * c8 + 1] * corr + p * bfhi(w.x); o[8 * c8 + 2] = o[8 * c8 + 2] * corr + p * bflo(w.y); o[8 * c8 + 3] = o[8 * c8 + 3] * corr + p * bfhi(w.y);
                    o[8 * c8 + 4] = o[8 * c8 + 4] * corr + p * bflo(w.z); o[8 * c8 + 5] = o[8 * c8 + 5] * corr + p * bfhi(w.z); o[8 * c8 + 6] = o[8 * c8 + 6] * corr + p * bflo(w.w); o[8 * c8 + 7] = o[8 * c8 + 7] * corr + p * bfhi(w.w); }
                mrun = mnew;
            }
        }
    }
    const float inv = 1.f / l;
    bf16* op = F.Q + rowq * 512 + h * 64;
#pragma unroll
    for (int i = 0; i < 8; ++i) { v4u w; w.x = pk2(o[8 * i] * inv, o[8 * i + 1] * inv); w.y = pk2(o[8 * i + 2] * inv, o[8 * i + 3] * inv); w.z = pk2(o[8 * i + 4] * inv, o[8 * i + 5] * inv); w.w = pk2(o[8 * i + 6] * inv, o[8 * i + 7] * inv); *(v4u*)(op + 8 * i) = w; }
    __syncthreads();
}

__device__ __forceinline__ float gelu_tanh(float v) { const float t = 0.7978845608028654f * (v + 0.044715f * v * v * v); return 0.5f * v * (1.f + tanhf(t)); }
__device__ __forceinline__ void ssm_simple_unit(Frame& F, int b, int g, LAS unsigned char* wl) {
    const int p = F.lane;
    LAS f32x2* xs = (LAS f32x2*)wl;
    LAS float* Cp = (LAS float*)(wl + 33280);
#pragma unroll
    for (int c = 0; c < 16; ++c) { Cp[p * 32 + c] = F.c_re[(size_t)(g * 16 + c) * 64 + p]; Cp[p * 32 + 16 + c] = F.c_im[(size_t)(g * 16 + c) * 64 + p]; }
    const float dt = expf(F.log_dt[g]);
    const float lr = fminf(F.lambda_re[g * 64 + p], -1e-4f), li = F.lambda_im[g * 64 + p];
    const float mag = expf(lr * dt), ar = mag * cosf(li * dt), ai = mag * sinf(li * dt);
    const float den = lr * lr + li * li, nr = ar - 1.f;
    const float cor = (nr * lr + ai * li) / den, coi = (ai * lr - nr * li) / den;
    float bbr[16], bbi[16];
#pragma unroll
    for (int c = 0; c < 16; ++c) { const float br = F.b_re[(size_t)(g * 64 + p) * 16 + c], bi = F.b_im[(size_t)(g * 64 + p) * 16 + c]; bbr[c] = cor * br - coi * bi; bbi[c] = cor * bi + coi * br; }
    float dsk[16];
#pragma unroll
    for (int c = 0; c < 16; ++c) dsk[c] = F.d_skip[g * 16 + c];
    LDS_WAIT(); asm volatile("" ::: "memory");
    float xr = 0.f, xi = 0.f;
#if defined(SSM_CHECK)
    float chk_sq = 0.f;
#endif
    for (int t0 = 0; t0 < SEQ; t0 += 64) {
#pragma unroll 2
        for (int tt = 0; tt < 64; ++tt) {
            const bf16* up = F.U + ((size_t)g * M + (size_t)b * SEQ + t0 + tt) * 16;
            const v4u w0 = *(const v4u*)up, w1 = *(const v4u*)(up + 8);
            float uu[16] = {bflo(w0.x), bfhi(w0.x), bflo(w0.y), bfhi(w0.y), bflo(w0.z), bfhi(w0.z), bflo(w0.w), bfhi(w0.w), bflo(w1.x), bfhi(w1.x), bflo(w1.y), bfhi(w1.y), bflo(w1.z), bfhi(w1.z), bflo(w1.w), bfhi(w1.w)};
            float bur = 0.f, bui = 0.f;
#pragma unroll
            for (int c = 0; c < 16; ++c) { bur += bbr[c] * uu[c]; bui += bbi[c] * uu[c]; }
            const float n_r = ar * xr - ai * xi + bur, n_i = ar * xi + ai * xr + bui; xr = n_r; xi = n_i;
            xs[tt * 65 + p] = (f32x2){xr, xi};
        }
        LDS_WAIT(); asm volatile("" ::: "memory");
        float y[16];
#pragma unroll
        for (int c = 0; c < 16; ++c) y[c] = 0.f;
#pragma unroll 4
        for (int pp = 0; pp < 64; ++pp) {
            const f32x2 xv = xs[F.lane * 65 + pp];
#pragma unroll
            for (int c4 = 0; c4 < 4; ++c4) { const f32x4 cr = *(const LAS f32x4*)(Cp + pp * 32 + c4 * 4), ci = *(const LAS f32x4*)(Cp + pp * 32 + 16 + c4 * 4);
                y[4 * c4] += cr.x * xv.x - ci.x * xv.y; y[4 * c4 + 1] += cr.y * xv.x - ci.y * xv.y; y[4 * c4 + 2] += cr.z * xv.x - ci.z * xv.y; y[4 * c4 + 3] += cr.w * xv.x - ci.w * xv.y; }
        }
#if defined(SSM_CHECK)
#pragma unroll
        for (int c = 0; c < 16; ++c) chk_sq += y[c] * y[c];
#endif
        const size_t row = (size_t)g * M + (size_t)b * SEQ + t0 + F.lane;
        const bf16* up = F.U + row * 16;
        const v4u w0 = *(const v4u*)up, w1 = *(const v4u*)(up + 8);
        const float uu[16] = {bflo(w0.x), bfhi(w0.x), bflo(w0.y), bfhi(w0.y), bflo(w0.z), bfhi(w0.z), bflo(w0.w), bfhi(w0.w), bflo(w1.x), bfhi(w1.x), bflo(w1.y), bfhi(w1.y), bflo(w1.z), bfhi(w1.z), bflo(w1.w), bfhi(w1.w)};
        float r[16];
#pragma unroll
        for (int c = 0; c < 16; ++c) r[c] = gelu_tanh(y[c] + dsk[c] * uu[c]);
        v4u o0, o1; o0.x = pk2(r[0], r[1]); o0.y = pk2(r[2], r[3]); o0.z = pk2(r[4], r[5]); o0.w = pk2(r[6], r[7]); o1.x = pk2(r[8], r[9]); o1.y = pk2(r[10], r[11]); o1.z = pk2(r[12], r[13]); o1.w = pk2(r[14], r[15]);
        bf16* yp = F.Y + row * 16; *(v4u*)yp = o0; *(v4u*)(yp + 8) = o1;
        LDS_WAIT(); asm volatile("" ::: "memory");
    }
#if defined(SSM_CHECK)
    chk_sq = wave_sum(chk_sq); if (F.lane == 0) atomicAdd((float*)(F.ctl + CW_CHK + 1), chk_sq);
#endif
}


constexpr size_t TB_FRAG = 0, TB_QF = 2 * MiB, TB_PF = 10 * MiB, TB_A64 = 18 * MiB;
constexpr int SSM_R2 = 64 * 1056;
constexpr int YS_PITCH = 1056;
constexpr int XS_OFF = RING_BYTES + 2048;
static_assert(SSM_R2 + 64 * YS_PITCH <= LDSCTL_OFF && SSM_R2 + 65536 <= XS_OFF, "scan unit LDS map");
typedef float f32x16 __attribute__((ext_vector_type(16)));
typedef short bf16x8s __attribute__((ext_vector_type(8)));
__device__ __forceinline__ int crow16(int r, int hi) { return (r & 3) + 8 * (r >> 2) + 4 * hi; }

__device__ __forceinline__ void p0_ssm_item(Frame& F, int it) {
    const int g = it >> 3, j = it & 7;
    LAS float* POWr = (LAS float*)(F.lds);
    LAS float* POWi = POWr + 65 * 64;
    LAS float* BBr = POWi + 65 * 64;
    LAS float* BBi = BBr + 1024;
    constexpr int CLD = 65;
    LAS float* Cr = BBi + 1024;
    LAS float* Ci = Cr + 16 * CLD;
    bf16* FRAG = (bf16*)((char*)F.out + TB_FRAG); bf16* QF = (bf16*)((char*)F.out + TB_QF); bf16* PF = (bf16*)((char*)F.out + TB_PF); float* A64 = (float*)((char*)F.out + TB_A64);
    const float dt = expf(F.log_dt[g]);
    {
      const int p = F.tid & 63, q = F.tid >> 6;
      const float lr = fminf(F.lambda_re[g * 64 + p], -1e-4f), li = F.lambda_im[g * 64 + p];
      const float mag = expf(lr * dt), ar = mag * cosf(li * dt), ai = mag * sinf(li * dt);
      float a2r = ar * ar - ai * ai, a2i = 2.f * ar * ai; float a4r = a2r * a2r - a2i * a2i, a4i = 2.f * a2r * a2i; const float a8r = a4r * a4r - a4i * a4i, a8i = 2.f * a4r * a4i;
      float br = 1.f, bi = 0.f;
      for (int i = 0; i < q; ++i) { const float t = br * a8r - bi * a8i; bi = br * a8i + bi * a8r; br = t; }
#pragma unroll
      for (int r = 0; r < 8; ++r) { POWr[(8 * q + r) * 64 + p] = br; POWi[(8 * q + r) * 64 + p] = bi; const float t = br * ar - bi * ai; bi = br * ai + bi * ar; br = t; }
      if (q == 7) { POWr[64 * 64 + p] = br; POWi[64 * 64 + p] = bi; } }
    for (int idx = F.tid; idx < 1024; idx += 512) { const int p = idx >> 4;
        const float lr = fminf(F.lambda_re[g * 64 + p], -1e-4f), li = F.lambda_im[g * 64 + p];
        const float mag = expf(lr * dt), ar = mag * cosf(li * dt), ai = mag * sinf(li * dt);
        const float den = lr * lr + li * li, nr = ar - 1.f, cor = (nr * lr + ai * li) / den, coi = (ai * lr - nr * li) / den;
        const float br = F.b_re[(size_t)g * 1024 + idx], bi = F.b_im[(size_t)g * 1024 + idx];
        BBr[idx] = cor * br - coi * bi; BBi[idx] = cor * bi + coi * br;
        Cr[(idx >> 6) * CLD + (idx & 63)] = F.c_re[(size_t)g * 1024 + idx]; Ci[(idx >> 6) * CLD + (idx & 63)] = F.c_im[(size_t)g * 1024 + idx]; }
    __syncthreads();
    {
      typedef short bfx8 __attribute__((ext_vector_type(8)));
      const int tau = 8 * j + F.wave, rw = F.lane & 15, qd = F.lane >> 4;
      f32x4 acc = (f32x4){0.f, 0.f, 0.f, 0.f};
#pragma unroll
      for (int kc = 0; kc < 4; ++kc) { unsigned aw[4], bw[4];
#pragma unroll
          for (int h2 = 0; h2 < 4; ++h2) { float av[2], bv[2];
#pragma unroll
              for (int e = 0; e < 2; ++e) { const int kk = kc * 32 + qd * 8 + 2 * h2 + e, p = kk & 63;
                  av[e] = (kk < 64) ? Cr[rw * CLD + p] : -Ci[rw * CLD + p];
                  const float wr = POWr[tau * 64 + p], wi = POWi[tau * 64 + p], br = BBr[p * 16 + rw], bi = BBi[p * 16 + rw];
                  bv[e] = (kk < 64) ? (wr * br - wi * bi) : (wr * bi + wi * br); }
              aw[h2] = pk2(av[0], av[1]); bw[h2] = pk2(bv[0], bv[1]); }
          acc = __builtin_amdgcn_mfma_f32_16x16x32_bf16(__builtin_bit_cast(bfx8, (v4u){aw[0], aw[1], aw[2], aw[3]}), __builtin_bit_cast(bfx8, (v4u){bw[0], bw[1], bw[2], bw[3]}), acc, 0, 0, 0); }
#pragma unroll
      for (int jj = 0; jj < 4; ++jj) { const int c = qd * 4 + jj; const bf16 v = (bf16)f2bf(acc[jj]);
          if (tau + 1 < 64) FRAG[((size_t)(g * 64 + tau + 1) * 32 + c) * 16 + rw] = v;
          FRAG[((size_t)(g * 64 + tau) * 32 + 16 + c) * 16 + rw] = v; } }
    if (j == 0 && F.tid < 256) FRAG[((size_t)(g * 64) * 32 + (F.tid >> 4)) * 16 + (F.tid & 15)] = 0;
    {
      const int s = 8 * j + (F.tid >> 6), p = F.tid & 63, kk = 63 - s; const float wr = POWr[kk * 64 + p], wi = POWi[kk * 64 + p];
      unsigned re[8], im[8];
#pragma unroll
      for (int c2 = 0; c2 < 8; ++c2) { const float br0 = BBr[p * 16 + 2 * c2], bi0 = BBi[p * 16 + 2 * c2], br1 = BBr[p * 16 + 2 * c2 + 1], bi1 = BBi[p * 16 + 2 * c2 + 1];
          re[c2] = pk2(wr * br0 - wi * bi0, wr * br1 - wi * bi1); im[c2] = pk2(wr * bi0 + wi * br0, wr * bi1 + wi * br1); }
      bf16* qre = QF + ((((size_t)(g * 64 + s)) * 4 + (p >> 5)) * 32 + (p & 31)) * 16; bf16* qim = QF + ((((size_t)(g * 64 + s)) * 4 + 2 + (p >> 5)) * 32 + (p & 31)) * 16;
      *(v4u*)qre = (v4u){re[0], re[1], re[2], re[3]}; *(v4u*)(qre + 8) = (v4u){re[4], re[5], re[6], re[7]};
      *(v4u*)qim = (v4u){im[0], im[1], im[2], im[3]}; *(v4u*)(qim + 8) = (v4u){im[4], im[5], im[6], im[7]}; }
    for (int idx = F.tid; idx < 1024; idx += 512) {
      const int tl = idx >> 7, c = (idx >> 3) & 15, kb = idx & 7, t = 8 * j + tl; unsigned o[8];
#pragma unroll
      for (int k2 = 0; k2 < 8; ++k2) { float vv[2];
#pragma unroll
          for (int e = 0; e < 2; ++e) { const int p = (kb * 16 + 2 * k2 + e) & 63; const float wr = POWr[(t + 1) * 64 + p], wi = POWi[(t + 1) * 64 + p], cr = Cr[c * CLD + p], ci = Ci[c * CLD + p];
              vv[e] = (kb < 4) ? (cr * wr - ci * wi) : -(cr * wi + ci * wr); }
          o[k2] = pk2(vv[0], vv[1]); }
      bf16* pp = PF + ((((size_t)(g * 32 + (t >> 1))) * 8 + kb) * 32 + (t & 1) * 16 + c) * 16;
      *(v4u*)pp = (v4u){o[0], o[1], o[2], o[3]}; *(v4u*)(pp + 8) = (v4u){o[4], o[5], o[6], o[7]}; }
    if (j == 0 && F.tid < 64) { A64[(size_t)(g * 64 + F.tid) * 2] = POWr[64 * 64 + F.tid]; A64[(size_t)(g * 64 + F.tid) * 2 + 1] = POWi[64 * 64 + F.tid]; }
    __syncthreads();
}

__device__ __forceinline__ float gelu_tanh_fast(float v) { const float t = 0.7978845608028654f * (v + 0.044715f * v * v * v); return v * __builtin_amdgcn_rcpf(1.f + __builtin_amdgcn_exp2f(-2.f * LOG2E * t)); }

__device__ __forceinline__ void ssm_mfma_unit(Frame& F, int b, int g, bf16* Yout) {
    LAS unsigned char* L = F.lds;
    const int tid = F.tid, lane = F.lane, wave = F.wave, r32 = lane & 31, hi = lane >> 5;
    const bf16* FRAG = (const bf16*)((const char*)F.out + TB_FRAG); const bf16* QF = (const bf16*)((const char*)F.out + TB_QF); const bf16* PF = (const bf16*)((const char*)F.out + TB_PF);
    const float* A64 = (const float*)((const char*)F.out + TB_A64);
    const int tp0 = wave, tp1 = 15 - wave, tp2 = 16 + wave, tp3 = 31 - wave;
    v4u uw[8];
#pragma unroll
    for (int i = 0; i < 4; ++i) { const bf16* up = F.U + ((size_t)g * M + (size_t)b * SEQ + tid + 512 * i) * 16; uw[2 * i] = *(const v4u*)up; uw[2 * i + 1] = *(const v4u*)(up + 8); }
    const int rbA = wave & 3, khA = wave >> 2;
    bf16x8s qfr[32];
    { const char* qf = (const char*)QF + ((size_t)(g * 64 + 32 * khA) * 4 + rbA) * 1024 + r32 * 32 + hi * 16;
#pragma unroll
      for (int s = 0; s < 32; ++s) qfr[s] = *(const bf16x8s*)(qf + (size_t)s * 4096); }
#pragma unroll
    for (int i = 0; i < 4; ++i) { const int tk = tid + 512 * i, ch = tk >> 6, s = tk & 63; LAS v4u* d = (LAS v4u*)(L + s * YS_PITCH + ch * 32); d[0] = uw[2 * i]; d[1] = uw[2 * i + 1]; }
    __syncthreads();
    LAS float* Eb = (LAS float*)(L + SSM_R2);
    { f32x16 acc = {};
#pragma unroll
      for (int s = 0; s < 32; ++s) { const bf16x8s bb = *(const LAS bf16x8s*)(L + (32 * khA + s) * YS_PITCH + r32 * 32 + hi * 16);
          acc = __builtin_amdgcn_mfma_f32_32x32x16_bf16(qfr[s], bb, acc, 0, 0, 0); }
#pragma unroll
      for (int r = 0; r < 16; ++r) Eb[khA * 4224 + (rbA * 32 + crow16(r, hi)) * 33 + r32] = acc[r]; }
    __builtin_amdgcn_sched_barrier(0);
    v4u fr[8];
#pragma unroll
    for (int i = 0; i < 8; ++i) fr[i] = *(const v4u*)((const char*)FRAG + (size_t)g * 65536 + tid * 16 + i * 8192);
    bf16x8s pfr[4][8];
    { const char* pf = (const char*)PF + (size_t)(g * 32) * 8 * 1024 + r32 * 32 + hi * 16;
#pragma unroll
      for (int kb = 0; kb < 8; ++kb) { pfr[0][kb] = *(const bf16x8s*)(pf + (size_t)(tp0 * 8 + kb) * 1024); pfr[1][kb] = *(const bf16x8s*)(pf + (size_t)(tp1 * 8 + kb) * 1024);
          pfr[2][kb] = *(const bf16x8s*)(pf + (size_t)(tp2 * 8 + kb) * 1024); pfr[3][kb] = *(const bf16x8s*)(pf + (size_t)(tp3 * 8 + kb) * 1024); } }
    __syncthreads();
    LAS bf16* Xs = (LAS bf16*)(L + XS_OFF);
    if (tid < 64) { const int p = tid; const float ar = A64[(size_t)(g * 64 + p) * 2], ai = A64[(size_t)(g * 64 + p) * 2 + 1]; float xr = 0.f, xi = 0.f;
#pragma unroll 4
        for (int c = 0; c < 32; ++c) { Xs[c * 136 + p] = (bf16)f2bf(xr); Xs[c * 136 + 64 + p] = (bf16)f2bf(xi);
            const float er = Eb[p * 33 + c] + Eb[4224 + p * 33 + c], ei = Eb[(64 + p) * 33 + c] + Eb[4224 + (64 + p) * 33 + c];
            const float n_r = ar * xr - ai * xi + er, n_i = ar * xi + ai * xr + ei; xr = n_r; xi = n_i; } }
    __syncthreads();
#pragma unroll
    for (int i = 0; i < 8; ++i) *(LAS v4u*)(L + SSM_R2 + tid * 16 + i * 8192) = fr[i];
    f32x16 acc0 = {}, acc1 = {}, acc2 = {}, acc3 = {};
#pragma unroll
    for (int kb = 0; kb < 8; ++kb) { const bf16x8s bb = *(const LAS bf16x8s*)((const LAS unsigned char*)Xs + r32 * 272 + kb * 32 + hi * 16);
        acc0 = __builtin_amdgcn_mfma_f32_32x32x16_bf16(pfr[0][kb], bb, acc0, 0, 0, 0); acc1 = __builtin_amdgcn_mfma_f32_32x32x16_bf16(pfr[1][kb], bb, acc1, 0, 0, 0);
        acc2 = __builtin_amdgcn_mfma_f32_32x32x16_bf16(pfr[2][kb], bb, acc2, 0, 0, 0); acc3 = __builtin_amdgcn_mfma_f32_32x32x16_bf16(pfr[3][kb], bb, acc3, 0, 0, 0); }
    __syncthreads();
    const LAS unsigned char* FRb = L + SSM_R2 + r32 * 32 + hi * 16;
#pragma unroll 2
    for (int s = 0; s < 64; ++s) { const bf16x8s bb = *(const LAS bf16x8s*)(L + s * YS_PITCH + r32 * 32 + hi * 16);
        if (s <= 2 * tp0 + 1) acc0 = __builtin_amdgcn_mfma_f32_32x32x16_bf16(*(const LAS bf16x8s*)(FRb + (2 * tp0 - s + 1) * 1024), bb, acc0, 0, 0, 0);
        if (s <= 2 * tp1 + 1) acc1 = __builtin_amdgcn_mfma_f32_32x32x16_bf16(*(const LAS bf16x8s*)(FRb + (2 * tp1 - s + 1) * 1024), bb, acc1, 0, 0, 0);
        if (s <= 2 * tp2 + 1) acc2 = __builtin_amdgcn_mfma_f32_32x32x16_bf16(*(const LAS bf16x8s*)(FRb + (2 * tp2 - s + 1) * 1024), bb, acc2, 0, 0, 0);
        if (s <= 2 * tp3 + 1) acc3 = __builtin_amdgcn_mfma_f32_32x32x16_bf16(*(const LAS bf16x8s*)(FRb + (2 * tp3 - s + 1) * 1024), bb, acc3, 0, 0, 0); }
    const f32x4 dk0 = *(const f32x4*)(F.d_skip + g * 16 + 4 * hi), dk1 = *(const f32x4*)(F.d_skip + g * 16 + 8 + 4 * hi);
#define SSM_EPI(ACC, TP) do { _Pragma("unroll") for (int q = 0; q < 4; ++q) { const int c0 = 8 * (q & 1) + 4 * hi, t = 2 * (TP) + (q >> 1); const f32x4 dd = (q & 1) ? dk1 : dk0; \
        const v2u uw_ = *(const LAS v2u*)(L + t * YS_PITCH + r32 * 32 + c0 * 2); \
        const float r0 = gelu_tanh_fast(ACC[4 * q] + dd.x * bflo(uw_.x)), r1 = gelu_tanh_fast(ACC[4 * q + 1] + dd.y * bfhi(uw_.x)), r2 = gelu_tanh_fast(ACC[4 * q + 2] + dd.z * bflo(uw_.y)), r3 = gelu_tanh_fast(ACC[4 * q + 3] + dd.w * bfhi(uw_.y)); \
        v2u o; o.x = pk2(r0, r1); o.y = pk2(r2, r3); *(LAS v2u*)(L + SSM_R2 + t * YS_PITCH + r32 * 32 + c0 * 2) = o; } } while (0)
    __syncthreads();
    SSM_EPI(acc0, tp0); SSM_EPI(acc1, tp1); SSM_EPI(acc2, tp2); SSM_EPI(acc3, tp3);
#undef SSM_EPI
    __syncthreads();
#pragma unroll
    for (int i = 0; i < 8; ++i) { const int gi = tid + 512 * i, tok = gi >> 1, hf = gi & 1;
        *(v4u*)((char*)Yout + ((size_t)g * M + (size_t)b * SEQ) * 32 + (size_t)gi * 16) = *(const LAS v4u*)(L + SSM_R2 + (tok & 63) * YS_PITCH + (tok >> 6) * 32 + hf * 16); }
    __syncthreads();
}

constexpr int WRX_LD = 1028;
__device__ __forceinline__ void p7_stage_weights(Frame& F) {
    LAS float* wx = (LAS float*)(F.lds);
    for (int i = 0; i < 16; ++i) { const int idx = F.tid + 512 * i, kk = idx >> 3, j4 = idx & 7; const f32x4 w = *(const f32x4*)(F.w_rexp + (size_t)kk * 32 + 4 * j4);
        wx[(4 * j4) * WRX_LD + kk] = w.x; wx[(4 * j4 + 1) * WRX_LD + kk] = w.y; wx[(4 * j4 + 2) * WRX_LD + kk] = w.z; wx[(4 * j4 + 3) * WRX_LD + kk] = w.w; }
    __syncthreads();
}
__device__ __forceinline__ void p7_block(Frame& F, int blk) {
    const LAS float* wx = (const LAS float*)(F.lds);
    LAS int* eL = (LAS int*)(F.lds + XS_OFF);
    LAS unsigned* baseL = (LAS unsigned*)(F.lds + XS_OFF + 1024);
    LAS float* wL = (LAS float*)(F.lds + XS_OFF + 2048);
    const int b = (blk * 64) / SEQ;
    const float* mod = F.MOD + b * 6144;
    f32x4 es[4], sh[4], wrg[4][4];
#pragma unroll
    for (int j = 0; j < 4; ++j) { const int c = 4 * F.lane + 256 * j; const f32x4 g4 = *(const f32x4*)(F.norm_ffn_g + c), sc = *(const f32x4*)(mod + 4096 + c); es[j] = g4 * (sc + 1.f); sh[j] = *(const f32x4*)(mod + 3072 + c);
#pragma unroll
        for (int e = 0; e < 4; ++e) wrg[j][e] = *(const f32x4*)(F.w_rg + (size_t)(c + e) * 4); }
    const float brg0 = F.b_rg[0], brg1 = F.b_rg[1], brg2 = F.b_rg[2], brg3 = F.b_rg[3];
#pragma unroll 1
    for (int rb = 0; rb < 8; rb += 4) {
        f32x4 v[4][4];
#pragma unroll
        for (int r = 0; r < 4; ++r) { const GAS v2u* xr = (const GAS v2u*)(F.X1B + (size_t)(blk * 64 + F.wave * 8 + rb + r) * D) + F.lane;
#pragma unroll
            for (int j = 0; j < 4; ++j) { const v2u t = xr[64 * j]; v[r][j] = (f32x4){bflo(t.x), bfhi(t.x), bflo(t.y), bfhi(t.y)}; } }
        float ss[4];
#pragma unroll
        for (int r = 0; r < 4; ++r) { float s = 0.f;
#pragma unroll
            for (int j = 0; j < 4; ++j) s += (v[r][j].x * v[r][j].x + v[r][j].y * v[r][j].y) + (v[r][j].z * v[r][j].z + v[r][j].w * v[r][j].w);
            ss[r] = s; }
#pragma unroll
        for (int r = 0; r < 4; ++r) ss[r] = wave_sum(ss[r]);
#pragma unroll
        for (int r = 0; r < 4; ++r) {
            const int rl = F.wave * 8 + rb + r, m = blk * 64 + rl;
            const float rstd = __builtin_amdgcn_rsqf(ss[r] * (1.f / D) + RMS_EPS);
            GAS unsigned* o4 = (GAS unsigned*)((unsigned char*)F.H + (size_t)m * D) + F.lane;
#pragma unroll
            for (int j = 0; j < 4; ++j) { v[r][j] = v[r][j] * rstd * es[j] + sh[j]; o4[64 * j] = pk4_fp8(v[r][j].x, v[r][j].y, v[r][j].z, v[r][j].w); }
            f32x4 lgv = (f32x4){0.f, 0.f, 0.f, 0.f};
#pragma unroll
            for (int j = 0; j < 4; ++j)
#pragma unroll
                for (int e = 0; e < 4; ++e) lgv += wrg[j][e] * v[r][j][e];
            const bool h5 = (F.lane & 32) != 0, h4 = (F.lane & 16) != 0, h3 = (F.lane & 8) != 0;
            float lg[4];
            { const float k0 = (h5 ? lgv.z : lgv.x) + __shfl_xor(h5 ? lgv.x : lgv.z, 32), k1 = (h5 ? lgv.w : lgv.y) + __shfl_xor(h5 ? lgv.y : lgv.w, 32);
              float z = (h4 ? k1 : k0) + __shfl_xor(h4 ? k0 : k1, 16);
              z += __shfl_xor(z, 8); z += __shfl_xor(z, 4); z += __shfl_xor(z, 2); z += __shfl_xor(z, 1);
              const int zi = __builtin_bit_cast(int, z);
              lg[0] = __builtin_bit_cast(float, __builtin_amdgcn_readlane(zi, 0)) + brg0; lg[1] = __builtin_bit_cast(float, __builtin_amdgcn_readlane(zi, 16)) + brg1;
              lg[2] = __builtin_bit_cast(float, __builtin_amdgcn_readlane(zi, 32)) + brg2; lg[3] = __builtin_bit_cast(float, __builtin_amdgcn_readlane(zi, 48)) + brg3; }
            int gi = 0; float lmax = lg[0];
#pragma unroll
            for (int i = 1; i < 4; ++i) if (lg[i] > lmax) { lmax = lg[i]; gi = i; }
            float se = 0.f;
#pragma unroll
            for (int i = 0; i < 4; ++i) se += __expf(lg[i] - lmax);
            const float pg = __builtin_amdgcn_rcpf(se);
            gi = __builtin_amdgcn_readfirstlane(gi);
            float le[8];
#pragma unroll
            for (int i = 0; i < 8; ++i) { const LAS float* wr = wx + (gi * 8 + i) * WRX_LD + 4 * F.lane; f32x4 a4 = (f32x4){0.f, 0.f, 0.f, 0.f};
#pragma unroll
                for (int j = 0; j < 4; ++j) a4 += v[r][j] * *(const LAS f32x4*)(wr + 256 * j);
                le[i] = (a4.x + a4.y) + (a4.z + a4.w); }
            { float k4[4], k2[2];
#pragma unroll
              for (int i = 0; i < 4; ++i) { const float keep = h5 ? le[i + 4] : le[i], send = h5 ? le[i] : le[i + 4]; k4[i] = keep + __shfl_xor(send, 32); }
#pragma unroll
              for (int i = 0; i < 2; ++i) { const float keep = h4 ? k4[i + 2] : k4[i], send = h4 ? k4[i] : k4[i + 2]; k2[i] = keep + __shfl_xor(send, 16); }
              float z = (h3 ? k2[1] : k2[0]) + __shfl_xor(h3 ? k2[0] : k2[1], 8);
              z += __shfl_xor(z, 4); z += __shfl_xor(z, 2); z += __shfl_xor(z, 1);
              const int zi = __builtin_bit_cast(int, z);
#pragma unroll
              for (int i = 0; i < 8; ++i) le[i] = __builtin_bit_cast(float, __builtin_amdgcn_readlane(zi, 8 * i)) + F.b_rexp[gi * 8 + i]; }
            int i0 = 0; float v0 = le[0];
#pragma unroll
            for (int i = 1; i < 8; ++i) if (le[i] > v0) { v0 = le[i]; i0 = i; }
            int i1 = -1; float v1 = -INFINITY;
#pragma unroll
            for (int i = 0; i < 8; ++i) if (i != i0 && (i1 < 0 || le[i] > v1)) { v1 = le[i]; i1 = i; }
            const float ex = __expf(v1 - v0), p0 = __builtin_amdgcn_rcpf(1.f + ex), p1 = ex * p0;
            if (F.lane == 0) { const int e0 = gi * 8 + i0, e1 = gi * 8 + i1; eL[2 * rl] = e0; eL[2 * rl + 1] = e1;
                wL[2 * rl] = pg * p0; wL[2 * rl + 1] = pg * p1; }
        }
    }
    __syncthreads();
    int e = 0, rank = 0, total = 0;
    if (F.tid < 128) { e = eL[F.tid];
        for (int a = 0; a < 128; ++a) { const int m_ = (eL[a] == e); total += m_; rank += (m_ && a < F.tid); }
        if (rank == 0) baseL[e] = __hip_atomic_fetch_add((unsigned*)(F.ctl + CW_CNT + 64 * e), (unsigned)total, RLX_AGENT); }
    __syncthreads();
    if (F.tid < 128) { const unsigned pos = baseL[e] + (unsigned)rank; F.LIST[(size_t)e * CAP + pos] = (unsigned)((blk * 64 + (F.tid >> 1)) * 2 + (F.tid & 1)); F.LISTW[(size_t)e * CAP + pos] = wL[F.tid];
        const unsigned aid_ = (unsigned)((blk * 64 + (F.tid >> 1)) * 2 + (F.tid & 1)); F.ROUTE[aid_] = (int)(e * CAP + (int)pos); F.RW[aid_] = wL[F.tid]; }
    __syncthreads();
}

__device__ __forceinline__ void p10_rows(Frame& F) {
    (void)moe_tables(F);
    const LAS int* tab = (const LAS int*)(F.lds + MOE_OFF);
    const int gw = F.vcu * NWAVES + F.wave, NGW = F.G * NWAVES;
    for (int ch = gw; ch < M / 8; ch += NGW) {
        int rowi = 0; float rwt = 0.f;
        if (F.lane < 16) { const int pos = F.ROUTE[ch * 16 + F.lane]; rowi = tab[pos >> 14] * 256 + (pos & (CAP - 1)); rwt = F.RW[ch * 16 + F.lane]; }
        const int b = (ch * 8) / SEQ;
        const float* mod = F.MOD + b * 6144 + 5120;
        f32x4 g2[4], fg[4];
#pragma unroll
        for (int j = 0; j < 4; ++j) { const int c = 4 * F.lane + 256 * j; g2[j] = *(const f32x4*)(mod + c); fg[j] = *(const f32x4*)(F.final_g + c); }
#pragma unroll 1
        for (int rb = 0; rb < 8; rb += 4) {
            f32x4 v[4][4]; unsigned ya[4][4], yb[4][4];
#pragma unroll
            for (int r = 0; r < 4; ++r) { const int m = ch * 8 + rb + r;
                const GAS v2u* xr = (const GAS v2u*)(F.X1B + (size_t)m * D) + F.lane;
                const int ri0 = __builtin_amdgcn_readlane(rowi, 2 * (rb + r)), ri1 = __builtin_amdgcn_readlane(rowi, 2 * (rb + r) + 1);
                const GAS unsigned* y0 = (const GAS unsigned*)((const unsigned char*)F.YROWS + (size_t)ri0 * D) + F.lane; const GAS unsigned* y1 = (const GAS unsigned*)((const unsigned char*)F.YROWS + (size_t)ri1 * D) + F.lane;
#pragma unroll
                for (int j = 0; j < 4; ++j) { const v2u t = __builtin_nontemporal_load(xr + 64 * j); v[r][j] = (f32x4){bflo(t.x), bfhi(t.x), bflo(t.y), bfhi(t.y)}; ya[r][j] = __builtin_nontemporal_load(y0 + 64 * j); yb[r][j] = __builtin_nontemporal_load(y1 + 64 * j); } }
            float ss[4];
#pragma unroll
            for (int r = 0; r < 4; ++r) { float s = 0.f;
                const float w0 = __builtin_bit_cast(float, __builtin_amdgcn_readlane(__builtin_bit_cast(int, rwt), 2 * (rb + r))) * (1.f / FP8_YSCALE), w1 = __builtin_bit_cast(float, __builtin_amdgcn_readlane(__builtin_bit_cast(int, rwt), 2 * (rb + r) + 1)) * (1.f / FP8_YSCALE);
#pragma unroll
                for (int j = 0; j < 4; ++j) { const int a = (int)ya[r][j], bb = (int)yb[r][j];
                    const f32x2 a0 = __builtin_amdgcn_cvt_pk_f32_fp8(a, false), a1 = __builtin_amdgcn_cvt_pk_f32_fp8(a, true), b0 = __builtin_amdgcn_cvt_pk_f32_fp8(bb, false), b1 = __builtin_amdgcn_cvt_pk_f32_fp8(bb, true);
                    f32x4 yv; yv.x = w0 * a0.x + w1 * b0.x; yv.y = w0 * a0.y + w1 * b0.y; yv.z = w0 * a1.x + w1 * b1.x; yv.w = w0 * a1.y + w1 * b1.y;
                    v[r][j] = v[r][j] + g2[j] * yv; s += (v[r][j].x * v[r][j].x + v[r][j].y * v[r][j].y) + (v[r][j].z * v[r][j].z + v[r][j].w * v[r][j].w); }
                ss[r] = s; }
#pragma unroll
            for (int r = 0; r < 4; ++r) ss[r] = wave_sum(ss[r]);
#pragma unroll
            for (int r = 0; r < 4; ++r) { const int m = ch * 8 + rb + r; GAS f32x4* xr = (GAS f32x4*)(F.out + (size_t)m * D) + F.lane;
                float rstd = 1.f / sqrtf(ss[r] * (1.f / D) + RMS_EPS);
#if defined(SSM_CHECK)
                { const float d_ = ((const float*)(F.ctl + CW_CHK))[0] / ((const float*)(F.ctl + CW_CHK))[1]; rstd *= 1.f + 0.5f * fminf(1.f, sqrtf(d_)); }
#endif
#pragma unroll
                for (int j = 0; j < 4; ++j) xr[64 * j] = v[r][j] * rstd * fg[j]; }
        }
    }
}

struct Args { const float* in[28]; float* out; unsigned char* ws; int ph_lo, ph_hi, grid, pad; };
typedef const __attribute__((address_space(4))) Args* KArgs;
__device__ __forceinline__ void load_ptrs(Frame& F) {
    KArgs ka = (KArgs)__builtin_amdgcn_kernarg_segment_ptr();
    asm volatile("" : "+s"(ka));
    F.tid = tid_opaque(); F.lane = F.tid & 63; F.wave = __builtin_amdgcn_readfirstlane(F.tid >> 6);
    F.G = ka->grid; { int bx = (int)blockIdx.x; asm volatile("" : "+s"(bx)); F.vcu = (F.G % 8 == 0) ? (bx % 8) * (F.G / 8) + bx / 8 : bx; }
    unsigned char* ws = ka->ws;
    F.ctl = (gu32*)(ws + WS_CTL);
    F.x = ka->in[0]; F.c = ka->in[1]; F.w_ada = ka->in[2]; F.b_ada = ka->in[3]; F.norm_mix_g = ka->in[4]; F.w_in = ka->in[5]; F.b_forget = ka->in[6]; F.w_out_fox = ka->in[7];
    F.lambda_re = ka->in[8]; F.lambda_im = ka->in[9]; F.log_dt = ka->in[10]; F.b_re = ka->in[11]; F.b_im = ka->in[12]; F.c_re = ka->in[13]; F.c_im = ka->in[14]; F.d_skip = ka->in[15];
    F.w_glu = ka->in[16]; F.w_out_ssm = ka->in[17]; F.w_o = ka->in[18]; F.norm_ffn_g = ka->in[19]; F.w_rg = ka->in[20]; F.b_rg = ka->in[21]; F.w_rexp = ka->in[22]; F.b_rexp = ka->in[23];
    F.w_gate = ka->in[24]; F.w_up = ka->in[25]; F.w_down = ka->in[26]; F.final_g = ka->in[27]; F.out = ka->out;
    F.MOD = (float*)(ws + WS_MOD); F.LOGF = (float*)(ws + WS_LOGF); F.CUM = (float*)(ws + WS_CUM); F.RW = (float*)(ws + WS_RW); F.ROUTE = (int*)(ws + WS_ROUTE); F.LIST = (unsigned*)(ws + WS_LIST); F.CUMP = (unsigned*)(ws + WS_CUMP); F.LISTW = (float*)(ws + WS_LISTW);
    F.WIN = (bf16*)(ws + WS_WIN); F.WGLU = (bf16*)(ws + WS_WGLU); F.WOF = (bf16*)(ws + WS_WOF); F.WOS = (bf16*)(ws + WS_WOS); F.WO = (bf16*)(ws + WS_WO); F.WGU = (bf16*)(ws + WS_WGU); F.WD = (bf16*)(ws + WS_WD);
    F.H = (bf16*)(ws + WS_H); F.Y = (bf16*)(ws + WS_Y); F.Q = (bf16*)(ws + WS_Q); F.K = (bf16*)(ws + WS_K); F.V = (bf16*)(ws + WS_V); F.U = (bf16*)(ws + WS_U); F.SGA = (bf16*)(ws + WS_SGA); F.SGB = (bf16*)(ws + WS_SGB);
    F.HID = (bf16*)(ws + WS_HID); F.YROWS = (bf16*)(ws + WS_YROWS); F.X1B = (bf16*)(ws + WS_X1B);
}
__global__ void __launch_bounds__(NWAVES * 64, 2) fwd(Args args) {
    extern __shared__ __attribute__((aligned(16))) unsigned char lds[];
    Frame F;
    F.lds = (LAS unsigned char*)lds;
    F.MISC = (volatile LAS unsigned*)(F.lds + MISC_OFF);
    { const int t0 = (int)threadIdx.x;
      for (int u = t0; u < (LDS_BYTES - LDSCTL_OFF) / 4; u += NWAVES * 64) ((LAS unsigned*)(F.lds + LDSCTL_OFF))[u] = 0u;
      __syncthreads();
      if ((t0 & 63) == 0) *(volatile LAS int*)(F.lds + TIDTAB_OFF + 4 * hw_wave_key()) = t0 >> 6;
      __syncthreads(); }
    load_ptrs(F);
    if (N_LAUNCHES == 1) (void)xcd_barrier_post((unsigned*)(F.ctl + CW_BAR), F.MISC + 8);
#if defined(TPROBE)
#define STAMP(kk) do { if (blockIdx.x == 0 && tid_opaque() == 0) F.ctl[CW_TS + (kk)] = (unsigned)__builtin_amdgcn_s_memrealtime(); } while (0)
#else
#define STAMP(kk) do { } while (0)
#endif
    STAMP(15);
#define GRID_BAR() do { if (N_LAUNCHES == 1) { load_ptrs(F); XcdBarrier b_; b_.bar = (unsigned*)(F.ctl + CW_BAR); b_.x = xb_xcc_id(); b_.st = (volatile LAS unsigned*)(F.lds + MISC_OFF) + 8; xcd_barrier(b_); } } while (0)
#define GRID_BAR_SH(seam_) do { if (N_LAUNCHES == 1) { load_ptrs(F); XcdBarrier b_; b_.bar = (unsigned*)(F.ctl + CW_BAR); b_.x = xb_xcc_id(); b_.st = (volatile LAS unsigned*)(F.lds + MISC_OFF) + 8; \
        const ShadowGateUp sh_{F.w_gate, F.w_up, F.WGU, F.lds, (seam_), (int)blockIdx.x}; xcd_barrier(b_, sh_); } } while (0)
#define SEAM_SH(k_) do { if (BOTH(k_)) GRID_BAR_SH(k_); else if (N_LAUNCHES != 1) { load_ptrs(F); __syncthreads(); const ShadowGateUp sh_{F.w_gate, F.w_up, F.WGU, F.lds, (k_), (int)blockIdx.x}; if (F.tid >= 64) sh_(); __syncthreads(); } } while (0)
    const int lo = (N_LAUNCHES == 1) ? 0 : args.ph_lo, hi = (N_LAUNCHES == 1) ? NPH : args.ph_hi;
#ifndef PH_MASK
#define PH_MASK 0x7ff
#endif
#define IN(k) ((((PH_MASK) >> (k)) & 1) && lo <= (k) && (k) < hi)
#define BOTH(k) (IN(k) && IN((k) + 1))

    if (IN(0)) { load_ptrs(F); p0_mod(F); load_ptrs(F);
        for (int it = F.vcu; it < 256; it += F.G) p0_ssm_item(F, it); __syncthreads(); load_ptrs(F); p0_copies(F, F.vcu, F.G);
        __syncthreads(); STAMP(0); }
    if (IN(1)) { load_ptrs(F);
        if (F.tid < 64) { unsigned sp = 0;
            while ((unsigned)__builtin_amdgcn_readfirstlane(__hip_atomic_load((unsigned*)(F.ctl + CW_MOD), RLX_AGENT)) < 192u) { __builtin_amdgcn_s_sleep(2); if (++sp > (1u << 22)) { if (F.tid == 0) __hip_atomic_store((unsigned*)(F.ctl + CW_TMO), 1u, RLX_AGENT); break; } }
            __builtin_amdgcn_fence(__ATOMIC_ACQUIRE, "agent"); asm volatile("s_waitcnt vmcnt(0)" ::: "memory"); }
        __syncthreads();
        p1_rows(F); SEAM_SH(1); STAMP(1); }
    if (IN(2)) { load_ptrs(F);
        p2_cumscan(F); VM_WAIT(); __syncthreads();
        { pg8::Gemm g{F.H, F.WIN, 1024, 128}; pg8::StaticOrder S; S.init(M, 2048, F.G, (int)blockIdx.x);
          EpiInProj E{F.Q};
          pg8::gemm_phase<EpiInProj, pg8::StaticOrder, true>(F.lds + RING_OFF, g, S, E); }
        __syncthreads();
        load_ptrs(F);
        { pg8::Gemm g{F.WD, F.WIN + (size_t)1024 * 1024, 512, 128}; pg8::StaticOrder8 S; S.init(M, 2048, F.G, (int)blockIdx.x); S.pn0 = 8;
          EpiInProj E{F.Q, 1.f / (FP8_GW * FP8_GH)};
          pg8::gemm_phase<EpiInProj, pg8::StaticOrder8, true>(F.lds + RING_OFF, g, S, E); }
        SEAM_SH(2); STAMP(2);
    }
    if (IN(3)) { load_ptrs(F);
#if defined(ATTN_SIMPLE)
        for (int u = F.vcu; u < NB * NH * 4; u += F.G) { const int bh = u >> 2, qblk = 3 - (u & 3); attn_simple_unit(F, bh >> 3, bh & 7, qblk); }
#else
        { static_assert(attn_body::ATTN_LDS_BYTES <= RING_BYTES, "attention LDS");
          const attn_body::AttnTensors AT{(const attn_body::bf16*)F.Q, (const attn_body::bf16*)F.K, (const attn_body::bf16*)F.V, (attn_body::bf16*)F.Q, F.CUMP};
          const attn_body::StaticOrder S((int)F.G, F.vcu);
          attn_body::attn_phase<attn_body::StaticOrder>((char*)lds + RING_OFF, AT, S); }
#endif
        __syncthreads();
#if defined(SSM_SIMPLE) || defined(SSM_CHECK)
        if (F.wave < 3) for (int u = F.wave * F.G + F.vcu; u < NB * NG; u += 3 * F.G) ssm_simple_unit(F, u & 7, u >> 3, F.lds + F.wave * 41472);
        __syncthreads();
#endif
#if !defined(SSM_SIMPLE)
        load_ptrs(F);
        for (int u = F.vcu; u < NB * NG; u += F.G) ssm_mfma_unit(F, u & 7, u >> 3,
#if defined(SSM_CHECK)
            (bf16*)((char*)F.out + 32 * MiB)
#else
            F.Y
#endif
            );
#endif
#if defined(SSM_CHECK)
        { VM_WAIT(); __syncthreads();
          const int u = F.vcu, b = u & 7, g = u >> 3; const bf16* y2 = (const bf16*)((const char*)F.out + 32 * MiB); float df = 0.f;
          for (int i = 0; i < 4; ++i) { const size_t off = ((size_t)g * M + (size_t)b * SEQ + F.tid + 512 * i) * 16;
              for (int hh = 0; hh < 2; ++hh) { const v4u a = __builtin_nontemporal_load((const v4u*)(F.Y + off + 8 * hh)), c = __builtin_nontemporal_load((const v4u*)(y2 + off + 8 * hh));
                  const float d0 = bflo(a.x) - bflo(c.x), d1 = bfhi(a.x) - bfhi(c.x), d2 = bflo(a.y) - bflo(c.y), d3 = bfhi(a.y) - bfhi(c.y), d4 = bflo(a.z) - bflo(c.z), d5 = bfhi(a.z) - bfhi(c.z), d6 = bflo(a.w) - bflo(c.w), d7 = bfhi(a.w) - bfhi(c.w);
                  df += d0 * d0 + d1 * d1 + d2 * d2 + d3 * d3 + d4 * d4 + d5 * d5 + d6 * d6 + d7 * d7; } }
          df = wave_sum(df); if (F.lane == 0) atomicAdd((float*)(F.ctl + CW_CHK), df); }
#endif
        __syncthreads();
        SEAM_SH(3); STAMP(3);
    }
    if (IN(4)) { load_ptrs(F);
        { pg8::Gemm g{F.Y, F.WGLU, 512, (size_t)4 * M * 32}; pg8::GroupMajorOrder S; S.init(M, 1024, F.G, (int)blockIdx.x); S.Mrows = M; EpiPair<0> E{F.V};
          pg8::gemm_phase<EpiPair<0>, pg8::GroupMajorOrder, true>(F.lds + RING_OFF, g, S, E); }
        SEAM_SH(4); STAMP(4);
    }
    if (IN(5)) { load_ptrs(F);
        pg8::Gemm g{F.Q, F.WOF, 512, 128}; pg8::DualOrder S; S.init(M, 1024, F.G, (int)blockIdx.x); S.a_delta = (size_t)(WS_V - WS_Q); S.b_delta = (size_t)(WS_WOS - WS_WOF);
        EpiGateChain E{F.SGA, F.SGB};
        pg8::gemm_phase<EpiGateChain, pg8::DualOrder, true>(F.lds + RING_OFF, g, S, E);
        SEAM_SH(5); STAMP(5);
    }
    if (IN(6)) { load_ptrs(F);
        pg8::Gemm g{F.SGA, F.WO, 1024, 128}; pg8::StaticOrder S; S.init(M, 1024, F.G, (int)blockIdx.x); EpiResid E{F.x, F.X1B, F.MOD};
        pg8::gemm_phase<EpiResid, pg8::StaticOrder, true>(F.lds + RING_OFF, g, S, E);
        SEAM_SH(6); STAMP(6);
    }
    if (IN(7)) { load_ptrs(F);
        p7_stage_weights(F);
        for (int blk = F.vcu; blk < M / 64; blk += F.G) p7_block(F, blk);
        if (BOTH(7)) GRID_BAR(); STAMP(7);
    }
    if (IN(8)) { load_ptrs(F);
        const int mt = moe_tables(F);
        MoeOrder<true> S{F.G, F.vcu, mt * 4, (const LAS int*)(F.lds + MOE_OFF), F.LIST, (size_t)1024 * 1024, 0};
        pg8::Gemm g{F.H, F.WGU, 512, 128}; EpiSwiGLU8 E{(unsigned char*)F.HID};
        pg8::gemm_phase<EpiSwiGLU8, MoeOrder<true>, true>(F.lds + RING_OFF, g, S, E);
        __syncthreads();
        { const int full = (mt * 4) / F.G, extra = (mt * 4) - full * F.G;
          load_ptrs(F); convert_wdown(F, extra); }
        if (BOTH(8)) GRID_BAR(); STAMP(8);
    }
    if (IN(9)) { load_ptrs(F);
        const int mt = moe_tables(F);
        MoeOrder<false> S{F.G, F.vcu, mt * 4, (const LAS int*)(F.lds + MOE_OFF), F.LIST, (size_t)1024 * 512, 0};
        pg8::Gemm g{F.HID, F.WD, 256, 128}; EpiDown E{F.YROWS};
        pg8::gemm_phase<EpiDown, MoeOrder<false>, true>(F.lds + RING_OFF, g, S, E);
        if (BOTH(9)) GRID_BAR(); STAMP(9);
    }
    if (IN(10)) { load_ptrs(F); p10_rows(F); }
#undef IN
#undef BOTH
}

extern "C" void kernel_launch(void* const* d_in, const int* in_sizes, int n_in, void* d_out, int out_size, void* d_ws, size_t ws_size, hipStream_t stream) {
    static int grid = 0;
    if (grid == 0) {
        if (n_in != 28 || in_sizes[0] != M * D || out_size != M * D || ws_size < WS_END) { fprintf(stderr, "kernel_launch: unexpected shapes (n_in %d, in0 %d, out %d, ws %zu); nothing launched\n", n_in, n_in > 0 ? in_sizes[0] : -1, out_size, ws_size); grid = -1; return; }
        int dev = 0, cus = 0, per_cu = 0;
        if (hipGetDevice(&dev) != hipSuccess || hipDeviceGetAttribute(&cus, hipDeviceAttributeMultiprocessorCount, dev) != hipSuccess) { grid = -1; return; }
        if (hipFuncSetAttribute((const void*)fwd, hipFuncAttributeMaxDynamicSharedMemorySize, LDS_BYTES) != hipSuccess) { fprintf(stderr, "kernel_launch: hipFuncSetAttribute failed\n"); grid = -1; return; }
        if (hipOccupancyMaxActiveBlocksPerMultiprocessor(&per_cu, (const void*)fwd, NWAVES * 64, LDS_BYTES) != hipSuccess || per_cu < 1) { fprintf(stderr, "kernel_launch: occupancy query reports %d\n", per_cu); }
        (void)hipGetLastError();
        grid = cus;
    }
    if (grid < 0) return;
    if (hipMemsetAsync((char*)d_ws + WS_CTL, 0, CTL_ZERO_BYTES, stream) != hipSuccess) return;
    Args a{};
    for (int i = 0; i < 28; ++i) a.in[i] = (const float*)d_in[i];
    a.out = (float*)d_out; a.ws = (unsigned char*)d_ws;
    for (int li = 0; li < N_LAUNCHES; ++li) {
        a.ph_lo = (N_LAUNCHES == NPH) ? li : 0; a.ph_hi = (N_LAUNCHES == NPH) ? li + 1 : NPH; a.grid = grid; a.pad = 0;
        hipLaunchKernelGGL(fwd, dim3(grid), dim3(NWAVES * 64), LDS_BYTES, stream, a);
        if (hipPeekAtLastError() != hipSuccess) { fprintf(stderr, "kernel_launch: launch %d failed\n", li); break; }
    }
}
```

```cpp
#include <hip/hip_runtime.h>
#include <cstdio>
#include <cstdint>

#ifndef MK_N_LAUNCHES
#define MK_N_LAUNCHES 1
#endif

constexpr int NB = 8, SEQ = 2048, D = 1024, M = NB * SEQ;
constexpr int NH = 8, HD = 64, FW = 512;
constexpr int SW = 512, NG = 32, NS = 64;
constexpr int INC = 4104;
constexpr int NE = 32, DE = 512;
constexpr int CAP = 16384;
constexpr float RMS_EPS = 1e-6f;
constexpr float LOG2E = 1.4426950408889634f;
constexpr float QSCALE = 0.125f * 1.4426950408889634f;

constexpr int TIDTAB_OFF = 147456 - 2048 + 512;
__device__ __forceinline__ int hw_wave_key() { return (int)(__builtin_amdgcn_s_getreg((5 << 11) | 4) & 0x3f); }
__device__ __forceinline__ int tid_opaque() {
    extern __shared__ __attribute__((aligned(16))) unsigned char lds_[];
    const int lane = (int)__builtin_amdgcn_mbcnt_hi(~0u, __builtin_amdgcn_mbcnt_lo(~0u, 0u));
    int w = *(const volatile __attribute__((address_space(3))) int*)((__attribute__((address_space(3))) unsigned char*)lds_ + TIDTAB_OFF + 4 * hw_wave_key());
    w = __builtin_amdgcn_readfirstlane(w);
    int t = w * 64 + lane; asm volatile("" : "+v"(t)); return t;
}

namespace pg8 {
#define PG8_LAS __attribute__((address_space(3)))
typedef unsigned short bf16_t;
typedef short bf16x8 __attribute__((ext_vector_type(8)));
typedef float f32x4 __attribute__((ext_vector_type(4)));
typedef unsigned u32x4 __attribute__((ext_vector_type(4)));
typedef int i32x4 __attribute__((ext_vector_type(4)));
typedef int i32x8 __attribute__((ext_vector_type(8)));
constexpr int BM = 256, BK = 64, HALF = 128, HTB = HALF * BK * 2, STAGE_BYTES = 8 * HTB, NXCD = 8, WGM = 8;

__host__ __device__ __forceinline__ int lds_byte(int r, int c) { const int st = (r >> 4) * 2 + (c >> 5), rr = r & 15, cc = c & 31, ob = rr * 64 + cc * 2; return st * 1024 + (ob ^ (((ob >> 9) & 1) << 5)); }
__host__ __device__ __forceinline__ void stage_rc(int b, int& R, int& C) { const int st = b / 1024, sb = b % 1024, swz = sb ^ (((sb >> 9) & 1) << 5); R = (st >> 1) * 16 + swz / 64; C = (st & 1) * 32 + (swz % 64) / 2; }
__host__ __device__ __forceinline__ int perm32(int rho) { const int n = rho >> 4, i = rho & 15; return 8 * (i >> 2) + 4 * n + (i & 3); }

struct Unit { int pm, pn, e, rows, lbase; };
struct Gemm { const bf16_t* A; const bf16_t* Bt; int K; size_t kstepA; };

struct StaticOrder {
    static constexpr bool GATHER = false, FP8 = false;
    int nM, nN, nwg, G, c;
    __host__ __device__ void init(int M_, int N_, int G_, int c_) { nM = M_ / BM; nN = N_ / BM; nwg = nM * nN; G = G_; c = c_; }
    __host__ __device__ bool next(int i, Unit& u) const {
        const long L = (long)i * G + c; if (L >= nwg) return false;
        int wgid = (int)L; { const int q = nwg / NXCD, r = nwg % NXCD, xcd = wgid % NXCD, off = wgid / NXCD; wgid = (xcd < r ? xcd * (q + 1) : r * (q + 1) + (xcd - r) * q) + off; }
        const int nig = WGM * nN, gid = wgid / nig, fm = gid * WGM, gsz = (nM - fm) < WGM ? (nM - fm) : WGM;
        u.pm = fm + ((wgid % nig) % gsz); u.pn = (wgid % nig) / gsz; u.e = 0; u.rows = 256; u.lbase = 0; return true;
    }
    __device__ __forceinline__ size_t a_base(const Unit& u, int K) const { return (size_t)u.pm * BM * K * 2; }
    __device__ __forceinline__ size_t b_base(const Unit& u, int K) const { return (size_t)u.pn * BM * K * 2; }
    __device__ __forceinline__ void a_offsets(const Unit&, const int*, const int*, int, unsigned (&)[2][2]) const {}
};

struct StaticOrder8 : StaticOrder { static constexpr bool FP8 = true; int pn0;
    __device__ __forceinline__ bool next(int i, Unit& u) const { if (!StaticOrder::next(i, u)) return false; u.pn += pn0; return true; }
};
struct DualOrder : StaticOrder {
    size_t a_delta, b_delta;
    __device__ __forceinline__ bool next(int i, Unit& u) const { if (!StaticOrder::next(i >> 1, u)) return false; u.e = i & 1; return true; }
    __device__ __forceinline__ size_t a_base(const Unit& u, int K) const { return (size_t)u.pm * BM * K * 2 + (u.e ? a_delta : (size_t)0); }
    __device__ __forceinline__ size_t b_base(const Unit& u, int K) const { return (size_t)u.pn * BM * K * 2 + (u.e ? b_delta : (size_t)0); }
};
struct GroupMajorOrder : StaticOrder {
    static constexpr bool GATHER = true;
    int Mrows;
    __device__ __forceinline__ size_t a_base(const Unit&, int) const { return 0; }
    __device__ __forceinline__ void a_offsets(const Unit& u, const int* Rr, const int* Cc, int, unsigned (&vo)[2][2]) const {
#pragma unroll
        for (int h = 0; h < 2; ++h)
#pragma unroll
            for (int i = 0; i < 2; ++i) vo[h][i] = (unsigned)(((Cc[i] >> 4) * Mrows + u.pm * BM + h * HALF + Rr[i]) * 32 + (Cc[i] & 15) * 2);
    }
};
__device__ __forceinline__ unsigned cvt_pk_bf16(float lo, float hi) { unsigned r; asm volatile("v_cvt_pk_bf16_f32 %0, %1, %2" : "=v"(r) : "v"(lo), "v"(hi)); return r; }

template <class T, class = void> struct epi_chains { static constexpr bool value = false; };
template <class T> struct epi_chains<T, decltype((void)T::CHAIN)> { static constexpr bool value = true; };
template <class T, class = void> struct epi_perm16 { static constexpr bool value = false; };
template <class T> struct epi_perm16<T, decltype((void)T::PERM16)> { static constexpr bool value = true; };
template <class Epi, class Sched, bool ALIGN_EPI>
__device__ __forceinline__ void gemm_phase(PG8_LAS unsigned char* lds, const Gemm g, const Sched& S, const Epi& E) {
    constexpr bool GATHER = Sched::GATHER;
    const int tid = tid_opaque(), wid = __builtin_amdgcn_readfirstlane(tid >> 6), lane = tid & 63, wr = wid >> 2, wc = wid & 3, fr = lane & 15, fq = lane >> 4;
    const int K = g.K, nt = K / BK;
    unsigned voffB[2], voC[2][2], voN[2][2]; int Rr[2], Cc[2];
#pragma unroll
    for (int i = 0; i < 2; ++i) { int R, C; stage_rc(tid * 16 + i * 8192, R, C); Rr[i] = R; Cc[i] = C;
        const int Rb = epi_perm16<Epi>::value ? ((R >> 5) * 64 + 16 * ((R & 15) >> 2) + 4 * ((R >> 4) & 1) + (R & 3)) : Epi::PERM ? ((R & ~31) + perm32(R & 31)) : R;
        voffB[i] = (unsigned)(Rb * K + C) * 2u; }
    const size_t kstep = (size_t)(BK * 2), kstepA = g.kstepA;
    const size_t hstep = epi_perm16<Epi>::value ? (size_t)8 * K * 2 : (size_t)HALF * K * 2;
    const unsigned ldsw = (unsigned)wid * 1024u;
    const int aoff = lds_byte(wr * 64 + fr, fq * 8), boff = lds_byte(wc * 32 + fr, fq * 8);
#define PG8_SA(b, h) (((b) * 2 + (h)) * HTB)
#define PG8_SB(b, h) ((4 + (b) * 2 + (h)) * HTB)
#define PG8_STAGE(bufoff, gbase, voff) do { _Pragma("unroll") for (int _i = 0; _i < 2; ++_i) \
        __builtin_amdgcn_global_load_lds((const unsigned*)((const char*)(gbase) + (voff)[_i]), (PG8_LAS unsigned*)(lds + (bufoff) + ldsw + _i * 8192), 16, 0, 0); } while (0)
#define PG8_LDA(dst, b, h) do { if constexpr (Sched::FP8) { _Pragma("unroll") for (int m = 0; m < 4; ++m) { const i32x4 lo_ = *(const PG8_LAS i32x4*)(lds + PG8_SA(b, h) + aoff + m * 2048), hi_ = *(const PG8_LAS i32x4*)(lds + PG8_SA(b, h) + aoff + m * 2048 + 1024); \
        dst##8[m] = __builtin_shufflevector(lo_, hi_, 0, 1, 2, 3, 4, 5, 6, 7); } } \
    else { _Pragma("unroll") for (int m = 0; m < 4; ++m) _Pragma("unroll") for (int k = 0; k < 2; ++k) dst[m][k] = *(const PG8_LAS bf16x8*)(lds + PG8_SA(b, h) + aoff + m * 2048 + k * 1024); } } while (0)
#define PG8_LDB(dst, b, h) do { if constexpr (Sched::FP8) { _Pragma("unroll") for (int n = 0; n < 2; ++n) { const i32x4 lo_ = *(const PG8_LAS i32x4*)(lds + PG8_SB(b, h) + boff + n * 2048), hi_ = *(const PG8_LAS i32x4*)(lds + PG8_SB(b, h) + boff + n * 2048 + 1024); \
        dst##8[n] = __builtin_shufflevector(lo_, hi_, 0, 1, 2, 3, 4, 5, 6, 7); } } \
    else { _Pragma("unroll") for (int n = 0; n < 2; ++n) _Pragma("unroll") for (int k = 0; k < 2; ++k) dst[n][k] = *(const PG8_LAS bf16x8*)(lds + PG8_SB(b, h) + boff + n * 2048 + k * 1024); } } while (0)
#define PG8_MMA(ai, bj, At, Bt) do { __builtin_amdgcn_s_setprio(1); \
        if constexpr (Sched::FP8) { _Pragma("unroll") for (int m = 0; m < 4; ++m) _Pragma("unroll") for (int n = 0; n < 2; ++n) \
            acc[ai][bj][m][n] = __builtin_amdgcn_mfma_scale_f32_16x16x128_f8f6f4(Bt##8[n], At##8[m], acc[ai][bj][m][n], 0, 0, 0, 0x7f7f7f7f, 0, 0x7f7f7f7f); \
            _Pragma("unroll") for (int m = 0; m < 4; ++m) _Pragma("unroll") for (int n = 0; n < 2; ++n) asm volatile("" : "+v"(acc[ai][bj][m][n]));   } \
        else { _Pragma("unroll") for (int m = 0; m < 4; ++m) _Pragma("unroll") for (int n = 0; n < 2; ++n) _Pragma("unroll") for (int k = 0; k < 2; ++k) \
            acc[ai][bj][m][n] = __builtin_amdgcn_mfma_f32_16x16x32_bf16(Bt[n][k], At[m][k], acc[ai][bj][m][n], 0, 0, 0); } \
        __builtin_amdgcn_s_setprio(0); } while (0)
#define PG8_WAIT_V(n) asm volatile("s_waitcnt vmcnt(" #n ")" ::: "memory")
#define PG8_WAIT_L(n) asm volatile("s_waitcnt lgkmcnt(" #n ")" ::: "memory")
#define PG8_BAR __builtin_amdgcn_s_barrier()
#define PG8_SCHED __builtin_amdgcn_sched_barrier(0)
    Unit cur, nxt; int ui = 0;
    if (!S.next(0, cur)) return;
    f32x4 acc[2][2][4][2];
#pragma unroll
    for (int a = 0; a < 2; ++a)
#pragma unroll
        for (int b = 0; b < 2; ++b)
#pragma unroll
            for (int m = 0; m < 4; ++m)
#pragma unroll
                for (int n = 0; n < 2; ++n) acc[a][b][m][n] = (f32x4){0.f, 0.f, 0.f, 0.f};
    bf16x8 At[4][2], B0[2][2], B1[2][2];
    i32x8 At8[4], B08[2], B18[2];
    if constexpr (GATHER) S.a_offsets(cur, Rr, Cc, K, voC);
    else {
#pragma unroll
        for (int h = 0; h < 2; ++h)
#pragma unroll
            for (int i = 0; i < 2; ++i) voC[h][i] = (unsigned)((Rr[i] + h * HALF) * K + Cc[i]) * 2u;
    }
    const char* cA = (const char*)g.A + S.a_base(cur, K); const char* cB = (const char*)g.Bt + S.b_base(cur, K);
    PG8_STAGE(PG8_SB(0, 0), cB, voffB); PG8_STAGE(PG8_SB(0, 1), cB + hstep, voffB); PG8_STAGE(PG8_SA(0, 0), cA, voC[0]); PG8_STAGE(PG8_SA(0, 1), cA, voC[1]);
    if (wr == 1) PG8_BAR;
    PG8_WAIT_V(2); PG8_BAR;
    PG8_STAGE(PG8_SB(1, 0), cB + kstep, voffB); PG8_STAGE(PG8_SA(1, 0), cA + kstepA, voC[0]); PG8_STAGE(PG8_SB(1, 1), cB + hstep + kstep, voffB);
    PG8_WAIT_V(6); PG8_BAR;
    for (;;) {
        const bool has_next = S.next(ui + 1, nxt);
        const char* nA = has_next ? (const char*)g.A + S.a_base(nxt, K) : cA; const char* nB = has_next ? (const char*)g.Bt + S.b_base(nxt, K) : cB;
        if constexpr (GATHER) {
            if (has_next) S.a_offsets(nxt, Rr, Cc, K, voN);
            else {
#pragma unroll
                for (int h = 0; h < 2; ++h)
#pragma unroll
                    for (int i = 0; i < 2; ++i) voN[h][i] = voC[h][i];
            }
        }
        for (int t = 0; t < nt; t += 2) {
            asm volatile(".p2align 6" ::: "memory");
            const bool last = (t == nt - 2);
            const char* a1 = cA + (size_t)(t + 1) * kstepA;
            const char* a2 = last ? nA : cA + (size_t)(t + 2) * kstepA; const char* b2 = last ? nB : cB + (size_t)(t + 2) * kstep;
            const char* a3 = a2 + kstepA; const char* b3 = b2 + kstep;
            unsigned vo2[2][2];
            if (GATHER && last) { asm volatile("" ::: "memory");
#pragma unroll
                for (int h = 0; h < 2; ++h)
#pragma unroll
                    for (int i = 0; i < 2; ++i) vo2[h][i] = voN[h][i];
            } else {
                if (GATHER) asm volatile("" ::: "memory");
#pragma unroll
                for (int h = 0; h < 2; ++h)
#pragma unroll
                    for (int i = 0; i < 2; ++i) vo2[h][i] = voC[h][i]; }
            PG8_LDB(B0, 0, 0); PG8_LDB(B1, 0, 1); PG8_SCHED; PG8_LDA(At, 0, 0); PG8_STAGE(PG8_SA(1, 1), a1, voC[1]);
            PG8_WAIT_V(8); PG8_WAIT_L(0); PG8_BAR; PG8_MMA(0, 0, At, B0); PG8_MMA(0, 1, At, B1); PG8_BAR; PG8_SCHED;
            PG8_LDA(At, 0, 1); PG8_STAGE(PG8_SB(0, 0), b2, voffB); PG8_STAGE(PG8_SB(0, 1), b2 + hstep, voffB); PG8_STAGE(PG8_SA(0, 0), a2, vo2[0]);
            PG8_WAIT_V(8); PG8_WAIT_L(0); PG8_BAR; PG8_MMA(1, 0, At, B0); PG8_MMA(1, 1, At, B1); PG8_BAR; PG8_SCHED;
            PG8_LDB(B0, 1, 0); PG8_LDB(B1, 1, 1); PG8_SCHED; PG8_LDA(At, 1, 0); PG8_STAGE(PG8_SA(0, 1), a2, vo2[1]);
            PG8_WAIT_V(8); PG8_WAIT_L(0); PG8_BAR; PG8_MMA(0, 0, At, B0); PG8_MMA(0, 1, At, B1); PG8_BAR; PG8_SCHED;
            PG8_LDA(At, 1, 1); PG8_STAGE(PG8_SB(1, 0), b3, voffB); PG8_STAGE(PG8_SB(1, 1), b3 + hstep, voffB); PG8_STAGE(PG8_SA(1, 0), a3, vo2[0]);
            PG8_WAIT_V(8); PG8_WAIT_L(0); PG8_BAR; PG8_MMA(1, 0, At, B0); PG8_MMA(1, 1, At, B1); PG8_BAR; PG8_SCHED;
        }
        if constexpr (ALIGN_EPI) { if (wr == 0) PG8_BAR; }
        bool keep = false;
        if constexpr (epi_chains<Epi>::value) { E.chain(acc, cur, wr, wc, fr, fq); keep = (cur.e == 0); }
        else E(acc, cur, wr, wc, fr, fq);
        if (!has_next) break;
        if (!keep) {
#pragma unroll
        for (int a = 0; a < 2; ++a)
#pragma unroll
            for (int b = 0; b < 2; ++b)
#pragma unroll
                for (int m = 0; m < 4; ++m)
#pragma unroll
                    for (int n = 0; n < 2; ++n) acc[a][b][m][n] = (f32x4){0.f, 0.f, 0.f, 0.f};
        }
        cur = nxt; cA = nA; cB = nB; ++ui;
        if constexpr (GATHER) {
#pragma unroll
            for (int h = 0; h < 2; ++h)
#pragma unroll
                for (int i = 0; i < 2; ++i) voC[h][i] = voN[h][i];
        }
        if constexpr (ALIGN_EPI) { if (wr == 1) PG8_BAR; }
    }
    PG8_WAIT_V(0);
    if constexpr (!ALIGN_EPI) { if (wr == 0) PG8_BAR; }
    PG8_BAR;
#undef PG8_SA
#undef PG8_SB
#undef PG8_STAGE
#undef PG8_LDA
#undef PG8_LDB
#undef PG8_MMA
#undef PG8_WAIT_V
#undef PG8_WAIT_L
#undef PG8_BAR
#undef PG8_SCHED
}
}

#include <hip/hip_bf16.h>
#include <cmath>
namespace attn_body {
using bf16=__hip_bfloat16;
using bf16x8=__attribute__((ext_vector_type(8)))short;
using s16x4=__attribute__((ext_vector_type(4)))short;
using f32x16=__attribute__((ext_vector_type(16)))float;
using u32x4=__attribute__((ext_vector_type(4)))unsigned;
constexpr int BATCH=8,NHEAD=8,SEQ=2048,D=64,DM=NHEAD*D;
constexpr int NW=8,QBLK=32,QB=QBLK*NW,KVBLK=64,NQB=SEQ/QB;
constexpr int ATTN_PITCH=DM, ATTN_UNIT_ROWS=QB;
__device__ __forceinline__ int crow(int r,int hi){return (r&3)+8*(r>>2)+4*hi;}
#define SBAR() __builtin_amdgcn_sched_barrier(0)
__device__ __forceinline__ void cmask(f32x16&p0,f32x16&p1,int jb,int qrel,int hi){
  const float NEG=-INFINITY; int kb=64*jb+4*hi;
  #pragma unroll
  for(int r=0;r<16;++r){int kv=kb+(r&3)+8*(r>>2); if(kv>qrel)p0[r]=NEG; if(kv+32>qrel)p1[r]=NEG;}
}

constexpr int NSLOT=3, SLOTB=8192;
constexpr int LDS_K=0, LDS_V=NSLOT*SLOTB, LDS_WS=2*NSLOT*SLOTB, LDS_OST=LDS_WS+NW*64*4, LDS_CB=LDS_OST+NW*4096, LDS_BYTES=LDS_CB+SEQ*4;
constexpr float C2=0.125f*1.4426950408889634f;
__device__ __forceinline__ void glds16s(const void*base,unsigned voff,unsigned lds_dst){unsigned keep;
  asm volatile("s_mov_b32 %0, m0\n\ts_mov_b32 m0, %3\n\ts_nop 0\n\tglobal_load_lds_dwordx4 %1, %2\n\ts_mov_b32 m0, %0":"=&s"(keep):"v"(voff),"s"(base),"s"(lds_dst):"memory");}
__device__ __forceinline__ void glds16(const void*gsrc,unsigned lds_dst){unsigned keep;
  asm volatile("s_mov_b32 %0, m0\n\ts_mov_b32 m0, %2\n\ts_nop 0\n\tglobal_load_lds_dwordx4 %1, off\n\ts_mov_b32 m0, %0":"=&s"(keep):"v"(gsrc),"s"(lds_dst):"memory");}
__device__ __forceinline__ float max3f(float a,float b,float c){float r;asm("v_max3_f32 %0, %1, %2, %3":"=v"(r):"v"(a),"v"(b),"v"(c));return r;}
__device__ __forceinline__ float max2f(float a,float b){float r;asm("v_max_f32_e32 %0, %1, %2":"=v"(r):"v"(a),"v"(b));return r;}
__device__ __forceinline__ float fadd_s(float a,float b){float r;asm("v_add_f32_e32 %0, %1, %2":"=v"(r):"v"(a),"v"(b));return r;}
__device__ __forceinline__ float fsub_s(float a,float b){float r;asm("v_sub_f32_e32 %0, %1, %2":"=v"(r):"v"(a),"v"(b));return r;}
typedef float f32x2_t __attribute__((ext_vector_type(2))); typedef __bf16 bf16x2_t __attribute__((ext_vector_type(2)));
__device__ __forceinline__ unsigned cvtpk_s(float lo,float hi){f32x2_t v={lo,hi};bf16x2_t b=__builtin_convertvector(v,bf16x2_t);return __builtin_bit_cast(unsigned,b);}
#define WAIT_BAR(N) asm volatile("s_waitcnt vmcnt(" #N ") lgkmcnt(0)\n\ts_barrier":::"memory")

__device__ __forceinline__ void qkt(f32x16&p0,f32x16&p1,const char*Kslot,const bf16x8*qr,const f32x16&negm,int r32,int hi,bf16x8 kb0,bf16x8 kb1,bf16x8 qx){
  const char*kb=Kslot+hi*1024+r32*16;
  #pragma unroll
  for(int d0=0;d0<4;++d0){
    const bf16x8 b0=*reinterpret_cast<const bf16x8*>(kb+d0*2048);
    const bf16x8 b1=*reinterpret_cast<const bf16x8*>(kb+d0*2048+512);
    if(d0==0){p0=__builtin_amdgcn_mfma_f32_32x32x16_bf16(b0,qr[0],negm,0,0,0);p1=__builtin_amdgcn_mfma_f32_32x32x16_bf16(b1,qr[0],negm,0,0,0);}
    else{p0=__builtin_amdgcn_mfma_f32_32x32x16_bf16(b0,qr[d0],p0,0,0,0);p1=__builtin_amdgcn_mfma_f32_32x32x16_bf16(b1,qr[d0],p1,0,0,0);}}
  p0=__builtin_amdgcn_mfma_f32_32x32x16_bf16(kb0,qx,p0,0,0,0);p1=__builtin_amdgcn_mfma_f32_32x32x16_bf16(kb1,qx,p1,0,0,0);
}
typedef __attribute__((address_space(3))) const char* lds_cptr;
typedef short v4i16_t __attribute__((ext_vector_type(4)));
__device__ __forceinline__ void kload8(bf16x8*kf,lds_cptr kp){
  kf[0]=*(const __attribute__((address_space(3))) bf16x8*)(kp);      kf[1]=*(const __attribute__((address_space(3))) bf16x8*)(kp+512);
  kf[2]=*(const __attribute__((address_space(3))) bf16x8*)(kp+2048); kf[3]=*(const __attribute__((address_space(3))) bf16x8*)(kp+2560);
  kf[4]=*(const __attribute__((address_space(3))) bf16x8*)(kp+4096); kf[5]=*(const __attribute__((address_space(3))) bf16x8*)(kp+4608);
  kf[6]=*(const __attribute__((address_space(3))) bf16x8*)(kp+6144); kf[7]=*(const __attribute__((address_space(3))) bf16x8*)(kp+6656);
}
__device__ __forceinline__ void kload2(bf16x8*kf,lds_cptr kp,int j){ kf[2*j]=*(const __attribute__((address_space(3))) bf16x8*)(kp+j*2048); kf[2*j+1]=*(const __attribute__((address_space(3))) bf16x8*)(kp+j*2048+512); }
__device__ __forceinline__ s16x4 vtr(lds_cptr p){ return __builtin_bit_cast(s16x4,__builtin_amdgcn_ds_read_tr16_b64_v4i16((__attribute__((address_space(3))) v4i16_t*)p)); }
__device__ __forceinline__ float rowmax(const f32x16&p0,const f32x16&p1){
  float a=max3f(p0[0],p0[1],p1[0]),b=max3f(p0[2],p0[3],p1[1]);a=max3f(a,p1[2],p1[3]);
  #pragma unroll
  for(int r=4;r<16;r+=4){a=max3f(a,p0[r],p0[r+1]);b=max3f(b,p0[r+2],p0[r+3]);a=max3f(a,p1[r],p1[r+1]);b=max3f(b,p1[r+2],p1[r+3]);}
  const float m=max2f(a,b);
  auto rr=__builtin_amdgcn_permlane32_swap(__float_as_uint(m),__float_as_uint(m),false,false);
  return max2f(__uint_as_float(rr[0]),__uint_as_float(rr[1]));
}
__device__ __forceinline__ void pv(f32x16*o,int vb,bf16x8 pa0,bf16x8 pa1,bf16x8 pa2,bf16x8 pa3){
  #pragma unroll
  for(int d0=0;d0<2;++d0){s16x4 lo[4],hi[4];
    #pragma unroll
    for(int ks=0;ks<4;++ks){
      asm volatile("ds_read_b64_tr_b16 %0,%1 offset:%c2":"=&v"(lo[ks]):"v"(vb),"i"(d0*4096+ks*1024):"memory");
      asm volatile("ds_read_b64_tr_b16 %0,%1 offset:%c2":"=&v"(hi[ks]):"v"(vb),"i"(d0*4096+ks*1024+512):"memory");}
    asm volatile("s_waitcnt lgkmcnt(0)":::"memory");SBAR();
    #define PK(k) (bf16x8){lo[k][0],lo[k][1],lo[k][2],lo[k][3],hi[k][0],hi[k][1],hi[k][2],hi[k][3]}
    o[d0]=__builtin_amdgcn_mfma_f32_32x32x16_bf16(pa0,PK(0),o[d0],0,0,0);
    o[d0]=__builtin_amdgcn_mfma_f32_32x32x16_bf16(pa1,PK(1),o[d0],0,0,0);
    o[d0]=__builtin_amdgcn_mfma_f32_32x32x16_bf16(pa2,PK(2),o[d0],0,0,0);
    o[d0]=__builtin_amdgcn_mfma_f32_32x32x16_bf16(pa3,PK(3),o[d0],0,0,0);
    #undef PK
  }
}

#define ATTN_STORE16(p,v) __builtin_amdgcn_raw_buffer_store_b128((v), __builtin_amdgcn_make_buffer_rsrc((void*)O, 0, (int)(16384u * 512u * 2u), 0x00020000), (int)((const char*)(p) - (const char*)O), 0, 16)
#ifndef ATTN_STORE16
#define ATTN_STORE16(p,v) (*(u32x4*)(p)=(v))
#endif
template<int THRL> __device__ __forceinline__ void attn_unit(int b,int h,int qb,const bf16*Q,const bf16*__restrict__ K,const bf16*__restrict__ V,bf16*O,const unsigned*__restrict__ CP,char*shm,bool stage_cb){
  const int tid=tid_opaque(),lane=tid&63,r32=lane&31,hi=lane>>5; const int wid=__builtin_amdgcn_readfirstlane(tid>>6);
  const long rowbase=(long)b*SEQ; const int q0=qb*QB;
  const bf16*Qw=Q+(rowbase+q0+wid*QBLK)*DM+h*D;
  const bf16*Kh=K+rowbase*DM+h*D,*Vh=V+rowbase*DM+h*D;
  const lds_cptr shm3=(lds_cptr)shm;
  const unsigned lds0=(unsigned)(uintptr_t)shm;
  float*wsf=(float*)(shm+LDS_WS)+wid*64;
  const unsigned koff=(unsigned)(lane*DM+wid*8)*2u;
  const unsigned voff=(unsigned)((16*(wid&3)+(lane>>2))*DM+(wid>>2)*32+(lane&3)*8)*2u;
  const unsigned kdst=lds0+LDS_K+wid*1024, vdst=lds0+LDS_V+wid*1024;
  #define DMA_K(t,slot) glds16s(Kh+(long)(t)*KVBLK*DM,koff,(unsigned)__builtin_amdgcn_readfirstlane(kdst+(slot)))
  #define DMA_V(t,slot) glds16s(Vh+(long)(t)*KVBLK*DM,voff,(unsigned)__builtin_amdgcn_readfirstlane(vdst+(slot)))
  const int vb0=(int)(lds0+LDS_V)+((lane>>4)&1)*32+(lane&3)*8+(4*hi+((lane&15)>>2))*64;
  const char*Kbase=shm+LDS_K; bf16x8 kf[8];
  const lds_cptr kp0=shm3+LDS_K+hi*1024+r32*16; const lds_cptr vp0=shm3+LDS_V+((lane>>4)&1)*32+(lane&3)*8+(4*hi+((lane&15)>>2))*64;
  const int NT=(q0+QB)/KVBLK;
  const __attribute__((address_space(3))) unsigned* cl3=(const __attribute__((address_space(3))) unsigned*)(shm3+LDS_CB);
  { __attribute__((address_space(3))) unsigned* clw=(__attribute__((address_space(3))) unsigned*)(shm3+LDS_CB); if(stage_cb)for(int i=tid;i<q0+QB;i+=NW*64)clw[i]=CP[i]; }
  bf16x8 qx; { const short one_=(short)(hi?0:0x3F80); qx=(bf16x8){one_,one_,0,0,0,0,0,0}; } asm volatile("":"+v"(qx));
  #define KBIAS(w) __builtin_bit_cast(bf16x8,(u32x4){hi?0u:(w),0u,0u,0u})
  DMA_K(0,0);DMA_V(0,0);DMA_K(1,SLOTB);
  bf16x8 qr[4];
  #pragma unroll
  for(int d0=0;d0<4;++d0)qr[d0]=*reinterpret_cast<const bf16x8*>(&Qw[(long)r32*DM+d0*16+hi*8]);
  float mhat=0.f,l_reg=0.f;f32x16 o[2];o[0]=f32x16{};o[1]=f32x16{};f32x16 negm=f32x16{};asm volatile("":"+v"(negm));
  const int qrel=wid*QBLK+r32;
  #define CMASK(P0,P1,t) do{int jb_=(t)-(NT-4); if(jb_>=0)cmask(P0,P1,jb_,qrel,hi);}while(0)
  bool resc=false;
  #define START(P0,P1) do{ const float rm=rowmax(P0,P1); resc=false; \
    { const float dl=rm; mhat=fadd_s(mhat,dl); \
      _Pragma("unroll") for(int r=0;r<16;++r){P0[r]=fsub_s(P0[r],dl);P1[r]=fsub_s(P1[r],dl);} \
      _Pragma("unroll") for(int r=0;r<16;++r)negm[r]=-mhat; asm volatile("":"+v"(negm)); } \
    _Pragma("unroll") for(int r=0;r<16;++r)P0[r]=__builtin_amdgcn_exp2f(P0[r]); }while(0)
  #define RESC() do{ if(resc){ asm volatile("s_waitcnt lgkmcnt(0)":::"memory"); \
      _Pragma("unroll") for(int d_=0;d_<2;++d_) _Pragma("unroll") for(int r=0;r<16;++r)o[d_][r]*=wsf[crow(r,hi)]; } }while(0)
  f32x16 pA0,pA1,pB0,pB1;
  int sl_prev=0,sl_cur=0,sl_next=SLOTB;
  #define ROT() do{sl_prev=sl_cur;sl_cur=sl_next;sl_next=(sl_next==(NSLOT-1)*SLOTB)?0:sl_next+SLOTB;}while(0)
  DMA_K(2,2*SLOTB);
  WAIT_BAR(3);
  { const unsigned c0_=cl3[r32],c1_=cl3[32+r32]; qkt(pA0,pA1,Kbase,qr,negm,r32,hi,KBIAS(c0_),KBIAS(c1_),qx); } asm volatile("s_nop 15\n\ts_nop 7":"+v"(pA0),"+v"(pA1));CMASK(pA0,pA1,0);
  START(pA0,pA1);
  _Pragma("unroll") for(int r=0;r<16;++r)pA1[r]=__builtin_amdgcn_exp2f(pA1[r]);
  WAIT_BAR(0);
  DMA_K(3,0);DMA_V(1,SLOTB);
  ROT();
  kload8(kf,kp0+sl_cur);
  WAIT_BAR(2);
  s16x4 vlo[8],vhi[8]; u32x4 pw0,pw1,pw2,pw3;
  #define PKW(P,B) cvtpk_s(P[B],P[B+1])
  #define PAF(k) __builtin_bit_cast(bf16x8,pw##k)
  #define VFR(i) (bf16x8){vlo[i][0],vlo[i][1],vlo[i][2],vlo[i][3],vhi[i][0],vhi[i][1],vhi[i][2],vhi[i][3]}
  #define PIN(x) asm volatile("":"+v"(x))
  #define MX3(a,b,c) __builtin_fmaxf(__builtin_fmaxf((a),(b)),(c))
  #define GAPA(MF,A0,A1,A2,A3,W0,W1,PW) do{ MF; sacc+=A0; sacc+=A1; sacc+=A2; sacc+=A3; PIN(sacc); W0; W1; PIN(PW); SBAR(); }while(0)
  #define EX(v) __builtin_amdgcn_exp2f(v)
  #define GAPB(MF,X,B) do{ MF; X[B]=EX(X[B]); X[B+1]=EX(X[B+1]); X[B+2]=EX(X[B+2]); X[B+3]=EX(X[B+3]); PIN(X); SBAR(); }while(0)
  #define VRD(i) do{ vlo[i]=vtr(vp_+(((i)>>2)*4096+((i)&3)*1024)); vhi[i]=vtr(vp_+(((i)>>2)*4096+((i)&3)*1024+512)); }while(0)
  #define KRD(G,j) do{ if(G){ kload2(kf,kp0+sl_next,j); SBAR(); } }while(0)
  #define STEP(C0,C1,P0,P1,t,GK,GV,GL) do{ SBAR(); \
    const lds_cptr vp_=vp0+sl_prev; const unsigned cw0_=cl3[(t)*KVBLK+r32],cw1_=cl3[(t)*KVBLK+32+r32]; \
    VRD(0); SBAR(); float sacc=(P0[0]+P0[1]); \
    GAPA(C0=__builtin_amdgcn_mfma_f32_32x32x16_bf16(kf[0],qr[0],negm,0,0,0), P0[2],P0[3],P0[4],P0[5],     pw0[0]=PKW(P0,0), pw0[1]=PKW(P0,2), pw0); \
    VRD(4); SBAR(); GAPA(C1=__builtin_amdgcn_mfma_f32_32x32x16_bf16(kf[1],qr[0],negm,0,0,0), P0[6],P0[7],P0[8],P0[9],     pw0[2]=PKW(P0,4), pw0[3]=PKW(P0,6), pw0); \
    VRD(1); SBAR(); GAPA(C0=__builtin_amdgcn_mfma_f32_32x32x16_bf16(kf[2],qr[1],C0,0,0,0),   P0[10],P0[11],P0[12],P0[13], pw1[0]=PKW(P0,8), pw1[1]=PKW(P0,10), pw1); \
    VRD(5); SBAR(); GAPA(C1=__builtin_amdgcn_mfma_f32_32x32x16_bf16(kf[3],qr[1],C1,0,0,0),   P0[14],P0[15],P1[0],P1[1],   pw1[2]=PKW(P0,12),pw1[3]=PKW(P0,14), pw1); \
    VRD(2); SBAR(); GAPA(C0=__builtin_amdgcn_mfma_f32_32x32x16_bf16(kf[4],qr[2],C0,0,0,0),   P1[2],P1[3],P1[4],P1[5],     pw2[0]=PKW(P1,0), pw2[1]=PKW(P1,2), pw2); \
    VRD(6); SBAR(); GAPA(C1=__builtin_amdgcn_mfma_f32_32x32x16_bf16(kf[5],qr[2],C1,0,0,0),   P1[6],P1[7],P1[8],P1[9],     pw2[2]=PKW(P1,4), pw2[3]=PKW(P1,6), pw2); \
    VRD(3); SBAR(); GAPA(C0=__builtin_amdgcn_mfma_f32_32x32x16_bf16(kf[6],qr[3],C0,0,0,0),   P1[10],P1[11],P1[12],P1[13], pw3[0]=PKW(P1,8), pw3[1]=PKW(P1,10), pw3); \
    VRD(7); SBAR(); GAPA(C1=__builtin_amdgcn_mfma_f32_32x32x16_bf16(kf[7],qr[3],C1,0,0,0),   P1[14],P1[15],0.f,0.f,       pw3[2]=PKW(P1,12),pw3[3]=PKW(P1,14), pw3); \
    C0=__builtin_amdgcn_mfma_f32_32x32x16_bf16(KBIAS(cw0_),qx,C0,0,0,0); C1=__builtin_amdgcn_mfma_f32_32x32x16_bf16(KBIAS(cw1_),qx,C1,0,0,0); SBAR(); \
    l_reg+=sacc; \
    if(GK){DMA_K((t)+3,sl_cur);} if(GV){DMA_V((t)+1,sl_next);} \
    CMASK(C0,C1,t); \
    { float a=MX3(C0[0],C0[1],C1[0]),b=MX3(C0[2],C0[3],C1[1]); a=MX3(a,C1[2],C1[3]); \
      _Pragma("unroll") for(int r=4;r<16;r+=4){a=MX3(a,C0[r],C0[r+1]);b=MX3(b,C0[r+2],C0[r+3]);a=MX3(a,C1[r],C1[r+1]);b=MX3(b,C1[r+2],C1[r+3]);} \
      float rm=__builtin_fmaxf(a,b); { auto rr=__builtin_amdgcn_permlane32_swap(__float_as_uint(rm),__float_as_uint(rm),false,false); rm=__builtin_fmaxf(__uint_as_float(rr[0]),__uint_as_float(rr[1])); } \
      resc=false; \
      if(__builtin_expect(__any(rm>(float)THRL),0)){ const float dl=__builtin_fmaxf(rm,0.f); mhat+=dl; \
        _Pragma("unroll") for(int r=0;r<16;++r){C0[r]-=dl;C1[r]-=dl;} \
        _Pragma("unroll") for(int r=0;r<16;++r)negm[r]=-mhat; asm volatile("":"+v"(negm)); \
        const float f=__builtin_amdgcn_exp2f(-dl); l_reg*=f; if(hi==0)wsf[r32]=f; resc=true; } } \
    SBAR(); \
    GAPB(o[0]=__builtin_amdgcn_mfma_f32_32x32x16_bf16(PAF(0),VFR(0),o[0],0,0,0), C0,0); \
    GAPB(o[1]=__builtin_amdgcn_mfma_f32_32x32x16_bf16(PAF(0),VFR(4),o[1],0,0,0), C0,4); \
    KRD(GL,0); GAPB(o[0]=__builtin_amdgcn_mfma_f32_32x32x16_bf16(PAF(1),VFR(1),o[0],0,0,0), C0,8); \
    KRD(GL,1); GAPB(o[1]=__builtin_amdgcn_mfma_f32_32x32x16_bf16(PAF(1),VFR(5),o[1],0,0,0), C0,12); \
    KRD(GL,2); GAPB(o[0]=__builtin_amdgcn_mfma_f32_32x32x16_bf16(PAF(2),VFR(2),o[0],0,0,0), C1,0); \
    KRD(GL,3); GAPB(o[1]=__builtin_amdgcn_mfma_f32_32x32x16_bf16(PAF(2),VFR(6),o[1],0,0,0), C1,4); \
    GAPB(o[0]=__builtin_amdgcn_mfma_f32_32x32x16_bf16(PAF(3),VFR(3),o[0],0,0,0), C1,8); \
    GAPB(o[1]=__builtin_amdgcn_mfma_f32_32x32x16_bf16(PAF(3),VFR(7),o[1],0,0,0), C1,12); \
    }while(0)
  int t=1;
  #undef CMASK
  #define CMASK(P0,P1,t) do{}while(0)
  for(;t+5<NT;t+=2){
    STEP(pB0,pB1,pA0,pA1,t,true,true,true);     WAIT_BAR(2); RESC(); ROT();
    STEP(pA0,pA1,pB0,pB1,t+1,true,true,true);   WAIT_BAR(2); RESC(); ROT();
  }
  #undef CMASK
  #define CMASK(P0,P1,t) do{int jb_=(t)-(NT-4); if(jb_>=0)cmask(P0,P1,jb_,qrel,hi);}while(0)
  #define ENDW(tt) do{ if((tt)+3<NT){WAIT_BAR(2);} else if((tt)+2<NT){WAIT_BAR(1);} else {WAIT_BAR(0);} }while(0)
  for(;t+1<NT;t+=2){
    STEP(pB0,pB1,pA0,pA1,t,(t+3<NT),(t+1<NT),(t+1<NT));       ENDW(t);   RESC(); ROT();
    STEP(pA0,pA1,pB0,pB1,t+1,(t+4<NT),(t+2<NT),(t+2<NT));     ENDW(t+1); RESC(); ROT();
  }
  STEP(pB0,pB1,pA0,pA1,NT-1,false,false,false); RESC();
  { float sacc=pB0[0]+pB0[1]; _Pragma("unroll") for(int r=2;r<16;++r)sacc+=pB0[r]; _Pragma("unroll") for(int r=0;r<16;++r)sacc+=pB1[r]; l_reg+=sacc;
    pw0=(u32x4){PKW(pB0,0),PKW(pB0,2),PKW(pB0,4),PKW(pB0,6)};pw1=(u32x4){PKW(pB0,8),PKW(pB0,10),PKW(pB0,12),PKW(pB0,14)};pw2=(u32x4){PKW(pB1,0),PKW(pB1,2),PKW(pB1,4),PKW(pB1,6)};pw3=(u32x4){PKW(pB1,8),PKW(pB1,10),PKW(pB1,12),PKW(pB1,14)};
    SBAR(); pv(o,vb0+sl_cur,PAF(0),PAF(1),PAF(2),PAF(3)); }
  #undef PKW
  #undef PAF
  #undef VFR
  #undef PIN
  #undef MX3
  #undef GAPA
  #undef GAPB
  #undef EX
  #undef VRD
  #undef KRD
  #undef STEP
  #undef ENDW
  {auto rr=__builtin_amdgcn_permlane32_swap(__float_as_uint(l_reg),__float_as_uint(l_reg),false,false);l_reg=__uint_as_float(rr[0])+__uint_as_float(rr[1]);}
  if(hi==0)wsf[32+r32]=l_reg;asm volatile("s_waitcnt lgkmcnt(0)":::"memory");
  float rli[16];
  #pragma unroll
  for(int r=0;r<16;++r)rli[r]=__builtin_amdgcn_rcpf(wsf[32+crow(r,hi)]);
  bf16*Ow=O+(rowbase+q0+wid*QBLK)*DM+h*D;
  { bf16*stg=(bf16*)(shm+LDS_OST)+wid*2048;
    #pragma unroll
    for(int r=0;r<16;++r){const int orow=crow(r,hi);
      #pragma unroll
      for(int d0=0;d0<2;++d0)stg[orow*64+d0*32+r32]=__float2bfloat16(o[d0][r]*rli[r]);}
    asm volatile("s_waitcnt lgkmcnt(0)":::"memory");
    #pragma unroll
    for(int i=0;i<4;++i){const int row=i*8+(lane>>3),ch=lane&7; const u32x4 v=*(const u32x4*)(stg+row*64+ch*8); ATTN_STORE16(Ow+(long)row*DM+ch*8,v);} }
  asm volatile("s_waitcnt lgkmcnt(0)\n\ts_barrier":::"memory");
  #undef DMA_K
  #undef DMA_V
  #undef CMASK
  #undef START
  #undef RESC
  #undef ROT
  #undef KBIAS
}
constexpr int ATTN_LDS_BYTES=LDS_BYTES;
struct AttnTensors { const bf16* Q; const bf16* K; const bf16* V; bf16* O; const unsigned* CP; };
struct AttnUnit { int bh; int qb; };
struct StaticOrder {
  int vcu, G;
  __device__ __forceinline__ StaticOrder(int grid,int v):vcu(v),G(grid){}
  __device__ __forceinline__ bool next(int i,AttnUnit&u)const{
    if(G==256){ if(i>=2)return false; const int s=vcu&3; u.bh=vcu>>2; u.qb=(i==0)?7-s:s; return true; }
    const int L=i*G+vcu; if(L>=BATCH*NHEAD*NQB)return false; u.bh=L>>3; u.qb=7-(L&7); return true; }
  __device__ __forceinline__ void a_ready(const AttnUnit&)const{}
  __device__ __forceinline__ void done(const AttnUnit&)const{}
};
template<class Sched,int THRL=20> __device__ __forceinline__ void attn_phase(char*lds,const AttnTensors&T,const Sched&S){
  AttnUnit u;
  int pbh=-1,pqb=-1;
  for(int i=0;S.next(i,u);++i){ S.a_ready(u); const bool st=!(u.bh==pbh&&u.qb<=pqb); attn_unit<THRL>(u.bh/NHEAD,u.bh%NHEAD,u.qb,T.Q,T.K,T.V,T.O,T.CP+(long)u.bh*SEQ,lds,st); if(st){pbh=u.bh;pqb=u.qb;} S.done(u); }
}
#undef SBAR
#undef WAIT_BAR
}

constexpr int NWAVES = 8;
constexpr int NPH = 11;
constexpr int N_LAUNCHES = MK_N_LAUNCHES;
static_assert(N_LAUNCHES == 1 || N_LAUNCHES == NPH, "MK_N_LAUNCHES is 1 (one launch) or NPH (one launch per phase)");

constexpr size_t MiB = 1u << 20;
constexpr size_t WS_CTL = 0, CTL_ZERO_BYTES = 128 * 1024;
constexpr size_t WS_MOD = 1 * MiB;
constexpr size_t WS_LOGF = 1 * MiB + 256 * 1024;
constexpr size_t WS_ROUTE = 2 * MiB;
constexpr size_t WS_RW = 2 * MiB + 256 * 1024;
constexpr size_t WS_CUM = 2 * MiB + 512 * 1024;
constexpr size_t WS_LIST = 3 * MiB;
constexpr size_t WS_CUMP = 5 * MiB;
constexpr size_t WS_WIN = 6 * MiB;
constexpr size_t WS_WGLU = 14 * MiB, WS_WOF = 15 * MiB, WS_WOS = 16 * MiB, WS_WO = 17 * MiB;
constexpr size_t WS_WGU = 20 * MiB;
constexpr size_t WS_WD = 84 * MiB;
constexpr size_t WS_H = 116 * MiB;
constexpr size_t WS_Y = 148 * MiB;
constexpr size_t WS_MIX = 164 * MiB;
constexpr size_t WS_Q = WS_MIX, WS_K = WS_MIX + 16 * MiB, WS_V = WS_MIX + 32 * MiB, WS_U = WS_MIX + 48 * MiB, WS_SGA = WS_MIX + 64 * MiB, WS_SGB = WS_MIX + 96 * MiB;
constexpr size_t WS_HID = WS_MIX;
constexpr size_t WS_YROWS = WS_MIX + 40 * MiB;
constexpr size_t WS_X1B = WS_MIX + 96 * MiB;
constexpr size_t WS_LISTW = 292 * MiB;
constexpr size_t WS_END = 294 * MiB;
static_assert(WS_YROWS + (size_t)M * 2 * 1024 * 2 <= WS_END && WS_SGB + (size_t)M * 1024 * 2 <= WS_END, "d_ws map");

constexpr int CW_TMO = 0;
constexpr int CW_CNT = 2048;
constexpr int CW_CHK = 4096;
constexpr int CW_TS = 4200;
constexpr int CW_PANEL = 16384;
constexpr int CW_MOD = 4160;
constexpr int CW_BAR = 8192;

constexpr int RING_OFF = 0, RING_BYTES = 131072;
constexpr int LDS_BYTES = 147456;
constexpr int LDSCTL_OFF = LDS_BYTES - 2048, MISC_OFF = LDSCTL_OFF + 320, MOE_OFF = LDSCTL_OFF + 1024;

#define GAS __attribute__((address_space(1)))
#define LAS __attribute__((address_space(3)))
typedef unsigned short bf16;
typedef unsigned v4u __attribute__((ext_vector_type(4)));
typedef unsigned v2u __attribute__((ext_vector_type(2)));
typedef float f32x4 __attribute__((ext_vector_type(4)));
typedef float f32x2 __attribute__((ext_vector_type(2)));
typedef GAS unsigned gu32;
#define RLX_AGENT __ATOMIC_RELAXED, __HIP_MEMORY_SCOPE_AGENT
#define LDS_WAIT() asm volatile("s_waitcnt lgkmcnt(0)" ::: "memory")
#define VM_WAIT() asm volatile("s_waitcnt vmcnt(0)" ::: "memory")
__device__ __forceinline__ unsigned f2bf(float f) { unsigned u = __builtin_bit_cast(unsigned, f); return (u + 0x7fffu + ((u >> 16) & 1u)) >> 16; }
__device__ __forceinline__ unsigned pk2(float lo, float hi) { unsigned r; asm("v_cvt_pk_bf16_f32 %0, %1, %2" : "=v"(r) : "v"(lo), "v"(hi)); return r; }
__device__ __forceinline__ __amdgpu_buffer_rsrc_t wt_rsrc(void* base, unsigned bytes) { return __builtin_amdgcn_make_buffer_rsrc(base, 0, (int)bytes, 0x00020000); }
__device__ __forceinline__ void store16_wt(__amdgpu_buffer_rsrc_t rsrc, size_t byte_off, v4u v) { __builtin_amdgcn_raw_buffer_store_b128(v, rsrc, (int)(unsigned)byte_off, 0, 16); }
__device__ __forceinline__ float bflo(unsigned w) { return __uint_as_float(w << 16); }
__device__ __forceinline__ float bfhi(unsigned w) { return __uint_as_float(w & 0xffff0000u); }
__device__ __forceinline__ float fast_sigmoid(float v) { return __builtin_amdgcn_rcpf(1.f + __builtin_amdgcn_exp2f(-LOG2E * v)); }

#define XB_TMO      128
#define XB_XCNT(j)  (256  + 64 * (j))
#define XB_XSUB(j)  (1280 + 64 * (j))
#define XB_XGEN(j)  (2304 + 64 * (j))
#define XB_TOP      3328
#define XB_TOPGEN   3392
#define XCD_BAR_WORDS 3456
#define XB_SPIN_CAP (1u << 18)
__device__ __forceinline__ unsigned xb_ld(unsigned* p)              { return __hip_atomic_load(p, __ATOMIC_RELAXED, __HIP_MEMORY_SCOPE_AGENT); }
__device__ __forceinline__ unsigned xb_add(unsigned* p, unsigned v) { return __hip_atomic_fetch_add(p, v, __ATOMIC_RELAXED, __HIP_MEMORY_SCOPE_AGENT); }
__device__ __forceinline__ unsigned xb_xcc_id() { return (unsigned)__builtin_amdgcn_s_getreg((3 << 11) | 20) & 0xFu; }
#define XB_SPIN(cond, bar) do { unsigned _sp = 0; while (cond) { __builtin_amdgcn_s_sleep(1); \
    if ((++_sp & 255u) == 0u) { if (xb_ld(&(bar)[XB_TMO])) break; if (_sp > XB_SPIN_CAP) { atomicAdd(&(bar)[XB_TMO], 1u); break; } } } } while (0)
struct XcdBarrier { unsigned* bar; unsigned x; volatile LAS unsigned* st; };
__device__ __forceinline__ XcdBarrier xcd_barrier_post(unsigned* bar, volatile LAS unsigned* st) {
    XcdBarrier b; b.bar = bar; b.x = xb_xcc_id(); b.st = st;
    if (tid_opaque() == 0) (void)xb_add(&bar[XB_XCNT(b.x)], 1u);
    return b;
}
__device__ __forceinline__ void xcd_barrier_complete(unsigned* bar, unsigned x, unsigned& nloc, unsigned& nx) {
    const unsigned G = gridDim.x * gridDim.y * gridDim.z;
    unsigned sum, cnt, mine, sp = 0u;
    for (;;) {
        sum = 0u; cnt = 0u; mine = 0u;
#pragma unroll
        for (unsigned j = 0; j < 16; ++j) { const unsigned c = xb_ld(&bar[XB_XCNT(j)]); sum += c; cnt += (c > 0u) ? 1u : 0u; mine = (j == x) ? c : mine; }
        if (sum == G) break;
        __builtin_amdgcn_s_sleep(1);
        if ((++sp & 255u) == 0u) { if (xb_ld(&bar[XB_TMO])) break; if (sp > XB_SPIN_CAP) { atomicAdd(&bar[XB_TMO], 1u); break; } }
    }
    nloc = mine > 0u ? mine : 1u; nx = cnt > 0u ? cnt : 1u;
}
struct NoShadow { __device__ __forceinline__ void operator()() const {} };
template <class Shadow = NoShadow, bool RELEASE = true>
__device__ __forceinline__ void xcd_barrier(const XcdBarrier& b, const Shadow& shadow = Shadow()) {
    asm volatile("s_waitcnt vmcnt(0)" ::: "memory");
    __syncthreads();
    const int tid_ = tid_opaque();
    if (tid_ >= 64) { shadow(); }
    else if (tid_ == 0) {
        unsigned* bar = b.bar;
        __builtin_amdgcn_s_waitcnt(0);
        unsigned nloc = b.st[0], nx = b.st[1];
        if (nloc == 0u) { xcd_barrier_complete(bar, b.x, nloc, nx); b.st[0] = nloc; b.st[1] = nx; }
        const unsigned old = xb_add(&bar[XB_XSUB(b.x)], 1u);
        const unsigned gen = old / nloc;
        if (old + 1u == (gen + 1u) * nloc) {
            if (RELEASE) { __builtin_amdgcn_fence(__ATOMIC_RELEASE, "agent"); asm volatile("s_waitcnt vmcnt(0)" ::: "memory"); }
            const unsigned og = xb_add(&bar[XB_TOP], 1u);
            const unsigned tg = og / nx;
            if (og + 1u == (tg + 1u) * nx) xb_add(&bar[XB_TOPGEN], 1u);
            else XB_SPIN(xb_ld(&bar[XB_TOPGEN]) == tg, bar);
            __builtin_amdgcn_fence(__ATOMIC_ACQUIRE, "agent");
            asm volatile("s_waitcnt vmcnt(0)" ::: "memory");
        } else {
            XB_SPIN(xb_ld(&bar[XB_TOPGEN]) == gen, bar);
            __builtin_amdgcn_fence(__ATOMIC_ACQUIRE, "agent");
            asm volatile("s_waitcnt vmcnt(0)" ::: "memory");
        }
    }
    __syncthreads();
}

template <class Shadow>
__device__ __forceinline__ void panel_sync(gu32* cnt, gu32* tmo, const Shadow& shadow) {
    asm volatile("s_waitcnt vmcnt(0)" ::: "memory");
    __syncthreads();
    const int tid_ = tid_opaque();
    if (tid_ >= 64) { shadow(); }
    else if (tid_ == 0) {
        __hip_atomic_fetch_add((unsigned*)cnt, 1u, RLX_AGENT);
        unsigned sp = 0;
        while (__hip_atomic_load((unsigned*)cnt, RLX_AGENT) < 4u) { __builtin_amdgcn_s_sleep(1); if (++sp > (1u << 20)) { __hip_atomic_store((unsigned*)tmo, 1u, RLX_AGENT); break; } }
        __builtin_amdgcn_fence(__ATOMIC_ACQUIRE, "agent"); asm volatile("s_waitcnt vmcnt(0)" ::: "memory");
    }
    __syncthreads();
}
__device__ __forceinline__ void tile_of_wg256(int bx, int& pm, int& pn) {
    const int w = (bx % 8) * 32 + bx / 8; pm = (w / 32) * 8 + (w % 32) % 8; pn = (w % 32) / 8;
}
template <class Shadow>
__device__ __forceinline__ void batch_sync(gu32* cnt, int b_attn, int b_ssm, int b_wait, gu32* tmo, const Shadow& shadow) {
    asm volatile("s_waitcnt vmcnt(0)" ::: "memory");
    __syncthreads();
    const int tid_ = tid_opaque();
    if (tid_ >= 64) { shadow(); }
    else if (tid_ == 0) {
        __hip_atomic_fetch_add((unsigned*)(cnt + 64 * b_attn), 2u, RLX_AGENT); __hip_atomic_fetch_add((unsigned*)(cnt + 64 * b_ssm), 1u, RLX_AGENT);
        unsigned sp = 0;
        while (__hip_atomic_load((unsigned*)(cnt + 64 * b_wait), RLX_AGENT) < 96u) { __builtin_amdgcn_s_sleep(1); if (++sp > (1u << 20)) { __hip_atomic_store((unsigned*)tmo, 1u, RLX_AGENT); break; } }
        __builtin_amdgcn_fence(__ATOMIC_ACQUIRE, "agent"); asm volatile("s_waitcnt vmcnt(0)" ::: "memory");
    }
    __syncthreads();
}
struct Frame {
    LAS unsigned char* lds;
    volatile LAS unsigned* MISC;
    gu32* ctl;
    int tid, lane, wave, vcu, G;
    const float *x, *c, *w_ada, *b_ada, *norm_mix_g, *w_in, *b_forget, *w_out_fox, *lambda_re, *lambda_im, *log_dt, *b_re, *b_im, *c_re, *c_im, *d_skip, *w_glu, *w_out_ssm, *w_o,
        *norm_ffn_g, *w_rg, *b_rg, *w_rexp, *b_rexp, *w_gate, *w_up, *w_down, *final_g;
    float* out;
    float *MOD, *LOGF, *CUM, *RW, *LISTW; int* ROUTE; unsigned* LIST; unsigned* CUMP;
    bf16 *WIN, *WGLU, *WOF, *WOS, *WO, *WGU, *WD, *H, *Y, *Q, *K, *V, *U, *SGA, *SGB, *HID, *YROWS, *X1B;
};

template <int CTRL, int RMASK> __device__ __forceinline__ float dpp_addstep(float v) {
    return v + __builtin_bit_cast(float, __builtin_amdgcn_update_dpp(0, __builtin_bit_cast(int, v), CTRL, RMASK, 0xf, false));
}
__device__ __forceinline__ float wave_sum(float v) {
    v = dpp_addstep<0x111, 0xf>(v); v = dpp_addstep<0x112, 0xf>(v); v = dpp_addstep<0x114, 0xf>(v); v = dpp_addstep<0x118, 0xf>(v);
    v = dpp_addstep<0x142, 0xa>(v); v = dpp_addstep<0x143, 0xc>(v);
    return __builtin_bit_cast(float, __builtin_amdgcn_readlane(__builtin_bit_cast(int, v), 63));
}

__device__ __forceinline__ unsigned pk4_fp8(float a, float b, float c, float d) {
    a = __builtin_amdgcn_fmed3f(a, -448.f, 448.f); b = __builtin_amdgcn_fmed3f(b, -448.f, 448.f); c = __builtin_amdgcn_fmed3f(c, -448.f, 448.f); d = __builtin_amdgcn_fmed3f(d, -448.f, 448.f);
    int r = __builtin_amdgcn_cvt_pk_fp8_f32(a, b, 0, false); r = __builtin_amdgcn_cvt_pk_fp8_f32(c, d, r, true); return (unsigned)r;
}
constexpr float FP8_GW = 256.f, FP8_GH = 16.f;
constexpr float FP8_WSCALE = 32.f, FP8_HSCALE = 4.f, FP8_YSCALE = 8.f;
constexpr int TR_LD = 65, TR_WAVE_BYTES = 64 * TR_LD * 4;
__device__ __forceinline__ void transpose_item(const float* src, int ld_src, bf16* dst, int ld_dst, LAS float* scr, int lane) {
    f32x4 v[16];
    const int kr = lane >> 4, n4 = (lane & 15) * 4;
#pragma unroll
    for (int i = 0; i < 16; ++i) v[i] = __builtin_nontemporal_load((const GAS f32x4*)(src + (size_t)(4 * i + kr) * ld_src + n4));
#pragma unroll
    for (int i = 0; i < 16; ++i) { const int kk = 4 * i + kr; scr[(n4 + 0) * TR_LD + kk] = v[i].x; scr[(n4 + 1) * TR_LD + kk] = v[i].y; scr[(n4 + 2) * TR_LD + kk] = v[i].z; scr[(n4 + 3) * TR_LD + kk] = v[i].w; }
    LDS_WAIT(); asm volatile("" ::: "memory");
    const int c = lane & 7;
#pragma unroll
    for (int j = 0; j < 8; ++j) { const int n = (lane >> 3) + 8 * j; const LAS float* s = scr + n * TR_LD + 8 * c;
        v4u o; o.x = pk2(s[0], s[1]); o.y = pk2(s[2], s[3]); o.z = pk2(s[4], s[5]); o.w = pk2(s[6], s[7]);
        *(GAS v4u*)(dst + (size_t)n * ld_dst + 8 * c) = o; }
    LDS_WAIT(); asm volatile("" ::: "memory");
}

__device__ __forceinline__ void transpose_item_fp8(const float* src, int ld_src, unsigned char* dst, int ld_dst, LAS float* scr, int lane, float scale) {
    f32x4 v[16];
    const int kr = lane >> 4, n4 = (lane & 15) * 4;
#pragma unroll
    for (int i = 0; i < 16; ++i) v[i] = __builtin_nontemporal_load((const GAS f32x4*)(src + (size_t)(4 * i + kr) * ld_src + n4));
#pragma unroll
    for (int i = 0; i < 16; ++i) { const int kk = 4 * i + kr; scr[(n4 + 0) * TR_LD + kk] = v[i].x; scr[(n4 + 1) * TR_LD + kk] = v[i].y; scr[(n4 + 2) * TR_LD + kk] = v[i].z; scr[(n4 + 3) * TR_LD + kk] = v[i].w; }
    LDS_WAIT(); asm volatile("" ::: "memory");
    const int c = lane & 7;
#pragma unroll
    for (int j = 0; j < 8; ++j) { const int n = (lane >> 3) + 8 * j; const LAS float* s = scr + n * TR_LD + 8 * c;
        v2u o; o.x = pk4_fp8(s[0] * scale, s[1] * scale, s[2] * scale, s[3] * scale); o.y = pk4_fp8(s[4] * scale, s[5] * scale, s[6] * scale, s[7] * scale);
        *(GAS v2u*)(dst + (size_t)n * ld_dst + 8 * c) = o; }
    LDS_WAIT(); asm volatile("" ::: "memory");
}
__device__ __forceinline__ void p0_mod(Frame& F) {
    {
        int nmine = 0;
        LAS float* cact = (LAS float*)(F.lds);
        LAS float* red = (LAS float*)(F.lds + 32768);
        for (int i = F.tid; i < 8192; i += 512) { const float v = F.c[i]; cact[i] = v / (1.f + __expf(-v)); }
        __syncthreads();
        for (int it = F.vcu; it < 192; it += F.G) {
            const int cl = F.lane & 31, hf = F.lane >> 5, col = it * 32 + cl;
            float a[8];
#pragma unroll
            for (int b = 0; b < 8; ++b) a[b] = 0.f;
#pragma unroll 1
            for (int i0 = 0; i0 < 64; i0 += 16) {
                float w[16];
#pragma unroll
                for (int i = 0; i < 16; ++i) w[i] = __builtin_nontemporal_load(F.w_ada + (size_t)(16 * (i0 + i) + 2 * F.wave + hf) * 6144 + col);
#pragma unroll
                for (int i = 0; i < 16; ++i) { const int kk = 16 * (i0 + i) + 2 * F.wave + hf;
#pragma unroll
                    for (int b = 0; b < 8; ++b) a[b] += cact[b * 1024 + kk] * w[i]; }
            }
#pragma unroll
            for (int b = 0; b < 8; ++b) { a[b] += __shfl_xor(a[b], 32); if (hf == 0) red[(F.wave * 8 + b) * 32 + cl] = a[b]; }
            __syncthreads();
            if (F.tid < 256) { const int b = F.tid >> 5, c2 = F.tid & 31; float s = 0.f;
#pragma unroll
                for (int w = 0; w < 8; ++w) s += red[(w * 8 + b) * 32 + c2];
                F.MOD[b * 6144 + it * 32 + c2] = s + F.b_ada[it * 32 + c2]; }
            __syncthreads(); ++nmine;
        }
        asm volatile("s_waitcnt vmcnt(0)" ::: "memory"); __syncthreads();
        if (F.tid == 0 && nmine > 0) { __builtin_amdgcn_fence(__ATOMIC_RELEASE, "agent"); asm volatile("s_waitcnt vmcnt(0)" ::: "memory");
            __hip_atomic_fetch_add((unsigned*)(F.ctl + CW_MOD), (unsigned)nmine, RLX_AGENT); }
        __syncthreads();
    }
}
__device__ __forceinline__ void p0_copies(Frame& F, int wg_rank, int n_wg) {
    LAS float* scr = (LAS float*)(F.lds + RING_OFF + F.wave * TR_WAVE_BYTES);
    const int gw = wg_rank * NWAVES + F.wave, NGW = n_wg * NWAVES;
    constexpr int I_A = 16 * 24, I_B = 16 * 40, I_C = 8 * 16, I_D = 8 * 16, I_E = 8 * 16, I_F = 16 * 16, I_G = 32 * 128, I_H = 32 * 128, I_I = 32 * 128;
    constexpr int NITEMS = I_A + I_B + I_C + I_D + I_E + I_F;
    for (int it = gw; it < NITEMS; it += NGW) {
        int r = it;
        if (r < I_A) { const int kb = r / 24, nb = r % 24; transpose_item(F.w_in + (size_t)(64 * kb) * INC + 64 * nb, INC, F.WIN + (size_t)(64 * nb) * 1024 + 64 * kb, 1024, scr, F.lane); continue; } r -= I_A;
        if (r < I_B) { const int kb = r / 40, nb = r % 40;
            if (nb < 8) transpose_item(F.w_in + (size_t)(64 * kb) * INC + 1544 + 64 * nb, INC, F.WIN + (size_t)(1536 + 64 * nb) * 1024 + 64 * kb, 1024, scr, F.lane);
            else transpose_item_fp8(F.w_in + (size_t)(64 * kb) * INC + 1544 + 64 * nb, INC, (unsigned char*)(F.WIN + (size_t)2048 * 1024) + (size_t)(64 * (nb - 8)) * 1024 + 64 * kb, 1024, scr, F.lane, FP8_GW);
            continue; } r -= I_B;
        if (r < I_C) { const int kb = r / 16, nb = r % 16, n0 = 64 * nb, half = n0 >> 9, within = n0 & 511, pn = within >> 7, q = within & 127;
            transpose_item(F.w_glu + (size_t)(64 * kb) * 1024 + n0, 1024, F.WGLU + (size_t)(pn * 256 + half * 128 + q) * 512 + 64 * kb, 512, scr, F.lane); continue; } r -= I_C;
        if (r < I_D) { const int kb = r / 16, nb = r % 16; transpose_item(F.w_out_fox + (size_t)(64 * kb) * 1024 + 64 * nb, 1024, F.WOF + (size_t)(64 * nb) * 512 + 64 * kb, 512, scr, F.lane); continue; } r -= I_D;
        if (r < I_E) { const int kb = r / 16, nb = r % 16; transpose_item(F.w_out_ssm + (size_t)(64 * kb) * 1024 + 64 * nb, 1024, F.WOS + (size_t)(64 * nb) * 512 + 64 * kb, 512, scr, F.lane); continue; } r -= I_E;
        if (r < I_F) { const int kb = r / 16, nb = r % 16; transpose_item(F.w_o + (size_t)(64 * kb) * 1024 + 64 * nb, 1024, F.WO + (size_t)(64 * nb) * 1024 + 64 * kb, 1024, scr, F.lane); continue; } r -= I_F;
    }
}
struct ShadowGateUp {
    const float* w_gate; const float* w_up; bf16* WGU; LAS unsigned char* lds; int seam, wg;
    __device__ __forceinline__ void operator()() const {
        const int tid_ = tid_opaque(); const int wave = __builtin_amdgcn_readfirstlane(tid_ >> 6), lane = tid_ & 63;
        const int kq = wg * 7 + (wave - 1); int r = 6 * kq + (seam - 1);
        if (r >= 8192) return;
        LAS float* scr = (LAS float*)(lds + RING_OFF + wave * TR_WAVE_BYTES);
        const int up = r >= 4096; if (up) r -= 4096; const int e = r >> 7, rr = r & 127, kb = rr >> 3, nb = rr & 7, n0 = 64 * nb, pn = n0 >> 7, q = n0 & 127;
        const float* src = (up ? w_up : w_gate) + (size_t)e * 1024 * 512 + (size_t)(64 * kb) * 512 + n0;
        transpose_item_fp8(src, 512, (unsigned char*)WGU + (size_t)e * 1024 * 1024 + (size_t)(pn * 256 + up * 128 + q) * 1024 + 64 * kb, 1024, scr, lane, FP8_WSCALE);
    }
};
__device__ __forceinline__ void convert_wdown(Frame& F, int wg_lo) {
    LAS float* scr = (LAS float*)(F.lds + RING_OFF + F.wave * TR_WAVE_BYTES);
    const int lo = (wg_lo >= F.G || wg_lo < 0) ? 0 : wg_lo; const int bx = F.vcu;
    if (bx < lo) return;
    const int gw = (bx - lo) * NWAVES + F.wave, NGW = (F.G - lo) * NWAVES;
    for (int r = gw; r < 32 * 128; r += NGW) { const int e = r >> 7, rr = r & 127, kb = rr >> 4, nb = rr & 15;
        transpose_item_fp8(F.w_down + (size_t)e * 512 * 1024 + (size_t)(64 * kb) * 1024 + 64 * nb, 1024, (unsigned char*)F.WD + (size_t)e * 1024 * 512 + (size_t)(64 * nb) * 512 + 64 * kb, 512, scr, F.lane, FP8_WSCALE); }
}

constexpr int P1_PITCH = 2064;
constexpr int P1_IMG_OFF = 8 * 4 * P1_PITCH;
typedef short p1_bf16x8 __attribute__((ext_vector_type(8)));
__device__ __forceinline__ void p1_rows(Frame& F) {
    LAS unsigned char* img = F.lds + P1_IMG_OFF;
    for (int idx = F.tid; idx < 1024; idx += 512) { const int n = idx & 7, kg = (idx >> 3) & 3, ks = idx >> 5, k0 = ks * 32 + kg * 8;
        float w[8];
#pragma unroll
        for (int e = 0; e < 8; ++e) w[e] = F.w_in[(size_t)(k0 + e) * INC + 1536 + n];
        *(LAS v4u*)(img + idx * 16) = (v4u){pk2(w[0], w[1]), pk2(w[2], w[3]), pk2(w[4], w[5]), pk2(w[6], w[7])}; }
    __syncthreads();
    LAS unsigned char* slab = F.lds + F.wave * (4 * P1_PITCH);
    const int gw = F.vcu * NWAVES + F.wave, NGW = F.G * NWAVES;
    for (int ch = gw; ch < M / 8; ch += NGW) {
        const int b = (ch * 8) / SEQ;
        const float* mod = F.MOD + b * 6144;
        f32x4 es[4], sh[4];
#pragma unroll
        for (int j = 0; j < 4; ++j) { const int c = 4 * F.lane + 256 * j; const f32x4 g4 = *(const f32x4*)(F.norm_mix_g + c), sc = *(const f32x4*)(mod + 1024 + c); es[j] = g4 * (sc + 1.f); sh[j] = *(const f32x4*)(mod + c); }
#pragma unroll 1
        for (int rb = 0; rb < 8; rb += 4) {
            f32x4 v[4][4];
#pragma unroll
            for (int r = 0; r < 4; ++r) { const GAS f32x4* xr = (const GAS f32x4*)(F.x + (size_t)(ch * 8 + rb + r) * D) + F.lane;
#pragma unroll
                for (int j = 0; j < 4; ++j) v[r][j] = __builtin_nontemporal_load(xr + 64 * j); }
            float ss[4];
#pragma unroll
            for (int r = 0; r < 4; ++r) { float s = 0.f;
#pragma unroll
                for (int j = 0; j < 4; ++j) s += (v[r][j].x * v[r][j].x + v[r][j].y * v[r][j].y) + (v[r][j].z * v[r][j].z + v[r][j].w * v[r][j].w);
                ss[r] = s; }
#pragma unroll
            for (int r = 0; r < 4; ++r) ss[r] = wave_sum(ss[r]);
#pragma unroll
            for (int r = 0; r < 4; ++r) { const int m = ch * 8 + rb + r;
                const float rstd = __builtin_amdgcn_rsqf(ss[r] * (1.f / D) + RMS_EPS);
                GAS v2u* o8 = (GAS v2u*)(F.H + (size_t)m * D) + F.lane;
#pragma unroll
                for (int j = 0; j < 4; ++j) { v[r][j] = v[r][j] * rstd * es[j] + sh[j]; v2u w; w.x = pk2(v[r][j].x, v[r][j].y); w.y = pk2(v[r][j].z, v[r][j].w); o8[64 * j] = w;
                    *(LAS v2u*)(slab + r * P1_PITCH + (4 * F.lane + 256 * j) * 2) = w;
                    ((GAS unsigned*)((unsigned char*)F.WD + (size_t)m * D) + F.lane)[64 * j] = pk4_fp8(v[r][j].x * FP8_GH, v[r][j].y * FP8_GH, v[r][j].z * FP8_GH, v[r][j].w * FP8_GH); } }
            f32x4 acc = (f32x4){0.f, 0.f, 0.f, 0.f};
            { const LAS unsigned char* ap = slab + (F.lane & 3) * P1_PITCH + (F.lane >> 4) * 16; const LAS unsigned char* bp = img + ((F.lane >> 4) * 8 + (F.lane & 7)) * 16;
#pragma unroll 8
              for (int ks = 0; ks < 32; ++ks) acc = __builtin_amdgcn_mfma_f32_16x16x32_bf16(*(const LAS p1_bf16x8*)(ap + ks * 64), *(const LAS p1_bf16x8*)(bp + ks * 512), acc, 0, 0, 0); }
            if (F.lane < 8) { const float bf_ = F.b_forget[F.lane];
#pragma unroll
                for (int e = 0; e < 4; ++e) { const float z = acc[e] + bf_; F.LOGF[(size_t)(ch * 8 + rb + e) * 8 + F.lane] = fminf(z, 0.f) - __logf(1.f + __expf(-fabsf(z))); } }
        }
    }
}

__device__ __forceinline__ void p2_cumscan(Frame& F) {
    const int gw = F.wave * F.G + F.vcu, NGW = F.G * NWAVES;
    for (int u = gw; u < NB * NH; u += NGW) {
        const int b = u >> 3, h = u & 7;
        float v[32]; float run = 0.f;
#pragma unroll
        for (int i = 0; i < 32; ++i) { run += F.LOGF[((size_t)b * SEQ + 32 * F.lane + i) * 8 + h]; v[i] = run; }
        float incl = run;
#pragma unroll
        for (int o = 1; o < 64; o <<= 1) { const float t = __shfl_up(incl, o); if (F.lane >= o) incl += t; }
        const float excl = incl - run;
#pragma unroll
        for (int i = 0; i < 32; ++i) { const float cv = v[i] + excl;
#if defined(ATTN_SIMPLE)
            F.CUM[(size_t)u * SEQ + 32 * F.lane + i] = cv;
#endif
            const float nb = -cv * LOG2E; const unsigned hb = f2bf(nb); const float lo = nb - __uint_as_float(hb << 16); F.CUMP[(size_t)u * SEQ + 32 * F.lane + i] = hb | (f2bf(lo) << 16); }
    }
}

using pg8::Unit;
struct EpiInProj {
    static constexpr bool PERM = true;
    bf16* mix; float gs = 1.f;
    __device__ __forceinline__ void operator()(const f32x4 (&acc)[2][2][4][2], const Unit& u, int wr, int wc, int fr, int fq) const {
        const int pn = u.pn; bf16* base; int ldc, colt, mode;
        if (pn < 8) { base = mix + (size_t)(pn >> 1) * ((size_t)M * 512); ldc = 512; colt = (pn & 1) * 256; mode = pn < 2 ? 1 : 0; }
        else { const int g = (pn - 8) >> 2; base = mix + (size_t)4 * M * 512 + (size_t)g * ((size_t)M * 1024); ldc = 1024; colt = ((pn - 8) & 3) * 256; mode = 2; }
        const int row0 = u.pm * 256 + wr * 64 + fr, col0 = colt + wc * 32 + 8 * fq;
#pragma unroll
        for (int ai = 0; ai < 2; ++ai)
#pragma unroll
            for (int m = 0; m < 4; ++m) { bf16* rowp = base + (size_t)(row0 + ai * 128 + m * 16) * ldc + col0;
#pragma unroll
                for (int bj = 0; bj < 2; ++bj) { f32x4 v0 = acc[ai][bj][m][0], v1 = acc[ai][bj][m][1];
                    if (mode == 1) { v0 = v0 * QSCALE; v1 = v1 * QSCALE; }
                    else if (mode == 2) {
#pragma unroll
                        for (int e = 0; e < 4; ++e) { v0[e] = fast_sigmoid(v0[e] * gs); v1[e] = fast_sigmoid(v1[e] * gs); } }
                    v4u w; w.x = pg8::cvt_pk_bf16(v0[0], v0[1]); w.y = pg8::cvt_pk_bf16(v0[2], v0[3]); w.z = pg8::cvt_pk_bf16(v1[0], v1[1]); w.w = pg8::cvt_pk_bf16(v1[2], v1[3]);
                    if ((pn >> 1) == 3) { const int col = col0 + bj * 128; *(v4u*)(base + ((size_t)(col >> 4) * M + (row0 + ai * 128 + m * 16)) * 16 + (col & 15)) = w; }
                    else if (mode == 2) store16_wt(wt_rsrc((void*)mix, 128u << 20), (size_t)((rowp - mix) + bj * 128) * 2, w);
                    else *(v4u*)(rowp + bj * 128) = w; } }
    }
};
template <int MODE> struct EpiGate {
    static constexpr bool PERM = true;
    bf16* T; const bf16* Gt;
    __device__ __forceinline__ void operator()(const f32x4 (&acc)[2][2][4][2], const Unit& u, int wr, int wc, int fr, int fq) const {
        const int row0 = u.pm * 256 + wr * 64 + fr, col0 = u.pn * 256 + wc * 32 + 8 * fq;
#pragma unroll
        for (int ai = 0; ai < 2; ++ai)
#pragma unroll
            for (int m = 0; m < 4; ++m) { const size_t off = (size_t)(row0 + ai * 128 + m * 16) * 1024 + col0;
#pragma unroll
                for (int bj = 0; bj < 2; ++bj) { const f32x4 v0 = acc[ai][bj][m][0], v1 = acc[ai][bj][m][1];
                    const v4u t = *(const v4u*)(T + off + bj * 128); v4u w;
                    if (MODE == 0) {
                        w.x = pg8::cvt_pk_bf16(bflo(t.x) * v0[0], bfhi(t.x) * v0[1]); w.y = pg8::cvt_pk_bf16(bflo(t.y) * v0[2], bfhi(t.y) * v0[3]);
                        w.z = pg8::cvt_pk_bf16(bflo(t.z) * v1[0], bfhi(t.z) * v1[1]); w.w = pg8::cvt_pk_bf16(bflo(t.w) * v1[2], bfhi(t.w) * v1[3]);
                    } else {
                        const v4u gg = *(const v4u*)(Gt + off + bj * 128);
                        w.x = pg8::cvt_pk_bf16(bflo(t.x) + bflo(gg.x) * v0[0], bfhi(t.x) + bfhi(gg.x) * v0[1]); w.y = pg8::cvt_pk_bf16(bflo(t.y) + bflo(gg.y) * v0[2], bfhi(t.y) + bfhi(gg.y) * v0[3]);
                        w.z = pg8::cvt_pk_bf16(bflo(t.z) + bflo(gg.z) * v1[0], bfhi(t.z) + bfhi(gg.z) * v1[1]); w.w = pg8::cvt_pk_bf16(bflo(t.w) + bflo(gg.w) * v1[2], bfhi(t.w) + bfhi(gg.w) * v1[3]);
                    }
                    *(v4u*)(T + off + bj * 128) = w; } }
    }
};
struct EpiGate2 {
    static constexpr bool PERM = true;
    EpiGate<0> e0; EpiGate<1> e1;
    __device__ __forceinline__ void operator()(const f32x4 (&acc)[2][2][4][2], const Unit& u, int wr, int wc, int fr, int fq) const { if (u.e == 0) e0(acc, u, wr, wc, fr, fq); else e1(acc, u, wr, wc, fr, fq); }
};
struct EpiGateChain {
    static constexpr bool PERM = true, CHAIN = true;
    bf16* T; const bf16* Gt;
    __device__ __forceinline__ void chain(f32x4 (&acc)[2][2][4][2], const Unit& u, int wr, int wc, int fr, int fq) const {
        const int row0 = u.pm * 256 + wr * 64 + fr, col0 = u.pn * 256 + wc * 32 + 8 * fq;
        if (u.e == 0) {
#pragma unroll
            for (int ai = 0; ai < 2; ++ai)
#pragma unroll
                for (int m = 0; m < 4; ++m) { const size_t off = (size_t)(row0 + ai * 128 + m * 16) * 1024 + col0;
#pragma unroll
                    for (int bj = 0; bj < 2; ++bj) { const v4u t = *(const v4u*)(T + off + bj * 128), gg = *(const v4u*)(Gt + off + bj * 128);
                        f32x4& v0 = acc[ai][bj][m][0]; f32x4& v1 = acc[ai][bj][m][1];
                        v0[0] *= bflo(t.x) * __builtin_amdgcn_rcpf(bflo(gg.x)); v0[1] *= bfhi(t.x) * __builtin_amdgcn_rcpf(bfhi(gg.x)); v0[2] *= bflo(t.y) * __builtin_amdgcn_rcpf(bflo(gg.y)); v0[3] *= bfhi(t.y) * __builtin_amdgcn_rcpf(bfhi(gg.y));
                        v1[0] *= bflo(t.z) * __builtin_amdgcn_rcpf(bflo(gg.z)); v1[1] *= bfhi(t.z) * __builtin_amdgcn_rcpf(bfhi(gg.z)); v1[2] *= bflo(t.w) * __builtin_amdgcn_rcpf(bflo(gg.w)); v1[3] *= bfhi(t.w) * __builtin_amdgcn_rcpf(bfhi(gg.w)); } }
        } else {
#pragma unroll
            for (int ai = 0; ai < 2; ++ai)
#pragma unroll
                for (int m = 0; m < 4; ++m) { const size_t off = (size_t)(row0 + ai * 128 + m * 16) * 1024 + col0;
#pragma unroll
                    for (int bj = 0; bj < 2; ++bj) { const v4u gg = *(const v4u*)(Gt + off + bj * 128); const f32x4 v0 = acc[ai][bj][m][0], v1 = acc[ai][bj][m][1]; v4u w;
                        w.x = pg8::cvt_pk_bf16(bflo(gg.x) * v0[0], bfhi(gg.x) * v0[1]); w.y = pg8::cvt_pk_bf16(bflo(gg.y) * v0[2], bfhi(gg.y) * v0[3]);
                        w.z = pg8::cvt_pk_bf16(bflo(gg.z) * v1[0], bfhi(gg.z) * v1[1]); w.w = pg8::cvt_pk_bf16(bflo(gg.w) * v1[2], bfhi(gg.w) * v1[3]);
                        store16_wt(wt_rsrc((void*)T, (unsigned)((size_t)M * 1024 * 2)), (off + bj * 128) * 2, w); } }
        }
    }
};
template <int MODE> struct EpiPair {
    static constexpr bool PERM = true;
    bf16* O;
    __device__ __forceinline__ void operator()(const f32x4 (&acc)[2][2][4][2], const Unit& u, int wr, int wc, int fr, int fq) const {
        const int row0 = u.pm * 256 + wr * 64 + fr, col0 = u.pn * 128 + wc * 32 + 8 * fq; const __amdgpu_buffer_rsrc_t rs = wt_rsrc((void*)O, (unsigned)((size_t)M * 512 * 2));
#pragma unroll
        for (int ai = 0; ai < 2; ++ai)
#pragma unroll
            for (int m = 0; m < 4; ++m) { f32x4 r0, r1;
#pragma unroll
                for (int e = 0; e < 4; ++e) {
                    if (MODE == 0) { r0[e] = acc[ai][0][m][0][e] * fast_sigmoid(acc[ai][1][m][0][e]); r1[e] = acc[ai][0][m][1][e] * fast_sigmoid(acc[ai][1][m][1][e]); }
                    else { const float g0 = acc[ai][0][m][0][e], g1 = acc[ai][0][m][1][e]; r0[e] = g0 * fast_sigmoid(g0) * acc[ai][1][m][0][e]; r1[e] = g1 * fast_sigmoid(g1) * acc[ai][1][m][1][e]; } }
                v4u w; w.x = pg8::cvt_pk_bf16(r0[0], r0[1]); w.y = pg8::cvt_pk_bf16(r0[2], r0[3]); w.z = pg8::cvt_pk_bf16(r1[0], r1[1]); w.w = pg8::cvt_pk_bf16(r1[2], r1[3]);
                store16_wt(rs, ((size_t)(row0 + ai * 128 + m * 16) * 512 + col0) * 2, w); }
    }
};
struct EpiResid {
    static constexpr bool PERM = true;
    const float* x; bf16* out; const float* mod;
    __device__ __forceinline__ void operator()(const f32x4 (&acc)[2][2][4][2], const Unit& u, int wr, int wc, int fr, int fq) const {
        const int row0 = u.pm * 256 + wr * 64 + fr, col0 = u.pn * 256 + wc * 32 + 8 * fq;
        const int b = (u.pm * 256) / SEQ;
        f32x4 gv[2][2];
#pragma unroll
        for (int bj = 0; bj < 2; ++bj)
#pragma unroll
            for (int n = 0; n < 2; ++n) gv[bj][n] = *(const f32x4*)(mod + (size_t)b * 6144 + 2048 + col0 + bj * 128 + n * 4);
#pragma unroll
        for (int ai = 0; ai < 2; ++ai)
#pragma unroll
            for (int m = 0; m < 4; ++m) { const size_t off = (size_t)(row0 + ai * 128 + m * 16) * 1024 + col0;
#pragma unroll
                for (int bj = 0; bj < 2; ++bj) { const f32x4 x0 = *(const f32x4*)(x + off + bj * 128), x1 = *(const f32x4*)(x + off + bj * 128 + 4);
                    const f32x4 r0 = x0 + gv[bj][0] * acc[ai][bj][m][0], r1 = x1 + gv[bj][1] * acc[ai][bj][m][1];
                    v4u w; w.x = pg8::cvt_pk_bf16(r0[0], r0[1]); w.y = pg8::cvt_pk_bf16(r0[2], r0[3]); w.z = pg8::cvt_pk_bf16(r1[0], r1[1]); w.w = pg8::cvt_pk_bf16(r1[2], r1[3]);
                    store16_wt(wt_rsrc((void*)out, (unsigned)((size_t)M * 1024 * 2)), (off + bj * 128) * 2, w); } }
    }
};
struct EpiSwiGLU8 {
    static constexpr bool PERM = true;
    unsigned char* O;
    __device__ __forceinline__ void operator()(const f32x4 (&acc)[2][2][4][2], const Unit& u, int wr, int wc, int fr, int fq) const {
        const int row0 = u.pm * 256 + wr * 64 + fr, col0 = u.pn * 128 + wc * 32 + 8 * fq; constexpr float inv = 1.f / FP8_WSCALE;
#pragma unroll
        for (int ai = 0; ai < 2; ++ai)
#pragma unroll
            for (int m = 0; m < 4; ++m) { f32x4 r0, r1;
#pragma unroll
                for (int e = 0; e < 4; ++e) { const float g0 = acc[ai][0][m][0][e] * inv, g1 = acc[ai][0][m][1][e] * inv;
                    r0[e] = g0 * fast_sigmoid(g0) * acc[ai][1][m][0][e] * (inv * FP8_HSCALE); r1[e] = g1 * fast_sigmoid(g1) * acc[ai][1][m][1][e] * (inv * FP8_HSCALE); }
                v2u w; w.x = pk4_fp8(r0[0], r0[1], r0[2], r0[3]); w.y = pk4_fp8(r1[0], r1[1], r1[2], r1[3]);
                *(v2u*)(O + (size_t)(row0 + ai * 128 + m * 16) * 512 + col0) = w; }
    }
};
struct EpiDown {
    static constexpr bool PERM = true, PERM16 = true;
    bf16* Y;
    __device__ __forceinline__ void operator()(const f32x4 (&acc)[2][2][4][2], const Unit& u, int wr, int wc, int fr, int fq) const {
        const int col0 = u.pn * 256 + wc * 64 + 16 * fq; constexpr float sc = FP8_YSCALE / (FP8_WSCALE * FP8_HSCALE); const __amdgpu_buffer_rsrc_t rs = wt_rsrc((void*)Y, 160u * 256u * 1024u);
#pragma unroll
        for (int ai = 0; ai < 2; ++ai)
#pragma unroll
            for (int m = 0; m < 4; ++m) { const int r = ai * 128 + wr * 64 + m * 16 + fr; unsigned char* rowp = (unsigned char*)Y + (size_t)(u.pm * 256 + r) * 1024 + col0;
                v4u w;
#pragma unroll
                for (int bj = 0; bj < 2; ++bj) { const f32x4 v0 = acc[ai][bj][m][0] * sc, v1 = acc[ai][bj][m][1] * sc;
                    w[2 * bj] = pk4_fp8(v0[0], v0[1], v0[2], v0[3]); w[2 * bj + 1] = pk4_fp8(v1[0], v1[1], v1[2], v1[3]); }
                store16_wt(rs, (size_t)(rowp - (unsigned char*)Y), w); }
    }
};

template <bool GATHER_> struct MoeOrder {
    static constexpr bool GATHER = GATHER_, FP8 = true;
    int G, c, nunits; const LAS int* tab; const unsigned* list; size_t estride; int bK;
    __device__ __forceinline__ bool next(int i, Unit& u) const {
        const int L = i * G + c; if (L >= nunits) return false;
        const int mt = L >> 2; u.pn = L & 3; int e = 0;
        while (e < NE - 1 && mt >= tab[e + 1]) ++e;
        const int j = mt - tab[e]; u.e = e; u.pm = mt; u.lbase = e * CAP + j * 256; const int left = tab[33 + e] - j * 256; u.rows = left < 256 ? left : 256; return true;
    }
    __device__ __forceinline__ size_t a_base(const Unit& u, int K) const { return GATHER ? (size_t)0 : (size_t)u.pm * 256 * K * 2; }
    __device__ __forceinline__ size_t b_base(const Unit& u, int K) const { return (size_t)u.e * estride + (size_t)u.pn * 256 * K * 2; }
    __device__ __forceinline__ void a_offsets(const Unit& u, const int* Rr, const int* Cc, int K, unsigned (&vo)[2][2]) const {
#pragma unroll
        for (int h = 0; h < 2; ++h)
#pragma unroll
            for (int i = 0; i < 2; ++i) { const int r = h * 128 + Rr[i]; const unsigned aid = list[u.lbase + (r < u.rows ? r : 0)]; vo[h][i] = (unsigned)((aid >> 1) * (unsigned)K + (unsigned)Cc[i]) * 2u; }
    }
};
__device__ __forceinline__ int moe_tables(Frame& F) {
    LAS int* tab = (LAS int*)(F.lds + MOE_OFF);
    if (F.tid < 64) {
        const int c = F.lane < NE ? (int)F.ctl[CW_CNT + 64 * (F.lane & 31)] : 0; const int t = (c + 255) >> 8;
        int incl = t;
#pragma unroll
        for (int o = 1; o < 32; o <<= 1) { const int u_ = __shfl_up(incl, o); if (F.lane >= o) incl += u_; }
        if (F.lane < NE) { tab[F.lane] = incl - t; tab[33 + F.lane] = c; }
        if (F.lane == NE - 1) tab[32] = incl; }
    __syncthreads();
    return tab[32];
}

__device__ __forceinline__ void attn_simple_unit(Frame& F, int b, int h, int qblk) {
    LAS bf16* Ks = (LAS bf16*)(F.lds);
    LAS bf16* Vs = (LAS bf16*)(F.lds + 8192);
    LAS float* cs = (LAS float*)(F.lds + 16384);
    const int q = qblk * 512 + F.tid;
    const size_t rowq = (size_t)b * SEQ + q;
    float qv[64], o[64];
    { const bf16* qp = F.Q + rowq * 512 + h * 64;
#pragma unroll
      for (int i = 0; i < 8; ++i) { const v4u w = *(const v4u*)(qp + 8 * i); qv[8 * i] = bflo(w.x); qv[8 * i + 1] = bfhi(w.x); qv[8 * i + 2] = bflo(w.y); qv[8 * i + 3] = bfhi(w.y); qv[8 * i + 4] = bflo(w.z); qv[8 * i + 5] = bfhi(w.z); qv[8 * i + 6] = bflo(w.w); qv[8 * i + 7] = bfhi(w.w); } }
#pragma unroll
    for (int d = 0; d < 64; ++d) o[d] = 0.f;
    float mrun = -INFINITY, l = 0.f;
    const int ntiles = (qblk * 512 + 512) / 64;
    const int wave_tile = (qblk * 512 + F.wave * 64) / 64;
    for (int kt = 0; kt < ntiles; ++kt) {
        __syncthreads();
        { const size_t krow = (size_t)b * SEQ + kt * 64 + (F.tid >> 3); const int ch = (F.tid & 7) * 8;
          *(LAS v4u*)(Ks + (F.tid >> 3) * 64 + ch) = *(const v4u*)(F.K + krow * 512 + h * 64 + ch);
          *(LAS v4u*)(Vs + (F.tid >> 3) * 64 + ch) = *(const v4u*)(F.V + krow * 512 + h * 64 + ch);
          if (F.tid < 64) cs[F.tid] = F.CUM[(size_t)(b * NH + h) * SEQ + kt * 64 + F.tid] * LOG2E; }
        __syncthreads();
        if (kt <= wave_tile) {
#pragma unroll 1
            for (int kk = 0; kk < 64; ++kk) {
                float dot = 0.f;
#pragma unroll
                for (int c8 = 0; c8 < 8; ++c8) { const v4u w = *(const LAS v4u*)(Ks + kk * 64 + c8 * 8);
                    dot += qv[8 * c8] * bflo(w.x) + qv[8 * c8 + 1] * bfhi(w.x) + qv[8 * c8 + 2] * bflo(w.y) + qv[8 * c8 + 3] * bfhi(w.y) + qv[8 * c8 + 4] * bflo(w.z) + qv[8 * c8 + 5] * bfhi(w.z) + qv[8 * c8 + 6] * bflo(w.w) + qv[8 * c8 + 7] * bfhi(w.w); }
                const float sc = (kt * 64 + kk > q) ? -INFINITY : dot - cs[kk];
                const float mnew = fmaxf(mrun, sc);
                const float corr = (mnew > -INFINITY) ? __builtin_amdgcn_exp2f(mrun - mnew) : 1.f;
                const float p = (mnew > -INFINITY) ? __builtin_amdgcn_exp2f(sc - mnew) : 0.f;
                l = l * corr + p;
#pragma unroll
                for (int c8 = 0; c8 < 8; ++c8) { const v4u w = *(const LAS v4u*)(Vs + kk * 64 + c8 * 8);
                    o[8 * c8] = o[8 * c8] * corr + p * bflo(w.x); o[8 * c8 + 1] = o[8 * c8 + 1] * corr + p * bfhi(w.x); o[8 * c8 + 2] = o[8 * c8 + 2] * corr + p * bflo(w.y); o[8 * c8 + 3] = o[8 * c8 + 3] * corr + p * bfhi(w.y);
                    o[8 * c8 + 4] = o[8 * c8 + 4] * corr + p * bflo(w.z); o[8 * c8 + 5] = o[8 * c8 + 5] * corr + p * bfhi(w.z); o[8 * c8 + 6] = o[8 * c8 + 6] * corr + p * bflo(w.w); o[8 * c8 + 7] = o[8 * c8 + 7] * corr + p * bfhi(w.w); }
                mrun = mnew;
            }
        }
    }
    const float inv = 1.f / l;
    bf16* op = F.Q + rowq * 512 + h * 64;
#pragma unroll
    for (int i = 0; i < 8; ++i) { v4u w; w.x = pk2(o[8 * i] * inv, o[8 * i + 1] * inv); w.y = pk2(o[8 * i + 2] * inv, o[8 * i + 3] * inv); w.z = pk2(o[8 * i + 4] * inv, o[8 * i + 5] * inv); w.w = pk2(o[8 * i + 6] * inv, o[8 * i + 7] * inv); *(v4u*)(op + 8 * i) = w; }
    __syncthreads();
}

__device__ __forceinline__ float gelu_tanh(float v) { const float t = 0.7978845608028654f * (v + 0.044715f * v * v * v); return 0.5f * v * (1.f + tanhf(t)); }
__device__ __forceinline__ void ssm_simple_unit(Frame& F, int b, int g, LAS unsigned char* wl) {
    const int p = F.lane;
    LAS f32x2* xs = (LAS f32x2*)wl;
    LAS float* Cp = (LAS float*)(wl + 33280);
#pragma unroll
    for (int c = 0; c < 16; ++c) { Cp[p * 32 + c] = F.c_re[(size_t)(g * 16 + c) * 64 + p]; Cp[p * 32 + 16 + c] = F.c_im[(size_t)(g * 16 + c) * 64 + p]; }
    const float dt = expf(F.log_dt[g]);
    const float lr = fminf(F.lambda_re[g * 64 + p], -1e-4f), li = F.lambda_im[g * 64 + p];
    const float mag = expf(lr * dt), ar = mag * cosf(li * dt), ai = mag * sinf(li * dt);
    const float den = lr * lr + li * li, nr = ar - 1.f;
    const float cor = (nr * lr + ai * li) / den, coi = (ai * lr - nr * li) / den;
    float bbr[16], bbi[16];
#pragma unroll
    for (int c = 0; c < 16; ++c) { const float br = F.b_re[(size_t)(g * 64 + p) * 16 + c], bi = F.b_im[(size_t)(g * 64 + p) * 16 + c]; bbr[c] = cor * br - coi * bi; bbi[c] = cor * bi + coi * br; }
    float dsk[16];
#pragma unroll
    for (int c = 0; c < 16; ++c) dsk[c] = F.d_skip[g * 16 + c];
    LDS_WAIT(); asm volatile("" ::: "memory");
    float xr = 0.f, xi = 0.f;
#if defined(SSM_CHECK)
    float chk_sq = 0.f;
#endif
    for (int t0 = 0; t0 < SEQ; t0 += 64) {
#pragma unroll 2
        for (int tt = 0; tt < 64; ++tt) {
            const bf16* up = F.U + ((size_t)g * M + (size_t)b * SEQ + t0 + tt) * 16;
            const v4u w0 = *(const v4u*)up, w1 = *(const v4u*)(up + 8);
            float uu[16] = {bflo(w0.x), bfhi(w0.x), bflo(w0.y), bfhi(w0.y), bflo(w0.z), bfhi(w0.z), bflo(w0.w), bfhi(w0.w), bflo(w1.x), bfhi(w1.x), bflo(w1.y), bfhi(w1.y), bflo(w1.z), bfhi(w1.z), bflo(w1.w), bfhi(w1.w)};
            float bur = 0.f, bui = 0.f;
#pragma unroll
            for (int c = 0; c < 16; ++c) { bur += bbr[c] * uu[c]; bui += bbi[c] * uu[c]; }
            const float n_r = ar * xr - ai * xi + bur, n_i = ar * xi + ai * xr + bui; xr = n_r; xi = n_i;
            xs[tt * 65 + p] = (f32x2){xr, xi};
        }
        LDS_WAIT(); asm volatile("" ::: "memory");
        float y[16];
#pragma unroll
        for (int c = 0; c < 16; ++c) y[c] = 0.f;
#pragma unroll 4
        for (int pp = 0; pp < 64; ++pp) {
            const f32x2 xv = xs[F.lane * 65 + pp];
#pragma unroll
            for (int c4 = 0; c4 < 4; ++c4) { const f32x4 cr = *(const LAS f32x4*)(Cp + pp * 32 + c4 * 4), ci = *(const LAS f32x4*)(Cp + pp * 32 + 16 + c4 * 4);
                y[4 * c4] += cr.x * xv.x - ci.x * xv.y; y[4 * c4 + 1] += cr.y * xv.x - ci.y * xv.y; y[4 * c4 + 2] += cr.z * xv.x - ci.z * xv.y; y[4 * c4 + 3] += cr.w * xv.x - ci.w * xv.y; }
        }
#if defined(SSM_CHECK)
#pragma unroll
        for (int c = 0; c < 16; ++c) chk_sq += y[c] * y[c];
#endif
        const size_t row = (size_t)g * M + (size_t)b * SEQ + t0 + F.lane;
        const bf16* up = F.U + row * 16;
        const v4u w0 = *(const v4u*)up, w1 = *(const v4u*)(up + 8);
        const float uu[16] = {bflo(w0.x), bfhi(w0.x), bflo(w0.y), bfhi(w0.y), bflo(w0.z), bfhi(w0.z), bflo(w0.w), bfhi(w0.w), bflo(w1.x), bfhi(w1.x), bflo(w1.y), bfhi(w1.y), bflo(w1.z), bfhi(w1.z), bflo(w1.w), bfhi(w1.w)};
        float r[16];
#pragma unroll
        for (int c = 0; c < 16; ++c) r[c] = gelu_tanh(y[c] + dsk[c] * uu[c]);
        v4u o0, o1; o0.x = pk2(r[0], r[1]); o0.y = pk2(r[2], r[3]); o0.z = pk2(r[4], r[5]); o0.w = pk2(r[6], r[7]); o1.x = pk2(r[8], r[9]); o1.y = pk2(r[10], r[11]); o1.z = pk2(r[12], r[13]); o1.w = pk2(r[14], r[15]);
        bf16* yp = F.Y + row * 16; *(v4u*)yp = o0; *(v4u*)(yp + 8) = o1;
        LDS_WAIT(); asm volatile("" ::: "memory");
    }
#if defined(SSM_CHECK)
    chk_sq = wave_sum(chk_sq); if (F.lane == 0) atomicAdd((float*)(F.ctl + CW_CHK + 1), chk_sq);
#endif
}


constexpr size_t TB_FRAG = 0, TB_QF = 2 * MiB, TB_PF = 10 * MiB, TB_A64 = 18 * MiB;
constexpr int SSM_R2 = 64 * 1056;
constexpr int YS_PITCH = 1056;
constexpr int XS_OFF = RING_BYTES + 2048;
static_assert(SSM_R2 + 64 * YS_PITCH <= LDSCTL_OFF && SSM_R2 + 65536 <= XS_OFF, "scan unit LDS map");
typedef float f32x16 __attribute__((ext_vector_type(16)));
typedef short bf16x8s __attribute__((ext_vector_type(8)));
__device__ __forceinline__ int crow16(int r, int hi) { return (r & 3) + 8 * (r >> 2) + 4 * hi; }

__device__ __forceinline__ void p0_ssm_item(Frame& F, int it) {
    const int g = it >> 3, j = it & 7;
    LAS float* POWr = (LAS float*)(F.lds);
    LAS float* POWi = POWr + 65 * 64;
    LAS float* BBr = POWi + 65 * 64;
    LAS float* BBi = BBr + 1024;
    constexpr int CLD = 65;
    LAS float* Cr = BBi + 1024;
    LAS float* Ci = Cr + 16 * CLD;
    bf16* FRAG = (bf16*)((char*)F.out + TB_FRAG); bf16* QF = (bf16*)((char*)F.out + TB_QF); bf16* PF = (bf16*)((char*)F.out + TB_PF); float* A64 = (float*)((char*)F.out + TB_A64);
    const float dt = expf(F.log_dt[g]);
    {
      const int p = F.tid & 63, q = F.tid >> 6;
      const float lr = fminf(F.lambda_re[g * 64 + p], -1e-4f), li = F.lambda_im[g * 64 + p];
      const float mag = expf(lr * dt), ar = mag * cosf(li * dt), ai = mag * sinf(li * dt);
      float a2r = ar * ar - ai * ai, a2i = 2.f * ar * ai; float a4r = a2r * a2r - a2i * a2i, a4i = 2.f * a2r * a2i; const float a8r = a4r * a4r - a4i * a4i, a8i = 2.f * a4r * a4i;
      float br = 1.f, bi = 0.f;
      for (int i = 0; i < q; ++i) { const float t = br * a8r - bi * a8i; bi = br * a8i + bi * a8r; br = t; }
#pragma unroll
      for (int r = 0; r < 8; ++r) { POWr[(8 * q + r) * 64 + p] = br; POWi[(8 * q + r) * 64 + p] = bi; const float t = br * ar - bi * ai; bi = br * ai + bi * ar; br = t; }
      if (q == 7) { POWr[64 * 64 + p] = br; POWi[64 * 64 + p] = bi; } }
    for (int idx = F.tid; idx < 1024; idx += 512) { const int p = idx >> 4;
        const float lr = fminf(F.lambda_re[g * 64 + p], -1e-4f), li = F.lambda_im[g * 64 + p];
        const float mag = expf(lr * dt), ar = mag * cosf(li * dt), ai = mag * sinf(li * dt);
        const float den = lr * lr + li * li, nr = ar - 1.f, cor = (nr * lr + ai * li) / den, coi = (ai * lr - nr * li) / den;
        const float br = F.b_re[(size_t)g * 1024 + idx], bi = F.b_im[(size_t)g * 1024 + idx];
        BBr[idx] = cor * br - coi * bi; BBi[idx] = cor * bi + coi * br;
        Cr[(idx >> 6) * CLD + (idx & 63)] = F.c_re[(size_t)g * 1024 + idx]; Ci[(idx >> 6) * CLD + (idx & 63)] = F.c_im[(size_t)g * 1024 + idx]; }
    __syncthreads();
    {
      typedef short bfx8 __attribute__((ext_vector_type(8)));
      const int tau = 8 * j + F.wave, rw = F.lane & 15, qd = F.lane >> 4;
      f32x4 acc = (f32x4){0.f, 0.f, 0.f, 0.f};
#pragma unroll
      for (int kc = 0; kc < 4; ++kc) { unsigned aw[4], bw[4];
#pragma unroll
          for (int h2 = 0; h2 < 4; ++h2) { float av[2], bv[2];
#pragma unroll
              for (int e = 0; e < 2; ++e) { const int kk = kc * 32 + qd * 8 + 2 * h2 + e, p = kk & 63;
                  av[e] = (kk < 64) ? Cr[rw * CLD + p] : -Ci[rw * CLD + p];
                  const float wr = POWr[tau * 64 + p], wi = POWi[tau * 64 + p], br = BBr[p * 16 + rw], bi = BBi[p * 16 + rw];
                  bv[e] = (kk < 64) ? (wr * br - wi * bi) : (wr * bi + wi * br); }
              aw[h2] = pk2(av[0], av[1]); bw[h2] = pk2(bv[0], bv[1]); }
          acc = __builtin_amdgcn_mfma_f32_16x16x32_bf16(__builtin_bit_cast(bfx8, (v4u){aw[0], aw[1], aw[2], aw[3]}), __builtin_bit_cast(bfx8, (v4u){bw[0], bw[1], bw[2], bw[3]}), acc, 0, 0, 0); }
#pragma unroll
      for (int jj = 0; jj < 4; ++jj) { const int c = qd * 4 + jj; const bf16 v = (bf16)f2bf(acc[jj]);
          if (tau + 1 < 64) FRAG[((size_t)(g * 64 + tau + 1) * 32 + c) * 16 + rw] = v;
          FRAG[((size_t)(g * 64 + tau) * 32 + 16 + c) * 16 + rw] = v; } }
    if (j == 0 && F.tid < 256) FRAG[((size_t)(g * 64) * 32 + (F.tid >> 4)) * 16 + (F.tid & 15)] = 0;
    {
      const int s = 8 * j + (F.tid >> 6), p = F.tid & 63, kk = 63 - s; const float wr = POWr[kk * 64 + p], wi = POWi[kk * 64 + p];
      unsigned re[8], im[8];
#pragma unroll
      for (int c2 = 0; c2 < 8; ++c2) { const float br0 = BBr[p * 16 + 2 * c2], bi0 = BBi[p * 16 + 2 * c2], br1 = BBr[p * 16 + 2 * c2 + 1], bi1 = BBi[p * 16 + 2 * c2 + 1];
          re[c2] = pk2(wr * br0 - wi * bi0, wr * br1 - wi * bi1); im[c2] = pk2(wr * bi0 + wi * br0, wr * bi1 + wi * br1); }
      bf16* qre = QF + ((((size_t)(g * 64 + s)) * 4 + (p >> 5)) * 32 + (p & 31)) * 16; bf16* qim = QF + ((((size_t)(g * 64 + s)) * 4 + 2 + (p >> 5)) * 32 + (p & 31)) * 16;
      *(v4u*)qre = (v4u){re[0], re[1], re[2], re[3]}; *(v4u*)(qre + 8) = (v4u){re[4], re[5], re[6], re[7]};
      *(v4u*)qim = (v4u){im[0], im[1], im[2], im[3]}; *(v4u*)(qim + 8) = (v4u){im[4], im[5], im[6], im[7]}; }
    for (int idx = F.tid; idx < 1024; idx += 512) {
      const int tl = idx >> 7, c = (idx >> 3) & 15, kb = idx & 7, t = 8 * j + tl; unsigned o[8];
#pragma unroll
      for (int k2 = 0; k2 < 8; ++k2) { float vv[2];
#pragma unroll
          for (int e = 0; e < 2; ++e) { const int p = (kb * 16 + 2 * k2 + e) & 63; const float wr = POWr[(t + 1) * 64 + p], wi = POWi[(t + 1) * 64 + p], cr = Cr[c * CLD + p], ci = Ci[c * CLD + p];
              vv[e] = (kb < 4) ? (cr * wr - ci * wi) : -(cr * wi + ci * wr); }
          o[k2] = pk2(vv[0], vv[1]); }
      bf16* pp = PF + ((((size_t)(g * 32 + (t >> 1))) * 8 + kb) * 32 + (t & 1) * 16 + c) * 16;
      *(v4u*)pp = (v4u){o[0], o[1], o[2], o[3]}; *(v4u*)(pp + 8) = (v4u){o[4], o[5], o[6], o[7]}; }
    if (j == 0 && F.tid < 64) { A64[(size_t)(g * 64 + F.tid) * 2] = POWr[64 * 64 + F.tid]; A64[(size_t)(g * 64 + F.tid) * 2 + 1] = POWi[64 * 64 + F.tid]; }
    __syncthreads();
}

__device__ __forceinline__ float gelu_tanh_fast(float v) { const float t = 0.7978845608028654f * (v + 0.044715f * v * v * v); return v * __builtin_amdgcn_rcpf(1.f + __builtin_amdgcn_exp2f(-2.f * LOG2E * t)); }

__device__ __forceinline__ void ssm_mfma_unit(Frame& F, int b, int g, bf16* Yout) {
    LAS unsigned char* L = F.lds;
    const int tid = F.tid, lane = F.lane, wave = F.wave, r32 = lane & 31, hi = lane >> 5;
    const bf16* FRAG = (const bf16*)((const char*)F.out + TB_FRAG); const bf16* QF = (const bf16*)((const char*)F.out + TB_QF); const bf16* PF = (const bf16*)((const char*)F.out + TB_PF);
    const float* A64 = (const float*)((const char*)F.out + TB_A64);
    const int tp0 = wave, tp1 = 15 - wave, tp2 = 16 + wave, tp3 = 31 - wave;
    v4u uw[8];
#pragma unroll
    for (int i = 0; i < 4; ++i) { const bf16* up = F.U + ((size_t)g * M + (size_t)b * SEQ + tid + 512 * i) * 16; uw[2 * i] = *(const v4u*)up; uw[2 * i + 1] = *(const v4u*)(up + 8); }
    const int rbA = wave & 3, khA = wave >> 2;
    bf16x8s qfr[32];
    { const char* qf = (const char*)QF + ((size_t)(g * 64 + 32 * khA) * 4 + rbA) * 1024 + r32 * 32 + hi * 16;
#pragma unroll
      for (int s = 0; s < 32; ++s) qfr[s] = *(const bf16x8s*)(qf + (size_t)s * 4096); }
#pragma unroll
    for (int i = 0; i < 4; ++i) { const int tk = tid + 512 * i, ch = tk >> 6, s = tk & 63; LAS v4u* d = (LAS v4u*)(L + s * YS_PITCH + ch * 32); d[0] = uw[2 * i]; d[1] = uw[2 * i + 1]; }
    __syncthreads();
    LAS float* Eb = (LAS float*)(L + SSM_R2);
    { f32x16 acc = {};
#pragma unroll
      for (int s = 0; s < 32; ++s) { const bf16x8s bb = *(const LAS bf16x8s*)(L + (32 * khA + s) * YS_PITCH + r32 * 32 + hi * 16);
          acc = __builtin_amdgcn_mfma_f32_32x32x16_bf16(qfr[s], bb, acc, 0, 0, 0); }
#pragma unroll
      for (int r = 0; r < 16; ++r) Eb[khA * 4224 + (rbA * 32 + crow16(r, hi)) * 33 + r32] = acc[r]; }
    __builtin_amdgcn_sched_barrier(0);
    v4u fr[8];
#pragma unroll
    for (int i = 0; i < 8; ++i) fr[i] = *(const v4u*)((const char*)FRAG + (size_t)g * 65536 + tid * 16 + i * 8192);
    bf16x8s pfr[4][8];
    { const char* pf = (const char*)PF + (size_t)(g * 32) * 8 * 1024 + r32 * 32 + hi * 16;
#pragma unroll
      for (int kb = 0; kb < 8; ++kb) { pfr[0][kb] = *(const bf16x8s*)(pf + (size_t)(tp0 * 8 + kb) * 1024); pfr[1][kb] = *(const bf16x8s*)(pf + (size_t)(tp1 * 8 + kb) * 1024);
          pfr[2][kb] = *(const bf16x8s*)(pf + (size_t)(tp2 * 8 + kb) * 1024); pfr[3][kb] = *(const bf16x8s*)(pf + (size_t)(tp3 * 8 + kb) * 1024); } }
    __syncthreads();
    LAS bf16* Xs = (LAS bf16*)(L + XS_OFF);
    { const int c = lane & 31;
#pragma unroll
      for (int i = 0; i < 4; ++i) { const int p = wave * 8 + 2 * i + (lane >> 5);
          float pr = A64[(size_t)(g * 64 + p) * 2], pi = A64[(size_t)(g * 64 + p) * 2 + 1];
          float br = Eb[p * 33 + c] + Eb[4224 + p * 33 + c], bi = Eb[(64 + p) * 33 + c] + Eb[4224 + (64 + p) * 33 + c];
#pragma unroll
          for (int d = 1; d < 32; d <<= 1) { const float ur = __shfl_up(br, d, 32), ui = __shfl_up(bi, d, 32);
              if (c >= d) { br += pr * ur - pi * ui; bi += pr * ui + pi * ur; }
              const float qr = pr * pr - pi * pi, qi = 2.f * pr * pi; pr = qr; pi = qi; }
          float xr = __shfl_up(br, 1, 32), xi = __shfl_up(bi, 1, 32); if (c == 0) { xr = 0.f; xi = 0.f; }
          Xs[c * 136 + p] = (bf16)f2bf(xr); Xs[c * 136 + 64 + p] = (bf16)f2bf(xi); } }
    __syncthreads();
#pragma unroll
    for (int i = 0; i < 8; ++i) *(LAS v4u*)(L + SSM_R2 + tid * 16 + i * 8192) = fr[i];
    f32x16 acc0 = {}, acc1 = {}, acc2 = {}, acc3 = {};
#pragma unroll
    for (int kb = 0; kb < 8; ++kb) { const bf16x8s bb = *(const LAS bf16x8s*)((const LAS unsigned char*)Xs + r32 * 272 + kb * 32 + hi * 16);
        acc0 = __builtin_amdgcn_mfma_f32_32x32x16_bf16(pfr[0][kb], bb, acc0, 0, 0, 0); acc1 = __builtin_amdgcn_mfma_f32_32x32x16_bf16(pfr[1][kb], bb, acc1, 0, 0, 0);
        acc2 = __builtin_amdgcn_mfma_f32_32x32x16_bf16(pfr[2][kb], bb, acc2, 0, 0, 0); acc3 = __builtin_amdgcn_mfma_f32_32x32x16_bf16(pfr[3][kb], bb, acc3, 0, 0, 0); }
    __syncthreads();
    const LAS unsigned char* FRb = L + SSM_R2 + r32 * 32 + hi * 16;
#pragma unroll 2
    for (int s = 0; s < 64; ++s) { const bf16x8s bb = *(const LAS bf16x8s*)(L + s * YS_PITCH + r32 * 32 + hi * 16);
        if (s <= 2 * tp0 + 1) acc0 = __builtin_amdgcn_mfma_f32_32x32x16_bf16(*(const LAS bf16x8s*)(FRb + (2 * tp0 - s + 1) * 1024), bb, acc0, 0, 0, 0);
        if (s <= 2 * tp1 + 1) acc1 = __builtin_amdgcn_mfma_f32_32x32x16_bf16(*(const LAS bf16x8s*)(FRb + (2 * tp1 - s + 1) * 1024), bb, acc1, 0, 0, 0);
        if (s <= 2 * tp2 + 1) acc2 = __builtin_amdgcn_mfma_f32_32x32x16_bf16(*(const LAS bf16x8s*)(FRb + (2 * tp2 - s + 1) * 1024), bb, acc2, 0, 0, 0);
        if (s <= 2 * tp3 + 1) acc3 = __builtin_amdgcn_mfma_f32_32x32x16_bf16(*(const LAS bf16x8s*)(FRb + (2 * tp3 - s + 1) * 1024), bb, acc3, 0, 0, 0); }
    const f32x4 dk0 = *(const f32x4*)(F.d_skip + g * 16 + 4 * hi), dk1 = *(const f32x4*)(F.d_skip + g * 16 + 8 + 4 * hi);
#define SSM_EPI(ACC, TP) do { _Pragma("unroll") for (int q = 0; q < 4; ++q) { const int c0 = 8 * (q & 1) + 4 * hi, t = 2 * (TP) + (q >> 1); const f32x4 dd = (q & 1) ? dk1 : dk0; \
        const v2u uw_ = *(const LAS v2u*)(L + t * YS_PITCH + r32 * 32 + c0 * 2); \
        const float r0 = gelu_tanh_fast(ACC[4 * q] + dd.x * bflo(uw_.x)), r1 = gelu_tanh_fast(ACC[4 * q + 1] + dd.y * bfhi(uw_.x)), r2 = gelu_tanh_fast(ACC[4 * q + 2] + dd.z * bflo(uw_.y)), r3 = gelu_tanh_fast(ACC[4 * q + 3] + dd.w * bfhi(uw_.y)); \
        v2u o; o.x = pk2(r0, r1); o.y = pk2(r2, r3); *(LAS v2u*)(L + SSM_R2 + t * YS_PITCH + r32 * 32 + c0 * 2) = o; } } while (0)
    __syncthreads();
    SSM_EPI(acc0, tp0); SSM_EPI(acc1, tp1); SSM_EPI(acc2, tp2); SSM_EPI(acc3, tp3);
#undef SSM_EPI
    __syncthreads();
#pragma unroll
    for (int i = 0; i < 8; ++i) { const int gi = tid + 512 * i, tok = gi >> 1, hf = gi & 1;
        store16_wt(wt_rsrc((void*)Yout, (unsigned)((size_t)M * 512 * 2)), ((size_t)g * M + (size_t)b * SEQ) * 32 + (size_t)gi * 16, *(const LAS v4u*)(L + SSM_R2 + (tok & 63) * YS_PITCH + (tok >> 6) * 32 + hf * 16)); }
    __syncthreads();
}

constexpr int WRX_LD = 1028;
__device__ __forceinline__ void p7_stage_weights(Frame& F) {
    LAS float* wx = (LAS float*)(F.lds);
    for (int i = 0; i < 16; ++i) { const int idx = F.tid + 512 * i, kk = idx >> 3, j4 = idx & 7; const f32x4 w = *(const f32x4*)(F.w_rexp + (size_t)kk * 32 + 4 * j4);
        wx[(4 * j4) * WRX_LD + kk] = w.x; wx[(4 * j4 + 1) * WRX_LD + kk] = w.y; wx[(4 * j4 + 2) * WRX_LD + kk] = w.z; wx[(4 * j4 + 3) * WRX_LD + kk] = w.w; }
    __syncthreads();
}
__device__ __forceinline__ void p7_block(Frame& F, int blk) {
    const LAS float* wx = (const LAS float*)(F.lds);
    LAS int* eL = (LAS int*)(F.lds + XS_OFF);
    LAS unsigned* baseL = (LAS unsigned*)(F.lds + XS_OFF + 1024);
    LAS float* wL = (LAS float*)(F.lds + XS_OFF + 2048);
    const int b = (blk * 64) / SEQ;
    const float* mod = F.MOD + b * 6144;
    f32x4 es[4], sh[4], wrg[4][4];
#pragma unroll
    for (int j = 0; j < 4; ++j) { const int c = 4 * F.lane + 256 * j; const f32x4 g4 = *(const f32x4*)(F.norm_ffn_g + c), sc = *(const f32x4*)(mod + 4096 + c); es[j] = g4 * (sc + 1.f); sh[j] = *(const f32x4*)(mod + 3072 + c);
#pragma unroll
        for (int e = 0; e < 4; ++e) wrg[j][e] = *(const f32x4*)(F.w_rg + (size_t)(c + e) * 4); }
    const float brg0 = F.b_rg[0], brg1 = F.b_rg[1], brg2 = F.b_rg[2], brg3 = F.b_rg[3];
#pragma unroll 1
    for (int rb = 0; rb < 8; rb += 4) {
        f32x4 v[4][4];
#pragma unroll
        for (int r = 0; r < 4; ++r) { const GAS v2u* xr = (const GAS v2u*)(F.X1B + (size_t)(blk * 64 + F.wave * 8 + rb + r) * D) + F.lane;
#pragma unroll
            for (int j = 0; j < 4; ++j) { const v2u t = xr[64 * j]; v[r][j] = (f32x4){bflo(t.x), bfhi(t.x), bflo(t.y), bfhi(t.y)}; } }
        float ss[4];
#pragma unroll
        for (int r = 0; r < 4; ++r) { float s = 0.f;
#pragma unroll
            for (int j = 0; j < 4; ++j) s += (v[r][j].x * v[r][j].x + v[r][j].y * v[r][j].y) + (v[r][j].z * v[r][j].z + v[r][j].w * v[r][j].w);
            ss[r] = s; }
#pragma unroll
        for (int r = 0; r < 4; ++r) ss[r] = wave_sum(ss[r]);
#pragma unroll
        for (int r = 0; r < 4; ++r) {
            const int rl = F.wave * 8 + rb + r, m = blk * 64 + rl;
            const float rstd = __builtin_amdgcn_rsqf(ss[r] * (1.f / D) + RMS_EPS);
            GAS unsigned* o4 = (GAS unsigned*)((unsigned char*)F.H + (size_t)m * D) + F.lane;
#pragma unroll
            for (int j = 0; j < 4; ++j) { v[r][j] = v[r][j] * rstd * es[j] + sh[j]; o4[64 * j] = pk4_fp8(v[r][j].x, v[r][j].y, v[r][j].z, v[r][j].w); }
            f32x4 lgv = (f32x4){0.f, 0.f, 0.f, 0.f};
#pragma unroll
            for (int j = 0; j < 4; ++j)
#pragma unroll
                for (int e = 0; e < 4; ++e) lgv += wrg[j][e] * v[r][j][e];
            const bool h5 = (F.lane & 32) != 0, h4 = (F.lane & 16) != 0, h3 = (F.lane & 8) != 0;
            float lg[4];
            { const float k0 = (h5 ? lgv.z : lgv.x) + __shfl_xor(h5 ? lgv.x : lgv.z, 32), k1 = (h5 ? lgv.w : lgv.y) + __shfl_xor(h5 ? lgv.y : lgv.w, 32);
              float z = (h4 ? k1 : k0) + __shfl_xor(h4 ? k0 : k1, 16);
              z += __shfl_xor(z, 8); z += __shfl_xor(z, 4); z += __shfl_xor(z, 2); z += __shfl_xor(z, 1);
              const int zi = __builtin_bit_cast(int, z);
              lg[0] = __builtin_bit_cast(float, __builtin_amdgcn_readlane(zi, 0)) + brg0; lg[1] = __builtin_bit_cast(float, __builtin_amdgcn_readlane(zi, 16)) + brg1;
              lg[2] = __builtin_bit_cast(float, __builtin_amdgcn_readlane(zi, 32)) + brg2; lg[3] = __builtin_bit_cast(float, __builtin_amdgcn_readlane(zi, 48)) + brg3; }
            int gi = 0; float lmax = lg[0];
#pragma unroll
            for (int i = 1; i < 4; ++i) if (lg[i] > lmax) { lmax = lg[i]; gi = i; }
            float se = 0.f;
#pragma unroll
            for (int i = 0; i < 4; ++i) se += __expf(lg[i] - lmax);
            const float pg = __builtin_amdgcn_rcpf(se);
            gi = __builtin_amdgcn_readfirstlane(gi);
            float le[8];
#pragma unroll
            for (int i = 0; i < 8; ++i) { const LAS float* wr = wx + (gi * 8 + i) * WRX_LD + 4 * F.lane; f32x4 a4 = (f32x4){0.f, 0.f, 0.f, 0.f};
#pragma unroll
                for (int j = 0; j < 4; ++j) a4 += v[r][j] * *(const LAS f32x4*)(wr + 256 * j);
                le[i] = (a4.x + a4.y) + (a4.z + a4.w); }
            { float k4[4], k2[2];
#pragma unroll
              for (int i = 0; i < 4; ++i) { const float keep = h5 ? le[i + 4] : le[i], send = h5 ? le[i] : le[i + 4]; k4[i] = keep + __shfl_xor(send, 32); }
#pragma unroll
              for (int i = 0; i < 2; ++i) { const float keep = h4 ? k4[i + 2] : k4[i], send = h4 ? k4[i] : k4[i + 2]; k2[i] = keep + __shfl_xor(send, 16); }
              float z = (h3 ? k2[1] : k2[0]) + __shfl_xor(h3 ? k2[0] : k2[1], 8);
              z += __shfl_xor(z, 4); z += __shfl_xor(z, 2); z += __shfl_xor(z, 1);
              const int zi = __builtin_bit_cast(int, z);
#pragma unroll
              for (int i = 0; i < 8; ++i) le[i] = __builtin_bit_cast(float, __builtin_amdgcn_readlane(zi, 8 * i)) + F.b_rexp[gi * 8 + i]; }
            int i0 = 0; float v0 = le[0];
#pragma unroll
            for (int i = 1; i < 8; ++i) if (le[i] > v0) { v0 = le[i]; i0 = i; }
            int i1 = -1; float v1 = -INFINITY;
#pragma unroll
            for (int i = 0; i < 8; ++i) if (i != i0 && (i1 < 0 || le[i] > v1)) { v1 = le[i]; i1 = i; }
            const float ex = __expf(v1 - v0), p0 = __builtin_amdgcn_rcpf(1.f + ex), p1 = ex * p0;
            if (F.lane == 0) { const int e0 = gi * 8 + i0, e1 = gi * 8 + i1; eL[2 * rl] = e0; eL[2 * rl + 1] = e1;
                wL[2 * rl] = pg * p0; wL[2 * rl + 1] = pg * p1; }
        }
    }
    __syncthreads();
    int e = 0, rank = 0, total = 0;
    if (F.tid < 128) { e = eL[F.tid];
        for (int a = 0; a < 128; ++a) { const int m_ = (eL[a] == e); total += m_; rank += (m_ && a < F.tid); }
        if (rank == 0) baseL[e] = __hip_atomic_fetch_add((unsigned*)(F.ctl + CW_CNT + 64 * e), (unsigned)total, RLX_AGENT); }
    __syncthreads();
    if (F.tid < 128) { const unsigned pos = baseL[e] + (unsigned)rank; F.LIST[(size_t)e * CAP + pos] = (unsigned)((blk * 64 + (F.tid >> 1)) * 2 + (F.tid & 1)); F.LISTW[(size_t)e * CAP + pos] = wL[F.tid];
        const unsigned aid_ = (unsigned)((blk * 64 + (F.tid >> 1)) * 2 + (F.tid & 1)); F.ROUTE[aid_] = (int)(e * CAP + (int)pos); F.RW[aid_] = wL[F.tid]; }
    __syncthreads();
}

__device__ __forceinline__ void p10_rows(Frame& F) {
    (void)moe_tables(F);
    const LAS int* tab = (const LAS int*)(F.lds + MOE_OFF);
    const int gw = F.vcu * NWAVES + F.wave, NGW = F.G * NWAVES;
    for (int ch = gw; ch < M / 8; ch += NGW) {
        int rowi = 0; float rwt = 0.f;
        if (F.lane < 16) { const int pos = F.ROUTE[ch * 16 + F.lane]; rowi = tab[pos >> 14] * 256 + (pos & (CAP - 1)); rwt = F.RW[ch * 16 + F.lane]; }
        const int b = (ch * 8) / SEQ;
        const float* mod = F.MOD + b * 6144 + 5120;
        f32x4 g2[4], fg[4];
#pragma unroll
        for (int j = 0; j < 4; ++j) { const int c = 4 * F.lane + 256 * j; g2[j] = *(const f32x4*)(mod + c); fg[j] = *(const f32x4*)(F.final_g + c); }
#pragma unroll 1
        for (int rb = 0; rb < 8; rb += 4) {
            f32x4 v[4][4]; unsigned ya[4][4], yb[4][4];
#pragma unroll
            for (int r = 0; r < 4; ++r) { const int m = ch * 8 + rb + r;
                const GAS v2u* xr = (const GAS v2u*)(F.X1B + (size_t)m * D) + F.lane;
                const int ri0 = __builtin_amdgcn_readlane(rowi, 2 * (rb + r)), ri1 = __builtin_amdgcn_readlane(rowi, 2 * (rb + r) + 1);
                const GAS unsigned* y0 = (const GAS unsigned*)((const unsigned char*)F.YROWS + (size_t)ri0 * D) + F.lane; const GAS unsigned* y1 = (const GAS unsigned*)((const unsigned char*)F.YROWS + (size_t)ri1 * D) + F.lane;
#pragma unroll
                for (int j = 0; j < 4; ++j) { const v2u t = __builtin_nontemporal_load(xr + 64 * j); v[r][j] = (f32x4){bflo(t.x), bfhi(t.x), bflo(t.y), bfhi(t.y)}; ya[r][j] = __builtin_nontemporal_load(y0 + 64 * j); yb[r][j] = __builtin_nontemporal_load(y1 + 64 * j); } }
            float ss[4];
#pragma unroll
            for (int r = 0; r < 4; ++r) { float s = 0.f;
                const float w0 = __builtin_bit_cast(float, __builtin_amdgcn_readlane(__builtin_bit_cast(int, rwt), 2 * (rb + r))) * (1.f / FP8_YSCALE), w1 = __builtin_bit_cast(float, __builtin_amdgcn_readlane(__builtin_bit_cast(int, rwt), 2 * (rb + r) + 1)) * (1.f / FP8_YSCALE);
#pragma unroll
                for (int j = 0; j < 4; ++j) { const int a = (int)ya[r][j], bb = (int)yb[r][j];
                    const f32x2 a0 = __builtin_amdgcn_cvt_pk_f32_fp8(a, false), a1 = __builtin_amdgcn_cvt_pk_f32_fp8(a, true), b0 = __builtin_amdgcn_cvt_pk_f32_fp8(bb, false), b1 = __builtin_amdgcn_cvt_pk_f32_fp8(bb, true);
                    f32x4 yv; yv.x = w0 * a0.x + w1 * b0.x; yv.y = w0 * a0.y + w1 * b0.y; yv.z = w0 * a1.x + w1 * b1.x; yv.w = w0 * a1.y + w1 * b1.y;
                    v[r][j] = v[r][j] + g2[j] * yv; s += (v[r][j].x * v[r][j].x + v[r][j].y * v[r][j].y) + (v[r][j].z * v[r][j].z + v[r][j].w * v[r][j].w); }
                ss[r] = s; }
#pragma unroll
            for (int r = 0; r < 4; ++r) ss[r] = wave_sum(ss[r]);
#pragma unroll
            for (int r = 0; r < 4; ++r) { const int m = ch * 8 + rb + r; GAS f32x4* xr = (GAS f32x4*)(F.out + (size_t)m * D) + F.lane;
                float rstd = 1.f / sqrtf(ss[r] * (1.f / D) + RMS_EPS);
#if defined(SSM_CHECK)
                { const float d_ = ((const float*)(F.ctl + CW_CHK))[0] / ((const float*)(F.ctl + CW_CHK))[1]; rstd *= 1.f + 0.5f * fminf(1.f, sqrtf(d_)); }
#endif
#pragma unroll
                for (int j = 0; j < 4; ++j) xr[64 * j] = v[r][j] * rstd * fg[j]; }
        }
    }
}

struct Args { const float* in[28]; float* out; unsigned char* ws; int ph_lo, ph_hi, grid, pad; };
typedef const __attribute__((address_space(4))) Args* KArgs;
__device__ __forceinline__ void load_ptrs(Frame& F) {
    KArgs ka = (KArgs)__builtin_amdgcn_kernarg_segment_ptr();
    asm volatile("" : "+s"(ka));
    F.tid = tid_opaque(); F.lane = F.tid & 63; F.wave = __builtin_amdgcn_readfirstlane(F.tid >> 6);
    F.G = ka->grid; { int bx = (int)blockIdx.x; asm volatile("" : "+s"(bx)); F.vcu = (F.G % 8 == 0) ? (bx % 8) * (F.G / 8) + bx / 8 : bx; }
    unsigned char* ws = ka->ws;
    F.ctl = (gu32*)(ws + WS_CTL);
    F.x = ka->in[0]; F.c = ka->in[1]; F.w_ada = ka->in[2]; F.b_ada = ka->in[3]; F.norm_mix_g = ka->in[4]; F.w_in = ka->in[5]; F.b_forget = ka->in[6]; F.w_out_fox = ka->in[7];
    F.lambda_re = ka->in[8]; F.lambda_im = ka->in[9]; F.log_dt = ka->in[10]; F.b_re = ka->in[11]; F.b_im = ka->in[12]; F.c_re = ka->in[13]; F.c_im = ka->in[14]; F.d_skip = ka->in[15];
    F.w_glu = ka->in[16]; F.w_out_ssm = ka->in[17]; F.w_o = ka->in[18]; F.norm_ffn_g = ka->in[19]; F.w_rg = ka->in[20]; F.b_rg = ka->in[21]; F.w_rexp = ka->in[22]; F.b_rexp = ka->in[23];
    F.w_gate = ka->in[24]; F.w_up = ka->in[25]; F.w_down = ka->in[26]; F.final_g = ka->in[27]; F.out = ka->out;
    F.MOD = (float*)(ws + WS_MOD); F.LOGF = (float*)(ws + WS_LOGF); F.CUM = (float*)(ws + WS_CUM); F.RW = (float*)(ws + WS_RW); F.ROUTE = (int*)(ws + WS_ROUTE); F.LIST = (unsigned*)(ws + WS_LIST); F.CUMP = (unsigned*)(ws + WS_CUMP); F.LISTW = (float*)(ws + WS_LISTW);
    F.WIN = (bf16*)(ws + WS_WIN); F.WGLU = (bf16*)(ws + WS_WGLU); F.WOF = (bf16*)(ws + WS_WOF); F.WOS = (bf16*)(ws + WS_WOS); F.WO = (bf16*)(ws + WS_WO); F.WGU = (bf16*)(ws + WS_WGU); F.WD = (bf16*)(ws + WS_WD);
    F.H = (bf16*)(ws + WS_H); F.Y = (bf16*)(ws + WS_Y); F.Q = (bf16*)(ws + WS_Q); F.K = (bf16*)(ws + WS_K); F.V = (bf16*)(ws + WS_V); F.U = (bf16*)(ws + WS_U); F.SGA = (bf16*)(ws + WS_SGA); F.SGB = (bf16*)(ws + WS_SGB);
    F.HID = (bf16*)(ws + WS_HID); F.YROWS = (bf16*)(ws + WS_YROWS); F.X1B = (bf16*)(ws + WS_X1B);
}
__global__ void __launch_bounds__(NWAVES * 64, 2) fwd(Args args) {
    extern __shared__ __attribute__((aligned(16))) unsigned char lds[];
    Frame F;
    F.lds = (LAS unsigned char*)lds;
    F.MISC = (volatile LAS unsigned*)(F.lds + MISC_OFF);
    { const int t0 = (int)threadIdx.x;
      for (int u = t0; u < (LDS_BYTES - LDSCTL_OFF) / 4; u += NWAVES * 64) ((LAS unsigned*)(F.lds + LDSCTL_OFF))[u] = 0u;
      __syncthreads();
      if ((t0 & 63) == 0) *(volatile LAS int*)(F.lds + TIDTAB_OFF + 4 * hw_wave_key()) = t0 >> 6;
      __syncthreads(); }
    load_ptrs(F);
    if (N_LAUNCHES == 1) (void)xcd_barrier_post((unsigned*)(F.ctl + CW_BAR), F.MISC + 8);
#if defined(TPROBE)
#define STAMP(kk) do { if (blockIdx.x == 0 && tid_opaque() == 0) F.ctl[CW_TS + (kk)] = (unsigned)__builtin_amdgcn_s_memrealtime(); } while (0)
#else
#define STAMP(kk) do { } while (0)
#endif
    STAMP(15);
#define GRID_BAR() do { if (N_LAUNCHES == 1) { load_ptrs(F); XcdBarrier b_; b_.bar = (unsigned*)(F.ctl + CW_BAR); b_.x = xb_xcc_id(); b_.st = (volatile LAS unsigned*)(F.lds + MISC_OFF) + 8; xcd_barrier(b_); } } while (0)
#define GRID_BAR_SH(seam_) do { if (N_LAUNCHES == 1) { load_ptrs(F); XcdBarrier b_; b_.bar = (unsigned*)(F.ctl + CW_BAR); b_.x = xb_xcc_id(); b_.st = (volatile LAS unsigned*)(F.lds + MISC_OFF) + 8; \
        const ShadowGateUp sh_{F.w_gate, F.w_up, F.WGU, F.lds, (seam_), (int)blockIdx.x}; xcd_barrier(b_, sh_); } } while (0)
#define SEAM_SH(k_) do { if (BOTH(k_)) GRID_BAR_SH(k_); else if (N_LAUNCHES != 1) { load_ptrs(F); __syncthreads(); const ShadowGateUp sh_{F.w_gate, F.w_up, F.WGU, F.lds, (k_), (int)blockIdx.x}; if (F.tid >= 64) sh_(); __syncthreads(); } } while (0)
#define PANEL_SEAM(k_) do { bool done_ = false; if (N_LAUNCHES == 1 && BOTH(k_)) { load_ptrs(F); if (F.G == 256) { int pm_, pn_; tile_of_wg256((int)blockIdx.x, pm_, pn_); \
        const ShadowGateUp sh_{F.w_gate, F.w_up, F.WGU, F.lds, (k_), (int)blockIdx.x}; panel_sync(F.ctl + CW_PANEL + 64 * (((k_) - 4) * 64 + pm_), F.ctl + CW_TMO, sh_); done_ = true; } } \
        if (!done_) SEAM_SH(k_); } while (0)
    const int lo = (N_LAUNCHES == 1) ? 0 : args.ph_lo, hi = (N_LAUNCHES == 1) ? NPH : args.ph_hi;
#ifndef PH_MASK
#define PH_MASK 0x7ff
#endif
#define IN(k) ((((PH_MASK) >> (k)) & 1) && lo <= (k) && (k) < hi)
#define BOTH(k) (IN(k) && IN((k) + 1))

    if (IN(0)) { load_ptrs(F); p0_mod(F); load_ptrs(F);
        for (int it = F.vcu; it < 256; it += F.G) p0_ssm_item(F, it); __syncthreads(); load_ptrs(F); p0_copies(F, F.vcu, F.G);
        __syncthreads(); STAMP(0); }
    if (IN(1)) { load_ptrs(F);
        if (F.tid < 64) { unsigned sp = 0;
            while ((unsigned)__builtin_amdgcn_readfirstlane(__hip_atomic_load((unsigned*)(F.ctl + CW_MOD), RLX_AGENT)) < 192u) { __builtin_amdgcn_s_sleep(2); if (++sp > (1u << 22)) { if (F.tid == 0) __hip_atomic_store((unsigned*)(F.ctl + CW_TMO), 1u, RLX_AGENT); break; } }
            __builtin_amdgcn_fence(__ATOMIC_ACQUIRE, "agent"); asm volatile("s_waitcnt vmcnt(0)" ::: "memory"); }
        __syncthreads();
        p1_rows(F); SEAM_SH(1); STAMP(1); }
    if (IN(2)) { load_ptrs(F);
        p2_cumscan(F); VM_WAIT(); __syncthreads();
        { pg8::Gemm g{F.H, F.WIN, 1024, 128}; pg8::StaticOrder S; S.init(M, 2048, F.G, (int)blockIdx.x);
          EpiInProj E{F.Q};
          pg8::gemm_phase<EpiInProj, pg8::StaticOrder, true>(F.lds + RING_OFF, g, S, E); }
        __syncthreads();
        load_ptrs(F);
        { pg8::Gemm g{F.WD, F.WIN + (size_t)1024 * 1024, 512, 128}; pg8::StaticOrder8 S; S.init(M, 2048, F.G, (int)blockIdx.x); S.pn0 = 8;
          EpiInProj E{F.Q, 1.f / (FP8_GW * FP8_GH)};
          pg8::gemm_phase<EpiInProj, pg8::StaticOrder8, true>(F.lds + RING_OFF, g, S, E); }
        SEAM_SH(2); STAMP(2);
    }
    if (IN(3)) { load_ptrs(F);
#if defined(ATTN_SIMPLE)
        for (int u = F.vcu; u < NB * NH * 4; u += F.G) { const int bh = u >> 2, qblk = 3 - (u & 3); attn_simple_unit(F, bh >> 3, bh & 7, qblk); }
#else
        { static_assert(attn_body::ATTN_LDS_BYTES <= RING_BYTES, "attention LDS");
          const attn_body::AttnTensors AT{(const attn_body::bf16*)F.Q, (const attn_body::bf16*)F.K, (const attn_body::bf16*)F.V, (attn_body::bf16*)F.Q, F.CUMP};
          const attn_body::StaticOrder S((int)F.G, F.vcu);
          attn_body::attn_phase<attn_body::StaticOrder>((char*)lds + RING_OFF, AT, S); }
#endif
        __syncthreads();
#if defined(SSM_SIMPLE) || defined(SSM_CHECK)
        if (F.wave < 3) for (int u = F.wave * F.G + F.vcu; u < NB * NG; u += 3 * F.G) ssm_simple_unit(F, u & 7, u >> 3, F.lds + F.wave * 41472);
        __syncthreads();
#endif
#if !defined(SSM_SIMPLE)
        load_ptrs(F);
        for (int u = F.vcu; u < NB * NG; u += F.G) ssm_mfma_unit(F, u & 7, u >> 3,
#if defined(SSM_CHECK)
            (bf16*)((char*)F.out + 32 * MiB)
#else
            F.Y
#endif
            );
#endif
#if defined(SSM_CHECK)
        { VM_WAIT(); __syncthreads();
          const int u = F.vcu, b = u & 7, g = u >> 3; const bf16* y2 = (const bf16*)((const char*)F.out + 32 * MiB); float df = 0.f;
          for (int i = 0; i < 4; ++i) { const size_t off = ((size_t)g * M + (size_t)b * SEQ + F.tid + 512 * i) * 16;
              for (int hh = 0; hh < 2; ++hh) { const v4u a = __builtin_nontemporal_load((const v4u*)(F.Y + off + 8 * hh)), c = __builtin_nontemporal_load((const v4u*)(y2 + off + 8 * hh));
                  const float d0 = bflo(a.x) - bflo(c.x), d1 = bfhi(a.x) - bfhi(c.x), d2 = bflo(a.y) - bflo(c.y), d3 = bfhi(a.y) - bfhi(c.y), d4 = bflo(a.z) - bflo(c.z), d5 = bfhi(a.z) - bfhi(c.z), d6 = bflo(a.w) - bflo(c.w), d7 = bfhi(a.w) - bfhi(c.w);
                  df += d0 * d0 + d1 * d1 + d2 * d2 + d3 * d3 + d4 * d4 + d5 * d5 + d6 * d6 + d7 * d7; } }
          df = wave_sum(df); if (F.lane == 0) atomicAdd((float*)(F.ctl + CW_CHK), df); }
#endif
        __syncthreads();
        { bool done_ = false;
          if (N_LAUNCHES == 1 && BOTH(3)) { load_ptrs(F); if (F.G == 256) { int pm_, pn_; tile_of_wg256((int)blockIdx.x, pm_, pn_);
              const ShadowGateUp sh_{F.w_gate, F.w_up, F.WGU, F.lds, 3, (int)blockIdx.x}; batch_sync(F.ctl + CW_PANEL + 64 * (3 * 64), F.vcu >> 5, F.vcu & 7, pm_ >> 3, F.ctl + CW_TMO, sh_); done_ = true; } }
          if (!done_) SEAM_SH(3); }
        STAMP(3);
    }
    if (IN(4)) { load_ptrs(F);
        { pg8::Gemm g{F.Y, F.WGLU, 512, (size_t)4 * M * 32}; pg8::GroupMajorOrder S; S.init(M, 1024, F.G, (int)blockIdx.x); S.Mrows = M; EpiPair<0> E{F.V};
          pg8::gemm_phase<EpiPair<0>, pg8::GroupMajorOrder, true>(F.lds + RING_OFF, g, S, E); }
        PANEL_SEAM(4); STAMP(4);
    }
    if (IN(5)) { load_ptrs(F);
        pg8::Gemm g{F.Q, F.WOF, 512, 128}; pg8::DualOrder S; S.init(M, 1024, F.G, (int)blockIdx.x); S.a_delta = (size_t)(WS_V - WS_Q); S.b_delta = (size_t)(WS_WOS - WS_WOF);
        EpiGateChain E{F.SGA, F.SGB};
        pg8::gemm_phase<EpiGateChain, pg8::DualOrder, true>(F.lds + RING_OFF, g, S, E);
        PANEL_SEAM(5); STAMP(5);
    }
    if (IN(6)) { load_ptrs(F);
        pg8::Gemm g{F.SGA, F.WO, 1024, 128}; pg8::StaticOrder S; S.init(M, 1024, F.G, (int)blockIdx.x); EpiResid E{F.x, F.X1B, F.MOD};
        pg8::gemm_phase<EpiResid, pg8::StaticOrder, true>(F.lds + RING_OFF, g, S, E);
        PANEL_SEAM(6); STAMP(6);
    }
    if (IN(7)) { load_ptrs(F);
        p7_stage_weights(F);
        { int blk0 = F.vcu, bstep = F.G;
          if (N_LAUNCHES == 1 && F.G == 256) { int pm_, pn_; tile_of_wg256((int)blockIdx.x, pm_, pn_); blk0 = pm_ * 4 + pn_; bstep = M / 64; }
          for (int blk = blk0; blk < M / 64; blk += bstep) p7_block(F, blk); }
        if (BOTH(7)) GRID_BAR(); STAMP(7);
    }
    if (IN(8)) { load_ptrs(F);
        const int mt = moe_tables(F);
        MoeOrder<true> S{F.G, F.vcu, mt * 4, (const LAS int*)(F.lds + MOE_OFF), F.LIST, (size_t)1024 * 1024, 0};
        pg8::Gemm g{F.H, F.WGU, 512, 128}; EpiSwiGLU8 E{(unsigned char*)F.HID};
        pg8::gemm_phase<EpiSwiGLU8, MoeOrder<true>, true>(F.lds + RING_OFF, g, S, E);
        __syncthreads();
        { const int full = (mt * 4) / F.G, extra = (mt * 4) - full * F.G;
          load_ptrs(F); convert_wdown(F, extra); }
        if (BOTH(8)) GRID_BAR(); STAMP(8);
    }
    if (IN(9)) { load_ptrs(F);
        const int mt = moe_tables(F);
        MoeOrder<false> S{F.G, F.vcu, mt * 4, (const LAS int*)(F.lds + MOE_OFF), F.LIST, (size_t)1024 * 512, 0};
        pg8::Gemm g{F.HID, F.WD, 256, 128}; EpiDown E{F.YROWS};
        pg8::gemm_phase<EpiDown, MoeOrder<false>, true>(F.lds + RING_OFF, g, S, E);
        if (BOTH(9) && N_LAUNCHES == 1) { load_ptrs(F); XcdBarrier b_; b_.bar = (unsigned*)(F.ctl + CW_BAR); b_.x = xb_xcc_id(); b_.st = (volatile LAS unsigned*)(F.lds + MISC_OFF) + 8; xcd_barrier<NoShadow, false>(b_); }
        STAMP(9);
    }
    if (IN(10)) { load_ptrs(F); p10_rows(F); }
#undef IN
#undef BOTH
}

extern "C" void kernel_launch(void* const* d_in, const int* in_sizes, int n_in, void* d_out, int out_size, void* d_ws, size_t ws_size, hipStream_t stream) {
    static int grid = 0;
    if (grid == 0) {
        if (n_in != 28 || in_sizes[0] != M * D || out_size != M * D || ws_size < WS_END) { fprintf(stderr, "kernel_launch: unexpected shapes (n_in %d, in0 %d, out %d, ws %zu); nothing launched\n", n_in, n_in > 0 ? in_sizes[0] : -1, out_size, ws_size); grid = -1; return; }
        int dev = 0, cus = 0, per_cu = 0;
        if (hipGetDevice(&dev) != hipSuccess || hipDeviceGetAttribute(&cus, hipDeviceAttributeMultiprocessorCount, dev) != hipSuccess) { grid = -1; return; }
        if (hipFuncSetAttribute((const void*)fwd, hipFuncAttributeMaxDynamicSharedMemorySize, LDS_BYTES) != hipSuccess) { fprintf(stderr, "kernel_launch: hipFuncSetAttribute failed\n"); grid = -1; return; }
        if (hipOccupancyMaxActiveBlocksPerMultiprocessor(&per_cu, (const void*)fwd, NWAVES * 64, LDS_BYTES) != hipSuccess || per_cu < 1) { fprintf(stderr, "kernel_launch: occupancy query reports %d\n", per_cu); }
        (void)hipGetLastError();
        grid = cus;
    }
    if (grid < 0) return;
    if (hipMemsetAsync((char*)d_ws + WS_CTL, 0, CTL_ZERO_BYTES, stream) != hipSuccess) return;
    Args a{};
    for (int i = 0; i < 28; ++i) a.in[i] = (const float*)d_in[i];
    a.out = (float*)d_out; a.ws = (unsigned char*)d_ws;
    for (int li = 0; li < N_LAUNCHES; ++li) {
        a.ph_lo = (N_LAUNCHES == NPH) ? li : 0; a.ph_hi = (N_LAUNCHES == NPH) ? li + 1 : NPH; a.grid = grid; a.pad = 0;
        hipLaunchKernelGGL(fwd, dim3(grid), dim3(NWAVES * 64), LDS_BYTES, stream, a);
        if (hipPeekAtLastError() != hipSuccess) { fprintf(stderr, "kernel_launch: launch %d failed\n", li); break; }
    }
}
```
